# Optimizing an MI355X kernel written in HIP

```python
import math
import jax, jax.numpy as jnp
from jax import lax
import numpy as np

D_MODEL = 2048
BATCH = 1
SEQ = 8192
DEPTH = 2
DEC_BATCH = 16
DEC_SEQ = 2048
PAST_LEN = 128

PLE_DIM = 256
GRID_W = 64
QBLK = 128
N_BRANCH = 4
H_A = 4
DK_A = 64
DV_A = 128
H_B = 4
Q_RANK_B = 512
KV_RANK_B = 512
DN_B = 128
DR_B = 64
DV_B = 128
H_C = 4
KV_C = 2
DH_C = 128
H_D = 4
DH_D = 128
DILATIONS = ((128, 1), (512, 4), (2048, 16))
N_DIL = 3
BRANCH_W = 512
D_FF = 4 * D_MODEL
N_BUCKETS = 32
REL_MAX_DIST = 1024
N_BIAS_HEADS = H_A + N_DIL * H_D
ROPE_THETA = 10000.0
NORM_EPS = 1e-6
NEG_INF = -1e30
IN_SIZES = (H_A * 2 * DK_A, H_A * 2 * DK_A, H_A * DV_A,
            Q_RANK_B, KV_RANK_B, DR_B,
            H_C * DH_C, KV_C * DH_C, KV_C * DH_C,
            N_DIL * H_D * DH_D, H_D * DH_D, H_D * DH_D)
IN_SPLITS = tuple(int(s) for s in np.cumsum(IN_SIZES)[:-1])
IN_WIDTH = int(sum(IN_SIZES))

kernel_name = 'gated_hybrid_bidir_encoder'


def rms_norm(x, g):
    xf = x.astype(jnp.float32)
    y = xf * lax.rsqrt(jnp.mean(xf * xf, axis=-1, keepdims=True) + NORM_EPS)
    return (y * g).astype(x.dtype)


def rel_bucket(rel):
    half = N_BUCKETS // 2
    exact = half // 2
    n = jnp.abs(rel)
    nf = jnp.maximum(n, 1).astype(jnp.float32)
    large = exact + (jnp.log(nf / exact) / math.log(REL_MAX_DIST / exact) * (half - exact)).astype(jnp.int32)
    large = jnp.minimum(large, half - 1)
    return jnp.where(rel > 0, half, 0) + jnp.where(n < exact, n, large)


def rope(x, pos):
    d = x.shape[-1]
    half = d // 2
    inv = jnp.power(ROPE_THETA, -2.0 * jnp.arange(half, dtype=jnp.float32) / d)
    ang = pos[:, None] * inv[None, :]
    cos = jnp.cos(ang)[:, None, :]
    sin = jnp.sin(ang)[:, None, :]
    x1 = x[..., :half].astype(jnp.float32)
    x2 = x[..., half:].astype(jnp.float32)
    return jnp.concatenate([x1 * cos - x2 * sin, x2 * cos + x1 * sin], axis=-1).astype(x.dtype)


def axial_rope(x, row, col):
    half = x.shape[-1] // 2
    return jnp.concatenate([rope(x[..., :half], row), rope(x[..., half:], col)], axis=-1)


def dense_attention(q, k, v, bias_tbl, scale):
    B, S, Hk, G, dk = q.shape
    T = k.shape[1]
    nb = S // QBLK
    qb = q.reshape(B, nb, QBLK, Hk, G, dk).transpose(1, 0, 2, 3, 4, 5)
    kpos = jnp.arange(T, dtype=jnp.int32)

    def one(args):
        qblk, idx = args
        s = jnp.einsum('bqhgd,bkhd->bhgqk', qblk, k, preferred_element_type=jnp.float32) * scale
        if bias_tbl is not None:
            qpos = idx * QBLK + jnp.arange(QBLK, dtype=jnp.int32)
            bucket = rel_bucket(kpos[None, :] - qpos[:, None])
            s = s + bias_tbl[bucket].transpose(2, 3, 0, 1)
        p = jax.nn.softmax(s, axis=-1)
        return jnp.einsum('bhgqk,bkhd->bqhgd', p.astype(v.dtype), v)

    o = lax.map(one, (qb, jnp.arange(nb, dtype=jnp.int32)))
    return o.transpose(1, 0, 2, 3, 4, 5).reshape(B, S, Hk, G, v.shape[-1])


def dilated_band_attention(q, k, v, window, dil, bias_tbl, scale):
    B, S, H, d = q.shape
    half = window // (2 * dil)
    L = S // dil
    nb = -(-L // half)
    Lp = nb * half

    def to_sub(x):
        return x.reshape(B, L, dil, H, x.shape[-1]).transpose(0, 2, 1, 3, 4)

    qs = jnp.pad(to_sub(q), ((0, 0), (0, 0), (0, Lp - L), (0, 0), (0, 0))).reshape(B, dil, nb, half, H, d)

    def key_blocks(x):
        xp = jnp.pad(to_sub(x), ((0, 0), (0, 0), (half, Lp - L + half), (0, 0), (0, 0)))
        xb = xp.reshape(B, dil, nb + 2, half, H, x.shape[-1])
        return jnp.concatenate([xb[:, :, :-2], xb[:, :, 1:-1], xb[:, :, 2:]], axis=3)

    kb = key_blocks(k)
    vb = key_blocks(v)
    s = jnp.einsum('brnqhd,brnkhd->brnhqk', qs, kb, preferred_element_type=jnp.float32) * scale
    qi = jnp.arange(half, dtype=jnp.int32)[:, None]
    kj = jnp.arange(3 * half, dtype=jnp.int32)[None, :]
    rel = kj - half - qi
    bias = bias_tbl[rel_bucket(rel * dil)].transpose(2, 0, 1)
    kpos = (jnp.arange(nb, dtype=jnp.int32)[:, None] - 1) * half + kj
    valid = (kpos >= 0) & (kpos < L)
    mask = (jnp.abs(rel) <= half)[None] & valid[:, None, :]
    s = jnp.where(mask[:, None], s + bias, NEG_INF)
    lse = jax.nn.logsumexp(s, axis=-1)
    p = jnp.exp(s - lse[..., None])
    o = jnp.einsum('brnhqk,brnkhd->brnqhd', p.astype(v.dtype), vb)
    o = o.reshape(B, dil, Lp, H, d)[:, :, :L].transpose(0, 2, 1, 3, 4).reshape(B, S, H, d)
    lse = lse.transpose(0, 1, 2, 4, 3).reshape(B, dil, Lp, H)[:, :, :L].transpose(0, 2, 1, 3).reshape(B, S, H)
    return o, lse


def diff_attention(aq, ak, av, q_g, k_g, lq1, lk1, lq2, lk2, out_g, bias_tbl, lam_init):
    B, S, _ = aq.shape
    q = rms_norm(aq.reshape(B, S, H_A, 2, DK_A), q_g)
    k = rms_norm(ak.reshape(B, S, H_A, 2, DK_A), k_g)
    v = av.reshape(B, S, H_A, DV_A)
    tbl = bias_tbl[:, :, None]
    o1 = dense_attention(q[:, :, :, 0, None], k[:, :, :, 0], v, tbl, DK_A ** -0.5)
    o2 = dense_attention(q[:, :, :, 1, None], k[:, :, :, 1], v, tbl, DK_A ** -0.5)
    lam = (jnp.exp(jnp.sum(lq1.astype(jnp.float32) * lk1.astype(jnp.float32)))
           - jnp.exp(jnp.sum(lq2.astype(jnp.float32) * lk2.astype(jnp.float32))) + lam_init)
    o = (o1 - lam.astype(o1.dtype) * o2)[:, :, :, 0]
    o = rms_norm(o, out_g) * (1.0 - lam_init)
    return o.reshape(B, S, H_A * DV_A)


def latent_attention(cq, ckv, kr, cq_g, ckv_g, w_uq, w_ukv, q_g, k_g, pos):
    B, S, _ = cq.shape
    q = (rms_norm(cq, cq_g) @ w_uq).reshape(B, S, H_B, DN_B + DR_B)
    kv = (rms_norm(ckv, ckv_g) @ w_ukv).reshape(B, S, H_B, DN_B + DV_B)
    k_nope = kv[..., :DN_B]
    v = kv[..., DN_B:]
    k = jnp.concatenate([k_nope, jnp.broadcast_to(kr[:, :, None, :], (B, S, H_B, DR_B))], axis=-1)
    q = rms_norm(q, q_g)
    k = rms_norm(k, k_g)
    q = jnp.concatenate([q[..., :DN_B], rope(q[..., DN_B:], pos)], axis=-1)
    k = jnp.concatenate([k[..., :DN_B], rope(k[..., DN_B:], pos)], axis=-1)
    o = dense_attention(q[:, :, :, None], k, v, None, (DN_B + DR_B) ** -0.5)
    return o.reshape(B, S, H_B * DV_B)


def axial_gqa(cq, ck, cv, q_g, k_g, row, col):
    B, S, _ = cq.shape
    q = axial_rope(rms_norm(cq.reshape(B, S, H_C, DH_C), q_g), row, col)
    k = axial_rope(rms_norm(ck.reshape(B, S, KV_C, DH_C), k_g), row, col)
    v = cv.reshape(B, S, KV_C, DH_C)
    o = dense_attention(q.reshape(B, S, KV_C, H_C // KV_C, DH_C), k, v, None, DH_C ** -0.5)
    return o.reshape(B, S, H_C * DH_C)


def dilated_mixture(dq, dk, dv, q_g, k_g, bias_tbl):
    B, S, _ = dq.shape
    q = rms_norm(dq.reshape(B, S, N_DIL, H_D, DH_D), q_g)
    k = rms_norm(dk.reshape(B, S, H_D, DH_D), k_g)
    v = dv.reshape(B, S, H_D, DH_D)
    outs = []
    lses = []
    for g, (window, dil) in enumerate(DILATIONS):
        o, l = dilated_band_attention(q[:, :, g], k, v, window, dil,
                                      bias_tbl[:, g * H_D:(g + 1) * H_D], DH_D ** -0.5)
        outs.append(o)
        lses.append(l)
    w = jax.nn.softmax(jnp.stack(lses), axis=0)
    o = jnp.einsum('gbsh,gbshd->bshd', w.astype(v.dtype), jnp.stack(outs))
    return o.reshape(B, S, H_D * DH_D)


def setup_inputs(seed: int = 0) -> dict:
    key = jax.random.key(seed)
    ks = iter(jax.random.split(key, 40))
    f32 = jnp.float32

    def nrm(shape, scale):
        return jax.random.normal(next(ks), shape, f32) * scale

    def gain(shape):
        return 1.0 + 0.1 * jax.random.normal(next(ks), shape, f32)

    return {
        'x_prompt': nrm((BATCH, SEQ, D_MODEL), 1.0),
        'x_sample': nrm((DEC_BATCH, DEC_SEQ, D_MODEL), 1.0),
        'p_prompt': nrm((DEPTH, BATCH, SEQ, PLE_DIM), 1.0),
        'p_sample': nrm((DEPTH, DEC_BATCH, DEC_SEQ, PLE_DIM), 1.0),
        'rel_bias': nrm((N_BUCKETS, N_BIAS_HEADS), 0.5),
        'norm_mix': gain((DEPTH, D_MODEL)),
        'w_in': nrm((DEPTH, D_MODEL, IN_WIDTH), D_MODEL ** -0.5),
        'a_q_norm': gain((DEPTH, DK_A)),
        'a_k_norm': gain((DEPTH, DK_A)),
        'a_lambda_q1': nrm((DEPTH, DK_A), 0.1),
        'a_lambda_k1': nrm((DEPTH, DK_A), 0.1),
        'a_lambda_q2': nrm((DEPTH, DK_A), 0.1),
        'a_lambda_k2': nrm((DEPTH, DK_A), 0.1),
        'a_out_norm': gain((DEPTH, DV_A)),
        'b_cq_norm': gain((DEPTH, Q_RANK_B)),
        'b_ckv_norm': gain((DEPTH, KV_RANK_B)),
        'b_w_uq': nrm((DEPTH, Q_RANK_B, H_B * (DN_B + DR_B)), Q_RANK_B ** -0.5),
        'b_w_ukv': nrm((DEPTH, KV_RANK_B, H_B * (DN_B + DV_B)), KV_RANK_B ** -0.5),
        'b_q_norm': gain((DEPTH, DN_B + DR_B)),
        'b_k_norm': gain((DEPTH, DN_B + DR_B)),
        'c_q_norm': gain((DEPTH, DH_C)),
        'c_k_norm': gain((DEPTH, DH_C)),
        'd_q_norm': gain((DEPTH, DH_D)),
        'd_k_norm': gain((DEPTH, DH_D)),
        'w_gate': nrm((DEPTH, N_BRANCH, D_MODEL, D_MODEL), D_MODEL ** -0.5),
        'w_branch': nrm((DEPTH, N_BRANCH, BRANCH_W, D_MODEL), BRANCH_W ** -0.5),
        'w_out': nrm((DEPTH, D_MODEL, D_MODEL), D_MODEL ** -0.5),
        'norm_ffn': gain((DEPTH, D_MODEL)),
        'w_ff1': nrm((DEPTH, D_MODEL, D_FF), D_MODEL ** -0.5),
        'w_ff2': nrm((DEPTH, D_FF, D_MODEL), D_FF ** -0.5),
        'norm_ple': gain((DEPTH, D_MODEL)),
        'w_ple_gate': nrm((DEPTH, D_MODEL, D_MODEL), D_MODEL ** -0.5),
        'w_ple_proj': nrm((DEPTH, PLE_DIM, D_MODEL), PLE_DIM ** -0.5),
    }


def reference(x_prompt, x_sample, p_prompt, p_sample, rel_bias, norm_mix, w_in,
              a_q_norm, a_k_norm, a_lambda_q1, a_lambda_k1, a_lambda_q2, a_lambda_k2, a_out_norm,
              b_cq_norm, b_ckv_norm, b_w_uq, b_w_ukv, b_q_norm, b_k_norm,
              c_q_norm, c_k_norm, d_q_norm, d_k_norm,
              w_gate, w_branch, w_out, norm_ffn, w_ff1, w_ff2,
              norm_ple, w_ple_gate, w_ple_proj):
    bias_a = rel_bias[:, :H_A]
    bias_d = rel_bias[:, H_A:]

    def trunk(x, p):
        B, S, _ = x.shape
        rows = S // GRID_W
        pos = jnp.arange(S, dtype=jnp.float32)
        row = jnp.repeat(jnp.arange(rows, dtype=jnp.float32), GRID_W)
        col = jnp.tile(jnp.arange(GRID_W, dtype=jnp.float32), rows)
        for i in range(DEPTH):
            lam_init = 0.8 - 0.6 * math.exp(-0.3 * i)
            h = rms_norm(x, norm_mix[i])
            (aq, ak, av, bcq, bckv, bkr, cq, ck, cv, dq, dk, dv) = jnp.split(h @ w_in[i], IN_SPLITS, axis=-1)
            branches = (
                diff_attention(aq, ak, av, a_q_norm[i], a_k_norm[i], a_lambda_q1[i], a_lambda_k1[i],
                               a_lambda_q2[i], a_lambda_k2[i], a_out_norm[i], bias_a, lam_init),
                latent_attention(bcq, bckv, bkr, b_cq_norm[i], b_ckv_norm[i], b_w_uq[i], b_w_ukv[i],
                                 b_q_norm[i], b_k_norm[i], pos),
                axial_gqa(cq, ck, cv, c_q_norm[i], c_k_norm[i], row, col),
                dilated_mixture(dq, dk, dv, d_q_norm[i], d_k_norm[i], bias_d),
            )
            merged = jax.nn.sigmoid(h @ w_gate[i, 0]) * (branches[0] @ w_branch[i, 0])
            for b in range(1, N_BRANCH):
                merged = merged + jax.nn.sigmoid(h @ w_gate[i, b]) * (branches[b] @ w_branch[i, b])
            x = x + merged @ w_out[i]
            h2 = rms_norm(x, norm_ffn[i])
            x = x + jnp.square(jax.nn.relu(h2 @ w_ff1[i])) @ w_ff2[i]
            h3 = rms_norm(x, norm_ple[i])
            x = x + jax.nn.sigmoid(h3 @ w_ple_gate[i]) * (p[i] @ w_ple_proj[i])
        return x

    y_prompt = trunk(x_prompt, p_prompt)
    y_sample = trunk(x_sample, p_sample)
    return (y_prompt, y_sample)
```

```cpp
#include <hip/hip_runtime.h>
#include <hip/hip_cooperative_groups.h>
#include <cstdio>
#include <cstdint>
namespace cg = cooperative_groups;

#ifndef COOP
#define COOP 1
#endif

#define LAS __attribute__((address_space(3)))
typedef unsigned short bf16_t;
typedef short bf16x8 __attribute__((ext_vector_type(8)));
typedef float f32x4 __attribute__((ext_vector_type(4)));
typedef float f32x16 __attribute__((ext_vector_type(16)));
typedef unsigned u32x4 __attribute__((ext_vector_type(4)));
typedef unsigned u32x2 __attribute__((ext_vector_type(2)));
typedef float f32x4u __attribute__((ext_vector_type(4), aligned(4)));

constexpr int DM = 2048, TALL = 40960, TP = 8192, SS = 2048;
constexpr int NP = 5120;
constexpr int TCM = 24576;
constexpr int NVT = 1280;
constexpr int DFF = 8192;
constexpr int PC_AQ = 0, PC_AK = 512, PC_BCQ = 1024, PC_BCKV = 1536, PC_CQ = 2048, PC_CK = 2560, PC_DQ = 2816, PC_DK = 4352, PC_BKR = 4864;
constexpr float LOG2E = 1.4426950408889634f;
constexpr float EPS = 1e-6f;
constexpr int TABA_N = 16384, TABA_OFF = 8192, TABD_N = 2304, TABD_OFF = 1152;

constexpr size_t MiB = 1u << 20;
constexpr size_t WS_CTL = 0;
constexpr size_t WS_TABA = 64 * 1024;
constexpr size_t WS_TABD = 384 * 1024;
constexpr size_t WS_W = 1 * MiB;
constexpr size_t WO_IN = 0;
constexpr size_t WO_INV = WO_IN + (size_t)NP * 2048 * 2;
constexpr size_t WO_G = WO_INV + (size_t)NVT * 2048 * 2;
constexpr size_t WO_B = WO_G + (size_t)8192 * 2048 * 2;
constexpr size_t WO_O = WO_B + (size_t)8192 * 512 * 2;
constexpr size_t WO_1 = WO_O + (size_t)2048 * 2048 * 2;
constexpr size_t WO_2 = WO_1 + (size_t)8192 * 2048 * 2;
constexpr size_t WO_PG = WO_2 + (size_t)2048 * 8192 * 2;
constexpr size_t WO_PP = WO_PG + (size_t)2048 * 2048 * 2;
constexpr size_t WO_UQ = WO_PP + (size_t)2048 * 256 * 2;
constexpr size_t WO_UKN = WO_UQ + (size_t)768 * 512 * 2;
constexpr size_t WO_UKV = WO_UKN + (size_t)512 * 512 * 2;
constexpr size_t WO_END = WO_UKV + (size_t)512 * 512 * 2;
static_assert(WO_END <= 148 * MiB, "weights");
constexpr size_t WS_H = WS_W + 148 * MiB;
constexpr size_t WS_R1 = WS_H + (size_t)TCM * 2048 * 2;
constexpr size_t R1_PROJ = 0;
constexpr size_t R1_VT = R1_PROJ + (size_t)TCM * NP * 2;
constexpr size_t R1_QB = R1_VT + (size_t)NVT * TCM * 2;
constexpr size_t R1_KB = R1_QB + (size_t)TCM * 768 * 2;
constexpr size_t R1_VTB = R1_KB + (size_t)TCM * 768 * 2;
constexpr size_t R1_END = R1_VTB + (size_t)512 * TCM * 2;
static_assert(R1_END >= (size_t)TCM * 8192 * 2, "Y / FFH overlay");
constexpr size_t WS_R2 = WS_R1 + R1_END;
constexpr size_t WS_R3 = WS_R2 + (size_t)TCM * 2048 * 4;
constexpr size_t WS_END = WS_R3 + (size_t)TCM * 2048 * 2;

constexpr int LDS_BYTES = 147456;

__device__ __forceinline__ unsigned cvt_pk_bf16(float lo, float hi) { unsigned r; asm volatile("v_cvt_pk_bf16_f32 %0, %1, %2" : "=v"(r) : "v"(lo), "v"(hi)); return r; }
__device__ __forceinline__ float bf_lo(unsigned u) { return __uint_as_float(u << 16); }
__device__ __forceinline__ float bf_hi(unsigned u) { return __uint_as_float(u & 0xffff0000u); }
__device__ __forceinline__ float wave_sum(float v) {
#pragma unroll
    for (int o = 1; o < 64; o <<= 1) v += __shfl_xor(v, o);
    return v;
}
__device__ __forceinline__ float sigmoidf_fast(float x) { return __builtin_amdgcn_rcpf(1.0f + __builtin_amdgcn_exp2f(-x * LOG2E)); }
__device__ __forceinline__ const float* xrow_ptr(const float* s0, const float* s1, int m) { return m < TP ? s0 + (size_t)m * DM : s1 + (size_t)(m - TP) * DM; }

namespace pg8 {
constexpr int BM = 256, BK = 64, HALF = 128, HTB = HALF * BK * 2, STAGE_BYTES = 8 * HTB, NXCD = 8, WGM = 8;
__host__ __device__ __forceinline__ int lds_byte(int r, int c) { const int st = (r >> 4) * 2 + (c >> 5), rr = r & 15, cc = c & 31, ob = rr * 64 + cc * 2; return st * 1024 + (ob ^ (((ob >> 9) & 1) << 5)); }
__host__ __device__ __forceinline__ void stage_rc(int b, int& R, int& C) { const int st = b / 1024, sb = b % 1024, swz = sb ^ (((sb >> 9) & 1) << 5); R = (st >> 1) * 16 + swz / 64; C = (st & 1) * 32 + (swz % 64) / 2; }
__host__ __device__ __forceinline__ int perm32(int rho) { const int n = rho >> 4, i = rho & 15; return 8 * (i >> 2) + 4 * n + (i & 3); }

struct Unit { int pm, pn; long aoff; };
struct Gemm { const bf16_t* A; const bf16_t* Bt; int lda, ldb, K; };

struct Order {
    int nM, nN, nwg, G, c, rep, adiv; long astep;
    __device__ void init(int nM_, int nN_, int G_, int c_, int rep_, int adiv_, long astep_) { nM = nM_; nN = nN_; nwg = nM * nN; G = G_; c = c_; rep = rep_; adiv = adiv_; astep = astep_; }
    __device__ bool next(int i, Unit& u) const {
        const int t = i / rep, sub = i - t * rep;
        const long L = (long)t * G + c; if (L >= nwg) return false;
        int wgid = (int)L; { const int q = nwg / NXCD, r = nwg % NXCD, xcd = wgid % NXCD, off = wgid / NXCD; wgid = (xcd < r ? xcd * (q + 1) : r * (q + 1) + (xcd - r) * q) + off; }
        const int nig = WGM * nN, gid = wgid / nig, fm = gid * WGM, gsz = (nM - fm) < WGM ? (nM - fm) : WGM;
        u.pm = fm + ((wgid % nig) % gsz); const int pn = (wgid % nig) / gsz; u.pn = pn + sub * nN; u.aoff = (long)(pn / adiv) * astep; return true;
    }
};

enum { EK_BF16 = 0, EK_SPLIT192 = 1, EK_RELU2 = 2, EK_GATE = 3, EK_RES = 4, EK_PLE = 5 };
struct Epi {
    static constexpr bool PERM = true;
    int kind; bf16_t* O; long ldc; const bf16_t* Y; float* part; const float* xs0; const float* xs1; float* xout; int m0;
    __device__ __forceinline__ void operator()(const f32x4 (&acc)[2][2][4][2], const Unit& u, int wr, int wc, int fr, int fq) const {
        const int row0 = u.pm * BM + wr * 64 + fr, col0 = u.pn * BM + wc * 32 + 8 * fq;
        if (kind <= EK_RELU2) {
#pragma unroll
            for (int ai = 0; ai < 2; ++ai)
#pragma unroll
                for (int m = 0; m < 4; ++m) { const int row = row0 + ai * HALF + m * 16;
#pragma unroll
                    for (int bj = 0; bj < 2; ++bj) { int col = col0 + bj * HALF; f32x4 v0 = acc[ai][bj][m][0], v1 = acc[ai][bj][m][1];
                        if (kind == EK_RELU2) {
#pragma unroll
                            for (int e = 0; e < 4; ++e) { float a = fmaxf(v0[e], 0.f), b = fmaxf(v1[e], 0.f); v0[e] = a * a; v1[e] = b * b; } }
                        if (kind == EK_SPLIT192) col = (col >> 7) * 192 + (col & 127);
                        u32x4 w; w.x = cvt_pk_bf16(v0[0], v0[1]); w.y = cvt_pk_bf16(v0[2], v0[3]); w.z = cvt_pk_bf16(v1[0], v1[1]); w.w = cvt_pk_bf16(v1[2], v1[3]);
                        *(u32x4*)(O + (size_t)row * ldc + col) = w; } }
        } else if (kind == EK_GATE) {
            const int b = col0 >> 11, cc = col0 & 2047;
#pragma unroll
            for (int ai = 0; ai < 2; ++ai)
#pragma unroll
                for (int m = 0; m < 4; ++m) { const int row = row0 + ai * HALF + m * 16;
#pragma unroll
                    for (int bj = 0; bj < 2; ++bj) { const int c = cc + bj * HALF; f32x4 v0 = acc[ai][bj][m][0], v1 = acc[ai][bj][m][1];
                        const u32x4 y = *(const u32x4*)(Y + (size_t)row * 8192 + (size_t)b * 2048 + c);
                        float* pp = part + (size_t)row * 2048 + c;
                        f32x4 p0 = (f32x4){0.f, 0.f, 0.f, 0.f}, p1 = p0;
                        if (b > 0) { p0 = *(const f32x4*)pp; p1 = *(const f32x4*)(pp + 4); }
                        p0[0] += sigmoidf_fast(v0[0]) * bf_lo(y.x); p0[1] += sigmoidf_fast(v0[1]) * bf_hi(y.x);
                        p0[2] += sigmoidf_fast(v0[2]) * bf_lo(y.y); p0[3] += sigmoidf_fast(v0[3]) * bf_hi(y.y);
                        p1[0] += sigmoidf_fast(v1[0]) * bf_lo(y.z); p1[1] += sigmoidf_fast(v1[1]) * bf_hi(y.z);
                        p1[2] += sigmoidf_fast(v1[2]) * bf_lo(y.w); p1[3] += sigmoidf_fast(v1[3]) * bf_hi(y.w);
                        if (b < 3) { *(f32x4*)pp = p0; *(f32x4*)(pp + 4) = p1; }
                        else { u32x4 w; w.x = cvt_pk_bf16(p0[0], p0[1]); w.y = cvt_pk_bf16(p0[2], p0[3]); w.z = cvt_pk_bf16(p1[0], p1[1]); w.w = cvt_pk_bf16(p1[2], p1[3]);
                            *(u32x4*)(O + (size_t)row * 2048 + c) = w; } } }
        } else {
#pragma unroll
            for (int ai = 0; ai < 2; ++ai)
#pragma unroll
                for (int m = 0; m < 4; ++m) { const int row = row0 + ai * HALF + m * 16; const int gm = m0 + row;
                    const float* xs = xrow_ptr(xs0, xs1, gm); float* xo = xout + (size_t)gm * DM;
#pragma unroll
                    for (int bj = 0; bj < 2; ++bj) { const int col = col0 + bj * HALF; f32x4 v0 = acc[ai][bj][m][0], v1 = acc[ai][bj][m][1];
                        const f32x4 x0 = *(const f32x4*)(xs + col), x1 = *(const f32x4*)(xs + col + 4);
                        if (kind == EK_PLE) { const u32x4 y = *(const u32x4*)(Y + (size_t)row * 2048 + col);
                            v0[0] = sigmoidf_fast(v0[0]) * bf_lo(y.x); v0[1] = sigmoidf_fast(v0[1]) * bf_hi(y.x); v0[2] = sigmoidf_fast(v0[2]) * bf_lo(y.y); v0[3] = sigmoidf_fast(v0[3]) * bf_hi(y.y);
                            v1[0] = sigmoidf_fast(v1[0]) * bf_lo(y.z); v1[1] = sigmoidf_fast(v1[1]) * bf_hi(y.z); v1[2] = sigmoidf_fast(v1[2]) * bf_lo(y.w); v1[3] = sigmoidf_fast(v1[3]) * bf_hi(y.w); }
                        *(f32x4*)(xo + col) = x0 + v0; *(f32x4*)(xo + col + 4) = x1 + v1; } }
        }
    }
};

template <bool ALIGN_EPI = true>
__device__ __forceinline__ void gemm_phase(LAS unsigned char* lds, const Gemm g, const Order& S, const Epi& E, const int tid) {
    const int wid = __builtin_amdgcn_readfirstlane(tid >> 6), lane = tid & 63, wr = wid >> 2, wc = wid & 3, fr = lane & 15, fq = lane >> 4;
    const int K = g.K, nt = K / BK;
    unsigned voffA[2], voffB[2];
#pragma unroll
    for (int i = 0; i < 2; ++i) { int R, C; stage_rc(tid * 16 + i * 8192, R, C); const int Rb = Epi::PERM ? ((R & ~31) + perm32(R & 31)) : R;
        voffA[i] = (unsigned)(R * g.lda + C) * 2u; voffB[i] = (unsigned)(Rb * g.ldb + C) * 2u; }
    const size_t kstep = (size_t)(BK * 2);
    const size_t hstA = (size_t)HALF * g.lda * 2, hstB = (size_t)HALF * g.ldb * 2;
    const size_t tstA = 2 * hstA, tstB = 2 * hstB;
    const unsigned ldsw = (unsigned)wid * 1024u;
    const int aoff = lds_byte(wr * 64 + fr, fq * 8), boff = lds_byte(wc * 32 + fr, fq * 8);
#define PG8_SA(b, h) (((b) * 2 + (h)) * HTB)
#define PG8_SB(b, h) ((4 + (b) * 2 + (h)) * HTB)
#define PG8_STAGE(bufoff, gbase, voff) do { _Pragma("unroll") for (int _i = 0; _i < 2; ++_i) \
        __builtin_amdgcn_global_load_lds((const unsigned*)((const char*)(gbase) + (voff)[_i]), (LAS unsigned*)(lds + (bufoff) + ldsw + _i * 8192), 16, 0, 0); } while (0)
#define PG8_LDA(dst, b, h) do { _Pragma("unroll") for (int m = 0; m < 4; ++m) _Pragma("unroll") for (int k = 0; k < 2; ++k) dst[m][k] = *(const LAS bf16x8*)(lds + PG8_SA(b, h) + aoff + m * 2048 + k * 1024); } while (0)
#define PG8_LDB(dst, b, h) do { _Pragma("unroll") for (int n = 0; n < 2; ++n) _Pragma("unroll") for (int k = 0; k < 2; ++k) dst[n][k] = *(const LAS bf16x8*)(lds + PG8_SB(b, h) + boff + n * 2048 + k * 1024); } while (0)
#define PG8_MMA(ai, bj, At, Bt) do { __builtin_amdgcn_s_setprio(1); _Pragma("unroll") for (int m = 0; m < 4; ++m) _Pragma("unroll") for (int n = 0; n < 2; ++n) _Pragma("unroll") for (int k = 0; k < 2; ++k) \
        acc[ai][bj][m][n] = __builtin_amdgcn_mfma_f32_16x16x32_bf16(Bt[n][k], At[m][k], acc[ai][bj][m][n], 0, 0, 0); __builtin_amdgcn_s_setprio(0); } while (0)
#define PG8_WAIT_V(n) asm volatile("s_waitcnt vmcnt(" #n ")" ::: "memory")
#define PG8_WAIT_L(n) asm volatile("s_waitcnt lgkmcnt(" #n ")" ::: "memory")
#define PG8_BAR __builtin_amdgcn_s_barrier()
#define PG8_SCHED __builtin_amdgcn_sched_barrier(0)
    Unit cur, nxt; int ui = 0;
    if (!S.next(0, cur)) return;
    f32x4 acc[2][2][4][2];
#pragma unroll
    for (int a = 0; a < 2; ++a)
#pragma unroll
        for (int b = 0; b < 2; ++b)
#pragma unroll
            for (int m = 0; m < 4; ++m)
#pragma unroll
                for (int n = 0; n < 2; ++n) acc[a][b][m][n] = (f32x4){0.f, 0.f, 0.f, 0.f};
    bf16x8 At[4][2], B0[2][2], B1[2][2];
    const char* cA = (const char*)g.A + (size_t)cur.pm * tstA + cur.aoff; const char* cB = (const char*)g.Bt + (size_t)cur.pn * tstB;
    PG8_STAGE(PG8_SB(0, 0), cB, voffB); PG8_STAGE(PG8_SB(0, 1), cB + hstB, voffB); PG8_STAGE(PG8_SA(0, 0), cA, voffA); PG8_STAGE(PG8_SA(0, 1), cA + hstA, voffA);
    if (wr == 1) PG8_BAR;
    PG8_WAIT_V(2); PG8_BAR;
    PG8_STAGE(PG8_SB(1, 0), cB + kstep, voffB); PG8_STAGE(PG8_SA(1, 0), cA + kstep, voffA); PG8_STAGE(PG8_SB(1, 1), cB + hstB + kstep, voffB);
    PG8_WAIT_V(6); PG8_BAR;
    for (;;) {
        const bool has_next = S.next(ui + 1, nxt);
        const char* nA = has_next ? (const char*)g.A + (size_t)nxt.pm * tstA + nxt.aoff : cA; const char* nB = has_next ? (const char*)g.Bt + (size_t)nxt.pn * tstB : cB;
        for (int t = 0; t < nt; t += 2) {
            const bool last = (t == nt - 2);
            const char* a1 = cA + (size_t)(t + 1) * kstep;
            const char* a2 = last ? nA : cA + (size_t)(t + 2) * kstep; const char* b2 = last ? nB : cB + (size_t)(t + 2) * kstep;
            const char* a3 = a2 + kstep; const char* b3 = b2 + kstep;
            PG8_LDB(B0, 0, 0); PG8_LDB(B1, 0, 1); PG8_SCHED; PG8_LDA(At, 0, 0); PG8_STAGE(PG8_SA(1, 1), a1 + hstA, voffA);
            PG8_WAIT_V(8); PG8_WAIT_L(0); PG8_BAR; PG8_MMA(0, 0, At, B0); PG8_MMA(0, 1, At, B1); PG8_BAR; PG8_SCHED;
            PG8_LDA(At, 0, 1); PG8_STAGE(PG8_SB(0, 0), b2, voffB); PG8_STAGE(PG8_SB(0, 1), b2 + hstB, voffB); PG8_STAGE(PG8_SA(0, 0), a2, voffA);
            PG8_WAIT_V(8); PG8_WAIT_L(0); PG8_BAR; PG8_MMA(1, 0, At, B0); PG8_MMA(1, 1, At, B1); PG8_BAR; PG8_SCHED;
            PG8_LDB(B0, 1, 0); PG8_LDB(B1, 1, 1); PG8_SCHED; PG8_LDA(At, 1, 0); PG8_STAGE(PG8_SA(0, 1), a2 + hstA, voffA);
            PG8_WAIT_V(8); PG8_WAIT_L(0); PG8_BAR; PG8_MMA(0, 0, At, B0); PG8_MMA(0, 1, At, B1); PG8_BAR; PG8_SCHED;
            PG8_LDA(At, 1, 1); PG8_STAGE(PG8_SB(1, 0), b3, voffB); PG8_STAGE(PG8_SB(1, 1), b3 + hstB, voffB); PG8_STAGE(PG8_SA(1, 0), a3, voffA);
            PG8_WAIT_V(8); PG8_WAIT_L(0); PG8_BAR; PG8_MMA(1, 0, At, B0); PG8_MMA(1, 1, At, B1); PG8_BAR; PG8_SCHED;
        }
        if constexpr (ALIGN_EPI) { if (wr == 0) PG8_BAR; }
        E(acc, cur, wr, wc, fr, fq);
        if (!has_next) break;
#pragma unroll
        for (int a = 0; a < 2; ++a)
#pragma unroll
            for (int b = 0; b < 2; ++b)
#pragma unroll
                for (int m = 0; m < 4; ++m)
#pragma unroll
                    for (int n = 0; n < 2; ++n) acc[a][b][m][n] = (f32x4){0.f, 0.f, 0.f, 0.f};
        cur = nxt; cA = nA; cB = nB; ++ui;
        if constexpr (ALIGN_EPI) { if (wr == 1) PG8_BAR; }
    }
    PG8_WAIT_V(0);
    if constexpr (!ALIGN_EPI) { if (wr == 0) PG8_BAR; }
    PG8_BAR;
#undef PG8_SA
#undef PG8_SB
#undef PG8_STAGE
#undef PG8_LDA
#undef PG8_LDB
#undef PG8_MMA
#undef PG8_WAIT_V
#undef PG8_WAIT_L
#undef PG8_BAR
#undef PG8_SCHED
}
}

struct Args { const float* in[33]; float* out; unsigned char* ws; int ph_lo, ph_hi; };
enum { I_XP = 0, I_XS, I_PP, I_PS, I_RELB, I_NMIX, I_WIN, I_AQN, I_AKN, I_ALQ1, I_ALK1, I_ALQ2, I_ALK2, I_AON, I_BCQN, I_BCKVN, I_BWUQ, I_BWUKV, I_BQN, I_BKN,
       I_CQN, I_CKN, I_DQN, I_DKN, I_WG, I_WB, I_WO, I_NFFN, I_W1, I_W2, I_NPLE, I_WPG, I_WPP };

__device__ __forceinline__ int rel_bucket(int rel) {
    const int n = rel < 0 ? -rel : rel;
    const float nf = (float)(n > 1 ? n : 1);
    int large = 8 + (int)(logf(nf / 8.0f) / 4.852030263919617f * 8.0f);
    large = large < 15 ? large : 15;
    return (rel > 0 ? 16 : 0) + (n < 8 ? n : large);
}
__device__ __forceinline__ void build_tables(const float* relb, float* tabA, float* tabD, int gtid, int gthreads) {
    for (int i = gtid; i < 4 * TABA_N; i += gthreads) { const int h = i / TABA_N, d = i % TABA_N - TABA_OFF; tabA[i] = relb[rel_bucket(d) * 16 + h] * LOG2E; }
    for (int i = gtid; i < 12 * TABD_N; i += gthreads) { const int gh = i / TABD_N, d = i % TABD_N - TABD_OFF; const int g = gh >> 2; const int dil = g == 0 ? 1 : (g == 1 ? 4 : 16);
        const int ad = d < 0 ? -d : d; const bool ok = (ad % dil == 0) && (ad <= 64 * dil);
        tabD[i] = ok ? relb[rel_bucket(d) * 16 + 4 + gh] * LOG2E : -1e30f; }
}
__device__ __forceinline__ void transpose_item(const float* W, int N, int k0, int n0, bf16_t* dst, int K, LAS float* scr, int lane) {
#pragma unroll 8
    for (int i = 0; i < 32; ++i) { const int kk = 2 * i + (lane >> 5); scr[kk * 33 + (lane & 31)] = W[(size_t)(k0 + kk) * N + n0 + (lane & 31)]; }
    asm volatile("s_waitcnt lgkmcnt(0)" ::: "memory");
    const int c = lane & 7;
#pragma unroll
    for (int j = 0; j < 4; ++j) { const int n = (lane >> 3) + 8 * j; const LAS float* s = scr + (8 * c) * 33 + n;
        u32x4 o; o.x = cvt_pk_bf16(s[0 * 33], s[1 * 33]); o.y = cvt_pk_bf16(s[2 * 33], s[3 * 33]); o.z = cvt_pk_bf16(s[4 * 33], s[5 * 33]); o.w = cvt_pk_bf16(s[6 * 33], s[7 * 33]);
        *(u32x4*)(dst + (size_t)n * K + k0 + 8 * c) = o; }
    asm volatile("s_waitcnt lgkmcnt(0)" ::: "memory");
}
__device__ __forceinline__ int win_row(int n0) {
    if (n0 < 512) return PC_AQ + n0;
    if (n0 < 1024) return PC_AK + (n0 - 512);
    if (n0 < 1536) return -(0 + (n0 - 1024) + 1);
    if (n0 < 2048) return PC_BCQ + (n0 - 1536);
    if (n0 < 2560) return PC_BCKV + (n0 - 2048);
    if (n0 < 2624) return PC_BKR + (n0 - 2560);
    if (n0 < 3136) return PC_CQ + (n0 - 2624);
    if (n0 < 3392) return PC_CK + (n0 - 3136);
    if (n0 < 3648) return -(512 + (n0 - 3392) + 1);
    if (n0 < 5184) return PC_DQ + (n0 - 3648);
    if (n0 < 5696) return PC_DK + (n0 - 5184);
    return -(768 + (n0 - 5696) + 1);
}
__device__ __forceinline__ void convert_weights(const Args& a, int layer, unsigned char* W, LAS float* scr, int gw, int ngw, int lane) {
    constexpr int I_IN = 32 * 194, I_G = 4 * 32 * 64, I_B = 4 * 8 * 64, I_O = 32 * 64, I_1 = 32 * 256, I_2 = 128 * 64, I_PG = 32 * 64, I_PPn = 4 * 64, I_UQ = 8 * 24, I_UKV = 8 * 32;
    constexpr int NIT = I_IN + I_G + I_B + I_O + I_1 + I_2 + I_PG + I_PPn + I_UQ + I_UKV;
    for (int it = gw; it < NIT; it += ngw) {
        int r = it;
        if (r < I_IN) { const int kb = r / 194, nb = r % 194; const int dr = win_row(nb * 32);
            bf16_t* dst = dr >= 0 ? (bf16_t*)(W + WO_IN) + (size_t)dr * 2048 : (bf16_t*)(W + WO_INV) + (size_t)(-dr - 1) * 2048;
            transpose_item(a.in[I_WIN] + (size_t)layer * 2048 * 6208, 6208, kb * 64, nb * 32, dst, 2048, scr, lane); continue; } r -= I_IN;
        if (r < I_G) { const int b = r / 2048, q = r % 2048, kb = q / 64, nb = q % 64;
            transpose_item(a.in[I_WG] + ((size_t)layer * 4 + b) * 2048 * 2048, 2048, kb * 64, nb * 32, (bf16_t*)(W + WO_G) + ((size_t)b * 2048 + nb * 32) * 2048, 2048, scr, lane); continue; } r -= I_G;
        if (r < I_B) { const int b = r / 512, q = r % 512, kb = q / 64, nb = q % 64;
            transpose_item(a.in[I_WB] + ((size_t)layer * 4 + b) * 512 * 2048, 2048, kb * 64, nb * 32, (bf16_t*)(W + WO_B) + ((size_t)b * 2048 + nb * 32) * 512, 512, scr, lane); continue; } r -= I_B;
        if (r < I_O) { const int kb = r / 64, nb = r % 64;
            transpose_item(a.in[I_WO] + (size_t)layer * 2048 * 2048, 2048, kb * 64, nb * 32, (bf16_t*)(W + WO_O) + (size_t)(nb * 32) * 2048, 2048, scr, lane); continue; } r -= I_O;
        if (r < I_1) { const int kb = r / 256, nb = r % 256;
            transpose_item(a.in[I_W1] + (size_t)layer * 2048 * 8192, 8192, kb * 64, nb * 32, (bf16_t*)(W + WO_1) + (size_t)(nb * 32) * 2048, 2048, scr, lane); continue; } r -= I_1;
        if (r < I_2) { const int kb = r / 64, nb = r % 64;
            transpose_item(a.in[I_W2] + (size_t)layer * 8192 * 2048, 2048, kb * 64, nb * 32, (bf16_t*)(W + WO_2) + (size_t)(nb * 32) * 8192, 8192, scr, lane); continue; } r -= I_2;
        if (r < I_PG) { const int kb = r / 64, nb = r % 64;
            transpose_item(a.in[I_WPG] + (size_t)layer * 2048 * 2048, 2048, kb * 64, nb * 32, (bf16_t*)(W + WO_PG) + (size_t)(nb * 32) * 2048, 2048, scr, lane); continue; } r -= I_PG;
        if (r < I_PPn) { const int kb = r / 64, nb = r % 64;
            transpose_item(a.in[I_WPP] + (size_t)layer * 256 * 2048, 2048, kb * 64, nb * 32, (bf16_t*)(W + WO_PP) + (size_t)(nb * 32) * 256, 256, scr, lane); continue; } r -= I_PPn;
        if (r < I_UQ) { const int kb = r / 24, nb = r % 24;
            transpose_item(a.in[I_BWUQ] + (size_t)layer * 512 * 768, 768, kb * 64, nb * 32, (bf16_t*)(W + WO_UQ) + (size_t)(nb * 32) * 512, 512, scr, lane); continue; } r -= I_UQ;
        { const int kb = r / 32, nb = r % 32; const int n0 = nb * 32, h = n0 >> 8, j0 = n0 & 255;
            bf16_t* dst = j0 < 128 ? (bf16_t*)(W + WO_UKN) + (size_t)(h * 128 + j0) * 512 : (bf16_t*)(W + WO_UKV) + (size_t)(h * 128 + j0 - 128) * 512;
            transpose_item(a.in[I_BWUKV] + (size_t)layer * 512 * 1024, 1024, kb * 64, n0, dst, 512, scr, lane); }
    }
}

__device__ __forceinline__ void norm_row(const float* x, const float* g, bf16_t* out, int lane) {
    f32x4 v[8]; float s = 0.f;
#pragma unroll
    for (int j = 0; j < 8; ++j) { v[j] = *(const f32x4*)(x + 4 * lane + 256 * j); s += (v[j][0] * v[j][0] + v[j][1] * v[j][1]) + (v[j][2] * v[j][2] + v[j][3] * v[j][3]); }
    const float rs = 1.0f / sqrtf(wave_sum(s) * (1.0f / 2048.0f) + EPS);
#pragma unroll
    for (int j = 0; j < 8; ++j) { const f32x4 gg = *(const f32x4*)(g + 4 * lane + 256 * j);
        u32x2 w; w.x = cvt_pk_bf16(v[j][0] * rs * gg[0], v[j][1] * rs * gg[1]); w.y = cvt_pk_bf16(v[j][2] * rs * gg[2], v[j][3] * rs * gg[3]);
        *(u32x2*)(out + 4 * lane + 256 * j) = w; }
}
__device__ __forceinline__ void load8(const bf16_t* p, float (&f)[8]) { const u32x4 v = *(const u32x4*)p; f[0] = bf_lo(v.x); f[1] = bf_hi(v.x); f[2] = bf_lo(v.y); f[3] = bf_hi(v.y); f[4] = bf_lo(v.z); f[5] = bf_hi(v.z); f[6] = bf_lo(v.w); f[7] = bf_hi(v.w); }
__device__ __forceinline__ void store8(bf16_t* p, const float (&f)[8]) { u32x4 w; w.x = cvt_pk_bf16(f[0], f[1]); w.y = cvt_pk_bf16(f[2], f[3]); w.z = cvt_pk_bf16(f[4], f[5]); w.w = cvt_pk_bf16(f[6], f[7]); *(u32x4*)p = w; }
template <int GRP> __device__ __forceinline__ void norm8(float (&f)[8], const float* g, float scale, int lane) {
    float s = 0.f;
#pragma unroll
    for (int e = 0; e < 8; ++e) s += f[e] * f[e];
#pragma unroll
    for (int o = 1; o < GRP; o <<= 1) s += __shfl_xor(s, o);
    const float rs = scale / sqrtf(s * (1.0f / (GRP * 8)) + EPS);
    const int gi = (lane & (GRP - 1)) * 8;
#pragma unroll
    for (int e = 0; e < 8; ++e) f[e] = f[e] * rs * g[gi + e];
}
__device__ __forceinline__ float rope_inv(int i) { return __builtin_amdgcn_exp2f(-(float)i * (13.287712379549449f / 32.0f)) * 0.15915494309189535f; }
__device__ __forceinline__ void sincos_rev(float rev, float& sn, float& cs) { rev -= rintf(rev); sn = __builtin_amdgcn_sinf(rev); cs = __builtin_amdgcn_cosf(rev); }
__device__ __forceinline__ void axial_rope8(float (&f)[8], float rowpos, float colpos, int lane) {
    const int j = lane & 15, hf = j >> 3, jj = j & 7; const float pos = hf ? colpos : rowpos; const float sgn = jj < 4 ? -1.f : 1.f; const int i0 = 8 * (jj & 3);
#pragma unroll
    for (int e = 0; e < 8; ++e) { const float pv = __shfl_xor(f[e], 4); float sn, cs; sincos_rev(pos * rope_inv(i0 + e), sn, cs); f[e] = f[e] * cs + sgn * pv * sn; }
}
__device__ __forceinline__ void post1_row(const Args& a, int layer, bf16_t* P, int tseq, int lane) {
    float f[8];
    const float sA = 0.125f * LOG2E, sC = 0.08838834764831845f * LOG2E;
    load8(P + PC_AQ + 8 * lane, f); norm8<8>(f, a.in[I_AQN] + layer * 64, sA, lane); store8(P + PC_AQ + 8 * lane, f);
    load8(P + PC_AK + 8 * lane, f); norm8<8>(f, a.in[I_AKN] + layer * 64, 1.f, lane); store8(P + PC_AK + 8 * lane, f);
    load8(P + PC_BCQ + 8 * lane, f); norm8<64>(f, a.in[I_BCQN] + layer * 512, 1.f, lane); store8(P + PC_BCQ + 8 * lane, f);
    load8(P + PC_BCKV + 8 * lane, f); norm8<64>(f, a.in[I_BCKVN] + layer * 512, 1.f, lane); store8(P + PC_BCKV + 8 * lane, f);
    const float rowpos = (float)(tseq >> 6), colpos = (float)(tseq & 63);
    load8(P + PC_CQ + 8 * lane, f); norm8<16>(f, a.in[I_CQN] + layer * 128, sC, lane); axial_rope8(f, rowpos, colpos, lane); store8(P + PC_CQ + 8 * lane, f);
    { const int l2 = lane & 31; load8(P + PC_CK + 8 * l2, f); norm8<16>(f, a.in[I_CKN] + layer * 128, 1.f, lane); axial_rope8(f, rowpos, colpos, lane); if (lane < 32) store8(P + PC_CK + 8 * l2, f); }
#pragma unroll
    for (int p = 0; p < 3; ++p) { load8(P + PC_DQ + 512 * p + 8 * lane, f); norm8<16>(f, a.in[I_DQN] + layer * 128, sC, lane); store8(P + PC_DQ + 512 * p + 8 * lane, f); }
    load8(P + PC_DK + 8 * lane, f); norm8<16>(f, a.in[I_DKN] + layer * 128, 1.f, lane); store8(P + PC_DK + 8 * lane, f);
}
__device__ __forceinline__ void mla_norm_rope(float (&f)[8], float (&r)[4], const float* g, float scale, float pos, int lane) {
    const int j = lane & 15;
    float s = 0.f;
#pragma unroll
    for (int e = 0; e < 8; ++e) s += f[e] * f[e];
#pragma unroll
    for (int e = 0; e < 4; ++e) s += r[e] * r[e];
#pragma unroll
    for (int o = 1; o < 16; o <<= 1) s += __shfl_xor(s, o);
    const float rs = scale / sqrtf(s * (1.0f / 192.0f) + EPS);
#pragma unroll
    for (int e = 0; e < 8; ++e) f[e] = f[e] * rs * g[8 * j + e];
#pragma unroll
    for (int e = 0; e < 4; ++e) r[e] = r[e] * rs * g[128 + 4 * j + e];
    const float sgn = j < 8 ? -1.f : 1.f; const int i0 = 4 * (j & 7);
#pragma unroll
    for (int e = 0; e < 4; ++e) { const float pv = __shfl_xor(r[e], 8); float sn, cs; sincos_rev(pos * rope_inv(i0 + e), sn, cs); r[e] = r[e] * cs + sgn * pv * sn; }
}
__device__ __forceinline__ void post2_row(const Args& a, int layer, bf16_t* Q, bf16_t* Kr, const bf16_t* P, int tseq, int lane) {
    const int h = lane >> 4, j = lane & 15; const float pos = (float)tseq;
    float f[8], r[4];
    { bf16_t* q = Q + h * 192; load8(q + 8 * j, f); const u32x2 v = *(const u32x2*)(q + 128 + 4 * j); r[0] = bf_lo(v.x); r[1] = bf_hi(v.x); r[2] = bf_lo(v.y); r[3] = bf_hi(v.y);
      mla_norm_rope(f, r, a.in[I_BQN] + layer * 192, 0.07216878364870323f * LOG2E, pos, lane);
      store8(q + 8 * j, f); u32x2 w; w.x = cvt_pk_bf16(r[0], r[1]); w.y = cvt_pk_bf16(r[2], r[3]); *(u32x2*)(q + 128 + 4 * j) = w; }
    { bf16_t* k = Kr + h * 192; load8(k + 8 * j, f); const u32x2 v = *(const u32x2*)(P + PC_BKR + 4 * j); r[0] = bf_lo(v.x); r[1] = bf_hi(v.x); r[2] = bf_lo(v.y); r[3] = bf_hi(v.y);
      mla_norm_rope(f, r, a.in[I_BKN] + layer * 192, 1.f, pos, lane);
      store8(k + 8 * j, f); u32x2 w; w.x = cvt_pk_bf16(r[0], r[1]); w.y = cvt_pk_bf16(r[2], r[3]); *(u32x2*)(k + 128 + 4 * j) = w; }
}

struct AState { float m, l; f32x16 o[4]; };
__device__ __forceinline__ void astate_init(AState& st) { st.m = -3.0e38f; st.l = 0.f;
#pragma unroll
    for (int d = 0; d < 4; ++d)
#pragma unroll
        for (int r = 0; r < 16; ++r) st.o[d][r] = 0.f; }
template <int DK, bool TAB, bool QLDS = false>
__device__ __forceinline__ void attn_pass(AState& st, const bf16_t* qp, const bf16_t* kp, long ldk, const bf16_t* vp, long ldv, int kbeg, int kend, const float* tp, LAS bf16x8* qst = nullptr) {
    constexpr int NS = DK / 16;
    bf16x8 qf[QLDS ? 1 : NS], kf[NS];
    if (QLDS) {
#pragma unroll
        for (int s = 0; s < NS; ++s) qst[s * 64] = *(const bf16x8*)(qp + 16 * s);
    } else {
#pragma unroll
        for (int s = 0; s < NS; ++s) qf[s] = *(const bf16x8*)(qp + 16 * s);
    }
    { const bf16_t* k0p = kp + (long)kbeg * ldk;
#pragma unroll
      for (int s = 0; s < NS; ++s) kf[s] = *(const bf16x8*)(k0p + 16 * s); }
    for (int k0 = kbeg; k0 < kend; k0 += 32) {
        bf16x8 vf[4][2];
#pragma unroll
        for (int d = 0; d < 4; ++d)
#pragma unroll
            for (int s = 0; s < 2; ++s) vf[d][s] = *(const bf16x8*)(vp + (long)(32 * d) * ldv + k0 + 16 * s);
        f32x4 tb[4];
        if (TAB) {
#pragma unroll
            for (int s = 0; s < 2; ++s) { tb[2 * s] = *(const f32x4u*)(tp + k0 + 16 * s); tb[2 * s + 1] = *(const f32x4u*)(tp + k0 + 16 * s + 4); } }
        f32x16 sc;
#pragma unroll
        for (int r = 0; r < 16; ++r) sc[r] = 0.f;
#pragma unroll
        for (int s = 0; s < NS; ++s) sc = __builtin_amdgcn_mfma_f32_32x32x16_bf16(kf[s], QLDS ? qst[s * 64] : qf[QLDS ? 0 : s], sc, 0, 0, 0);
        if (k0 + 32 < kend) { const bf16_t* knp = kp + (long)(k0 + 32) * ldk;
#pragma unroll
            for (int s = 0; s < NS; ++s) kf[s] = *(const bf16x8*)(knp + 16 * s); }
        if (TAB) {
#pragma unroll
            for (int r = 0; r < 16; ++r) sc[r] += tb[r >> 2][r & 3]; }
        float mx = sc[0];
#pragma unroll
        for (int r = 1; r < 16; ++r) mx = fmaxf(mx, sc[r]);
        mx = fmaxf(mx, __shfl_xor(mx, 32));
        const float mn = fmaxf(st.m, mx);
        const float alpha = __builtin_amdgcn_exp2f(st.m - mn);
        st.m = mn;
        float ps = 0.f;
#pragma unroll
        for (int r = 0; r < 16; ++r) { sc[r] = __builtin_amdgcn_exp2f(sc[r] - mn); ps += sc[r]; }
        st.l = st.l * alpha + ps;
#pragma unroll
        for (int d = 0; d < 4; ++d)
#pragma unroll
            for (int r = 0; r < 16; ++r) st.o[d][r] *= alpha;
        u32x4 p0, p1;
        p0.x = cvt_pk_bf16(sc[0], sc[1]); p0.y = cvt_pk_bf16(sc[2], sc[3]); p0.z = cvt_pk_bf16(sc[4], sc[5]); p0.w = cvt_pk_bf16(sc[6], sc[7]);
        p1.x = cvt_pk_bf16(sc[8], sc[9]); p1.y = cvt_pk_bf16(sc[10], sc[11]); p1.z = cvt_pk_bf16(sc[12], sc[13]); p1.w = cvt_pk_bf16(sc[14], sc[15]);
        const bf16x8 pf0 = __builtin_bit_cast(bf16x8, p0), pf1 = __builtin_bit_cast(bf16x8, p1);
#pragma unroll
        for (int d = 0; d < 4; ++d) { st.o[d] = __builtin_amdgcn_mfma_f32_32x32x16_bf16(vf[d][0], pf0, st.o[d], 0, 0, 0); st.o[d] = __builtin_amdgcn_mfma_f32_32x32x16_bf16(vf[d][1], pf1, st.o[d], 0, 0, 0); }
    }
}
__device__ __forceinline__ void astate_finish(AState& st) {
    const float l = st.l + __shfl_xor(st.l, 32); const float inv = 1.0f / l;
#pragma unroll
    for (int d = 0; d < 4; ++d)
#pragma unroll
        for (int r = 0; r < 16; ++r) st.o[d][r] *= inv;
}
__device__ __forceinline__ void store_o(const f32x16 (&o)[4], bf16_t* op) {
#pragma unroll
    for (int d = 0; d < 4; ++d)
#pragma unroll
        for (int g = 0; g < 4; ++g) { u32x2 w; w.x = cvt_pk_bf16(o[d][4 * g], o[d][4 * g + 1]); w.y = cvt_pk_bf16(o[d][4 * g + 2], o[d][4 * g + 3]); *(u32x2*)(op + 32 * d + 8 * g) = w; }
}
__device__ __forceinline__ int pi32(int n) { return (n & ~12) | ((n & 4) << 1) | ((n & 8) >> 1); }

struct AttnBufs { const bf16_t* PROJ; const bf16_t* VT; const bf16_t* QB; const bf16_t* KB; const bf16_t* VTB; bf16_t* BR; const float* tabA; const float* tabD; };

__device__ __forceinline__ void attn_unit(const Args& a, const AttnBufs& B, int layer, int mixer, int head, int row0  , int S, int q0  , int lane, LAS float* stash) {
#define ATT_LANE_SETUP int ln_ = lane; asm volatile("" : "+v"(ln_)); const int n = ln_ & 31, hi = ln_ >> 5, pr = pi32(n); const long qrow = (long)row0 + q0 + n; bf16_t* op = B.BR + qrow * 2048 + 4 * hi;
#ifdef ONLY_MIXER
    mixer = ONLY_MIXER;
#endif
    if (mixer == 0) {
        ATT_LANE_SETUP
        const float lam_init = layer == 0 ? 0.2f : 0.35550906759f;
        const float d1 = wave_sum(a.in[I_ALQ1][layer * 64 + lane] * a.in[I_ALK1][layer * 64 + lane]);
        const float d2 = wave_sum(a.in[I_ALQ2][layer * 64 + lane] * a.in[I_ALK2][layer * 64 + lane]);
        const float lam = expf(d1) - expf(d2) + lam_init;
        const bf16_t* vp = B.VT + (long)(head * 128 + n) * TCM + row0 + 8 * hi;
        const float* tp = B.tabA + head * TABA_N + TABA_OFF - (q0 + n) + 8 * hi;
        { AState st; astate_init(st);
          attn_pass<64, true>(st, B.PROJ + qrow * NP + PC_AQ + head * 128 + 8 * hi, B.PROJ + (long)(row0 + pr) * NP + PC_AK + head * 128 + 8 * hi, NP, vp, TCM, 0, S, tp);
          astate_finish(st);
#pragma unroll
          for (int d = 0; d < 4; ++d)
#pragma unroll
              for (int r = 0; r < 16; ++r) stash[(d * 16 + r) * 64 + lane] = st.o[d][r]; }
        AState st; astate_init(st);
        attn_pass<64, true>(st, B.PROJ + qrow * NP + PC_AQ + head * 128 + 64 + 8 * hi, B.PROJ + (long)(row0 + pr) * NP + PC_AK + head * 128 + 64 + 8 * hi, NP, vp, TCM, 0, S, tp);
        astate_finish(st);
        float ss = 0.f;
#pragma unroll
        for (int d = 0; d < 4; ++d)
#pragma unroll
            for (int r = 0; r < 16; ++r) { const float v = stash[(d * 16 + r) * 64 + lane] - lam * st.o[d][r]; st.o[d][r] = v; ss += v * v; }
        ss += __shfl_xor(ss, 32);
        const float rs = (1.0f - lam_init) / sqrtf(ss * (1.0f / 128.0f) + EPS);
        const float* gn = a.in[I_AON] + layer * 128 + 4 * hi;
#pragma unroll
        for (int d = 0; d < 4; ++d)
#pragma unroll
            for (int g = 0; g < 4; ++g) { const f32x4 gg = *(const f32x4*)(gn + 32 * d + 8 * g);
#pragma unroll
                for (int e = 0; e < 4; ++e) st.o[d][4 * g + e] *= rs * gg[e]; }
        store_o(st.o, op + head * 128);
    } else if (mixer == 1) {
        ATT_LANE_SETUP
        AState st; astate_init(st);
        attn_pass<192, false, true>(st, B.QB + qrow * 768 + head * 192 + 8 * hi, B.KB + (long)(row0 + pr) * 768 + head * 192 + 8 * hi, 768,
                              B.VTB + (long)(head * 128 + n) * TCM + row0 + 8 * hi, TCM, 0, S, nullptr, (LAS bf16x8*)stash + lane);
        astate_finish(st); store_o(st.o, op + 512 + head * 128);
    } else if (mixer == 2) {
        ATT_LANE_SETUP
        const int kv = head >> 1;
        AState st; astate_init(st);
        attn_pass<128, false>(st, B.PROJ + qrow * NP + PC_CQ + head * 128 + 8 * hi, B.PROJ + (long)(row0 + pr) * NP + PC_CK + kv * 128 + 8 * hi, NP,
                              B.VT + (long)(512 + kv * 128 + n) * TCM + row0 + 8 * hi, TCM, 0, S, nullptr);
        astate_finish(st); store_o(st.o, op + 1024 + head * 128);
    } else {
        ATT_LANE_SETUP
        AState st; astate_init(st);
        const bf16_t* kp = B.PROJ + (long)(row0 + pr) * NP + PC_DK + head * 128 + 8 * hi;
        const bf16_t* vp = B.VT + (long)(768 + head * 128 + n) * TCM + row0 + 8 * hi;
#pragma unroll 1
        for (int g = 0; g < 3; ++g) { const int W = g == 0 ? 64 : (g == 1 ? 256 : 1024);
            const int kb = q0 - W > 0 ? q0 - W : 0, ke = q0 + 32 + W < S ? q0 + 32 + W : S;
            attn_pass<128, true>(st, B.PROJ + qrow * NP + PC_DQ + (g * 4 + head) * 128 + 8 * hi, kp, NP, vp, TCM, kb, ke, B.tabD + (g * 4 + head) * TABD_N + TABD_OFF - (q0 + n) + 8 * hi); }
        astate_finish(st); store_o(st.o, op + 1536 + head * 128);
    }
}
__device__ __forceinline__ void attn_phase(const Args& a, const AttnBufs& B, int layer, int chunk, unsigned* ctr, int lane, LAS float* stash) {
    const int npr = chunk == 0 ? 1 : 0, nsm = chunk == 0 ? 4 : 12, TC = chunk == 0 ? 16384 : 24576;
    const int nP = npr * 1024, nS = nsm * 256, nD = TC / 8, total = 3 * nP + 3 * nS + nD;
    for (;;) {
        unsigned uu = 0; if (lane == 0) uu = atomicAdd(ctr, 1u);
        int u = __builtin_amdgcn_readfirstlane((int)uu);
        if (u >= total) break;
        int mixer, head, row0, S, q0;
        if (u < 3 * nP) { mixer = u / nP; const int r = u % nP; q0 = (r % 256) * 32; head = r / 256; row0 = 0; S = TP; }
        else { u -= 3 * nP;
            if (u < 3 * nS) { mixer = u / nS; const int r = u % nS; q0 = (r % 64) * 32; head = (r / 64) % 4; row0 = npr * TP + (r / 256) * SS; S = SS; }
            else { u -= 3 * nS; mixer = 3; const int qb = u % (TC / 32); head = u / (TC / 32); const int q = qb * 32;
                if (npr && q < TP) { row0 = 0; S = TP; } else { row0 = npr * TP + ((q - npr * TP) / SS) * SS; S = SS; }
                q0 = q - row0; } }
#ifdef ONLY_MIXER
        if (mixer != ONLY_MIXER) continue;
#endif
        attn_unit(a, B, layer, mixer, head, row0, S, q0, lane, stash);
    }
}

__global__ void __launch_bounds__(512, 2) mega(Args a) {
    extern __shared__ __attribute__((aligned(16))) unsigned char lds_raw[];
    LAS unsigned char* lds = (LAS unsigned char*)lds_raw;
    const int G = gridDim.x, bx = blockIdx.x;
    unsigned char* ws = a.ws;
    unsigned* ctl = (unsigned*)(ws + WS_CTL);
    float* tabA = (float*)(ws + WS_TABA); float* tabD = (float*)(ws + WS_TABD);
    unsigned char* W = ws + WS_W;
    bf16_t* H = (bf16_t*)(ws + WS_H);
    bf16_t* PROJ = (bf16_t*)(ws + WS_R1 + R1_PROJ); bf16_t* VT = (bf16_t*)(ws + WS_R1 + R1_VT); bf16_t* QB = (bf16_t*)(ws + WS_R1 + R1_QB);
    bf16_t* KB = (bf16_t*)(ws + WS_R1 + R1_KB); bf16_t* VTB = (bf16_t*)(ws + WS_R1 + R1_VTB);
    bf16_t* Y = (bf16_t*)(ws + WS_R1); bf16_t* FFH = (bf16_t*)(ws + WS_R1);
    bf16_t* BR = (bf16_t*)(ws + WS_R2); float* PART = (float*)(ws + WS_R2); bf16_t* U = (bf16_t*)(ws + WS_R2);
    bf16_t* MERGED = (bf16_t*)(ws + WS_R3); bf16_t* P16 = (bf16_t*)(ws + WS_R3);
    cg::grid_group grid = cg::this_grid();

    for (int pid = a.ph_lo; pid < a.ph_hi; ++pid) {
        int tid = threadIdx.x; asm volatile("" : "+v"(tid));
        const int lane = tid & 63, wave = __builtin_amdgcn_readfirstlane(tid >> 6);
        const int gw = bx * 8 + wave, ngw = G * 8;
        const int layer = pid / 31, q = pid % 31;
        if (q == 0) {
            if (layer == 0) build_tables(a.in[I_RELB], tabA, tabD, bx * 512 + tid, G * 512);
#ifndef NO_CONV
            convert_weights(a, layer, W, (LAS float*)(lds + wave * 16384), gw, ngw, lane);
#endif
        } else {
            const int chunk = (q - 1) / 15, k = (q - 1) % 15 + 1;
            const int m0 = chunk == 0 ? 0 : 16384, TC = chunk == 0 ? 16384 : 24576, nMt = TC / 256;
            const float* xs0 = layer == 0 ? a.in[I_XP] : a.out; const float* xs1 = layer == 0 ? a.in[I_XS] : a.out + (size_t)TP * DM;
#ifdef NO_ROWS
            if (0) {
#else
            if (k == 1 || k == 10 || k == 13) {
#endif
                if (k == 1 || k == 10) { if (k == 10) { xs0 = a.out; xs1 = a.out + (size_t)TP * DM; }
                    const float* g = (k == 1 ? a.in[I_NMIX] : a.in[I_NFFN]) + layer * DM;
                    for (int r = gw; r < TC; r += ngw) norm_row(xrow_ptr(xs0, xs1, m0 + r), g, H + (size_t)r * DM, lane);
                } else {
                    const float* g = a.in[I_NPLE] + layer * DM;
                    for (int r = gw; r < TC; r += ngw) { const int m = m0 + r; norm_row(a.out + (size_t)m * DM, g, H + (size_t)r * DM, lane);
                        const float* pr = m < TP ? a.in[I_PP] + ((size_t)layer * TP + m) * 256 : a.in[I_PS] + ((size_t)layer * 32768 + (m - TP)) * 256;
                        const f32x4 v = *(const f32x4*)(pr + 4 * lane); u32x2 w; w.x = cvt_pk_bf16(v[0], v[1]); w.y = cvt_pk_bf16(v[2], v[3]); *(u32x2*)(P16 + (size_t)r * 256 + 4 * lane) = w; }
                }
#ifdef NO_ROWS
            } else if (0) {
#else
            } else if (k == 3 || k == 5) {
#endif
                for (int r = gw; r < TC; r += ngw) { const int m = m0 + r; const int tseq = m < TP ? m : (m - TP) % SS;
                    if (k == 3) post1_row(a, layer, PROJ + (size_t)r * NP, tseq, lane);
                    else post2_row(a, layer, QB + (size_t)r * 768, KB + (size_t)r * 768, PROJ + (size_t)r * NP, tseq, lane); }
            } else if (k == 6) {
                AttnBufs B{PROJ, VT, QB, KB, VTB, BR, tabA, tabD};
#ifndef NO_ATTN
                attn_phase(a, B, layer, chunk, ctl + 64 * (layer * 2 + chunk), lane, (LAS float*)(lds + wave * 16384));
#endif
            } else {
                const int njobs = (k == 2) ? 2 : (k == 4 ? 3 : 1);
                int coff = 0;
                for (int j = 0; j < njobs; ++j) {
                    pg8::Gemm g; pg8::Epi E; int nM = nMt, nN = 8, rep = 1, adiv = 1 << 30; long astep = 0;
                    E.kind = pg8::EK_BF16; E.O = nullptr; E.ldc = 0; E.Y = nullptr; E.part = nullptr; E.xs0 = xs0; E.xs1 = xs1; E.xout = a.out; E.m0 = m0;
                    g.A = H; g.Bt = (const bf16_t*)(W + WO_IN); g.lda = 2048; g.ldb = 2048; g.K = 2048;
                    if (k == 2 && j == 0) { nN = NP / 256; E.O = PROJ; E.ldc = NP; }
                    else if (k == 2) { g.A = (const bf16_t*)(W + WO_INV); g.Bt = H; nM = NVT / 256; nN = nMt; E.O = VT; E.ldc = TCM; }
                    else if (k == 4 && j == 0) { g.A = PROJ + PC_BCQ; g.lda = NP; g.Bt = (const bf16_t*)(W + WO_UQ); g.ldb = 512; g.K = 512; nN = 3; E.O = QB; E.ldc = 768; }
                    else if (k == 4 && j == 1) { g.A = PROJ + PC_BCKV; g.lda = NP; g.Bt = (const bf16_t*)(W + WO_UKN); g.ldb = 512; g.K = 512; nN = 2; E.kind = pg8::EK_SPLIT192; E.O = KB; E.ldc = 768; }
                    else if (k == 4) { g.A = (const bf16_t*)(W + WO_UKV); g.lda = 512; g.Bt = PROJ + PC_BCKV; g.ldb = NP; g.K = 512; nM = 2; nN = nMt; E.O = VTB; E.ldc = TCM; }
                    else if (k == 7) { g.A = BR; g.Bt = (const bf16_t*)(W + WO_B); g.ldb = 512; g.K = 512; nN = 32; adiv = 8; astep = 1024; E.O = Y; E.ldc = 8192; }
                    else if (k == 8) { g.Bt = (const bf16_t*)(W + WO_G); rep = 4; E.kind = pg8::EK_GATE; E.O = MERGED; E.Y = Y; E.part = PART; }
                    else if (k == 9) { g.A = MERGED; g.Bt = (const bf16_t*)(W + WO_O); E.kind = pg8::EK_RES; }
                    else if (k == 11) { g.Bt = (const bf16_t*)(W + WO_1); nN = 32; E.kind = pg8::EK_RELU2; E.O = FFH; E.ldc = 8192; }
                    else if (k == 12) { g.A = FFH; g.lda = 8192; g.Bt = (const bf16_t*)(W + WO_2); g.ldb = 8192; g.K = 8192; E.kind = pg8::EK_RES; E.xs0 = a.out; E.xs1 = a.out + (size_t)TP * DM; }
                    else if (k == 14) { g.A = P16; g.lda = 256; g.Bt = (const bf16_t*)(W + WO_PP); g.ldb = 256; g.K = 256; E.O = U; E.ldc = 2048; }
                    else { g.Bt = (const bf16_t*)(W + WO_PG); E.kind = pg8::EK_PLE; E.Y = U; E.xs0 = a.out; E.xs1 = a.out + (size_t)TP * DM; }
                    pg8::Order S; S.init(nM, nN, G, (bx + G - coff) % G, rep, adiv, astep);
#ifndef NO_GEMM
                    pg8::gemm_phase<true>(lds, g, S, E, tid);
#endif
                    coff = (coff + (nM * nN) % G) % G;
                }
            }
        }
        if (pid + 1 < a.ph_hi) grid.sync();
    }
}

extern "C" void kernel_launch(void* const* d_in, const int* in_sizes, int n_in, void* d_out, int out_size, void* d_ws, size_t ws_size, hipStream_t stream) {
    static int grid = 0;
    if (grid == 0) {
        if (n_in != 33 || out_size != TALL * DM || ws_size < WS_END) { fprintf(stderr, "kernel_launch: unexpected shapes (n_in %d out %d ws %zu need %zu)\n", n_in, out_size, ws_size, (size_t)WS_END); grid = -1; return; }
        int dev = 0, cus = 0, per_cu = 0;
        hipGetDevice(&dev); hipDeviceGetAttribute(&cus, hipDeviceAttributeMultiprocessorCount, dev);
        if (hipFuncSetAttribute((const void*)mega, hipFuncAttributeMaxDynamicSharedMemorySize, LDS_BYTES) != hipSuccess) { fprintf(stderr, "kernel_launch: hipFuncSetAttribute failed\n"); grid = -1; return; }
        if (hipOccupancyMaxActiveBlocksPerMultiprocessor(&per_cu, (const void*)mega, 512, LDS_BYTES) != hipSuccess || per_cu < 1) per_cu = 1;
        (void)hipGetLastError();
        grid = cus * per_cu;
        if (grid <= 0) grid = 256;
    }
    if (grid < 0) return;
    hipMemsetAsync((char*)d_ws + WS_CTL, 0, 4096, stream);
    Args a{};
    for (int i = 0; i < 33; ++i) a.in[i] = (const float*)d_in[i];
    a.out = (float*)d_out; a.ws = (unsigned char*)d_ws;
    constexpr int NPH = 62;
#if COOP
    a.ph_lo = 0; a.ph_hi = NPH;
    void* args[] = {&a};
    hipError_t e = hipLaunchCooperativeKernel((const void*)mega, dim3(grid), dim3(512), args, LDS_BYTES, stream);
    if (e != hipSuccess) fprintf(stderr, "cooperative launch failed: %s (grid %d)\n", hipGetErrorString(e), grid);
#else
    for (int p = 0; p < NPH; ++p) { a.ph_lo = p; a.ph_hi = p + 1; hipLaunchKernelGGL(mega, dim3(grid), dim3(512), LDS_BYTES, stream, a); }
#endif
}
```

```cpp
#include <hip/hip_runtime.h>
#include <hip/hip_cooperative_groups.h>
#include <cstdio>
#include <cstdint>
namespace cg = cooperative_groups;

#ifndef COOP
#define COOP 1
#endif
#ifndef ATTN_V2
#define ATTN_V2 1
#endif

#define LAS __attribute__((address_space(3)))
typedef unsigned short bf16_t;
typedef short bf16x8 __attribute__((ext_vector_type(8)));
typedef float f32x4 __attribute__((ext_vector_type(4)));
typedef float f32x16 __attribute__((ext_vector_type(16)));
typedef unsigned u32x4 __attribute__((ext_vector_type(4)));
typedef unsigned u32x2 __attribute__((ext_vector_type(2)));
typedef float f32x4u __attribute__((ext_vector_type(4), aligned(4)));

constexpr int DM = 2048, TALL = 40960, TP = 8192, SS = 2048;
constexpr int NP = 5120;
constexpr int TCM = 24576;
constexpr int NVT = 1280;
constexpr int DFF = 8192;
constexpr int PC_AQ = 0, PC_AK = 512, PC_BCQ = 1024, PC_BCKV = 1536, PC_CQ = 2048, PC_CK = 2560, PC_DQ = 2816, PC_DK = 4352, PC_BKR = 4864;
constexpr float LOG2E = 1.4426950408889634f;
constexpr float EPS = 1e-6f;
constexpr int TABA_N = 16384, TABA_OFF = 8192, TABD_N = 2304, TABD_OFF = 1152;

constexpr size_t MiB = 1u << 20;
constexpr size_t WS_CTL = 0;
constexpr size_t WS_TABA = 64 * 1024;
constexpr size_t WS_TABD = 384 * 1024;
constexpr size_t WS_W = 1 * MiB;
constexpr size_t WO_IN = 0;
constexpr size_t WO_INV = WO_IN + (size_t)NP * 2048 * 2;
constexpr size_t WO_G = WO_INV + (size_t)NVT * 2048 * 2;
constexpr size_t WO_B = WO_G + (size_t)8192 * 2048 * 2;
constexpr size_t WO_O = WO_B + (size_t)8192 * 512 * 2;
constexpr size_t WO_1 = WO_O + (size_t)2048 * 2048 * 2;
constexpr size_t WO_2 = WO_1 + (size_t)8192 * 2048 * 2;
constexpr size_t WO_PG = WO_2 + (size_t)2048 * 8192 * 2;
constexpr size_t WO_PP = WO_PG + (size_t)2048 * 2048 * 2;
constexpr size_t WO_UQ = WO_PP + (size_t)2048 * 256 * 2;
constexpr size_t WO_UKN = WO_UQ + (size_t)768 * 512 * 2;
constexpr size_t WO_UKV = WO_UKN + (size_t)512 * 512 * 2;
constexpr size_t WO_END = WO_UKV + (size_t)512 * 512 * 2;
static_assert(WO_END <= 148 * MiB, "weights");
constexpr size_t WS_H = WS_W + 148 * MiB;
constexpr size_t WS_R1 = WS_H + (size_t)TCM * 2048 * 2;
constexpr size_t R1_PROJ = 0;
constexpr size_t R1_VT = R1_PROJ + (size_t)TCM * NP * 2;
constexpr size_t R1_QB = R1_VT + (size_t)NVT * TCM * 2;
constexpr size_t R1_KB = R1_QB + (size_t)TCM * 768 * 2;
constexpr size_t R1_VTB = R1_KB + (size_t)TCM * 768 * 2;
constexpr size_t R1_END = R1_VTB + (size_t)512 * TCM * 2;
static_assert(R1_END >= (size_t)TCM * 8192 * 2, "Y / FFH overlay");
constexpr size_t WS_R2 = WS_R1 + R1_END;
constexpr size_t WS_R3 = WS_R2 + (size_t)TCM * 2048 * 4;
constexpr size_t WS_END = WS_R3 + (size_t)TCM * 2048 * 2;

constexpr int LDS_BYTES = 147456;

__device__ __forceinline__ unsigned cvt_pk_bf16(float lo, float hi) { unsigned r; asm volatile("v_cvt_pk_bf16_f32 %0, %1, %2" : "=v"(r) : "v"(lo), "v"(hi)); return r; }
__device__ __forceinline__ float bf_lo(unsigned u) { return __uint_as_float(u << 16); }
__device__ __forceinline__ float bf_hi(unsigned u) { return __uint_as_float(u & 0xffff0000u); }
__device__ __forceinline__ float wave_sum(float v) {
#pragma unroll
    for (int o = 1; o < 64; o <<= 1) v += __shfl_xor(v, o);
    return v;
}
__device__ __forceinline__ float sigmoidf_fast(float x) { return __builtin_amdgcn_rcpf(1.0f + __builtin_amdgcn_exp2f(-x * LOG2E)); }
__device__ __forceinline__ const float* xrow_ptr(const float* s0, const float* s1, int m) { return m < TP ? s0 + (size_t)m * DM : s1 + (size_t)(m - TP) * DM; }

namespace pg8 {
constexpr int BM = 256, BK = 64, HALF = 128, HTB = HALF * BK * 2, STAGE_BYTES = 8 * HTB, NXCD = 8, WGM = 8;
__host__ __device__ __forceinline__ int lds_byte(int r, int c) { const int st = (r >> 4) * 2 + (c >> 5), rr = r & 15, cc = c & 31, ob = rr * 64 + cc * 2; return st * 1024 + (ob ^ (((ob >> 9) & 1) << 5)); }
__host__ __device__ __forceinline__ void stage_rc(int b, int& R, int& C) { const int st = b / 1024, sb = b % 1024, swz = sb ^ (((sb >> 9) & 1) << 5); R = (st >> 1) * 16 + swz / 64; C = (st & 1) * 32 + (swz % 64) / 2; }
__host__ __device__ __forceinline__ int perm32(int rho) { const int n = rho >> 4, i = rho & 15; return 8 * (i >> 2) + 4 * n + (i & 3); }

struct Unit { int pm, pn; long aoff; };
struct Gemm { const bf16_t* A; const bf16_t* Bt; int lda, ldb, K; };

struct Order {
    int nM, nN, nwg, G, c, rep, adiv; long astep;
    __device__ void init(int nM_, int nN_, int G_, int c_, int rep_, int adiv_, long astep_) { nM = nM_; nN = nN_; nwg = nM * nN; G = G_; c = c_; rep = rep_; adiv = adiv_; astep = astep_; }
    __device__ bool next(int i, Unit& u) const {
        const int t = i / rep, sub = i - t * rep;
        const long L = (long)t * G + c; if (L >= nwg) return false;
        int wgid = (int)L; { const int q = nwg / NXCD, r = nwg % NXCD, xcd = wgid % NXCD, off = wgid / NXCD; wgid = (xcd < r ? xcd * (q + 1) : r * (q + 1) + (xcd - r) * q) + off; }
        const int nig = WGM * nN, gid = wgid / nig, fm = gid * WGM, gsz = (nM - fm) < WGM ? (nM - fm) : WGM;
        u.pm = fm + ((wgid % nig) % gsz); const int pn = (wgid % nig) / gsz; u.pn = pn + sub * nN; u.aoff = (long)(pn / adiv) * astep; return true;
    }
};

enum { EK_BF16 = 0, EK_SPLIT192 = 1, EK_RELU2 = 2, EK_GATE = 3, EK_RES = 4, EK_PLE = 5 };
struct Epi {
    static constexpr bool PERM = true;
    int kind; bf16_t* O; long ldc; const bf16_t* Y; float* part; const float* xs0; const float* xs1; float* xout; int m0;
    __device__ __forceinline__ void operator()(const f32x4 (&acc)[2][2][4][2], const Unit& u, int wr, int wc, int fr, int fq) const {
        const int row0 = u.pm * BM + wr * 64 + fr, col0 = u.pn * BM + wc * 32 + 8 * fq;
        if (kind <= EK_RELU2) {
#pragma unroll
            for (int ai = 0; ai < 2; ++ai)
#pragma unroll
                for (int m = 0; m < 4; ++m) { const int row = row0 + ai * HALF + m * 16;
#pragma unroll
                    for (int bj = 0; bj < 2; ++bj) { int col = col0 + bj * HALF; f32x4 v0 = acc[ai][bj][m][0], v1 = acc[ai][bj][m][1];
                        if (kind == EK_RELU2) {
#pragma unroll
                            for (int e = 0; e < 4; ++e) { float a = fmaxf(v0[e], 0.f), b = fmaxf(v1[e], 0.f); v0[e] = a * a; v1[e] = b * b; } }
                        if (kind == EK_SPLIT192) col = (col >> 7) * 192 + (col & 127);
                        u32x4 w; w.x = cvt_pk_bf16(v0[0], v0[1]); w.y = cvt_pk_bf16(v0[2], v0[3]); w.z = cvt_pk_bf16(v1[0], v1[1]); w.w = cvt_pk_bf16(v1[2], v1[3]);
                        *(u32x4*)(O + (size_t)row * ldc + col) = w; } }
        } else if (kind == EK_GATE) {
            const int b = col0 >> 11, cc = col0 & 2047;
#pragma unroll
            for (int ai = 0; ai < 2; ++ai)
#pragma unroll
                for (int m = 0; m < 4; ++m) { const int row = row0 + ai * HALF + m * 16;
#pragma unroll
                    for (int bj = 0; bj < 2; ++bj) { const int c = cc + bj * HALF; f32x4 v0 = acc[ai][bj][m][0], v1 = acc[ai][bj][m][1];
                        const u32x4 y = *(const u32x4*)(Y + (size_t)row * 8192 + (size_t)b * 2048 + c);
                        float* pp = part + (size_t)row * 2048 + c;
                        f32x4 p0 = (f32x4){0.f, 0.f, 0.f, 0.f}, p1 = p0;
                        if (b > 0) { p0 = *(const f32x4*)pp; p1 = *(const f32x4*)(pp + 4); }
                        p0[0] += sigmoidf_fast(v0[0]) * bf_lo(y.x); p0[1] += sigmoidf_fast(v0[1]) * bf_hi(y.x);
                        p0[2] += sigmoidf_fast(v0[2]) * bf_lo(y.y); p0[3] += sigmoidf_fast(v0[3]) * bf_hi(y.y);
                        p1[0] += sigmoidf_fast(v1[0]) * bf_lo(y.z); p1[1] += sigmoidf_fast(v1[1]) * bf_hi(y.z);
                        p1[2] += sigmoidf_fast(v1[2]) * bf_lo(y.w); p1[3] += sigmoidf_fast(v1[3]) * bf_hi(y.w);
                        if (b < 3) { *(f32x4*)pp = p0; *(f32x4*)(pp + 4) = p1; }
                        else { u32x4 w; w.x = cvt_pk_bf16(p0[0], p0[1]); w.y = cvt_pk_bf16(p0[2], p0[3]); w.z = cvt_pk_bf16(p1[0], p1[1]); w.w = cvt_pk_bf16(p1[2], p1[3]);
                            *(u32x4*)(O + (size_t)row * 2048 + c) = w; } } }
        } else {
#pragma unroll
            for (int ai = 0; ai < 2; ++ai)
#pragma unroll
                for (int m = 0; m < 4; ++m) { const int row = row0 + ai * HALF + m * 16; const int gm = m0 + row;
                    const float* xs = xrow_ptr(xs0, xs1, gm); float* xo = xout + (size_t)gm * DM;
#pragma unroll
                    for (int bj = 0; bj < 2; ++bj) { const int col = col0 + bj * HALF; f32x4 v0 = acc[ai][bj][m][0], v1 = acc[ai][bj][m][1];
                        const f32x4 x0 = *(const f32x4*)(xs + col), x1 = *(const f32x4*)(xs + col + 4);
                        if (kind == EK_PLE) { const u32x4 y = *(const u32x4*)(Y + (size_t)row * 2048 + col);
                            v0[0] = sigmoidf_fast(v0[0]) * bf_lo(y.x); v0[1] = sigmoidf_fast(v0[1]) * bf_hi(y.x); v0[2] = sigmoidf_fast(v0[2]) * bf_lo(y.y); v0[3] = sigmoidf_fast(v0[3]) * bf_hi(y.y);
                            v1[0] = sigmoidf_fast(v1[0]) * bf_lo(y.z); v1[1] = sigmoidf_fast(v1[1]) * bf_hi(y.z); v1[2] = sigmoidf_fast(v1[2]) * bf_lo(y.w); v1[3] = sigmoidf_fast(v1[3]) * bf_hi(y.w); }
                        *(f32x4*)(xo + col) = x0 + v0; *(f32x4*)(xo + col + 4) = x1 + v1; } }
        }
    }
};

template <bool ALIGN_EPI = true>
__device__ __forceinline__ void gemm_phase(LAS unsigned char* lds, const Gemm g, const Order& S, const Epi& E, const int tid) {
    const int wid = __builtin_amdgcn_readfirstlane(tid >> 6), lane = tid & 63, wr = wid >> 2, wc = wid & 3, fr = lane & 15, fq = lane >> 4;
    const int K = g.K, nt = K / BK;
    unsigned voffA[2], voffB[2];
#pragma unroll
    for (int i = 0; i < 2; ++i) { int R, C; stage_rc(tid * 16 + i * 8192, R, C); const int Rb = Epi::PERM ? ((R & ~31) + perm32(R & 31)) : R;
        voffA[i] = (unsigned)(R * g.lda + C) * 2u; voffB[i] = (unsigned)(Rb * g.ldb + C) * 2u; }
    const size_t kstep = (size_t)(BK * 2);
    const size_t hstA = (size_t)HALF * g.lda * 2, hstB = (size_t)HALF * g.ldb * 2;
    const size_t tstA = 2 * hstA, tstB = 2 * hstB;
    const unsigned ldsw = (unsigned)wid * 1024u;
    const int aoff = lds_byte(wr * 64 + fr, fq * 8), boff = lds_byte(wc * 32 + fr, fq * 8);
#define PG8_SA(b, h) (((b) * 2 + (h)) * HTB)
#define PG8_SB(b, h) ((4 + (b) * 2 + (h)) * HTB)
#define PG8_STAGE(bufoff, gbase, voff) do { _Pragma("unroll") for (int _i = 0; _i < 2; ++_i) \
        __builtin_amdgcn_global_load_lds((const unsigned*)((const char*)(gbase) + (voff)[_i]), (LAS unsigned*)(lds + (bufoff) + ldsw + _i * 8192), 16, 0, 0); } while (0)
#define PG8_LDA(dst, b, h) do { _Pragma("unroll") for (int m = 0; m < 4; ++m) _Pragma("unroll") for (int k = 0; k < 2; ++k) dst[m][k] = *(const LAS bf16x8*)(lds + PG8_SA(b, h) + aoff + m * 2048 + k * 1024); } while (0)
#define PG8_LDB(dst, b, h) do { _Pragma("unroll") for (int n = 0; n < 2; ++n) _Pragma("unroll") for (int k = 0; k < 2; ++k) dst[n][k] = *(const LAS bf16x8*)(lds + PG8_SB(b, h) + boff + n * 2048 + k * 1024); } while (0)
#define PG8_MMA(ai, bj, At, Bt) do { __builtin_amdgcn_s_setprio(1); _Pragma("unroll") for (int m = 0; m < 4; ++m) _Pragma("unroll") for (int n = 0; n < 2; ++n) _Pragma("unroll") for (int k = 0; k < 2; ++k) \
        acc[ai][bj][m][n] = __builtin_amdgcn_mfma_f32_16x16x32_bf16(Bt[n][k], At[m][k], acc[ai][bj][m][n], 0, 0, 0); __builtin_amdgcn_s_setprio(0); } while (0)
#define PG8_WAIT_V(n) asm volatile("s_waitcnt vmcnt(" #n ")" ::: "memory")
#define PG8_WAIT_L(n) asm volatile("s_waitcnt lgkmcnt(" #n ")" ::: "memory")
#define PG8_BAR __builtin_amdgcn_s_barrier()
#define PG8_SCHED __builtin_amdgcn_sched_barrier(0)
    Unit cur, nxt; int ui = 0;
    if (!S.next(0, cur)) return;
    f32x4 acc[2][2][4][2];
#pragma unroll
    for (int a = 0; a < 2; ++a)
#pragma unroll
        for (int b = 0; b < 2; ++b)
#pragma unroll
            for (int m = 0; m < 4; ++m)
#pragma unroll
                for (int n = 0; n < 2; ++n) acc[a][b][m][n] = (f32x4){0.f, 0.f, 0.f, 0.f};
    bf16x8 At[4][2], B0[2][2], B1[2][2];
    const char* cA = (const char*)g.A + (size_t)cur.pm * tstA + cur.aoff; const char* cB = (const char*)g.Bt + (size_t)cur.pn * tstB;
    PG8_STAGE(PG8_SB(0, 0), cB, voffB); PG8_STAGE(PG8_SB(0, 1), cB + hstB, voffB); PG8_STAGE(PG8_SA(0, 0), cA, voffA); PG8_STAGE(PG8_SA(0, 1), cA + hstA, voffA);
    if (wr == 1) PG8_BAR;
    PG8_WAIT_V(2); PG8_BAR;
    PG8_STAGE(PG8_SB(1, 0), cB + kstep, voffB); PG8_STAGE(PG8_SA(1, 0), cA + kstep, voffA); PG8_STAGE(PG8_SB(1, 1), cB + hstB + kstep, voffB);
    PG8_WAIT_V(6); PG8_BAR;
    for (;;) {
        const bool has_next = S.next(ui + 1, nxt);
        const char* nA = has_next ? (const char*)g.A + (size_t)nxt.pm * tstA + nxt.aoff : cA; const char* nB = has_next ? (const char*)g.Bt + (size_t)nxt.pn * tstB : cB;
        for (int t = 0; t < nt; t += 2) {
            const bool last = (t == nt - 2);
            const char* a1 = cA + (size_t)(t + 1) * kstep;
            const char* a2 = last ? nA : cA + (size_t)(t + 2) * kstep; const char* b2 = last ? nB : cB + (size_t)(t + 2) * kstep;
            const char* a3 = a2 + kstep; const char* b3 = b2 + kstep;
            PG8_LDB(B0, 0, 0); PG8_LDB(B1, 0, 1); PG8_SCHED; PG8_LDA(At, 0, 0); PG8_STAGE(PG8_SA(1, 1), a1 + hstA, voffA);
            PG8_WAIT_V(8); PG8_WAIT_L(0); PG8_BAR; PG8_MMA(0, 0, At, B0); PG8_MMA(0, 1, At, B1); PG8_BAR; PG8_SCHED;
            PG8_LDA(At, 0, 1); PG8_STAGE(PG8_SB(0, 0), b2, voffB); PG8_STAGE(PG8_SB(0, 1), b2 + hstB, voffB); PG8_STAGE(PG8_SA(0, 0), a2, voffA);
            PG8_WAIT_V(8); PG8_WAIT_L(0); PG8_BAR; PG8_MMA(1, 0, At, B0); PG8_MMA(1, 1, At, B1); PG8_BAR; PG8_SCHED;
            PG8_LDB(B0, 1, 0); PG8_LDB(B1, 1, 1); PG8_SCHED; PG8_LDA(At, 1, 0); PG8_STAGE(PG8_SA(0, 1), a2 + hstA, voffA);
            PG8_WAIT_V(8); PG8_WAIT_L(0); PG8_BAR; PG8_MMA(0, 0, At, B0); PG8_MMA(0, 1, At, B1); PG8_BAR; PG8_SCHED;
            PG8_LDA(At, 1, 1); PG8_STAGE(PG8_SB(1, 0), b3, voffB); PG8_STAGE(PG8_SB(1, 1), b3 + hstB, voffB); PG8_STAGE(PG8_SA(1, 0), a3, voffA);
            PG8_WAIT_V(8); PG8_WAIT_L(0); PG8_BAR; PG8_MMA(1, 0, At, B0); PG8_MMA(1, 1, At, B1); PG8_BAR; PG8_SCHED;
        }
        if constexpr (ALIGN_EPI) { if (wr == 0) PG8_BAR; }
        E(acc, cur, wr, wc, fr, fq);
        if (!has_next) break;
#pragma unroll
        for (int a = 0; a < 2; ++a)
#pragma unroll
            for (int b = 0; b < 2; ++b)
#pragma unroll
                for (int m = 0; m < 4; ++m)
#pragma unroll
                    for (int n = 0; n < 2; ++n) acc[a][b][m][n] = (f32x4){0.f, 0.f, 0.f, 0.f};
        cur = nxt; cA = nA; cB = nB; ++ui;
        if constexpr (ALIGN_EPI) { if (wr == 1) PG8_BAR; }
    }
    PG8_WAIT_V(0);
    if constexpr (!ALIGN_EPI) { if (wr == 0) PG8_BAR; }
    PG8_BAR;
#undef PG8_SA
#undef PG8_SB
#undef PG8_STAGE
#undef PG8_LDA
#undef PG8_LDB
#undef PG8_MMA
#undef PG8_WAIT_V
#undef PG8_WAIT_L
#undef PG8_BAR
#undef PG8_SCHED
}
}

struct Args { const float* in[33]; float* out; unsigned char* ws; int ph_lo, ph_hi; };
enum { I_XP = 0, I_XS, I_PP, I_PS, I_RELB, I_NMIX, I_WIN, I_AQN, I_AKN, I_ALQ1, I_ALK1, I_ALQ2, I_ALK2, I_AON, I_BCQN, I_BCKVN, I_BWUQ, I_BWUKV, I_BQN, I_BKN,
       I_CQN, I_CKN, I_DQN, I_DKN, I_WG, I_WB, I_WO, I_NFFN, I_W1, I_W2, I_NPLE, I_WPG, I_WPP };

__device__ __forceinline__ int rel_bucket(int rel) {
    const int n = rel < 0 ? -rel : rel;
    const float nf = (float)(n > 1 ? n : 1);
    int large = 8 + (int)(logf(nf / 8.0f) / 4.852030263919617f * 8.0f);
    large = large < 15 ? large : 15;
    return (rel > 0 ? 16 : 0) + (n < 8 ? n : large);
}
__device__ __forceinline__ void build_tables(const float* relb, float* tabA, float* tabD, int gtid, int gthreads) {
    for (int i = gtid; i < 4 * TABA_N; i += gthreads) { const int h = i / TABA_N, d = i % TABA_N - TABA_OFF; tabA[i] = relb[rel_bucket(d) * 16 + h] * LOG2E; }
    for (int i = gtid; i < 12 * TABD_N; i += gthreads) { const int gh = i / TABD_N, d = i % TABD_N - TABD_OFF; const int g = gh >> 2; const int dil = g == 0 ? 1 : (g == 1 ? 4 : 16);
        const int ad = d < 0 ? -d : d; const bool ok = (ad % dil == 0) && (ad <= 64 * dil);
        tabD[i] = ok ? relb[rel_bucket(d) * 16 + 4 + gh] * LOG2E : -1e30f; }
}
__device__ __forceinline__ void transpose_item(const float* W, int N, int k0, int n0, bf16_t* dst, int K, LAS float* scr, int lane) {
#pragma unroll 8
    for (int i = 0; i < 32; ++i) { const int kk = 2 * i + (lane >> 5); scr[kk * 33 + (lane & 31)] = W[(size_t)(k0 + kk) * N + n0 + (lane & 31)]; }
    asm volatile("s_waitcnt lgkmcnt(0)" ::: "memory");
    const int c = lane & 7;
#pragma unroll
    for (int j = 0; j < 4; ++j) { const int n = (lane >> 3) + 8 * j; const LAS float* s = scr + (8 * c) * 33 + n;
        u32x4 o; o.x = cvt_pk_bf16(s[0 * 33], s[1 * 33]); o.y = cvt_pk_bf16(s[2 * 33], s[3 * 33]); o.z = cvt_pk_bf16(s[4 * 33], s[5 * 33]); o.w = cvt_pk_bf16(s[6 * 33], s[7 * 33]);
        *(u32x4*)(dst + (size_t)n * K + k0 + 8 * c) = o; }
    asm volatile("s_waitcnt lgkmcnt(0)" ::: "memory");
}
__device__ __forceinline__ int win_row(int n0) {
    if (n0 < 512) return PC_AQ + n0;
    if (n0 < 1024) return PC_AK + (n0 - 512);
    if (n0 < 1536) return -(0 + (n0 - 1024) + 1);
    if (n0 < 2048) return PC_BCQ + (n0 - 1536);
    if (n0 < 2560) return PC_BCKV + (n0 - 2048);
    if (n0 < 2624) return PC_BKR + (n0 - 2560);
    if (n0 < 3136) return PC_CQ + (n0 - 2624);
    if (n0 < 3392) return PC_CK + (n0 - 3136);
    if (n0 < 3648) return -(512 + (n0 - 3392) + 1);
    if (n0 < 5184) return PC_DQ + (n0 - 3648);
    if (n0 < 5696) return PC_DK + (n0 - 5184);
    return -(768 + (n0 - 5696) + 1);
}
__device__ __forceinline__ void convert_weights(const Args& a, int layer, unsigned char* W, LAS float* scr, int gw, int ngw, int lane) {
    constexpr int I_IN = 32 * 194, I_G = 4 * 32 * 64, I_B = 4 * 8 * 64, I_O = 32 * 64, I_1 = 32 * 256, I_2 = 128 * 64, I_PG = 32 * 64, I_PPn = 4 * 64, I_UQ = 8 * 24, I_UKV = 8 * 32;
    constexpr int NIT = I_IN + I_G + I_B + I_O + I_1 + I_2 + I_PG + I_PPn + I_UQ + I_UKV;
    for (int it = gw; it < NIT; it += ngw) {
        int r = it;
        if (r < I_IN) { const int kb = r / 194, nb = r % 194; const int dr = win_row(nb * 32);
            bf16_t* dst = dr >= 0 ? (bf16_t*)(W + WO_IN) + (size_t)dr * 2048 : (bf16_t*)(W + WO_INV) + (size_t)(-dr - 1) * 2048;
            transpose_item(a.in[I_WIN] + (size_t)layer * 2048 * 6208, 6208, kb * 64, nb * 32, dst, 2048, scr, lane); continue; } r -= I_IN;
        if (r < I_G) { const int b = r / 2048, q = r % 2048, kb = q / 64, nb = q % 64;
            transpose_item(a.in[I_WG] + ((size_t)layer * 4 + b) * 2048 * 2048, 2048, kb * 64, nb * 32, (bf16_t*)(W + WO_G) + ((size_t)b * 2048 + nb * 32) * 2048, 2048, scr, lane); continue; } r -= I_G;
        if (r < I_B) { const int b = r / 512, q = r % 512, kb = q / 64, nb = q % 64;
            transpose_item(a.in[I_WB] + ((size_t)layer * 4 + b) * 512 * 2048, 2048, kb * 64, nb * 32, (bf16_t*)(W + WO_B) + ((size_t)b * 2048 + nb * 32) * 512, 512, scr, lane); continue; } r -= I_B;
        if (r < I_O) { const int kb = r / 64, nb = r % 64;
            transpose_item(a.in[I_WO] + (size_t)layer * 2048 * 2048, 2048, kb * 64, nb * 32, (bf16_t*)(W + WO_O) + (size_t)(nb * 32) * 2048, 2048, scr, lane); continue; } r -= I_O;
        if (r < I_1) { const int kb = r / 256, nb = r % 256;
            transpose_item(a.in[I_W1] + (size_t)layer * 2048 * 8192, 8192, kb * 64, nb * 32, (bf16_t*)(W + WO_1) + (size_t)(nb * 32) * 2048, 2048, scr, lane); continue; } r -= I_1;
        if (r < I_2) { const int kb = r / 64, nb = r % 64;
            transpose_item(a.in[I_W2] + (size_t)layer * 8192 * 2048, 2048, kb * 64, nb * 32, (bf16_t*)(W + WO_2) + (size_t)(nb * 32) * 8192, 8192, scr, lane); continue; } r -= I_2;
        if (r < I_PG) { const int kb = r / 64, nb = r % 64;
            transpose_item(a.in[I_WPG] + (size_t)layer * 2048 * 2048, 2048, kb * 64, nb * 32, (bf16_t*)(W + WO_PG) + (size_t)(nb * 32) * 2048, 2048, scr, lane); continue; } r -= I_PG;
        if (r < I_PPn) { const int kb = r / 64, nb = r % 64;
            transpose_item(a.in[I_WPP] + (size_t)layer * 256 * 2048, 2048, kb * 64, nb * 32, (bf16_t*)(W + WO_PP) + (size_t)(nb * 32) * 256, 256, scr, lane); continue; } r -= I_PPn;
        if (r < I_UQ) { const int kb = r / 24, nb = r % 24;
            transpose_item(a.in[I_BWUQ] + (size_t)layer * 512 * 768, 768, kb * 64, nb * 32, (bf16_t*)(W + WO_UQ) + (size_t)(nb * 32) * 512, 512, scr, lane); continue; } r -= I_UQ;
        { const int kb = r / 32, nb = r % 32; const int n0 = nb * 32, h = n0 >> 8, j0 = n0 & 255;
            bf16_t* dst = j0 < 128 ? (bf16_t*)(W + WO_UKN) + (size_t)(h * 128 + j0) * 512 : (bf16_t*)(W + WO_UKV) + (size_t)(h * 128 + j0 - 128) * 512;
            transpose_item(a.in[I_BWUKV] + (size_t)layer * 512 * 1024, 1024, kb * 64, n0, dst, 512, scr, lane); }
    }
}

__device__ __forceinline__ void norm_row(const float* x, const float* g, bf16_t* out, int lane) {
    f32x4 v[8]; float s = 0.f;
#pragma unroll
    for (int j = 0; j < 8; ++j) { v[j] = *(const f32x4*)(x + 4 * lane + 256 * j); s += (v[j][0] * v[j][0] + v[j][1] * v[j][1]) + (v[j][2] * v[j][2] + v[j][3] * v[j][3]); }
    const float rs = 1.0f / sqrtf(wave_sum(s) * (1.0f / 2048.0f) + EPS);
#pragma unroll
    for (int j = 0; j < 8; ++j) { const f32x4 gg = *(const f32x4*)(g + 4 * lane + 256 * j);
        u32x2 w; w.x = cvt_pk_bf16(v[j][0] * rs * gg[0], v[j][1] * rs * gg[1]); w.y = cvt_pk_bf16(v[j][2] * rs * gg[2], v[j][3] * rs * gg[3]);
        *(u32x2*)(out + 4 * lane + 256 * j) = w; }
}
__device__ __forceinline__ void load8(const bf16_t* p, float (&f)[8]) { const u32x4 v = *(const u32x4*)p; f[0] = bf_lo(v.x); f[1] = bf_hi(v.x); f[2] = bf_lo(v.y); f[3] = bf_hi(v.y); f[4] = bf_lo(v.z); f[5] = bf_hi(v.z); f[6] = bf_lo(v.w); f[7] = bf_hi(v.w); }
__device__ __forceinline__ void store8(bf16_t* p, const float (&f)[8]) { u32x4 w; w.x = cvt_pk_bf16(f[0], f[1]); w.y = cvt_pk_bf16(f[2], f[3]); w.z = cvt_pk_bf16(f[4], f[5]); w.w = cvt_pk_bf16(f[6], f[7]); *(u32x4*)p = w; }
template <int GRP> __device__ __forceinline__ void norm8(float (&f)[8], const float* g, float scale, int lane) {
    float s = 0.f;
#pragma unroll
    for (int e = 0; e < 8; ++e) s += f[e] * f[e];
#pragma unroll
    for (int o = 1; o < GRP; o <<= 1) s += __shfl_xor(s, o);
    const float rs = scale / sqrtf(s * (1.0f / (GRP * 8)) + EPS);
    const int gi = (lane & (GRP - 1)) * 8;
#pragma unroll
    for (int e = 0; e < 8; ++e) f[e] = f[e] * rs * g[gi + e];
}
__device__ __forceinline__ float rope_inv(int i) { return __builtin_amdgcn_exp2f(-(float)i * (13.287712379549449f / 32.0f)) * 0.15915494309189535f; }
__device__ __forceinline__ void sincos_rev(float rev, float& sn, float& cs) { rev -= rintf(rev); sn = __builtin_amdgcn_sinf(rev); cs = __builtin_amdgcn_cosf(rev); }
__device__ __forceinline__ void axial_rope8(float (&f)[8], float rowpos, float colpos, int lane) {
    const int j = lane & 15, hf = j >> 3, jj = j & 7; const float pos = hf ? colpos : rowpos; const float sgn = jj < 4 ? -1.f : 1.f; const int i0 = 8 * (jj & 3);
#pragma unroll
    for (int e = 0; e < 8; ++e) { const float pv = __shfl_xor(f[e], 4); float sn, cs; sincos_rev(pos * rope_inv(i0 + e), sn, cs); f[e] = f[e] * cs + sgn * pv * sn; }
}
__device__ __forceinline__ void post1_row(const Args& a, int layer, bf16_t* P, int tseq, int lane) {
    float f[8];
    const float sA = 0.125f * LOG2E, sC = 0.08838834764831845f * LOG2E;
    load8(P + PC_AQ + 8 * lane, f); norm8<8>(f, a.in[I_AQN] + layer * 64, sA, lane); store8(P + PC_AQ + 8 * lane, f);
    load8(P + PC_AK + 8 * lane, f); norm8<8>(f, a.in[I_AKN] + layer * 64, 1.f, lane); store8(P + PC_AK + 8 * lane, f);
    load8(P + PC_BCQ + 8 * lane, f); norm8<64>(f, a.in[I_BCQN] + layer * 512, 1.f, lane); store8(P + PC_BCQ + 8 * lane, f);
    load8(P + PC_BCKV + 8 * lane, f); norm8<64>(f, a.in[I_BCKVN] + layer * 512, 1.f, lane); store8(P + PC_BCKV + 8 * lane, f);
    const float rowpos = (float)(tseq >> 6), colpos = (float)(tseq & 63);
    load8(P + PC_CQ + 8 * lane, f); norm8<16>(f, a.in[I_CQN] + layer * 128, sC, lane); axial_rope8(f, rowpos, colpos, lane); store8(P + PC_CQ + 8 * lane, f);
    { const int l2 = lane & 31; load8(P + PC_CK + 8 * l2, f); norm8<16>(f, a.in[I_CKN] + layer * 128, 1.f, lane); axial_rope8(f, rowpos, colpos, lane); if (lane < 32) store8(P + PC_CK + 8 * l2, f); }
#pragma unroll
    for (int p = 0; p < 3; ++p) { load8(P + PC_DQ + 512 * p + 8 * lane, f); norm8<16>(f, a.in[I_DQN] + layer * 128, sC, lane); store8(P + PC_DQ + 512 * p + 8 * lane, f); }
    load8(P + PC_DK + 8 * lane, f); norm8<16>(f, a.in[I_DKN] + layer * 128, 1.f, lane); store8(P + PC_DK + 8 * lane, f);
}
__device__ __forceinline__ void mla_norm_rope(float (&f)[8], float (&r)[4], const float* g, float scale, float pos, int lane) {
    const int j = lane & 15;
    float s = 0.f;
#pragma unroll
    for (int e = 0; e < 8; ++e) s += f[e] * f[e];
#pragma unroll
    for (int e = 0; e < 4; ++e) s += r[e] * r[e];
#pragma unroll
    for (int o = 1; o < 16; o <<= 1) s += __shfl_xor(s, o);
    const float rs = scale / sqrtf(s * (1.0f / 192.0f) + EPS);
#pragma unroll
    for (int e = 0; e < 8; ++e) f[e] = f[e] * rs * g[8 * j + e];
#pragma unroll
    for (int e = 0; e < 4; ++e) r[e] = r[e] * rs * g[128 + 4 * j + e];
    const float sgn = j < 8 ? -1.f : 1.f; const int i0 = 4 * (j & 7);
#pragma unroll
    for (int e = 0; e < 4; ++e) { const float pv = __shfl_xor(r[e], 8); float sn, cs; sincos_rev(pos * rope_inv(i0 + e), sn, cs); r[e] = r[e] * cs + sgn * pv * sn; }
}
__device__ __forceinline__ void post2_row(const Args& a, int layer, bf16_t* Q, bf16_t* Kr, const bf16_t* P, int tseq, int lane) {
    const int h = lane >> 4, j = lane & 15; const float pos = (float)tseq;
    float f[8], r[4];
    { bf16_t* q = Q + h * 192; load8(q + 8 * j, f); const u32x2 v = *(const u32x2*)(q + 128 + 4 * j); r[0] = bf_lo(v.x); r[1] = bf_hi(v.x); r[2] = bf_lo(v.y); r[3] = bf_hi(v.y);
      mla_norm_rope(f, r, a.in[I_BQN] + layer * 192, 0.07216878364870323f * LOG2E, pos, lane);
      store8(q + 8 * j, f); u32x2 w; w.x = cvt_pk_bf16(r[0], r[1]); w.y = cvt_pk_bf16(r[2], r[3]); *(u32x2*)(q + 128 + 4 * j) = w; }
    { bf16_t* k = Kr + h * 192; load8(k + 8 * j, f); const u32x2 v = *(const u32x2*)(P + PC_BKR + 4 * j); r[0] = bf_lo(v.x); r[1] = bf_hi(v.x); r[2] = bf_lo(v.y); r[3] = bf_hi(v.y);
      mla_norm_rope(f, r, a.in[I_BKN] + layer * 192, 1.f, pos, lane);
      store8(k + 8 * j, f); u32x2 w; w.x = cvt_pk_bf16(r[0], r[1]); w.y = cvt_pk_bf16(r[2], r[3]); *(u32x2*)(k + 128 + 4 * j) = w; }
}

struct AState { float m, l; f32x16 o[4]; };
__device__ __forceinline__ void astate_init(AState& st) { st.m = -3.0e38f; st.l = 0.f;
#pragma unroll
    for (int d = 0; d < 4; ++d)
#pragma unroll
        for (int r = 0; r < 16; ++r) st.o[d][r] = 0.f; }
template <int DK, bool TAB, bool QLDS = false>
__device__ __forceinline__ void attn_pass(AState& st, const bf16_t* qp, const bf16_t* kp, long ldk, const bf16_t* vp, long ldv, int kbeg, int kend, const float* tp, LAS bf16x8* qst = nullptr) {
    constexpr int NS = DK / 16;
    bf16x8 qf[QLDS ? 1 : NS], kf[NS];
    if (QLDS) {
#pragma unroll
        for (int s = 0; s < NS; ++s) qst[s * 64] = *(const bf16x8*)(qp + 16 * s);
    } else {
#pragma unroll
        for (int s = 0; s < NS; ++s) qf[s] = *(const bf16x8*)(qp + 16 * s);
    }
    { const bf16_t* k0p = kp + (long)kbeg * ldk;
#pragma unroll
      for (int s = 0; s < NS; ++s) kf[s] = *(const bf16x8*)(k0p + 16 * s); }
    for (int k0 = kbeg; k0 < kend; k0 += 32) {
        bf16x8 vf[4][2];
#pragma unroll
        for (int d = 0; d < 4; ++d)
#pragma unroll
            for (int s = 0; s < 2; ++s) vf[d][s] = *(const bf16x8*)(vp + (long)(32 * d) * ldv + k0 + 16 * s);
        f32x4 tb[4];
        if (TAB) {
#pragma unroll
            for (int s = 0; s < 2; ++s) { tb[2 * s] = *(const f32x4u*)(tp + k0 + 16 * s); tb[2 * s + 1] = *(const f32x4u*)(tp + k0 + 16 * s + 4); } }
        f32x16 sc;
#pragma unroll
        for (int r = 0; r < 16; ++r) sc[r] = 0.f;
#pragma unroll
        for (int s = 0; s < NS; ++s) sc = __builtin_amdgcn_mfma_f32_32x32x16_bf16(kf[s], QLDS ? qst[s * 64] : qf[QLDS ? 0 : s], sc, 0, 0, 0);
        if (k0 + 32 < kend) { const bf16_t* knp = kp + (long)(k0 + 32) * ldk;
#pragma unroll
            for (int s = 0; s < NS; ++s) kf[s] = *(const bf16x8*)(knp + 16 * s); }
        if (TAB) {
#pragma unroll
            for (int r = 0; r < 16; ++r) sc[r] += tb[r >> 2][r & 3]; }
        float mx = sc[0];
#pragma unroll
        for (int r = 1; r < 16; ++r) mx = fmaxf(mx, sc[r]);
        mx = fmaxf(mx, __shfl_xor(mx, 32));
        const float mn = fmaxf(st.m, mx);
        const float alpha = __builtin_amdgcn_exp2f(st.m - mn);
        st.m = mn;
        float ps = 0.f;
#pragma unroll
        for (int r = 0; r < 16; ++r) { sc[r] = __builtin_amdgcn_exp2f(sc[r] - mn); ps += sc[r]; }
        st.l = st.l * alpha + ps;
#pragma unroll
        for (int d = 0; d < 4; ++d)
#pragma unroll
            for (int r = 0; r < 16; ++r) st.o[d][r] *= alpha;
        u32x4 p0, p1;
        p0.x = cvt_pk_bf16(sc[0], sc[1]); p0.y = cvt_pk_bf16(sc[2], sc[3]); p0.z = cvt_pk_bf16(sc[4], sc[5]); p0.w = cvt_pk_bf16(sc[6], sc[7]);
        p1.x = cvt_pk_bf16(sc[8], sc[9]); p1.y = cvt_pk_bf16(sc[10], sc[11]); p1.z = cvt_pk_bf16(sc[12], sc[13]); p1.w = cvt_pk_bf16(sc[14], sc[15]);
        const bf16x8 pf0 = __builtin_bit_cast(bf16x8, p0), pf1 = __builtin_bit_cast(bf16x8, p1);
#pragma unroll
        for (int d = 0; d < 4; ++d) { st.o[d] = __builtin_amdgcn_mfma_f32_32x32x16_bf16(vf[d][0], pf0, st.o[d], 0, 0, 0); st.o[d] = __builtin_amdgcn_mfma_f32_32x32x16_bf16(vf[d][1], pf1, st.o[d], 0, 0, 0); }
    }
}
__device__ __forceinline__ void astate_finish(AState& st) {
    const float l = st.l + __shfl_xor(st.l, 32); const float inv = 1.0f / l;
#pragma unroll
    for (int d = 0; d < 4; ++d)
#pragma unroll
        for (int r = 0; r < 16; ++r) st.o[d][r] *= inv;
}
__device__ __forceinline__ void store_o(const f32x16 (&o)[4], bf16_t* op) {
#pragma unroll
    for (int d = 0; d < 4; ++d)
#pragma unroll
        for (int g = 0; g < 4; ++g) { u32x2 w; w.x = cvt_pk_bf16(o[d][4 * g], o[d][4 * g + 1]); w.y = cvt_pk_bf16(o[d][4 * g + 2], o[d][4 * g + 3]); *(u32x2*)(op + 32 * d + 8 * g) = w; }
}
__device__ __forceinline__ int pi32(int n) { return (n & ~12) | ((n & 4) << 1) | ((n & 8) >> 1); }

struct AttnBufs { const bf16_t* PROJ; const bf16_t* VT; const bf16_t* QB; const bf16_t* KB; const bf16_t* VTB; bf16_t* BR; const float* tabA; const float* tabD; };

__device__ __forceinline__ void attn_unit(const Args& a, const AttnBufs& B, int layer, int mixer, int head, int row0  , int S, int q0  , int lane, LAS float* stash) {
#define ATT_LANE_SETUP int ln_ = lane; asm volatile("" : "+v"(ln_)); const int n = ln_ & 31, hi = ln_ >> 5, pr = pi32(n); const long qrow = (long)row0 + q0 + n; bf16_t* op = B.BR + qrow * 2048 + 4 * hi;
#ifdef ONLY_MIXER
    mixer = ONLY_MIXER;
#endif
    if (mixer == 0) {
        ATT_LANE_SETUP
        const float lam_init = layer == 0 ? 0.2f : 0.35550906759f;
        const float d1 = wave_sum(a.in[I_ALQ1][layer * 64 + lane] * a.in[I_ALK1][layer * 64 + lane]);
        const float d2 = wave_sum(a.in[I_ALQ2][layer * 64 + lane] * a.in[I_ALK2][layer * 64 + lane]);
        const float lam = expf(d1) - expf(d2) + lam_init;
        const bf16_t* vp = B.VT + (long)(head * 128 + n) * TCM + row0 + 8 * hi;
        const float* tp = B.tabA + head * TABA_N + TABA_OFF - (q0 + n) + 8 * hi;
        { AState st; astate_init(st);
          attn_pass<64, true>(st, B.PROJ + qrow * NP + PC_AQ + head * 128 + 8 * hi, B.PROJ + (long)(row0 + pr) * NP + PC_AK + head * 128 + 8 * hi, NP, vp, TCM, 0, S, tp);
          astate_finish(st);
#pragma unroll
          for (int d = 0; d < 4; ++d)
#pragma unroll
              for (int r = 0; r < 16; ++r) stash[(d * 16 + r) * 64 + lane] = st.o[d][r]; }
        AState st; astate_init(st);
        attn_pass<64, true>(st, B.PROJ + qrow * NP + PC_AQ + head * 128 + 64 + 8 * hi, B.PROJ + (long)(row0 + pr) * NP + PC_AK + head * 128 + 64 + 8 * hi, NP, vp, TCM, 0, S, tp);
        astate_finish(st);
        float ss = 0.f;
#pragma unroll
        for (int d = 0; d < 4; ++d)
#pragma unroll
            for (int r = 0; r < 16; ++r) { const float v = stash[(d * 16 + r) * 64 + lane] - lam * st.o[d][r]; st.o[d][r] = v; ss += v * v; }
        ss += __shfl_xor(ss, 32);
        const float rs = (1.0f - lam_init) / sqrtf(ss * (1.0f / 128.0f) + EPS);
        const float* gn = a.in[I_AON] + layer * 128 + 4 * hi;
#pragma unroll
        for (int d = 0; d < 4; ++d)
#pragma unroll
            for (int g = 0; g < 4; ++g) { const f32x4 gg = *(const f32x4*)(gn + 32 * d + 8 * g);
#pragma unroll
                for (int e = 0; e < 4; ++e) st.o[d][4 * g + e] *= rs * gg[e]; }
        store_o(st.o, op + head * 128);
    } else if (mixer == 1) {
        ATT_LANE_SETUP
        AState st; astate_init(st);
        attn_pass<192, false, true>(st, B.QB + qrow * 768 + head * 192 + 8 * hi, B.KB + (long)(row0 + pr) * 768 + head * 192 + 8 * hi, 768,
                              B.VTB + (long)(head * 128 + n) * TCM + row0 + 8 * hi, TCM, 0, S, nullptr, (LAS bf16x8*)stash + lane);
        astate_finish(st); store_o(st.o, op + 512 + head * 128);
    } else if (mixer == 2) {
        ATT_LANE_SETUP
        const int kv = head >> 1;
        AState st; astate_init(st);
        attn_pass<128, false>(st, B.PROJ + qrow * NP + PC_CQ + head * 128 + 8 * hi, B.PROJ + (long)(row0 + pr) * NP + PC_CK + kv * 128 + 8 * hi, NP,
                              B.VT + (long)(512 + kv * 128 + n) * TCM + row0 + 8 * hi, TCM, 0, S, nullptr);
        astate_finish(st); store_o(st.o, op + 1024 + head * 128);
    } else {
        ATT_LANE_SETUP
        AState st; astate_init(st);
        const bf16_t* kp = B.PROJ + (long)(row0 + pr) * NP + PC_DK + head * 128 + 8 * hi;
        const bf16_t* vp = B.VT + (long)(768 + head * 128 + n) * TCM + row0 + 8 * hi;
#pragma unroll 1
        for (int g = 0; g < 3; ++g) { const int W = g == 0 ? 64 : (g == 1 ? 256 : 1024);
            const int kb = q0 - W > 0 ? q0 - W : 0, ke = q0 + 32 + W < S ? q0 + 32 + W : S;
            attn_pass<128, true>(st, B.PROJ + qrow * NP + PC_DQ + (g * 4 + head) * 128 + 8 * hi, kp, NP, vp, TCM, kb, ke, B.tabD + (g * 4 + head) * TABD_N + TABD_OFF - (q0 + n) + 8 * hi); }
        astate_finish(st); store_o(st.o, op + 1536 + head * 128);
    }
}
__device__ __forceinline__ void attn_phase(const Args& a, const AttnBufs& B, int layer, int chunk, unsigned* ctr, int lane, LAS float* stash) {
    const int npr = chunk == 0 ? 1 : 0, nsm = chunk == 0 ? 4 : 12, TC = chunk == 0 ? 16384 : 24576;
    const int nP = npr * 1024, nS = nsm * 256, nD = TC / 8, total = 3 * nP + 3 * nS + nD;
    for (;;) {
        unsigned uu = 0; if (lane == 0) uu = atomicAdd(ctr, 1u);
        int u = __builtin_amdgcn_readfirstlane((int)uu);
        if (u >= total) break;
        int mixer, head, row0, S, q0;
        if (u < 3 * nP) { mixer = u / nP; const int r = u % nP; q0 = (r % 256) * 32; head = r / 256; row0 = 0; S = TP; }
        else { u -= 3 * nP;
            if (u < 3 * nS) { mixer = u / nS; const int r = u % nS; q0 = (r % 64) * 32; head = (r / 64) % 4; row0 = npr * TP + (r / 256) * SS; S = SS; }
            else { u -= 3 * nS; mixer = 3; const int qb = u % (TC / 32); head = u / (TC / 32); const int q = qb * 32;
                if (npr && q < TP) { row0 = 0; S = TP; } else { row0 = npr * TP + ((q - npr * TP) / SS) * SS; S = SS; }
                q0 = q - row0; } }
#ifdef ONLY_MIXER
        if (mixer != ONLY_MIXER) continue;
#endif
        attn_unit(a, B, layer, mixer, head, row0, S, q0, lane, stash);
    }
}


constexpr int A2_RSV = 144, A2_BUFSZ = 64 * 400 + 128 * A2_RSV;
static_assert(2 * A2_BUFSZ <= 131072 && 2 * A2_BUFSZ >= 65536, "attention LDS");
template <int DKL, int DK, bool TAB>
__device__ __forceinline__ void attn2_pass(AState& st, LAS unsigned char* buf, const bf16_t* qp, int koff, const bf16_t* Kg, long ldk, const bf16_t* Vg, long ldv,
                                           int kbeg, int kend, const float* tp, int wlo, int whi, int tid_in, int lane) {
    constexpr int NS = DK / 16, PR = DKL / 8, NKP = DKL / 64, RSK = DKL * 2 + 16, KBYTES = 64 * RSK;
    int tid = tid_in; asm volatile("" : "+v"(tid));
    const int n = lane & 31, hi = lane >> 5, pr = pi32(n);
    bf16x8 qf[NS];
#pragma unroll
    for (int s = 0; s < NS; ++s) qf[s] = *(const bf16x8*)(qp + 16 * s);
    u32x4 kreg[NKP], vreg[2];
    int krow[NKP], kc[NKP];
#pragma unroll
    for (int i = 0; i < NKP; ++i) { const int p = tid + 512 * i; krow[i] = p / PR; kc[i] = p % PR; }
#define A2_GLOAD(k0_) do { _Pragma("unroll") for (int i = 0; i < NKP; ++i) kreg[i] = *(const u32x4*)(Kg + (long)((k0_) + krow[i]) * ldk + 8 * kc[i]); \
        _Pragma("unroll") for (int i = 0; i < 2; ++i) { const int p = tid + 512 * i; vreg[i] = *(const u32x4*)(Vg + (long)(p >> 3) * ldv + (k0_) + 8 * (p & 7)); } } while (0)
#define A2_LSTORE(b_) do { _Pragma("unroll") for (int i = 0; i < NKP; ++i) *(LAS u32x4*)(buf + (b_) * A2_BUFSZ + krow[i] * RSK + kc[i] * 16) = kreg[i]; \
        _Pragma("unroll") for (int i = 0; i < 2; ++i) { const int p = tid + 512 * i; *(LAS u32x4*)(buf + (b_) * A2_BUFSZ + KBYTES + (p >> 3) * A2_RSV + (p & 7) * 16) = vreg[i]; } } while (0)
    A2_GLOAD(kbeg); A2_LSTORE(0); __syncthreads();
    int b = 0;
    const int kfo = pr * RSK + koff + hi * 16, vfo = KBYTES + n * A2_RSV + hi * 16;
    for (int k0 = kbeg; k0 < kend; k0 += 64) {
        const bool more = k0 + 64 < kend;
        if (more) A2_GLOAD(k0 + 64);
        LAS unsigned char* bb = buf + b * A2_BUFSZ;
#pragma unroll
        for (int sb = 0; sb < 2; ++sb) {
            const int ks = k0 + 32 * sb;
            if (ks + 32 <= wlo || ks >= whi) continue;
            f32x4 tb[4];
            if (TAB) {
#pragma unroll
                for (int s = 0; s < 2; ++s) { tb[2 * s] = *(const f32x4u*)(tp + ks + 16 * s); tb[2 * s + 1] = *(const f32x4u*)(tp + ks + 16 * s + 4); } }
            f32x16 sc;
#pragma unroll
            for (int r = 0; r < 16; ++r) sc[r] = 0.f;
#pragma unroll
            for (int s = 0; s < NS; ++s) { const bf16x8 kf = *(const LAS bf16x8*)(bb + kfo + (32 * sb) * RSK + 32 * s); sc = __builtin_amdgcn_mfma_f32_32x32x16_bf16(kf, qf[s], sc, 0, 0, 0); }
            if (TAB) {
#pragma unroll
                for (int r = 0; r < 16; ++r) sc[r] += tb[r >> 2][r & 3]; }
            float mx = sc[0];
#pragma unroll
            for (int r = 1; r < 16; ++r) mx = fmaxf(mx, sc[r]);
            mx = fmaxf(mx, __shfl_xor(mx, 32));
            if (__any(mx > st.m + 8.0f)) {
                const float mn = fmaxf(st.m, mx); const float alpha = __builtin_amdgcn_exp2f(st.m - mn); st.m = mn; st.l *= alpha;
#pragma unroll
                for (int d = 0; d < 4; ++d)
#pragma unroll
                    for (int r = 0; r < 16; ++r) st.o[d][r] *= alpha;
            }
            float ps = 0.f;
#pragma unroll
            for (int r = 0; r < 16; ++r) { sc[r] = __builtin_amdgcn_exp2f(sc[r] - st.m); ps += sc[r]; }
            st.l += ps;
            u32x4 p0, p1;
            p0.x = cvt_pk_bf16(sc[0], sc[1]); p0.y = cvt_pk_bf16(sc[2], sc[3]); p0.z = cvt_pk_bf16(sc[4], sc[5]); p0.w = cvt_pk_bf16(sc[6], sc[7]);
            p1.x = cvt_pk_bf16(sc[8], sc[9]); p1.y = cvt_pk_bf16(sc[10], sc[11]); p1.z = cvt_pk_bf16(sc[12], sc[13]); p1.w = cvt_pk_bf16(sc[14], sc[15]);
            const bf16x8 pf0 = __builtin_bit_cast(bf16x8, p0), pf1 = __builtin_bit_cast(bf16x8, p1);
#pragma unroll
            for (int d = 0; d < 4; ++d) {
                const bf16x8 v0 = *(const LAS bf16x8*)(bb + vfo + (32 * d) * A2_RSV + 64 * sb), v1 = *(const LAS bf16x8*)(bb + vfo + (32 * d) * A2_RSV + 64 * sb + 32);
                st.o[d] = __builtin_amdgcn_mfma_f32_32x32x16_bf16(v0, pf0, st.o[d], 0, 0, 0); st.o[d] = __builtin_amdgcn_mfma_f32_32x32x16_bf16(v1, pf1, st.o[d], 0, 0, 0); }
        }
        if (more) A2_LSTORE(b ^ 1);
        __syncthreads();
        b ^= 1;
    }
#undef A2_GLOAD
#undef A2_LSTORE
}

__device__ __forceinline__ void attn2_unit(const Args& a, const AttnBufs& B, int layer, int mixer, int head, int row0, int S, int q0, int tid, int lane, int wave, LAS unsigned char* buf) {
#ifdef ONLY_MIXER2
    mixer = ONLY_MIXER2;
#endif
    if (mixer == 0) {
        int ln_ = lane; asm volatile("" : "+v"(ln_)); const int n = ln_ & 31, hi = ln_ >> 5;
        const int half = wave >> 2, qw = q0 + 32 * (wave & 3); const long qrow = (long)row0 + qw + n;
        const float lam_init = layer == 0 ? 0.2f : 0.35550906759f;
        AState st; astate_init(st);
        attn2_pass<128, 64, true>(st, buf, B.PROJ + qrow * NP + PC_AQ + head * 128 + 64 * half + 8 * hi, 128 * half, B.PROJ + (long)row0 * NP + PC_AK + head * 128, NP,
                                  B.VT + (long)(head * 128) * TCM + row0, TCM, 0, S, B.tabA + head * TABA_N + TABA_OFF - (qw + n) + 8 * hi, 0, S, tid, ln_);
        astate_finish(st);
        LAS float* xb = (LAS float*)buf + (wave & 3) * 4096;
        if (half == 1) {
#pragma unroll
            for (int d = 0; d < 4; ++d)
#pragma unroll
                for (int r = 0; r < 16; ++r) xb[(d * 16 + r) * 64 + ln_] = st.o[d][r]; }
        __syncthreads();
        if (half == 0) {
            const float d1 = wave_sum(a.in[I_ALQ1][layer * 64 + ln_] * a.in[I_ALK1][layer * 64 + ln_]);
            const float d2 = wave_sum(a.in[I_ALQ2][layer * 64 + ln_] * a.in[I_ALK2][layer * 64 + ln_]);
            const float lam = expf(d1) - expf(d2) + lam_init;
            float ss = 0.f;
#pragma unroll
            for (int d = 0; d < 4; ++d)
#pragma unroll
                for (int r = 0; r < 16; ++r) { const float v = st.o[d][r] - lam * xb[(d * 16 + r) * 64 + ln_]; st.o[d][r] = v; ss += v * v; }
            ss += __shfl_xor(ss, 32);
            const float rs = (1.0f - lam_init) / sqrtf(ss * (1.0f / 128.0f) + EPS);
            const float* gn = a.in[I_AON] + layer * 128 + 4 * hi;
#pragma unroll
            for (int d = 0; d < 4; ++d)
#pragma unroll
                for (int g = 0; g < 4; ++g) { const f32x4 gg = *(const f32x4*)(gn + 32 * d + 8 * g);
#pragma unroll
                    for (int e = 0; e < 4; ++e) st.o[d][4 * g + e] *= rs * gg[e]; }
            store_o(st.o, B.BR + qrow * 2048 + 4 * hi + head * 128);
        }
    } else if (mixer == 1) {
        int ln_ = lane; asm volatile("" : "+v"(ln_)); const int n = ln_ & 31, hi = ln_ >> 5;
        const int qw = q0 + 32 * wave; const long qrow = (long)row0 + qw + n;
        AState st; astate_init(st);
        attn2_pass<192, 192, false>(st, buf, B.QB + qrow * 768 + head * 192 + 8 * hi, 0, B.KB + (long)row0 * 768 + head * 192, 768,
                                    B.VTB + (long)(head * 128) * TCM + row0, TCM, 0, S, nullptr, 0, S, tid, ln_);
        astate_finish(st); store_o(st.o, B.BR + qrow * 2048 + 4 * hi + 512 + head * 128);
    } else if (mixer == 2) {
        int ln_ = lane; asm volatile("" : "+v"(ln_)); const int n = ln_ & 31, hi = ln_ >> 5;
        const int qw = q0 + 32 * wave; const long qrow = (long)row0 + qw + n; const int kv = head >> 1;
        AState st; astate_init(st);
        attn2_pass<128, 128, false>(st, buf, B.PROJ + qrow * NP + PC_CQ + head * 128 + 8 * hi, 0, B.PROJ + (long)row0 * NP + PC_CK + kv * 128, NP,
                                    B.VT + (long)(512 + kv * 128) * TCM + row0, TCM, 0, S, nullptr, 0, S, tid, ln_);
        astate_finish(st); store_o(st.o, B.BR + qrow * 2048 + 4 * hi + 1024 + head * 128);
    } else {
        int ln_ = lane; asm volatile("" : "+v"(ln_)); const int n = ln_ & 31, hi = ln_ >> 5;
        const int qw = q0 + 32 * wave; const long qrow = (long)row0 + qw + n;
        AState st; astate_init(st);
#pragma unroll 1
        for (int g = 0; g < 3; ++g) { const int W = g == 0 ? 64 : (g == 1 ? 256 : 1024);
            const int kb = q0 - W > 0 ? q0 - W : 0, ke = q0 + 256 + W < S ? q0 + 256 + W : S;
            attn2_pass<128, 128, true>(st, buf, B.PROJ + qrow * NP + PC_DQ + (g * 4 + head) * 128 + 8 * hi, 0, B.PROJ + (long)row0 * NP + PC_DK + head * 128, NP,
                                       B.VT + (long)(768 + head * 128) * TCM + row0, TCM, kb, ke, B.tabD + (g * 4 + head) * TABD_N + TABD_OFF - (qw + n) + 8 * hi, qw - W, qw + 32 + W, tid, ln_); }
        astate_finish(st); store_o(st.o, B.BR + qrow * 2048 + 4 * hi + 1536 + head * 128);
    }
}
__device__ __forceinline__ void attn2_phase(const Args& a, const AttnBufs& B, int layer, int chunk, unsigned* ctr, int tid, int lane, int wave, LAS unsigned char* lds) {
    const int npr = chunk == 0 ? 1 : 0, nsm = chunk == 0 ? 4 : 12, TC = chunk == 0 ? 16384 : 24576;
    const int c0 = npr * 128, c1 = npr * 128, c2 = npr * 256, c3 = TC / 64, c4 = nsm * 32, c5 = nsm * 32, c6 = nsm * 64;
    const int total = c0 + c1 + c2 + c3 + c4 + c5 + c6;
    volatile LAS int* uw = (volatile LAS int*)(lds + 131072);
    for (;;) {
        __syncthreads();
        if (tid == 0) *uw = (int)atomicAdd(ctr, 1u);
        __syncthreads();
        int u = __builtin_amdgcn_readfirstlane(*uw);
        if (u >= total) break;
        int mixer, head, row0, S, q0;
        if (u < c0 + c1 + c2) { row0 = 0; S = TP;
            if (u < c0) { mixer = 1; q0 = (u % 32) * 256; head = u / 32; }
            else if (u < c0 + c1) { u -= c0; mixer = 2; q0 = (u % 32) * 256; head = u / 32; }
            else { u -= c0 + c1; mixer = 0; q0 = (u % 64) * 128; head = u / 64; }
        } else { u -= c0 + c1 + c2;
            if (u < c3) { mixer = 3; const int nb = TC / 256; const int q = (u % nb) * 256; head = u / nb;
                if (npr && q < TP) { row0 = 0; S = TP; } else { row0 = npr * TP + ((q - npr * TP) / SS) * SS; S = SS; }
                q0 = q - row0; }
            else { u -= c3; S = SS;
                if (u < c4) { mixer = 1; q0 = (u % 8) * 256; head = (u / 8) % 4; row0 = npr * TP + (u / 32) * SS; }
                else if (u < c4 + c5) { u -= c4; mixer = 2; q0 = (u % 8) * 256; head = (u / 8) % 4; row0 = npr * TP + (u / 32) * SS; }
                else { u -= c4 + c5; mixer = 0; q0 = (u % 16) * 128; head = (u / 16) % 4; row0 = npr * TP + (u / 64) * SS; } } }
        attn2_unit(a, B, layer, mixer, head, row0, S, q0, tid, lane, wave, lds);
    }
}

__global__ void __launch_bounds__(512, 2) mega(Args a) {
    extern __shared__ __attribute__((aligned(16))) unsigned char lds_raw[];
    LAS unsigned char* lds = (LAS unsigned char*)lds_raw;
    const int G = gridDim.x, bx = blockIdx.x;
    unsigned char* ws = a.ws;
    unsigned* ctl = (unsigned*)(ws + WS_CTL);
    float* tabA = (float*)(ws + WS_TABA); float* tabD = (float*)(ws + WS_TABD);
    unsigned char* W = ws + WS_W;
    bf16_t* H = (bf16_t*)(ws + WS_H);
    bf16_t* PROJ = (bf16_t*)(ws + WS_R1 + R1_PROJ); bf16_t* VT = (bf16_t*)(ws + WS_R1 + R1_VT); bf16_t* QB = (bf16_t*)(ws + WS_R1 + R1_QB);
    bf16_t* KB = (bf16_t*)(ws + WS_R1 + R1_KB); bf16_t* VTB = (bf16_t*)(ws + WS_R1 + R1_VTB);
    bf16_t* Y = (bf16_t*)(ws + WS_R1); bf16_t* FFH = (bf16_t*)(ws + WS_R1);
    bf16_t* BR = (bf16_t*)(ws + WS_R2); float* PART = (float*)(ws + WS_R2); bf16_t* U = (bf16_t*)(ws + WS_R2);
    bf16_t* MERGED = (bf16_t*)(ws + WS_R3); bf16_t* P16 = (bf16_t*)(ws + WS_R3);
    cg::grid_group grid = cg::this_grid();

    for (int pid = a.ph_lo; pid < a.ph_hi; ++pid) {
        int tid = threadIdx.x; asm volatile("" : "+v"(tid));
        const int lane = tid & 63, wave = __builtin_amdgcn_readfirstlane(tid >> 6);
        const int gw = bx * 8 + wave, ngw = G * 8;
        const int layer = pid / 31, q = pid % 31;
        if (q == 0) {
            if (layer == 0) build_tables(a.in[I_RELB], tabA, tabD, bx * 512 + tid, G * 512);
#ifndef NO_CONV
            convert_weights(a, layer, W, (LAS float*)(lds + wave * 16384), gw, ngw, lane);
#endif
        } else {
            const int chunk = (q - 1) / 15, k = (q - 1) % 15 + 1;
            const int m0 = chunk == 0 ? 0 : 16384, TC = chunk == 0 ? 16384 : 24576, nMt = TC / 256;
            const float* xs0 = layer == 0 ? a.in[I_XP] : a.out; const float* xs1 = layer == 0 ? a.in[I_XS] : a.out + (size_t)TP * DM;
#ifdef NO_ROWS
            if (0) {
#else
            if (k == 1 || k == 10 || k == 13) {
#endif
                if (k == 1 || k == 10) { if (k == 10) { xs0 = a.out; xs1 = a.out + (size_t)TP * DM; }
                    const float* g = (k == 1 ? a.in[I_NMIX] : a.in[I_NFFN]) + layer * DM;
                    for (int r = gw; r < TC; r += ngw) norm_row(xrow_ptr(xs0, xs1, m0 + r), g, H + (size_t)r * DM, lane);
                } else {
                    const float* g = a.in[I_NPLE] + layer * DM;
                    for (int r = gw; r < TC; r += ngw) { const int m = m0 + r; norm_row(a.out + (size_t)m * DM, g, H + (size_t)r * DM, lane);
                        const float* pr = m < TP ? a.in[I_PP] + ((size_t)layer * TP + m) * 256 : a.in[I_PS] + ((size_t)layer * 32768 + (m - TP)) * 256;
                        const f32x4 v = *(const f32x4*)(pr + 4 * lane); u32x2 w; w.x = cvt_pk_bf16(v[0], v[1]); w.y = cvt_pk_bf16(v[2], v[3]); *(u32x2*)(P16 + (size_t)r * 256 + 4 * lane) = w; }
                }
#ifdef NO_ROWS
            } else if (0) {
#else
            } else if (k == 3 || k == 5) {
#endif
                for (int r = gw; r < TC; r += ngw) { const int m = m0 + r; const int tseq = m < TP ? m : (m - TP) % SS;
                    if (k == 3) post1_row(a, layer, PROJ + (size_t)r * NP, tseq, lane);
                    else post2_row(a, layer, QB + (size_t)r * 768, KB + (size_t)r * 768, PROJ + (size_t)r * NP, tseq, lane); }
            } else if (k == 6) {
                AttnBufs B{PROJ, VT, QB, KB, VTB, BR, tabA, tabD};
#ifndef NO_ATTN
                #if ATTN_V2
                attn2_phase(a, B, layer, chunk, ctl + 64 * (layer * 2 + chunk), tid, lane, wave, lds);
#else
                attn_phase(a, B, layer, chunk, ctl + 64 * (layer * 2 + chunk), lane, (LAS float*)(lds + wave * 16384));
#endif
#endif
            } else {
                const int njobs = (k == 2) ? 2 : (k == 4 ? 3 : 1);
                int coff = 0;
                for (int j = 0; j < njobs; ++j) {
                    pg8::Gemm g; pg8::Epi E; int nM = nMt, nN = 8, rep = 1, adiv = 1 << 30; long astep = 0;
                    E.kind = pg8::EK_BF16; E.O = nullptr; E.ldc = 0; E.Y = nullptr; E.part = nullptr; E.xs0 = xs0; E.xs1 = xs1; E.xout = a.out; E.m0 = m0;
                    g.A = H; g.Bt = (const bf16_t*)(W + WO_IN); g.lda = 2048; g.ldb = 2048; g.K = 2048;
                    if (k == 2 && j == 0) { nN = NP / 256; E.O = PROJ; E.ldc = NP; }
                    else if (k == 2) { g.A = (const bf16_t*)(W + WO_INV); g.Bt = H; nM = NVT / 256; nN = nMt; E.O = VT; E.ldc = TCM; }
                    else if (k == 4 && j == 0) { g.A = PROJ + PC_BCQ; g.lda = NP; g.Bt = (const bf16_t*)(W + WO_UQ); g.ldb = 512; g.K = 512; nN = 3; E.O = QB; E.ldc = 768; }
                    else if (k == 4 && j == 1) { g.A = PROJ + PC_BCKV; g.lda = NP; g.Bt = (const bf16_t*)(W + WO_UKN); g.ldb = 512; g.K = 512; nN = 2; E.kind = pg8::EK_SPLIT192; E.O = KB; E.ldc = 768; }
                    else if (k == 4) { g.A = (const bf16_t*)(W + WO_UKV); g.lda = 512; g.Bt = PROJ + PC_BCKV; g.ldb = NP; g.K = 512; nM = 2; nN = nMt; E.O = VTB; E.ldc = TCM; }
                    else if (k == 7) { g.A = BR; g.Bt = (const bf16_t*)(W + WO_B); g.ldb = 512; g.K = 512; nN = 32; adiv = 8; astep = 1024; E.O = Y; E.ldc = 8192; }
                    else if (k == 8) { g.Bt = (const bf16_t*)(W + WO_G); rep = 4; E.kind = pg8::EK_GATE; E.O = MERGED; E.Y = Y; E.part = PART; }
                    else if (k == 9) { g.A = MERGED; g.Bt = (const bf16_t*)(W + WO_O); E.kind = pg8::EK_RES; }
                    else if (k == 11) { g.Bt = (const bf16_t*)(W + WO_1); nN = 32; E.kind = pg8::EK_RELU2; E.O = FFH; E.ldc = 8192; }
                    else if (k == 12) { g.A = FFH; g.lda = 8192; g.Bt = (const bf16_t*)(W + WO_2); g.ldb = 8192; g.K = 8192; E.kind = pg8::EK_RES; E.xs0 = a.out; E.xs1 = a.out + (size_t)TP * DM; }
                    else if (k == 14) { g.A = P16; g.lda = 256; g.Bt = (const bf16_t*)(W + WO_PP); g.ldb = 256; g.K = 256; E.O = U; E.ldc = 2048; }
                    else { g.Bt = (const bf16_t*)(W + WO_PG); E.kind = pg8::EK_PLE; E.Y = U; E.xs0 = a.out; E.xs1 = a.out + (size_t)TP * DM; }
                    pg8::Order S; S.init(nM, nN, G, (bx + G - coff) % G, rep, adiv, astep);
#ifndef NO_GEMM
                    pg8::gemm_phase<true>(lds, g, S, E, tid);
#endif
                    coff = (coff + (nM * nN) % G) % G;
                }
            }
        }
        if (pid + 1 < a.ph_hi) grid.sync();
    }
}

extern "C" void kernel_launch(void* const* d_in, const int* in_sizes, int n_in, void* d_out, int out_size, void* d_ws, size_t ws_size, hipStream_t stream) {
    static int grid = 0;
    if (grid == 0) {
        if (n_in != 33 || out_size != TALL * DM || ws_size < WS_END) { fprintf(stderr, "kernel_launch: unexpected shapes (n_in %d out %d ws %zu need %zu)\n", n_in, out_size, ws_size, (size_t)WS_END); grid = -1; return; }
        int dev = 0, cus = 0, per_cu = 0;
        hipGetDevice(&dev); hipDeviceGetAttribute(&cus, hipDeviceAttributeMultiprocessorCount, dev);
        if (hipFuncSetAttribute((const void*)mega, hipFuncAttributeMaxDynamicSharedMemorySize, LDS_BYTES) != hipSuccess) { fprintf(stderr, "kernel_launch: hipFuncSetAttribute failed\n"); grid = -1; return; }
        if (hipOccupancyMaxActiveBlocksPerMultiprocessor(&per_cu, (const void*)mega, 512, LDS_BYTES) != hipSuccess || per_cu < 1) per_cu = 1;
        (void)hipGetLastError();
        grid = cus * per_cu;
        if (grid <= 0) grid = 256;
    }
    if (grid < 0) return;
    hipMemsetAsync((char*)d_ws + WS_CTL, 0, 4096, stream);
    Args a{};
    for (int i = 0; i < 33; ++i) a.in[i] = (const float*)d_in[i];
    a.out = (float*)d_out; a.ws = (unsigned char*)d_ws;
    constexpr int NPH = 62;
#if COOP
    a.ph_lo = 0; a.ph_hi = NPH;
    void* args[] = {&a};
    hipError_t e = hipLaunchCooperativeKernel((const void*)mega, dim3(grid), dim3(512), args, LDS_BYTES, stream);
    if (e != hipSuccess) fprintf(stderr, "cooperative launch failed: %s (grid %d)\n", hipGetErrorString(e), grid);
#else
    for (int p = 0; p < NPH; ++p) { a.ph_lo = p; a.ph_hi = p + 1; hipLaunchKernelGGL(mega, dim3(grid), dim3(512), LDS_BYTES, stream, a); }
#endif
}
```

```cpp
#include <hip/hip_runtime.h>
#include <hip/hip_cooperative_groups.h>
#include <cstdio>
#include <cstdint>
namespace cg = cooperative_groups;

#ifndef COOP
#define COOP 1
#endif
#ifndef ATTN_V2
#define ATTN_V2 1
#endif

#define LAS __attribute__((address_space(3)))
typedef unsigned short bf16_t;
typedef short bf16x8 __attribute__((ext_vector_type(8)));
typedef float f32x4 __attribute__((ext_vector_type(4)));
typedef float f32x16 __attribute__((ext_vector_type(16)));
typedef unsigned u32x4 __attribute__((ext_vector_type(4)));
typedef unsigned u32x2 __attribute__((ext_vector_type(2)));
typedef float f32x4u __attribute__((ext_vector_type(4), aligned(4)));

constexpr int DM = 2048, TALL = 40960, TP = 8192, SS = 2048;
constexpr int NP = 5120;
constexpr int TCM = 24576;
constexpr int NVT = 1280;
constexpr int DFF = 8192;
constexpr int PC_AQ = 0, PC_AK = 512, PC_BCQ = 1024, PC_BCKV = 1536, PC_CQ = 2048, PC_CK = 2560, PC_DQ = 2816, PC_DK = 4352, PC_BKR = 4864;
constexpr float LOG2E = 1.4426950408889634f;
constexpr float EPS = 1e-6f;
constexpr int TABA_N = 16384, TABA_OFF = 8192, TABD_N = 2304, TABD_OFF = 1152;

constexpr size_t MiB = 1u << 20;
constexpr size_t WS_CTL = 0;
constexpr size_t WS_TABA = 64 * 1024;
constexpr size_t WS_TABD = 384 * 1024;
constexpr size_t WS_W = 1 * MiB;
constexpr size_t WO_IN = 0;
constexpr size_t WO_INV = WO_IN + (size_t)NP * 2048 * 2;
constexpr size_t WO_G = WO_INV + (size_t)NVT * 2048 * 2;
constexpr size_t WO_B = WO_G + (size_t)8192 * 2048 * 2;
constexpr size_t WO_O = WO_B + (size_t)8192 * 512 * 2;
constexpr size_t WO_1 = WO_O + (size_t)2048 * 2048 * 2;
constexpr size_t WO_2 = WO_1 + (size_t)8192 * 2048 * 2;
constexpr size_t WO_PG = WO_2 + (size_t)2048 * 8192 * 2;
constexpr size_t WO_PP = WO_PG + (size_t)2048 * 2048 * 2;
constexpr size_t WO_UQ = WO_PP + (size_t)2048 * 256 * 2;
constexpr size_t WO_UKN = WO_UQ + (size_t)768 * 512 * 2;
constexpr size_t WO_UKV = WO_UKN + (size_t)512 * 512 * 2;
constexpr size_t WO_END = WO_UKV + (size_t)512 * 512 * 2;
static_assert(WO_END <= 148 * MiB, "weights");
constexpr size_t WS_H = WS_W + 148 * MiB;
constexpr size_t WS_R1 = WS_H + (size_t)TCM * 2048 * 2;
constexpr size_t R1_PROJ = 0;
constexpr size_t R1_VT = R1_PROJ + (size_t)TCM * NP * 2;
constexpr size_t R1_QB = R1_VT + (size_t)NVT * TCM * 2;
constexpr size_t R1_KB = R1_QB + (size_t)TCM * 768 * 2;
constexpr size_t R1_VTB = R1_KB + (size_t)TCM * 768 * 2;
constexpr size_t R1_END = R1_VTB + (size_t)512 * TCM * 2;
static_assert(R1_END >= (size_t)TCM * 8192 * 2, "Y / FFH overlay");
constexpr size_t WS_R2 = WS_R1 + R1_END;
constexpr size_t WS_R3 = WS_R2 + (size_t)TCM * 2048 * 4;
constexpr size_t WS_END = WS_R3 + (size_t)TCM * 2048 * 2;

constexpr int LDS_BYTES = 147456;

__device__ __forceinline__ unsigned cvt_pk_bf16(float lo, float hi) { unsigned r; asm volatile("v_cvt_pk_bf16_f32 %0, %1, %2" : "=v"(r) : "v"(lo), "v"(hi)); return r; }
__device__ __forceinline__ float bf_lo(unsigned u) { return __uint_as_float(u << 16); }
__device__ __forceinline__ float bf_hi(unsigned u) { return __uint_as_float(u & 0xffff0000u); }
__device__ __forceinline__ float wave_sum(float v) {
#pragma unroll
    for (int o = 1; o < 64; o <<= 1) v += __shfl_xor(v, o);
    return v;
}
__device__ __forceinline__ float sigmoidf_fast(float x) { return __builtin_amdgcn_rcpf(1.0f + __builtin_amdgcn_exp2f(-x * LOG2E)); }
__device__ __forceinline__ const float* xrow_ptr(const float* s0, const float* s1, int m) { return m < TP ? s0 + (size_t)m * DM : s1 + (size_t)(m - TP) * DM; }

namespace pg8 {
constexpr int BM = 256, BK = 64, HALF = 128, HTB = HALF * BK * 2, STAGE_BYTES = 8 * HTB, NXCD = 8, WGM = 8;
__host__ __device__ __forceinline__ int lds_byte(int r, int c) { const int st = (r >> 4) * 2 + (c >> 5), rr = r & 15, cc = c & 31, ob = rr * 64 + cc * 2; return st * 1024 + (ob ^ (((ob >> 9) & 1) << 5)); }
__host__ __device__ __forceinline__ void stage_rc(int b, int& R, int& C) { const int st = b / 1024, sb = b % 1024, swz = sb ^ (((sb >> 9) & 1) << 5); R = (st >> 1) * 16 + swz / 64; C = (st & 1) * 32 + (swz % 64) / 2; }
__host__ __device__ __forceinline__ int perm32(int rho) { const int n = rho >> 4, i = rho & 15; return 8 * (i >> 2) + 4 * n + (i & 3); }

struct Unit { int pm, pn; long aoff; };
struct Gemm { const bf16_t* A; const bf16_t* Bt; int lda, ldb, K; };

struct Order {
    int nM, nN, nwg, G, c, rep, adiv; long astep;
    __device__ void init(int nM_, int nN_, int G_, int c_, int rep_, int adiv_, long astep_) { nM = nM_; nN = nN_; nwg = nM * nN; G = G_; c = c_; rep = rep_; adiv = adiv_; astep = astep_; }
    __device__ bool next(int i, Unit& u) const {
        const int t = i / rep, sub = i - t * rep;
        const long L = (long)t * G + c; if (L >= nwg) return false;
        int wgid = (int)L; { const int q = nwg / NXCD, r = nwg % NXCD, xcd = wgid % NXCD, off = wgid / NXCD; wgid = (xcd < r ? xcd * (q + 1) : r * (q + 1) + (xcd - r) * q) + off; }
        const int nig = WGM * nN, gid = wgid / nig, fm = gid * WGM, gsz = (nM - fm) < WGM ? (nM - fm) : WGM;
        u.pm = fm + ((wgid % nig) % gsz); const int pn = (wgid % nig) / gsz; u.pn = pn + sub * nN; u.aoff = (long)(pn / adiv) * astep; return true;
    }
};

enum { EK_BF16 = 0, EK_SPLIT192 = 1, EK_RELU2 = 2, EK_GATE = 3, EK_RES = 4, EK_PLE = 5 };
struct Epi {
    static constexpr bool PERM = true;
    int kind; bf16_t* O; long ldc; const bf16_t* Y; float* part; const float* xs0; const float* xs1; float* xout; int m0;
    __device__ __forceinline__ void operator()(const f32x4 (&acc)[2][2][4][2], const Unit& u, int wr, int wc, int fr, int fq) const {
        const int row0 = u.pm * BM + wr * 64 + fr, col0 = u.pn * BM + wc * 32 + 8 * fq;
        if (kind <= EK_RELU2) {
#pragma unroll
            for (int ai = 0; ai < 2; ++ai)
#pragma unroll
                for (int m = 0; m < 4; ++m) { const int row = row0 + ai * HALF + m * 16;
#pragma unroll
                    for (int bj = 0; bj < 2; ++bj) { int col = col0 + bj * HALF; f32x4 v0 = acc[ai][bj][m][0], v1 = acc[ai][bj][m][1];
                        if (kind == EK_RELU2) {
#pragma unroll
                            for (int e = 0; e < 4; ++e) { float a = fmaxf(v0[e], 0.f), b = fmaxf(v1[e], 0.f); v0[e] = a * a; v1[e] = b * b; } }
                        if (kind == EK_SPLIT192) col = (col >> 7) * 192 + (col & 127);
                        u32x4 w; w.x = cvt_pk_bf16(v0[0], v0[1]); w.y = cvt_pk_bf16(v0[2], v0[3]); w.z = cvt_pk_bf16(v1[0], v1[1]); w.w = cvt_pk_bf16(v1[2], v1[3]);
                        *(u32x4*)(O + (size_t)row * ldc + col) = w; } }
        } else if (kind == EK_GATE) {
            const int oc = u.pn * 64 + wc * 16 + 4 * fq;
#pragma unroll
            for (int ai = 0; ai < 2; ++ai)
#pragma unroll
                for (int m = 0; m < 4; ++m) { const int row = row0 + ai * HALF + m * 16;
                    const bf16_t* yp = Y + (size_t)row * 8192 + oc;
                    f32x4 r = (f32x4){0.f, 0.f, 0.f, 0.f};
#pragma unroll
                    for (int b = 0; b < 4; ++b) { const u32x2 y = *(const u32x2*)(yp + b * 2048); const f32x4 v = acc[ai][b >> 1][m][b & 1];
                        r[0] += sigmoidf_fast(v[0]) * bf_lo(y.x); r[1] += sigmoidf_fast(v[1]) * bf_hi(y.x); r[2] += sigmoidf_fast(v[2]) * bf_lo(y.y); r[3] += sigmoidf_fast(v[3]) * bf_hi(y.y); }
                    u32x2 w; w.x = cvt_pk_bf16(r[0], r[1]); w.y = cvt_pk_bf16(r[2], r[3]);
                    *(u32x2*)(O + (size_t)row * 2048 + oc) = w; }
        } else {
#pragma unroll
            for (int ai = 0; ai < 2; ++ai)
#pragma unroll
                for (int m = 0; m < 4; ++m) { const int row = row0 + ai * HALF + m * 16; const int gm = m0 + row;
                    const float* xs = xrow_ptr(xs0, xs1, gm); float* xo = xout + (size_t)gm * DM;
#pragma unroll
                    for (int bj = 0; bj < 2; ++bj) { const int col = col0 + bj * HALF; f32x4 v0 = acc[ai][bj][m][0], v1 = acc[ai][bj][m][1];
                        const f32x4 x0 = *(const f32x4*)(xs + col), x1 = *(const f32x4*)(xs + col + 4);
                        if (kind == EK_PLE) { const u32x4 y = *(const u32x4*)(Y + (size_t)row * 2048 + col);
                            v0[0] = sigmoidf_fast(v0[0]) * bf_lo(y.x); v0[1] = sigmoidf_fast(v0[1]) * bf_hi(y.x); v0[2] = sigmoidf_fast(v0[2]) * bf_lo(y.y); v0[3] = sigmoidf_fast(v0[3]) * bf_hi(y.y);
                            v1[0] = sigmoidf_fast(v1[0]) * bf_lo(y.z); v1[1] = sigmoidf_fast(v1[1]) * bf_hi(y.z); v1[2] = sigmoidf_fast(v1[2]) * bf_lo(y.w); v1[3] = sigmoidf_fast(v1[3]) * bf_hi(y.w); }
                        *(f32x4*)(xo + col) = x0 + v0; *(f32x4*)(xo + col + 4) = x1 + v1; } }
        }
    }
};

template <bool ALIGN_EPI = true>
__device__ __forceinline__ void gemm_phase(LAS unsigned char* lds, const Gemm g, const Order& S, const Epi& E, const int tid) {
    const int wid = __builtin_amdgcn_readfirstlane(tid >> 6), lane = tid & 63, wr = wid >> 2, wc = wid & 3, fr = lane & 15, fq = lane >> 4;
    const int K = g.K, nt = K / BK;
    unsigned voffA[2], voffB[2];
#pragma unroll
    for (int i = 0; i < 2; ++i) { int R, C; stage_rc(tid * 16 + i * 8192, R, C); const int Rb = Epi::PERM ? ((R & ~31) + perm32(R & 31)) : R;
        voffA[i] = (unsigned)(R * g.lda + C) * 2u; voffB[i] = (unsigned)(Rb * g.ldb + C) * 2u; }
    const size_t kstep = (size_t)(BK * 2);
    const size_t hstA = (size_t)HALF * g.lda * 2, hstB = (size_t)HALF * g.ldb * 2;
    const size_t tstA = 2 * hstA, tstB = 2 * hstB;
    const unsigned ldsw = (unsigned)wid * 1024u;
    const int aoff = lds_byte(wr * 64 + fr, fq * 8), boff = lds_byte(wc * 32 + fr, fq * 8);
#define PG8_SA(b, h) (((b) * 2 + (h)) * HTB)
#define PG8_SB(b, h) ((4 + (b) * 2 + (h)) * HTB)
#define PG8_STAGE(bufoff, gbase, voff) do { _Pragma("unroll") for (int _i = 0; _i < 2; ++_i) \
        __builtin_amdgcn_global_load_lds((const unsigned*)((const char*)(gbase) + (voff)[_i]), (LAS unsigned*)(lds + (bufoff) + ldsw + _i * 8192), 16, 0, 0); } while (0)
#define PG8_LDA(dst, b, h) do { _Pragma("unroll") for (int m = 0; m < 4; ++m) _Pragma("unroll") for (int k = 0; k < 2; ++k) dst[m][k] = *(const LAS bf16x8*)(lds + PG8_SA(b, h) + aoff + m * 2048 + k * 1024); } while (0)
#define PG8_LDB(dst, b, h) do { _Pragma("unroll") for (int n = 0; n < 2; ++n) _Pragma("unroll") for (int k = 0; k < 2; ++k) dst[n][k] = *(const LAS bf16x8*)(lds + PG8_SB(b, h) + boff + n * 2048 + k * 1024); } while (0)
#define PG8_MMA(ai, bj, At, Bt) do { __builtin_amdgcn_s_setprio(1); _Pragma("unroll") for (int m = 0; m < 4; ++m) _Pragma("unroll") for (int n = 0; n < 2; ++n) _Pragma("unroll") for (int k = 0; k < 2; ++k) \
        acc[ai][bj][m][n] = __builtin_amdgcn_mfma_f32_16x16x32_bf16(Bt[n][k], At[m][k], acc[ai][bj][m][n], 0, 0, 0); __builtin_amdgcn_s_setprio(0); } while (0)
#define PG8_WAIT_V(n) asm volatile("s_waitcnt vmcnt(" #n ")" ::: "memory")
#define PG8_WAIT_L(n) asm volatile("s_waitcnt lgkmcnt(" #n ")" ::: "memory")
#define PG8_BAR __builtin_amdgcn_s_barrier()
#define PG8_SCHED __builtin_amdgcn_sched_barrier(0)
    Unit cur, nxt; int ui = 0;
    if (!S.next(0, cur)) return;
    f32x4 acc[2][2][4][2];
#pragma unroll
    for (int a = 0; a < 2; ++a)
#pragma unroll
        for (int b = 0; b < 2; ++b)
#pragma unroll
            for (int m = 0; m < 4; ++m)
#pragma unroll
                for (int n = 0; n < 2; ++n) acc[a][b][m][n] = (f32x4){0.f, 0.f, 0.f, 0.f};
    bf16x8 At[4][2], B0[2][2], B1[2][2];
    const char* cA = (const char*)g.A + (size_t)cur.pm * tstA + cur.aoff; const char* cB = (const char*)g.Bt + (size_t)cur.pn * tstB;
    PG8_STAGE(PG8_SB(0, 0), cB, voffB); PG8_STAGE(PG8_SB(0, 1), cB + hstB, voffB); PG8_STAGE(PG8_SA(0, 0), cA, voffA); PG8_STAGE(PG8_SA(0, 1), cA + hstA, voffA);
    if (wr == 1) PG8_BAR;
    PG8_WAIT_V(2); PG8_BAR;
    PG8_STAGE(PG8_SB(1, 0), cB + kstep, voffB); PG8_STAGE(PG8_SA(1, 0), cA + kstep, voffA); PG8_STAGE(PG8_SB(1, 1), cB + hstB + kstep, voffB);
    PG8_WAIT_V(6); PG8_BAR;
    for (;;) {
        const bool has_next = S.next(ui + 1, nxt);
        const char* nA = has_next ? (const char*)g.A + (size_t)nxt.pm * tstA + nxt.aoff : cA; const char* nB = has_next ? (const char*)g.Bt + (size_t)nxt.pn * tstB : cB;
        for (int t = 0; t < nt; t += 2) {
            const bool last = (t == nt - 2);
            const char* a1 = cA + (size_t)(t + 1) * kstep;
            const char* a2 = last ? nA : cA + (size_t)(t + 2) * kstep; const char* b2 = last ? nB : cB + (size_t)(t + 2) * kstep;
            const char* a3 = a2 + kstep; const char* b3 = b2 + kstep;
            PG8_LDB(B0, 0, 0); PG8_LDB(B1, 0, 1); PG8_SCHED; PG8_LDA(At, 0, 0); PG8_STAGE(PG8_SA(1, 1), a1 + hstA, voffA);
            PG8_WAIT_V(8); PG8_WAIT_L(0); PG8_BAR; PG8_MMA(0, 0, At, B0); PG8_MMA(0, 1, At, B1); PG8_BAR; PG8_SCHED;
            PG8_LDA(At, 0, 1); PG8_STAGE(PG8_SB(0, 0), b2, voffB); PG8_STAGE(PG8_SB(0, 1), b2 + hstB, voffB); PG8_STAGE(PG8_SA(0, 0), a2, voffA);
            PG8_WAIT_V(8); PG8_WAIT_L(0); PG8_BAR; PG8_MMA(1, 0, At, B0); PG8_MMA(1, 1, At, B1); PG8_BAR; PG8_SCHED;
            PG8_LDB(B0, 1, 0); PG8_LDB(B1, 1, 1); PG8_SCHED; PG8_LDA(At, 1, 0); PG8_STAGE(PG8_SA(0, 1), a2 + hstA, voffA);
            PG8_WAIT_V(8); PG8_WAIT_L(0); PG8_BAR; PG8_MMA(0, 0, At, B0); PG8_MMA(0, 1, At, B1); PG8_BAR; PG8_SCHED;
            PG8_LDA(At, 1, 1); PG8_STAGE(PG8_SB(1, 0), b3, voffB); PG8_STAGE(PG8_SB(1, 1), b3 + hstB, voffB); PG8_STAGE(PG8_SA(1, 0), a3, voffA);
            PG8_WAIT_V(8); PG8_WAIT_L(0); PG8_BAR; PG8_MMA(1, 0, At, B0); PG8_MMA(1, 1, At, B1); PG8_BAR; PG8_SCHED;
        }
        if constexpr (ALIGN_EPI) { if (wr == 0) PG8_BAR; }
        E(acc, cur, wr, wc, fr, fq);
        if (!has_next) break;
#pragma unroll
        for (int a = 0; a < 2; ++a)
#pragma unroll
            for (int b = 0; b < 2; ++b)
#pragma unroll
                for (int m = 0; m < 4; ++m)
#pragma unroll
                    for (int n = 0; n < 2; ++n) acc[a][b][m][n] = (f32x4){0.f, 0.f, 0.f, 0.f};
        cur = nxt; cA = nA; cB = nB; ++ui;
        if constexpr (ALIGN_EPI) { if (wr == 1) PG8_BAR; }
    }
    PG8_WAIT_V(0);
    if constexpr (!ALIGN_EPI) { if (wr == 0) PG8_BAR; }
    PG8_BAR;
#undef PG8_SA
#undef PG8_SB
#undef PG8_STAGE
#undef PG8_LDA
#undef PG8_LDB
#undef PG8_MMA
#undef PG8_WAIT_V
#undef PG8_WAIT_L
#undef PG8_BAR
#undef PG8_SCHED
}
}

struct Args { const float* in[33]; float* out; unsigned char* ws; int ph_lo, ph_hi; };
enum { I_XP = 0, I_XS, I_PP, I_PS, I_RELB, I_NMIX, I_WIN, I_AQN, I_AKN, I_ALQ1, I_ALK1, I_ALQ2, I_ALK2, I_AON, I_BCQN, I_BCKVN, I_BWUQ, I_BWUKV, I_BQN, I_BKN,
       I_CQN, I_CKN, I_DQN, I_DKN, I_WG, I_WB, I_WO, I_NFFN, I_W1, I_W2, I_NPLE, I_WPG, I_WPP };

__device__ __forceinline__ int rel_bucket(int rel) {
    const int n = rel < 0 ? -rel : rel;
    const float nf = (float)(n > 1 ? n : 1);
    int large = 8 + (int)(logf(nf / 8.0f) / 4.852030263919617f * 8.0f);
    large = large < 15 ? large : 15;
    return (rel > 0 ? 16 : 0) + (n < 8 ? n : large);
}
__device__ __forceinline__ void build_tables(const float* relb, float* tabA, float* tabD, int gtid, int gthreads) {
    for (int i = gtid; i < 4 * TABA_N; i += gthreads) { const int h = i / TABA_N, d = i % TABA_N - TABA_OFF; tabA[i] = relb[rel_bucket(d) * 16 + h] * LOG2E; }
    for (int i = gtid; i < 12 * TABD_N; i += gthreads) { const int gh = i / TABD_N, d = i % TABD_N - TABD_OFF; const int g = gh >> 2; const int dil = g == 0 ? 1 : (g == 1 ? 4 : 16);
        const int ad = d < 0 ? -d : d; const bool ok = (ad % dil == 0) && (ad <= 64 * dil);
        tabD[i] = ok ? relb[rel_bucket(d) * 16 + 4 + gh] * LOG2E : -1e30f; }
}
__device__ __forceinline__ void transpose_item(const float* W, int N, int k0, int n0, bf16_t* dst, int K, LAS float* scr, int lane, int gate_b = -1) {
#pragma unroll 8
    for (int i = 0; i < 32; ++i) { const int kk = 2 * i + (lane >> 5); scr[kk * 33 + (lane & 31)] = W[(size_t)(k0 + kk) * N + n0 + (lane & 31)]; }
    asm volatile("s_waitcnt lgkmcnt(0)" ::: "memory");
    const int c = lane & 7;
#pragma unroll
    for (int j = 0; j < 4; ++j) { const int n = (lane >> 3) + 8 * j; const LAS float* s = scr + (8 * c) * 33 + n;
        u32x4 o; o.x = cvt_pk_bf16(s[0 * 33], s[1 * 33]); o.y = cvt_pk_bf16(s[2 * 33], s[3 * 33]); o.z = cvt_pk_bf16(s[4 * 33], s[5 * 33]); o.w = cvt_pk_bf16(s[6 * 33], s[7 * 33]);
        size_t drow = (size_t)n;
        if (gate_b >= 0) { const int nn = n0 + n, j = nn & 63; drow = (size_t)((nn >> 6) * 256 + 128 * (gate_b >> 1) + 32 * (j >> 4) + 8 * ((j >> 2) & 3) + 4 * (gate_b & 1) + (j & 3)); }
        *(u32x4*)(dst + drow * K + k0 + 8 * c) = o; }
    asm volatile("s_waitcnt lgkmcnt(0)" ::: "memory");
}
__device__ __forceinline__ int win_row(int n0) {
    if (n0 < 512) return PC_AQ + n0;
    if (n0 < 1024) return PC_AK + (n0 - 512);
    if (n0 < 1536) return -(0 + (n0 - 1024) + 1);
    if (n0 < 2048) return PC_BCQ + (n0 - 1536);
    if (n0 < 2560) return PC_BCKV + (n0 - 2048);
    if (n0 < 2624) return PC_BKR + (n0 - 2560);
    if (n0 < 3136) return PC_CQ + (n0 - 2624);
    if (n0 < 3392) return PC_CK + (n0 - 3136);
    if (n0 < 3648) return -(512 + (n0 - 3392) + 1);
    if (n0 < 5184) return PC_DQ + (n0 - 3648);
    if (n0 < 5696) return PC_DK + (n0 - 5184);
    return -(768 + (n0 - 5696) + 1);
}
__device__ __forceinline__ void convert_weights(const Args& a, int layer, unsigned char* W, LAS float* scr, int gw, int ngw, int lane) {
    constexpr int I_IN = 32 * 194, I_G = 4 * 32 * 64, I_B = 4 * 8 * 64, I_O = 32 * 64, I_1 = 32 * 256, I_2 = 128 * 64, I_PG = 32 * 64, I_PPn = 4 * 64, I_UQ = 8 * 24, I_UKV = 8 * 32;
    constexpr int NIT = I_IN + I_G + I_B + I_O + I_1 + I_2 + I_PG + I_PPn + I_UQ + I_UKV;
    for (int it = gw; it < NIT; it += ngw) {
        int r = it;
        if (r < I_IN) { const int kb = r / 194, nb = r % 194; const int dr = win_row(nb * 32);
            bf16_t* dst = dr >= 0 ? (bf16_t*)(W + WO_IN) + (size_t)dr * 2048 : (bf16_t*)(W + WO_INV) + (size_t)(-dr - 1) * 2048;
            transpose_item(a.in[I_WIN] + (size_t)layer * 2048 * 6208, 6208, kb * 64, nb * 32, dst, 2048, scr, lane); continue; } r -= I_IN;
        if (r < I_G) { const int b = r / 2048, q = r % 2048, kb = q / 64, nb = q % 64;
            transpose_item(a.in[I_WG] + ((size_t)layer * 4 + b) * 2048 * 2048, 2048, kb * 64, nb * 32, (bf16_t*)(W + WO_G), 2048, scr, lane, b); continue; } r -= I_G;
        if (r < I_B) { const int b = r / 512, q = r % 512, kb = q / 64, nb = q % 64;
            transpose_item(a.in[I_WB] + ((size_t)layer * 4 + b) * 512 * 2048, 2048, kb * 64, nb * 32, (bf16_t*)(W + WO_B) + ((size_t)b * 2048 + nb * 32) * 512, 512, scr, lane); continue; } r -= I_B;
        if (r < I_O) { const int kb = r / 64, nb = r % 64;
            transpose_item(a.in[I_WO] + (size_t)layer * 2048 * 2048, 2048, kb * 64, nb * 32, (bf16_t*)(W + WO_O) + (size_t)(nb * 32) * 2048, 2048, scr, lane); continue; } r -= I_O;
        if (r < I_1) { const int kb = r / 256, nb = r % 256;
            transpose_item(a.in[I_W1] + (size_t)layer * 2048 * 8192, 8192, kb * 64, nb * 32, (bf16_t*)(W + WO_1) + (size_t)(nb * 32) * 2048, 2048, scr, lane); continue; } r -= I_1;
        if (r < I_2) { const int kb = r / 64, nb = r % 64;
            transpose_item(a.in[I_W2] + (size_t)layer * 8192 * 2048, 2048, kb * 64, nb * 32, (bf16_t*)(W + WO_2) + (size_t)(nb * 32) * 8192, 8192, scr, lane); continue; } r -= I_2;
        if (r < I_PG) { const int kb = r / 64, nb = r % 64;
            transpose_item(a.in[I_WPG] + (size_t)layer * 2048 * 2048, 2048, kb * 64, nb * 32, (bf16_t*)(W + WO_PG) + (size_t)(nb * 32) * 2048, 2048, scr, lane); continue; } r -= I_PG;
        if (r < I_PPn) { const int kb = r / 64, nb = r % 64;
            transpose_item(a.in[I_WPP] + (size_t)layer * 256 * 2048, 2048, kb * 64, nb * 32, (bf16_t*)(W + WO_PP) + (size_t)(nb * 32) * 256, 256, scr, lane); continue; } r -= I_PPn;
        if (r < I_UQ) { const int kb = r / 24, nb = r % 24;
            transpose_item(a.in[I_BWUQ] + (size_t)layer * 512 * 768, 768, kb * 64, nb * 32, (bf16_t*)(W + WO_UQ) + (size_t)(nb * 32) * 512, 512, scr, lane); continue; } r -= I_UQ;
        { const int kb = r / 32, nb = r % 32; const int n0 = nb * 32, h = n0 >> 8, j0 = n0 & 255;
            bf16_t* dst = j0 < 128 ? (bf16_t*)(W + WO_UKN) + (size_t)(h * 128 + j0) * 512 : (bf16_t*)(W + WO_UKV) + (size_t)(h * 128 + j0 - 128) * 512;
            transpose_item(a.in[I_BWUKV] + (size_t)layer * 512 * 1024, 1024, kb * 64, n0, dst, 512, scr, lane); }
    }
}

__device__ __forceinline__ void norm_row(const float* x, const float* g, bf16_t* out, int lane) {
    f32x4 v[8]; float s = 0.f;
#pragma unroll
    for (int j = 0; j < 8; ++j) { v[j] = *(const f32x4*)(x + 4 * lane + 256 * j); s += (v[j][0] * v[j][0] + v[j][1] * v[j][1]) + (v[j][2] * v[j][2] + v[j][3] * v[j][3]); }
    const float rs = 1.0f / sqrtf(wave_sum(s) * (1.0f / 2048.0f) + EPS);
#pragma unroll
    for (int j = 0; j < 8; ++j) { const f32x4 gg = *(const f32x4*)(g + 4 * lane + 256 * j);
        u32x2 w; w.x = cvt_pk_bf16(v[j][0] * rs * gg[0], v[j][1] * rs * gg[1]); w.y = cvt_pk_bf16(v[j][2] * rs * gg[2], v[j][3] * rs * gg[3]);
        *(u32x2*)(out + 4 * lane + 256 * j) = w; }
}
__device__ __forceinline__ void load8(const bf16_t* p, float (&f)[8]) { const u32x4 v = *(const u32x4*)p; f[0] = bf_lo(v.x); f[1] = bf_hi(v.x); f[2] = bf_lo(v.y); f[3] = bf_hi(v.y); f[4] = bf_lo(v.z); f[5] = bf_hi(v.z); f[6] = bf_lo(v.w); f[7] = bf_hi(v.w); }
__device__ __forceinline__ void store8(bf16_t* p, const float (&f)[8]) { u32x4 w; w.x = cvt_pk_bf16(f[0], f[1]); w.y = cvt_pk_bf16(f[2], f[3]); w.z = cvt_pk_bf16(f[4], f[5]); w.w = cvt_pk_bf16(f[6], f[7]); *(u32x4*)p = w; }
template <int GRP> __device__ __forceinline__ void norm8(float (&f)[8], const float* g, float scale, int lane) {
    float s = 0.f;
#pragma unroll
    for (int e = 0; e < 8; ++e) s += f[e] * f[e];
#pragma unroll
    for (int o = 1; o < GRP; o <<= 1) s += __shfl_xor(s, o);
    const float rs = scale / sqrtf(s * (1.0f / (GRP * 8)) + EPS);
    const int gi = (lane & (GRP - 1)) * 8;
#pragma unroll
    for (int e = 0; e < 8; ++e) f[e] = f[e] * rs * g[gi + e];
}
__device__ __forceinline__ float rope_inv(int i) { return __builtin_amdgcn_exp2f(-(float)i * (13.287712379549449f / 32.0f)) * 0.15915494309189535f; }
__device__ __forceinline__ void sincos_rev(float rev, float& sn, float& cs) { rev -= rintf(rev); sn = __builtin_amdgcn_sinf(rev); cs = __builtin_amdgcn_cosf(rev); }
__device__ __forceinline__ void axial_rope8(float (&f)[8], float rowpos, float colpos, int lane) {
    const int j = lane & 15, hf = j >> 3, jj = j & 7; const float pos = hf ? colpos : rowpos; const float sgn = jj < 4 ? -1.f : 1.f; const int i0 = 8 * (jj & 3);
#pragma unroll
    for (int e = 0; e < 8; ++e) { const float pv = __shfl_xor(f[e], 4); float sn, cs; sincos_rev(pos * rope_inv(i0 + e), sn, cs); f[e] = f[e] * cs + sgn * pv * sn; }
}
__device__ __forceinline__ void post1_row(const Args& a, int layer, bf16_t* P, int tseq, int lane) {
    float f[8];
    const float sA = 0.125f * LOG2E, sC = 0.08838834764831845f * LOG2E;
    load8(P + PC_AQ + 8 * lane, f); norm8<8>(f, a.in[I_AQN] + layer * 64, sA, lane); store8(P + PC_AQ + 8 * lane, f);
    load8(P + PC_AK + 8 * lane, f); norm8<8>(f, a.in[I_AKN] + layer * 64, 1.f, lane); store8(P + PC_AK + 8 * lane, f);
    load8(P + PC_BCQ + 8 * lane, f); norm8<64>(f, a.in[I_BCQN] + layer * 512, 1.f, lane); store8(P + PC_BCQ + 8 * lane, f);
    load8(P + PC_BCKV + 8 * lane, f); norm8<64>(f, a.in[I_BCKVN] + layer * 512, 1.f, lane); store8(P + PC_BCKV + 8 * lane, f);
    const float rowpos = (float)(tseq >> 6), colpos = (float)(tseq & 63);
    load8(P + PC_CQ + 8 * lane, f); norm8<16>(f, a.in[I_CQN] + layer * 128, sC, lane); axial_rope8(f, rowpos, colpos, lane); store8(P + PC_CQ + 8 * lane, f);
    { const int l2 = lane & 31; load8(P + PC_CK + 8 * l2, f); norm8<16>(f, a.in[I_CKN] + layer * 128, 1.f, lane); axial_rope8(f, rowpos, colpos, lane); if (lane < 32) store8(P + PC_CK + 8 * l2, f); }
#pragma unroll
    for (int p = 0; p < 3; ++p) { load8(P + PC_DQ + 512 * p + 8 * lane, f); norm8<16>(f, a.in[I_DQN] + layer * 128, sC, lane); store8(P + PC_DQ + 512 * p + 8 * lane, f); }
    load8(P + PC_DK + 8 * lane, f); norm8<16>(f, a.in[I_DKN] + layer * 128, 1.f, lane); store8(P + PC_DK + 8 * lane, f);
}
__device__ __forceinline__ void mla_norm_rope(float (&f)[8], float (&r)[4], const float* g, float scale, float pos, int lane) {
    const int j = lane & 15;
    float s = 0.f;
#pragma unroll
    for (int e = 0; e < 8; ++e) s += f[e] * f[e];
#pragma unroll
    for (int e = 0; e < 4; ++e) s += r[e] * r[e];
#pragma unroll
    for (int o = 1; o < 16; o <<= 1) s += __shfl_xor(s, o);
    const float rs = scale / sqrtf(s * (1.0f / 192.0f) + EPS);
#pragma unroll
    for (int e = 0; e < 8; ++e) f[e] = f[e] * rs * g[8 * j + e];
#pragma unroll
    for (int e = 0; e < 4; ++e) r[e] = r[e] * rs * g[128 + 4 * j + e];
    const float sgn = j < 8 ? -1.f : 1.f; const int i0 = 4 * (j & 7);
#pragma unroll
    for (int e = 0; e < 4; ++e) { const float pv = __shfl_xor(r[e], 8); float sn, cs; sincos_rev(pos * rope_inv(i0 + e), sn, cs); r[e] = r[e] * cs + sgn * pv * sn; }
}
__device__ __forceinline__ void post2_row(const Args& a, int layer, bf16_t* Q, bf16_t* Kr, const bf16_t* P, int tseq, int lane) {
    const int h = lane >> 4, j = lane & 15; const float pos = (float)tseq;
    float f[8], r[4];
    { bf16_t* q = Q + h * 192; load8(q + 8 * j, f); const u32x2 v = *(const u32x2*)(q + 128 + 4 * j); r[0] = bf_lo(v.x); r[1] = bf_hi(v.x); r[2] = bf_lo(v.y); r[3] = bf_hi(v.y);
      mla_norm_rope(f, r, a.in[I_BQN] + layer * 192, 0.07216878364870323f * LOG2E, pos, lane);
      store8(q + 8 * j, f); u32x2 w; w.x = cvt_pk_bf16(r[0], r[1]); w.y = cvt_pk_bf16(r[2], r[3]); *(u32x2*)(q + 128 + 4 * j) = w; }
    { bf16_t* k = Kr + h * 192; load8(k + 8 * j, f); const u32x2 v = *(const u32x2*)(P + PC_BKR + 4 * j); r[0] = bf_lo(v.x); r[1] = bf_hi(v.x); r[2] = bf_lo(v.y); r[3] = bf_hi(v.y);
      mla_norm_rope(f, r, a.in[I_BKN] + layer * 192, 1.f, pos, lane);
      store8(k + 8 * j, f); u32x2 w; w.x = cvt_pk_bf16(r[0], r[1]); w.y = cvt_pk_bf16(r[2], r[3]); *(u32x2*)(k + 128 + 4 * j) = w; }
}

struct AState { float m, l; f32x16 o[4]; };
__device__ __forceinline__ void astate_init(AState& st) { st.m = -3.0e38f; st.l = 0.f;
#pragma unroll
    for (int d = 0; d < 4; ++d)
#pragma unroll
        for (int r = 0; r < 16; ++r) st.o[d][r] = 0.f; }
template <int DK, bool TAB, bool QLDS = false>
__device__ __forceinline__ void attn_pass(AState& st, const bf16_t* qp, const bf16_t* kp, long ldk, const bf16_t* vp, long ldv, int kbeg, int kend, const float* tp, LAS bf16x8* qst = nullptr) {
    constexpr int NS = DK / 16;
    bf16x8 qf[QLDS ? 1 : NS], kf[NS];
    if (QLDS) {
#pragma unroll
        for (int s = 0; s < NS; ++s) qst[s * 64] = *(const bf16x8*)(qp + 16 * s);
    } else {
#pragma unroll
        for (int s = 0; s < NS; ++s) qf[s] = *(const bf16x8*)(qp + 16 * s);
    }
    { const bf16_t* k0p = kp + (long)kbeg * ldk;
#pragma unroll
      for (int s = 0; s < NS; ++s) kf[s] = *(const bf16x8*)(k0p + 16 * s); }
    for (int k0 = kbeg; k0 < kend; k0 += 32) {
        bf16x8 vf[4][2];
#pragma unroll
        for (int d = 0; d < 4; ++d)
#pragma unroll
            for (int s = 0; s < 2; ++s) vf[d][s] = *(const bf16x8*)(vp + (long)(32 * d) * ldv + k0 + 16 * s);
        f32x4 tb[4];
        if (TAB) {
#pragma unroll
            for (int s = 0; s < 2; ++s) { tb[2 * s] = *(const f32x4u*)(tp + k0 + 16 * s); tb[2 * s + 1] = *(const f32x4u*)(tp + k0 + 16 * s + 4); } }
        f32x16 sc;
#pragma unroll
        for (int r = 0; r < 16; ++r) sc[r] = 0.f;
#pragma unroll
        for (int s = 0; s < NS; ++s) sc = __builtin_amdgcn_mfma_f32_32x32x16_bf16(kf[s], QLDS ? qst[s * 64] : qf[QLDS ? 0 : s], sc, 0, 0, 0);
        if (k0 + 32 < kend) { const bf16_t* knp = kp + (long)(k0 + 32) * ldk;
#pragma unroll
            for (int s = 0; s < NS; ++s) kf[s] = *(const bf16x8*)(knp + 16 * s); }
        if (TAB) {
#pragma unroll
            for (int r = 0; r < 16; ++r) sc[r] += tb[r >> 2][r & 3]; }
        float mx = sc[0];
#pragma unroll
        for (int r = 1; r < 16; ++r) mx = fmaxf(mx, sc[r]);
        mx = fmaxf(mx, __shfl_xor(mx, 32));
        const float mn = fmaxf(st.m, mx);
        const float alpha = __builtin_amdgcn_exp2f(st.m - mn);
        st.m = mn;
        float ps = 0.f;
#pragma unroll
        for (int r = 0; r < 16; ++r) { sc[r] = __builtin_amdgcn_exp2f(sc[r] - mn); ps += sc[r]; }
        st.l = st.l * alpha + ps;
#pragma unroll
        for (int d = 0; d < 4; ++d)
#pragma unroll
            for (int r = 0; r < 16; ++r) st.o[d][r] *= alpha;
        u32x4 p0, p1;
        p0.x = cvt_pk_bf16(sc[0], sc[1]); p0.y = cvt_pk_bf16(sc[2], sc[3]); p0.z = cvt_pk_bf16(sc[4], sc[5]); p0.w = cvt_pk_bf16(sc[6], sc[7]);
        p1.x = cvt_pk_bf16(sc[8], sc[9]); p1.y = cvt_pk_bf16(sc[10], sc[11]); p1.z = cvt_pk_bf16(sc[12], sc[13]); p1.w = cvt_pk_bf16(sc[14], sc[15]);
        const bf16x8 pf0 = __builtin_bit_cast(bf16x8, p0), pf1 = __builtin_bit_cast(bf16x8, p1);
#pragma unroll
        for (int d = 0; d < 4; ++d) { st.o[d] = __builtin_amdgcn_mfma_f32_32x32x16_bf16(vf[d][0], pf0, st.o[d], 0, 0, 0); st.o[d] = __builtin_amdgcn_mfma_f32_32x32x16_bf16(vf[d][1], pf1, st.o[d], 0, 0, 0); }
    }
}
__device__ __forceinline__ void astate_finish(AState& st) {
    const float l = st.l + __shfl_xor(st.l, 32); const float inv = 1.0f / l;
#pragma unroll
    for (int d = 0; d < 4; ++d)
#pragma unroll
        for (int r = 0; r < 16; ++r) st.o[d][r] *= inv;
}
__device__ __forceinline__ void store_o(const f32x16 (&o)[4], bf16_t* op) {
#pragma unroll
    for (int d = 0; d < 4; ++d)
#pragma unroll
        for (int g = 0; g < 4; ++g) { u32x2 w; w.x = cvt_pk_bf16(o[d][4 * g], o[d][4 * g + 1]); w.y = cvt_pk_bf16(o[d][4 * g + 2], o[d][4 * g + 3]); *(u32x2*)(op + 32 * d + 8 * g) = w; }
}
__device__ __forceinline__ int pi32(int n) { return (n & ~12) | ((n & 4) << 1) | ((n & 8) >> 1); }

struct AttnBufs { const bf16_t* PROJ; const bf16_t* VT; const bf16_t* QB; const bf16_t* KB; const bf16_t* VTB; bf16_t* BR; const float* tabA; const float* tabD; };

__device__ __forceinline__ void attn_unit(const Args& a, const AttnBufs& B, int layer, int mixer, int head, int row0  , int S, int q0  , int lane, LAS float* stash) {
#define ATT_LANE_SETUP int ln_ = lane; asm volatile("" : "+v"(ln_)); const int n = ln_ & 31, hi = ln_ >> 5, pr = pi32(n); const long qrow = (long)row0 + q0 + n; bf16_t* op = B.BR + qrow * 2048 + 4 * hi;
#ifdef ONLY_MIXER
    mixer = ONLY_MIXER;
#endif
    if (mixer == 0) {
        ATT_LANE_SETUP
        const float lam_init = layer == 0 ? 0.2f : 0.35550906759f;
        const float d1 = wave_sum(a.in[I_ALQ1][layer * 64 + lane] * a.in[I_ALK1][layer * 64 + lane]);
        const float d2 = wave_sum(a.in[I_ALQ2][layer * 64 + lane] * a.in[I_ALK2][layer * 64 + lane]);
        const float lam = expf(d1) - expf(d2) + lam_init;
        const bf16_t* vp = B.VT + (long)(head * 128 + n) * TCM + row0 + 8 * hi;
        const float* tp = B.tabA + head * TABA_N + TABA_OFF - (q0 + n) + 8 * hi;
        { AState st; astate_init(st);
          attn_pass<64, true>(st, B.PROJ + qrow * NP + PC_AQ + head * 128 + 8 * hi, B.PROJ + (long)(row0 + pr) * NP + PC_AK + head * 128 + 8 * hi, NP, vp, TCM, 0, S, tp);
          astate_finish(st);
#pragma unroll
          for (int d = 0; d < 4; ++d)
#pragma unroll
              for (int r = 0; r < 16; ++r) stash[(d * 16 + r) * 64 + lane] = st.o[d][r]; }
        AState st; astate_init(st);
        attn_pass<64, true>(st, B.PROJ + qrow * NP + PC_AQ + head * 128 + 64 + 8 * hi, B.PROJ + (long)(row0 + pr) * NP + PC_AK + head * 128 + 64 + 8 * hi, NP, vp, TCM, 0, S, tp);
        astate_finish(st);
        float ss = 0.f;
#pragma unroll
        for (int d = 0; d < 4; ++d)
#pragma unroll
            for (int r = 0; r < 16; ++r) { const float v = stash[(d * 16 + r) * 64 + lane] - lam * st.o[d][r]; st.o[d][r] = v; ss += v * v; }
        ss += __shfl_xor(ss, 32);
        const float rs = (1.0f - lam_init) / sqrtf(ss * (1.0f / 128.0f) + EPS);
        const float* gn = a.in[I_AON] + layer * 128 + 4 * hi;
#pragma unroll
        for (int d = 0; d < 4; ++d)
#pragma unroll
            for (int g = 0; g < 4; ++g) { const f32x4 gg = *(const f32x4*)(gn + 32 * d + 8 * g);
#pragma unroll
                for (int e = 0; e < 4; ++e) st.o[d][4 * g + e] *= rs * gg[e]; }
        store_o(st.o, op + head * 128);
    } else if (mixer == 1) {
        ATT_LANE_SETUP
        AState st; astate_init(st);
        attn_pass<192, false, true>(st, B.QB + qrow * 768 + head * 192 + 8 * hi, B.KB + (long)(row0 + pr) * 768 + head * 192 + 8 * hi, 768,
                              B.VTB + (long)(head * 128 + n) * TCM + row0 + 8 * hi, TCM, 0, S, nullptr, (LAS bf16x8*)stash + lane);
        astate_finish(st); store_o(st.o, op + 512 + head * 128);
    } else if (mixer == 2) {
        ATT_LANE_SETUP
        const int kv = head >> 1;
        AState st; astate_init(st);
        attn_pass<128, false>(st, B.PROJ + qrow * NP + PC_CQ + head * 128 + 8 * hi, B.PROJ + (long)(row0 + pr) * NP + PC_CK + kv * 128 + 8 * hi, NP,
                              B.VT + (long)(512 + kv * 128 + n) * TCM + row0 + 8 * hi, TCM, 0, S, nullptr);
        astate_finish(st); store_o(st.o, op + 1024 + head * 128);
    } else {
        ATT_LANE_SETUP
        AState st; astate_init(st);
        const bf16_t* kp = B.PROJ + (long)(row0 + pr) * NP + PC_DK + head * 128 + 8 * hi;
        const bf16_t* vp = B.VT + (long)(768 + head * 128 + n) * TCM + row0 + 8 * hi;
#pragma unroll 1
        for (int g = 0; g < 3; ++g) { const int W = g == 0 ? 64 : (g == 1 ? 256 : 1024);
            const int kb = q0 - W > 0 ? q0 - W : 0, ke = q0 + 32 + W < S ? q0 + 32 + W : S;
            attn_pass<128, true>(st, B.PROJ + qrow * NP + PC_DQ + (g * 4 + head) * 128 + 8 * hi, kp, NP, vp, TCM, kb, ke, B.tabD + (g * 4 + head) * TABD_N + TABD_OFF - (q0 + n) + 8 * hi); }
        astate_finish(st); store_o(st.o, op + 1536 + head * 128);
    }
}
__device__ __forceinline__ void attn_phase(const Args& a, const AttnBufs& B, int layer, int chunk, unsigned* ctr, int lane, LAS float* stash) {
    const int npr = chunk == 0 ? 1 : 0, nsm = chunk == 0 ? 4 : 12, TC = chunk == 0 ? 16384 : 24576;
    const int nP = npr * 1024, nS = nsm * 256, nD = TC / 8, total = 3 * nP + 3 * nS + nD;
    for (;;) {
        unsigned uu = 0; if (lane == 0) uu = atomicAdd(ctr, 1u);
        int u = __builtin_amdgcn_readfirstlane((int)uu);
        if (u >= total) break;
        int mixer, head, row0, S, q0;
        if (u < 3 * nP) { mixer = u / nP; const int r = u % nP; q0 = (r % 256) * 32; head = r / 256; row0 = 0; S = TP; }
        else { u -= 3 * nP;
            if (u < 3 * nS) { mixer = u / nS; const int r = u % nS; q0 = (r % 64) * 32; head = (r / 64) % 4; row0 = npr * TP + (r / 256) * SS; S = SS; }
            else { u -= 3 * nS; mixer = 3; const int qb = u % (TC / 32); head = u / (TC / 32); const int q = qb * 32;
                if (npr && q < TP) { row0 = 0; S = TP; } else { row0 = npr * TP + ((q - npr * TP) / SS) * SS; S = SS; }
                q0 = q - row0; } }
#ifdef ONLY_MIXER
        if (mixer != ONLY_MIXER) continue;
#endif
        attn_unit(a, B, layer, mixer, head, row0, S, q0, lane, stash);
    }
}


constexpr int A2_RSV = 144, A2_BUFSZ = 64 * 400 + 128 * A2_RSV;
static_assert(2 * A2_BUFSZ <= 131072 && 2 * A2_BUFSZ >= 65536, "attention LDS");
template <int DKL, int DK, bool TAB>
__device__ __forceinline__ void attn2_pass(AState& st, LAS unsigned char* buf, const bf16_t* qp, int koff, const bf16_t* Kg, long ldk, const bf16_t* Vg, long ldv,
                                           int kbeg, int kend, const float* tp, int wlo, int whi, int tid_in, int lane) {
    constexpr int NS = DK / 16, PR = DKL / 8, NKP = DKL / 64, RSK = DKL * 2 + 16, KBYTES = 64 * RSK;
    int tid = tid_in; asm volatile("" : "+v"(tid));
    const int n = lane & 31, hi = lane >> 5, pr = pi32(n);
    bf16x8 qf[NS];
#pragma unroll
    for (int s = 0; s < NS; ++s) qf[s] = *(const bf16x8*)(qp + 16 * s);
    u32x4 kreg[NKP], vreg[2];
    int krow[NKP], kc[NKP];
#pragma unroll
    for (int i = 0; i < NKP; ++i) { const int p = tid + 512 * i; krow[i] = p / PR; kc[i] = p % PR; }
#define A2_GLOAD(k0_) do { _Pragma("unroll") for (int i = 0; i < NKP; ++i) kreg[i] = *(const u32x4*)(Kg + (long)((k0_) + krow[i]) * ldk + 8 * kc[i]); \
        _Pragma("unroll") for (int i = 0; i < 2; ++i) { const int p = tid + 512 * i; vreg[i] = *(const u32x4*)(Vg + (long)(p >> 3) * ldv + (k0_) + 8 * (p & 7)); } } while (0)
#define A2_LSTORE(b_) do { _Pragma("unroll") for (int i = 0; i < NKP; ++i) *(LAS u32x4*)(buf + (b_) * A2_BUFSZ + krow[i] * RSK + kc[i] * 16) = kreg[i]; \
        _Pragma("unroll") for (int i = 0; i < 2; ++i) { const int p = tid + 512 * i; *(LAS u32x4*)(buf + (b_) * A2_BUFSZ + KBYTES + (p >> 3) * A2_RSV + (p & 7) * 16) = vreg[i]; } } while (0)
    A2_GLOAD(kbeg); A2_LSTORE(0); __syncthreads();
    int b = 0;
    const int kfo = pr * RSK + koff + hi * 16, vfo = KBYTES + n * A2_RSV + hi * 16;
    for (int k0 = kbeg; k0 < kend; k0 += 64) {
        const bool more = k0 + 64 < kend;
        if (more) A2_GLOAD(k0 + 64);
        LAS unsigned char* bb = buf + b * A2_BUFSZ;
#pragma unroll
        for (int sb = 0; sb < 2; ++sb) {
            const int ks = k0 + 32 * sb;
            if (ks + 32 <= wlo || ks >= whi) continue;
            f32x4 tb[4];
            if (TAB) {
#pragma unroll
                for (int s = 0; s < 2; ++s) { tb[2 * s] = *(const f32x4u*)(tp + ks + 16 * s); tb[2 * s + 1] = *(const f32x4u*)(tp + ks + 16 * s + 4); } }
            f32x16 sc;
#pragma unroll
            for (int r = 0; r < 16; ++r) sc[r] = 0.f;
#pragma unroll
            for (int s = 0; s < NS; ++s) { const bf16x8 kf = *(const LAS bf16x8*)(bb + kfo + (32 * sb) * RSK + 32 * s); sc = __builtin_amdgcn_mfma_f32_32x32x16_bf16(kf, qf[s], sc, 0, 0, 0); }
            if (TAB) {
#pragma unroll
                for (int r = 0; r < 16; ++r) sc[r] += tb[r >> 2][r & 3]; }
            float mx = sc[0];
#pragma unroll
            for (int r = 1; r < 16; ++r) mx = fmaxf(mx, sc[r]);
            mx = fmaxf(mx, __shfl_xor(mx, 32));
            if (__any(mx > st.m + 8.0f)) {
                const float mn = fmaxf(st.m, mx); const float alpha = __builtin_amdgcn_exp2f(st.m - mn); st.m = mn; st.l *= alpha;
#pragma unroll
                for (int d = 0; d < 4; ++d)
#pragma unroll
                    for (int r = 0; r < 16; ++r) st.o[d][r] *= alpha;
            }
            float ps = 0.f;
#pragma unroll
            for (int r = 0; r < 16; ++r) { sc[r] = __builtin_amdgcn_exp2f(sc[r] - st.m); ps += sc[r]; }
            st.l += ps;
            u32x4 p0, p1;
            p0.x = cvt_pk_bf16(sc[0], sc[1]); p0.y = cvt_pk_bf16(sc[2], sc[3]); p0.z = cvt_pk_bf16(sc[4], sc[5]); p0.w = cvt_pk_bf16(sc[6], sc[7]);
            p1.x = cvt_pk_bf16(sc[8], sc[9]); p1.y = cvt_pk_bf16(sc[10], sc[11]); p1.z = cvt_pk_bf16(sc[12], sc[13]); p1.w = cvt_pk_bf16(sc[14], sc[15]);
            const bf16x8 pf0 = __builtin_bit_cast(bf16x8, p0), pf1 = __builtin_bit_cast(bf16x8, p1);
#pragma unroll
            for (int d = 0; d < 4; ++d) {
                const bf16x8 v0 = *(const LAS bf16x8*)(bb + vfo + (32 * d) * A2_RSV + 64 * sb), v1 = *(const LAS bf16x8*)(bb + vfo + (32 * d) * A2_RSV + 64 * sb + 32);
                st.o[d] = __builtin_amdgcn_mfma_f32_32x32x16_bf16(v0, pf0, st.o[d], 0, 0, 0); st.o[d] = __builtin_amdgcn_mfma_f32_32x32x16_bf16(v1, pf1, st.o[d], 0, 0, 0); }
        }
        if (more) A2_LSTORE(b ^ 1);
        __syncthreads();
        b ^= 1;
    }
#undef A2_GLOAD
#undef A2_LSTORE
}

__device__ __forceinline__ void attn2_unit(const Args& a, const AttnBufs& B, int layer, int mixer, int head, int row0, int S, int q0, int tid, int lane, int wave, LAS unsigned char* buf) {
#ifdef ONLY_MIXER2
    mixer = ONLY_MIXER2;
#endif
    if (mixer == 0) {
        int ln_ = lane; asm volatile("" : "+v"(ln_)); const int n = ln_ & 31, hi = ln_ >> 5;
        const int half = wave >> 2, qw = q0 + 32 * (wave & 3); const long qrow = (long)row0 + qw + n;
        const float lam_init = layer == 0 ? 0.2f : 0.35550906759f;
        AState st; astate_init(st);
        attn2_pass<128, 64, true>(st, buf, B.PROJ + qrow * NP + PC_AQ + head * 128 + 64 * half + 8 * hi, 128 * half, B.PROJ + (long)row0 * NP + PC_AK + head * 128, NP,
                                  B.VT + (long)(head * 128) * TCM + row0, TCM, 0, S, B.tabA + head * TABA_N + TABA_OFF - (qw + n) + 8 * hi, 0, S, tid, ln_);
        astate_finish(st);
        LAS float* xb = (LAS float*)buf + (wave & 3) * 4096;
        if (half == 1) {
#pragma unroll
            for (int d = 0; d < 4; ++d)
#pragma unroll
                for (int r = 0; r < 16; ++r) xb[(d * 16 + r) * 64 + ln_] = st.o[d][r]; }
        __syncthreads();
        if (half == 0) {
            const float d1 = wave_sum(a.in[I_ALQ1][layer * 64 + ln_] * a.in[I_ALK1][layer * 64 + ln_]);
            const float d2 = wave_sum(a.in[I_ALQ2][layer * 64 + ln_] * a.in[I_ALK2][layer * 64 + ln_]);
            const float lam = expf(d1) - expf(d2) + lam_init;
            float ss = 0.f;
#pragma unroll
            for (int d = 0; d < 4; ++d)
#pragma unroll
                for (int r = 0; r < 16; ++r) { const float v = st.o[d][r] - lam * xb[(d * 16 + r) * 64 + ln_]; st.o[d][r] = v; ss += v * v; }
            ss += __shfl_xor(ss, 32);
            const float rs = (1.0f - lam_init) / sqrtf(ss * (1.0f / 128.0f) + EPS);
            const float* gn = a.in[I_AON] + layer * 128 + 4 * hi;
#pragma unroll
            for (int d = 0; d < 4; ++d)
#pragma unroll
                for (int g = 0; g < 4; ++g) { const f32x4 gg = *(const f32x4*)(gn + 32 * d + 8 * g);
#pragma unroll
                    for (int e = 0; e < 4; ++e) st.o[d][4 * g + e] *= rs * gg[e]; }
            store_o(st.o, B.BR + qrow * 2048 + 4 * hi + head * 128);
        }
    } else if (mixer == 1) {
        int ln_ = lane; asm volatile("" : "+v"(ln_)); const int n = ln_ & 31, hi = ln_ >> 5;
        const int qw = q0 + 32 * wave; const long qrow = (long)row0 + qw + n;
        AState st; astate_init(st);
        attn2_pass<192, 192, false>(st, buf, B.QB + qrow * 768 + head * 192 + 8 * hi, 0, B.KB + (long)row0 * 768 + head * 192, 768,
                                    B.VTB + (long)(head * 128) * TCM + row0, TCM, 0, S, nullptr, 0, S, tid, ln_);
        astate_finish(st); store_o(st.o, B.BR + qrow * 2048 + 4 * hi + 512 + head * 128);
    } else if (mixer == 2) {
        int ln_ = lane; asm volatile("" : "+v"(ln_)); const int n = ln_ & 31, hi = ln_ >> 5;
        const int qw = q0 + 32 * wave; const long qrow = (long)row0 + qw + n; const int kv = head >> 1;
        AState st; astate_init(st);
        attn2_pass<128, 128, false>(st, buf, B.PROJ + qrow * NP + PC_CQ + head * 128 + 8 * hi, 0, B.PROJ + (long)row0 * NP + PC_CK + kv * 128, NP,
                                    B.VT + (long)(512 + kv * 128) * TCM + row0, TCM, 0, S, nullptr, 0, S, tid, ln_);
        astate_finish(st); store_o(st.o, B.BR + qrow * 2048 + 4 * hi + 1024 + head * 128);
    } else {
        int ln_ = lane; asm volatile("" : "+v"(ln_)); const int n = ln_ & 31, hi = ln_ >> 5;
        const int qw = q0 + 32 * wave; const long qrow = (long)row0 + qw + n;
        AState st; astate_init(st);
#pragma unroll 1
        for (int g = 0; g < 3; ++g) { const int W = g == 0 ? 64 : (g == 1 ? 256 : 1024);
            const int kb = q0 - W > 0 ? q0 - W : 0, ke = q0 + 256 + W < S ? q0 + 256 + W : S;
            attn2_pass<128, 128, true>(st, buf, B.PROJ + qrow * NP + PC_DQ + (g * 4 + head) * 128 + 8 * hi, 0, B.PROJ + (long)row0 * NP + PC_DK + head * 128, NP,
                                       B.VT + (long)(768 + head * 128) * TCM + row0, TCM, kb, ke, B.tabD + (g * 4 + head) * TABD_N + TABD_OFF - (qw + n) + 8 * hi, qw - W, qw + 32 + W, tid, ln_); }
        astate_finish(st); store_o(st.o, B.BR + qrow * 2048 + 4 * hi + 1536 + head * 128);
    }
}
__device__ __forceinline__ void attn2_phase(const Args& a, const AttnBufs& B, int layer, int chunk, unsigned* ctr, int tid, int lane, int wave, LAS unsigned char* lds) {
    const int npr = chunk == 0 ? 1 : 0, nsm = chunk == 0 ? 4 : 12, TC = chunk == 0 ? 16384 : 24576;
    const int c0 = npr * 128, c1 = npr * 128, c2 = npr * 256, c3 = TC / 64, c4 = nsm * 32, c5 = nsm * 32, c6 = nsm * 64;
    const int total = c0 + c1 + c2 + c3 + c4 + c5 + c6;
    volatile LAS int* uw = (volatile LAS int*)(lds + 131072);
    for (;;) {
        __syncthreads();
        if (tid == 0) *uw = (int)atomicAdd(ctr, 1u);
        __syncthreads();
        int u = __builtin_amdgcn_readfirstlane(*uw);
        if (u >= total) break;
        int mixer, head, row0, S, q0;
        if (u < c0 + c1 + c2) { row0 = 0; S = TP;
            if (u < c0) { mixer = 1; q0 = (u % 32) * 256; head = u / 32; }
            else if (u < c0 + c1) { u -= c0; mixer = 2; q0 = (u % 32) * 256; head = u / 32; }
            else { u -= c0 + c1; mixer = 0; q0 = (u % 64) * 128; head = u / 64; }
        } else { u -= c0 + c1 + c2;
            if (u < c3) { mixer = 3; const int nb = TC / 256; const int q = (u % nb) * 256; head = u / nb;
                if (npr && q < TP) { row0 = 0; S = TP; } else { row0 = npr * TP + ((q - npr * TP) / SS) * SS; S = SS; }
                q0 = q - row0; }
            else { u -= c3; S = SS;
                if (u < c4) { mixer = 1; q0 = (u % 8) * 256; head = (u / 8) % 4; row0 = npr * TP + (u / 32) * SS; }
                else if (u < c4 + c5) { u -= c4; mixer = 2; q0 = (u % 8) * 256; head = (u / 8) % 4; row0 = npr * TP + (u / 32) * SS; }
                else { u -= c4 + c5; mixer = 0; q0 = (u % 16) * 128; head = (u / 16) % 4; row0 = npr * TP + (u / 64) * SS; } } }
        attn2_unit(a, B, layer, mixer, head, row0, S, q0, tid, lane, wave, lds);
    }
}

__global__ void __launch_bounds__(512, 2) mega(Args a) {
    extern __shared__ __attribute__((aligned(16))) unsigned char lds_raw[];
    LAS unsigned char* lds = (LAS unsigned char*)lds_raw;
    const int G = gridDim.x, bx = blockIdx.x;
    unsigned char* ws = a.ws;
    unsigned* ctl = (unsigned*)(ws + WS_CTL);
    float* tabA = (float*)(ws + WS_TABA); float* tabD = (float*)(ws + WS_TABD);
    unsigned char* W = ws + WS_W;
    bf16_t* H = (bf16_t*)(ws + WS_H);
    bf16_t* PROJ = (bf16_t*)(ws + WS_R1 + R1_PROJ); bf16_t* VT = (bf16_t*)(ws + WS_R1 + R1_VT); bf16_t* QB = (bf16_t*)(ws + WS_R1 + R1_QB);
    bf16_t* KB = (bf16_t*)(ws + WS_R1 + R1_KB); bf16_t* VTB = (bf16_t*)(ws + WS_R1 + R1_VTB);
    bf16_t* Y = (bf16_t*)(ws + WS_R1); bf16_t* FFH = (bf16_t*)(ws + WS_R1);
    bf16_t* BR = (bf16_t*)(ws + WS_R2); float* PART = (float*)(ws + WS_R2); bf16_t* U = (bf16_t*)(ws + WS_R2);
    bf16_t* MERGED = (bf16_t*)(ws + WS_R3); bf16_t* P16 = (bf16_t*)(ws + WS_R3);
    cg::grid_group grid = cg::this_grid();

    for (int pid = a.ph_lo; pid < a.ph_hi; ++pid) {
        int tid = threadIdx.x; asm volatile("" : "+v"(tid));
        const int lane = tid & 63, wave = __builtin_amdgcn_readfirstlane(tid >> 6);
        const int gw = bx * 8 + wave, ngw = G * 8;
        const int layer = pid / 31, q = pid % 31;
        if (q == 0) {
            if (layer == 0) build_tables(a.in[I_RELB], tabA, tabD, bx * 512 + tid, G * 512);
#ifndef NO_CONV
            convert_weights(a, layer, W, (LAS float*)(lds + wave * 16384), gw, ngw, lane);
#endif
        } else {
            const int chunk = (q - 1) / 15, k = (q - 1) % 15 + 1;
            const int m0 = chunk == 0 ? 0 : 16384, TC = chunk == 0 ? 16384 : 24576, nMt = TC / 256;
            const float* xs0 = layer == 0 ? a.in[I_XP] : a.out; const float* xs1 = layer == 0 ? a.in[I_XS] : a.out + (size_t)TP * DM;
#ifdef NO_ROWS
            if (0) {
#else
            if (k == 1 || k == 10 || k == 13) {
#endif
                if (k == 1 || k == 10) { if (k == 10) { xs0 = a.out; xs1 = a.out + (size_t)TP * DM; }
                    const float* g = (k == 1 ? a.in[I_NMIX] : a.in[I_NFFN]) + layer * DM;
                    for (int r = gw; r < TC; r += ngw) norm_row(xrow_ptr(xs0, xs1, m0 + r), g, H + (size_t)r * DM, lane);
                } else {
                    const float* g = a.in[I_NPLE] + layer * DM;
                    for (int r = gw; r < TC; r += ngw) { const int m = m0 + r; norm_row(a.out + (size_t)m * DM, g, H + (size_t)r * DM, lane);
                        const float* pr = m < TP ? a.in[I_PP] + ((size_t)layer * TP + m) * 256 : a.in[I_PS] + ((size_t)layer * 32768 + (m - TP)) * 256;
                        const f32x4 v = *(const f32x4*)(pr + 4 * lane); u32x2 w; w.x = cvt_pk_bf16(v[0], v[1]); w.y = cvt_pk_bf16(v[2], v[3]); *(u32x2*)(P16 + (size_t)r * 256 + 4 * lane) = w; }
                }
#ifdef NO_ROWS
            } else if (0) {
#else
            } else if (k == 3 || k == 5) {
#endif
                for (int r = gw; r < TC; r += ngw) { const int m = m0 + r; const int tseq = m < TP ? m : (m - TP) % SS;
                    if (k == 3) post1_row(a, layer, PROJ + (size_t)r * NP, tseq, lane);
                    else post2_row(a, layer, QB + (size_t)r * 768, KB + (size_t)r * 768, PROJ + (size_t)r * NP, tseq, lane); }
            } else if (k == 6) {
                AttnBufs B{PROJ, VT, QB, KB, VTB, BR, tabA, tabD};
#ifndef NO_ATTN
                #if ATTN_V2
                attn2_phase(a, B, layer, chunk, ctl + 64 * (layer * 2 + chunk), tid, lane, wave, lds);
#else
                attn_phase(a, B, layer, chunk, ctl + 64 * (layer * 2 + chunk), lane, (LAS float*)(lds + wave * 16384));
#endif
#endif
            } else {
                const int njobs = (k == 2) ? 2 : (k == 4 ? 3 : 1);
                int coff = 0;
                for (int j = 0; j < njobs; ++j) {
                    pg8::Gemm g; pg8::Epi E; int nM = nMt, nN = 8, rep = 1, adiv = 1 << 30; long astep = 0;
                    E.kind = pg8::EK_BF16; E.O = nullptr; E.ldc = 0; E.Y = nullptr; E.part = nullptr; E.xs0 = xs0; E.xs1 = xs1; E.xout = a.out; E.m0 = m0;
                    g.A = H; g.Bt = (const bf16_t*)(W + WO_IN); g.lda = 2048; g.ldb = 2048; g.K = 2048;
                    if (k == 2 && j == 0) { nN = NP / 256; E.O = PROJ; E.ldc = NP; }
                    else if (k == 2) { g.A = (const bf16_t*)(W + WO_INV); g.Bt = H; nM = NVT / 256; nN = nMt; E.O = VT; E.ldc = TCM; }
                    else if (k == 4 && j == 0) { g.A = PROJ + PC_BCQ; g.lda = NP; g.Bt = (const bf16_t*)(W + WO_UQ); g.ldb = 512; g.K = 512; nN = 3; E.O = QB; E.ldc = 768; }
                    else if (k == 4 && j == 1) { g.A = PROJ + PC_BCKV; g.lda = NP; g.Bt = (const bf16_t*)(W + WO_UKN); g.ldb = 512; g.K = 512; nN = 2; E.kind = pg8::EK_SPLIT192; E.O = KB; E.ldc = 768; }
                    else if (k == 4) { g.A = (const bf16_t*)(W + WO_UKV); g.lda = 512; g.Bt = PROJ + PC_BCKV; g.ldb = NP; g.K = 512; nM = 2; nN = nMt; E.O = VTB; E.ldc = TCM; }
                    else if (k == 7) { g.A = BR; g.Bt = (const bf16_t*)(W + WO_B); g.ldb = 512; g.K = 512; nN = 32; adiv = 8; astep = 1024; E.O = Y; E.ldc = 8192; }
                    else if (k == 8) { g.Bt = (const bf16_t*)(W + WO_G); nN = 32; E.kind = pg8::EK_GATE; E.O = MERGED; E.Y = Y; }
                    else if (k == 9) { g.A = MERGED; g.Bt = (const bf16_t*)(W + WO_O); E.kind = pg8::EK_RES; }
                    else if (k == 11) { g.Bt = (const bf16_t*)(W + WO_1); nN = 32; E.kind = pg8::EK_RELU2; E.O = FFH; E.ldc = 8192; }
                    else if (k == 12) { g.A = FFH; g.lda = 8192; g.Bt = (const bf16_t*)(W + WO_2); g.ldb = 8192; g.K = 8192; E.kind = pg8::EK_RES; E.xs0 = a.out; E.xs1 = a.out + (size_t)TP * DM; }
                    else if (k == 14) { g.A = P16; g.lda = 256; g.Bt = (const bf16_t*)(W + WO_PP); g.ldb = 256; g.K = 256; E.O = U; E.ldc = 2048; }
                    else { g.Bt = (const bf16_t*)(W + WO_PG); E.kind = pg8::EK_PLE; E.Y = U; E.xs0 = a.out; E.xs1 = a.out + (size_t)TP * DM; }
                    pg8::Order S; S.init(nM, nN, G, (bx + G - coff) % G, rep, adiv, astep);
#ifndef NO_GEMM
                    pg8::gemm_phase<true>(lds, g, S, E, tid);
#endif
                    coff = (coff + (nM * nN) % G) % G;
                }
            }
        }
        if (pid + 1 < a.ph_hi) grid.sync();
    }
}

extern "C" void kernel_launch(void* const* d_in, const int* in_sizes, int n_in, void* d_out, int out_size, void* d_ws, size_t ws_size, hipStream_t stream) {
    static int grid = 0;
    if (grid == 0) {
        if (n_in != 33 || out_size != TALL * DM || ws_size < WS_END) { fprintf(stderr, "kernel_launch: unexpected shapes (n_in %d out %d ws %zu need %zu)\n", n_in, out_size, ws_size, (size_t)WS_END); grid = -1; return; }
        int dev = 0, cus = 0, per_cu = 0;
        hipGetDevice(&dev); hipDeviceGetAttribute(&cus, hipDeviceAttributeMultiprocessorCount, dev);
        if (hipFuncSetAttribute((const void*)mega, hipFuncAttributeMaxDynamicSharedMemorySize, LDS_BYTES) != hipSuccess) { fprintf(stderr, "kernel_launch: hipFuncSetAttribute failed\n"); grid = -1; return; }
        if (hipOccupancyMaxActiveBlocksPerMultiprocessor(&per_cu, (const void*)mega, 512, LDS_BYTES) != hipSuccess || per_cu < 1) per_cu = 1;
        (void)hipGetLastError();
        grid = cus * per_cu;
        if (grid <= 0) grid = 256;
    }
    if (grid < 0) return;
    hipMemsetAsync((char*)d_ws + WS_CTL, 0, 4096, stream);
    Args a{};
    for (int i = 0; i < 33; ++i) a.in[i] = (const float*)d_in[i];
    a.out = (float*)d_out; a.ws = (unsigned char*)d_ws;
    constexpr int NPH = 62;
#if COOP
    a.ph_lo = 0; a.ph_hi = NPH;
    void* args[] = {&a};
    hipError_t e = hipLaunchCooperativeKernel((const void*)mega, dim3(grid), dim3(512), args, LDS_BYTES, stream);
    if (e != hipSuccess) fprintf(stderr, "cooperative launch failed: %s (grid %d)\n", hipGetErrorString(e), grid);
#else
    for (int p = 0; p < NPH; ++p) { a.ph_lo = p; a.ph_hi = p + 1; hipLaunchKernelGGL(mega, dim3(grid), dim3(512), LDS_BYTES, stream, a); }
#endif
}
```

```cpp
#include <hip/hip_runtime.h>
#include <hip/hip_cooperative_groups.h>
#include <cstdio>
#include <cstdint>
namespace cg = cooperative_groups;

#ifndef COOP
#define COOP 1
#endif
#ifndef ATTN_V2
#define ATTN_V2 1
#endif

#define LAS __attribute__((address_space(3)))
typedef unsigned short bf16_t;
typedef short bf16x8 __attribute__((ext_vector_type(8)));
typedef float f32x4 __attribute__((ext_vector_type(4)));
typedef float f32x16 __attribute__((ext_vector_type(16)));
typedef unsigned u32x4 __attribute__((ext_vector_type(4)));
typedef unsigned u32x2 __attribute__((ext_vector_type(2)));
typedef float f32x4u __attribute__((ext_vector_type(4), aligned(4)));

constexpr int DM = 2048, TALL = 40960, TP = 8192, SS = 2048;
constexpr int NP = 5120;
constexpr int TCM = 24576;
constexpr int NVT = 1280;
constexpr int DFF = 8192;
constexpr int PC_AQ = 0, PC_AK = 512, PC_BCQ = 1024, PC_BCKV = 1536, PC_CQ = 2048, PC_CK = 2560, PC_DQ = 2816, PC_DK = 4352, PC_BKR = 4864;
constexpr float LOG2E = 1.4426950408889634f;
constexpr float EPS = 1e-6f;
constexpr int TABA_N = 16384, TABA_OFF = 8192, TABD_N = 2304, TABD_OFF = 1152;

constexpr size_t MiB = 1u << 20;
constexpr size_t WS_CTL = 0;
constexpr size_t WS_TABA = 64 * 1024;
constexpr size_t WS_TABD = 384 * 1024;
constexpr size_t WS_W = 1 * MiB;
constexpr size_t WO_IN = 0;
constexpr size_t WO_INV = WO_IN + (size_t)NP * 2048 * 2;
constexpr size_t WO_G = WO_INV + (size_t)NVT * 2048 * 2;
constexpr size_t WO_B = WO_G + (size_t)8192 * 2048 * 2;
constexpr size_t WO_O = WO_B + (size_t)8192 * 512 * 2;
constexpr size_t WO_1 = WO_O + (size_t)2048 * 2048 * 2;
constexpr size_t WO_2 = WO_1 + (size_t)8192 * 2048 * 2;
constexpr size_t WO_PG = WO_2 + (size_t)2048 * 8192 * 2;
constexpr size_t WO_PP = WO_PG + (size_t)2048 * 2048 * 2;
constexpr size_t WO_UQ = WO_PP + (size_t)2048 * 256 * 2;
constexpr size_t WO_UKN = WO_UQ + (size_t)768 * 512 * 2;
constexpr size_t WO_UKV = WO_UKN + (size_t)512 * 512 * 2;
constexpr size_t WO_END = WO_UKV + (size_t)512 * 512 * 2;
static_assert(WO_END <= 148 * MiB, "weights");
constexpr size_t WS_H = WS_W + 148 * MiB;
constexpr size_t WS_R1 = WS_H + (size_t)TCM * 2048 * 2;
constexpr size_t R1_PROJ = 0;
constexpr size_t R1_VT = R1_PROJ + (size_t)TCM * NP * 2;
constexpr size_t R1_QB = R1_VT + (size_t)NVT * TCM * 2;
constexpr size_t R1_KB = R1_QB + (size_t)TCM * 768 * 2;
constexpr size_t R1_VTB = R1_KB + (size_t)TCM * 768 * 2;
constexpr size_t R1_END = R1_VTB + (size_t)512 * TCM * 2;
static_assert(R1_END >= (size_t)TCM * 8192 * 2, "Y / FFH overlay");
constexpr size_t WS_R2 = WS_R1 + R1_END;
constexpr size_t WS_R3 = WS_R2 + (size_t)TCM * 2048 * 4;
constexpr size_t WS_END = WS_R3 + (size_t)TCM * 2048 * 2;

constexpr int LDS_BYTES = 147456;

__device__ __forceinline__ unsigned cvt_pk_bf16(float lo, float hi) { unsigned r; asm volatile("v_cvt_pk_bf16_f32 %0, %1, %2" : "=v"(r) : "v"(lo), "v"(hi)); return r; }
__device__ __forceinline__ float bf_lo(unsigned u) { return __uint_as_float(u << 16); }
__device__ __forceinline__ float bf_hi(unsigned u) { return __uint_as_float(u & 0xffff0000u); }
__device__ __forceinline__ float wave_sum(float v) {
#pragma unroll
    for (int o = 1; o < 64; o <<= 1) v += __shfl_xor(v, o);
    return v;
}
__device__ __forceinline__ float sigmoidf_fast(float x) { return __builtin_amdgcn_rcpf(1.0f + __builtin_amdgcn_exp2f(-x * LOG2E)); }
__device__ __forceinline__ const float* xrow_ptr(const float* s0, const float* s1, int m) { return m < TP ? s0 + (size_t)m * DM : s1 + (size_t)(m - TP) * DM; }

namespace pg8 {
constexpr int BM = 256, BK = 64, HALF = 128, HTB = HALF * BK * 2, STAGE_BYTES = 8 * HTB, NXCD = 8, WGM = 8;
__host__ __device__ __forceinline__ int lds_byte(int r, int c) { const int st = (r >> 4) * 2 + (c >> 5), rr = r & 15, cc = c & 31, ob = rr * 64 + cc * 2; return st * 1024 + (ob ^ (((ob >> 9) & 1) << 5)); }
__host__ __device__ __forceinline__ void stage_rc(int b, int& R, int& C) { const int st = b / 1024, sb = b % 1024, swz = sb ^ (((sb >> 9) & 1) << 5); R = (st >> 1) * 16 + swz / 64; C = (st & 1) * 32 + (swz % 64) / 2; }
__host__ __device__ __forceinline__ int perm32(int rho) { const int n = rho >> 4, i = rho & 15; return 8 * (i >> 2) + 4 * n + (i & 3); }

struct Unit { int pm, pn; long aoff; };
struct Gemm { const bf16_t* A; const bf16_t* Bt; int lda, ldb, K; };

struct Order {
    int nM, nN, nwg, G, c, rep, adiv; long astep;
    __device__ void init(int nM_, int nN_, int G_, int c_, int rep_, int adiv_, long astep_) { nM = nM_; nN = nN_; nwg = nM * nN; G = G_; c = c_; rep = rep_; adiv = adiv_; astep = astep_; }
    __device__ bool next(int i, Unit& u) const {
        const int t = i / rep, sub = i - t * rep;
        const long L = (long)t * G + c; if (L >= nwg) return false;
        int wgid = (int)L; { const int q = nwg / NXCD, r = nwg % NXCD, xcd = wgid % NXCD, off = wgid / NXCD; wgid = (xcd < r ? xcd * (q + 1) : r * (q + 1) + (xcd - r) * q) + off; }
        const int nig = WGM * nN, gid = wgid / nig, fm = gid * WGM, gsz = (nM - fm) < WGM ? (nM - fm) : WGM;
        u.pm = fm + ((wgid % nig) % gsz); const int pn = (wgid % nig) / gsz; u.pn = pn + sub * nN; u.aoff = (long)(pn / adiv) * astep; return true;
    }
};

enum { EK_BF16 = 0, EK_SPLIT192 = 1, EK_RELU2 = 2, EK_GATE = 3, EK_RES = 4, EK_PLE = 5 };
struct Epi {
    static constexpr bool PERM = true;
    int kind; bf16_t* O; long ldc; const bf16_t* Y; float* part; const float* xs0; const float* xs1; float* xout; int m0;
    __device__ __forceinline__ void operator()(const f32x4 (&acc)[2][2][4][2], const Unit& u, int wr, int wc, int fr, int fq) const {
        const int row0 = u.pm * BM + wr * 64 + fr, col0 = u.pn * BM + wc * 32 + 8 * fq;
        if (kind <= EK_RELU2) {
#pragma unroll
            for (int ai = 0; ai < 2; ++ai)
#pragma unroll
                for (int m = 0; m < 4; ++m) { const int row = row0 + ai * HALF + m * 16;
#pragma unroll
                    for (int bj = 0; bj < 2; ++bj) { int col = col0 + bj * HALF; f32x4 v0 = acc[ai][bj][m][0], v1 = acc[ai][bj][m][1];
                        if (kind == EK_RELU2) {
#pragma unroll
                            for (int e = 0; e < 4; ++e) { float a = fmaxf(v0[e], 0.f), b = fmaxf(v1[e], 0.f); v0[e] = a * a; v1[e] = b * b; } }
                        if (kind == EK_SPLIT192) col = (col >> 7) * 192 + (col & 127);
                        u32x4 w; w.x = cvt_pk_bf16(v0[0], v0[1]); w.y = cvt_pk_bf16(v0[2], v0[3]); w.z = cvt_pk_bf16(v1[0], v1[1]); w.w = cvt_pk_bf16(v1[2], v1[3]);
                        *(u32x4*)(O + (size_t)row * ldc + col) = w; } }
        } else if (kind == EK_GATE) {
            const int oc = u.pn * 64 + wc * 16 + 4 * fq;
#pragma unroll
            for (int ai = 0; ai < 2; ++ai)
#pragma unroll
                for (int m = 0; m < 4; ++m) { const int row = row0 + ai * HALF + m * 16;
                    const bf16_t* yp = Y + (size_t)row * 8192 + oc;
                    f32x4 r = (f32x4){0.f, 0.f, 0.f, 0.f};
#pragma unroll
                    for (int b = 0; b < 4; ++b) { const u32x2 y = *(const u32x2*)(yp + b * 2048); const f32x4 v = acc[ai][b >> 1][m][b & 1];
                        r[0] += sigmoidf_fast(v[0]) * bf_lo(y.x); r[1] += sigmoidf_fast(v[1]) * bf_hi(y.x); r[2] += sigmoidf_fast(v[2]) * bf_lo(y.y); r[3] += sigmoidf_fast(v[3]) * bf_hi(y.y); }
                    u32x2 w; w.x = cvt_pk_bf16(r[0], r[1]); w.y = cvt_pk_bf16(r[2], r[3]);
                    *(u32x2*)(O + (size_t)row * 2048 + oc) = w; }
        } else {
#pragma unroll
            for (int ai = 0; ai < 2; ++ai)
#pragma unroll
                for (int m = 0; m < 4; ++m) { const int row = row0 + ai * HALF + m * 16; const int gm = m0 + row;
                    const float* xs = xrow_ptr(xs0, xs1, gm); float* xo = xout + (size_t)gm * DM;
#pragma unroll
                    for (int bj = 0; bj < 2; ++bj) { const int col = col0 + bj * HALF; f32x4 v0 = acc[ai][bj][m][0], v1 = acc[ai][bj][m][1];
                        const f32x4 x0 = *(const f32x4*)(xs + col), x1 = *(const f32x4*)(xs + col + 4);
                        if (kind == EK_PLE) { const u32x4 y = *(const u32x4*)(Y + (size_t)row * 2048 + col);
                            v0[0] = sigmoidf_fast(v0[0]) * bf_lo(y.x); v0[1] = sigmoidf_fast(v0[1]) * bf_hi(y.x); v0[2] = sigmoidf_fast(v0[2]) * bf_lo(y.y); v0[3] = sigmoidf_fast(v0[3]) * bf_hi(y.y);
                            v1[0] = sigmoidf_fast(v1[0]) * bf_lo(y.z); v1[1] = sigmoidf_fast(v1[1]) * bf_hi(y.z); v1[2] = sigmoidf_fast(v1[2]) * bf_lo(y.w); v1[3] = sigmoidf_fast(v1[3]) * bf_hi(y.w); }
                        *(f32x4*)(xo + col) = x0 + v0; *(f32x4*)(xo + col + 4) = x1 + v1; } }
        }
    }
};

template <bool ALIGN_EPI = true>
__device__ __forceinline__ void gemm_phase(LAS unsigned char* lds, const Gemm g, const Order& S, const Epi& E, const int tid) {
    const int wid = __builtin_amdgcn_readfirstlane(tid >> 6), lane = tid & 63, wr = wid >> 2, wc = wid & 3, fr = lane & 15, fq = lane >> 4;
    const int K = g.K, nt = K / BK;
    unsigned voffA[2], voffB[2];
#pragma unroll
    for (int i = 0; i < 2; ++i) { int R, C; stage_rc(tid * 16 + i * 8192, R, C); const int Rb = Epi::PERM ? ((R & ~31) + perm32(R & 31)) : R;
        voffA[i] = (unsigned)(R * g.lda + C) * 2u; voffB[i] = (unsigned)(Rb * g.ldb + C) * 2u; }
    const size_t kstep = (size_t)(BK * 2);
    const size_t hstA = (size_t)HALF * g.lda * 2, hstB = (size_t)HALF * g.ldb * 2;
    const size_t tstA = 2 * hstA, tstB = 2 * hstB;
    const unsigned ldsw = (unsigned)wid * 1024u;
    const int aoff = lds_byte(wr * 64 + fr, fq * 8), boff = lds_byte(wc * 32 + fr, fq * 8);
#define PG8_SA(b, h) (((b) * 2 + (h)) * HTB)
#define PG8_SB(b, h) ((4 + (b) * 2 + (h)) * HTB)
#define PG8_STAGE(bufoff, gbase, voff) do { _Pragma("unroll") for (int _i = 0; _i < 2; ++_i) \
        __builtin_amdgcn_global_load_lds((const unsigned*)((const char*)(gbase) + (voff)[_i]), (LAS unsigned*)(lds + (bufoff) + ldsw + _i * 8192), 16, 0, 0); } while (0)
#define PG8_LDA(dst, b, h) do { _Pragma("unroll") for (int m = 0; m < 4; ++m) _Pragma("unroll") for (int k = 0; k < 2; ++k) dst[m][k] = *(const LAS bf16x8*)(lds + PG8_SA(b, h) + aoff + m * 2048 + k * 1024); } while (0)
#define PG8_LDB(dst, b, h) do { _Pragma("unroll") for (int n = 0; n < 2; ++n) _Pragma("unroll") for (int k = 0; k < 2; ++k) dst[n][k] = *(const LAS bf16x8*)(lds + PG8_SB(b, h) + boff + n * 2048 + k * 1024); } while (0)
#define PG8_MMA(ai, bj, At, Bt) do { __builtin_amdgcn_s_setprio(1); _Pragma("unroll") for (int m = 0; m < 4; ++m) _Pragma("unroll") for (int n = 0; n < 2; ++n) _Pragma("unroll") for (int k = 0; k < 2; ++k) \
        acc[ai][bj][m][n] = __builtin_amdgcn_mfma_f32_16x16x32_bf16(Bt[n][k], At[m][k], acc[ai][bj][m][n], 0, 0, 0); __builtin_amdgcn_s_setprio(0); } while (0)
#define PG8_WAIT_V(n) asm volatile("s_waitcnt vmcnt(" #n ")" ::: "memory")
#define PG8_WAIT_L(n) asm volatile("s_waitcnt lgkmcnt(" #n ")" ::: "memory")
#define PG8_BAR __builtin_amdgcn_s_barrier()
#define PG8_SCHED __builtin_amdgcn_sched_barrier(0)
    Unit cur, nxt; int ui = 0;
    if (!S.next(0, cur)) return;
    f32x4 acc[2][2][4][2];
#pragma unroll
    for (int a = 0; a < 2; ++a)
#pragma unroll
        for (int b = 0; b < 2; ++b)
#pragma unroll
            for (int m = 0; m < 4; ++m)
#pragma unroll
                for (int n = 0; n < 2; ++n) acc[a][b][m][n] = (f32x4){0.f, 0.f, 0.f, 0.f};
    bf16x8 At[4][2], B0[2][2], B1[2][2];
    const char* cA = (const char*)g.A + (size_t)cur.pm * tstA + cur.aoff; const char* cB = (const char*)g.Bt + (size_t)cur.pn * tstB;
    PG8_STAGE(PG8_SB(0, 0), cB, voffB); PG8_STAGE(PG8_SB(0, 1), cB + hstB, voffB); PG8_STAGE(PG8_SA(0, 0), cA, voffA); PG8_STAGE(PG8_SA(0, 1), cA + hstA, voffA);
    if (wr == 1) PG8_BAR;
    PG8_WAIT_V(2); PG8_BAR;
    PG8_STAGE(PG8_SB(1, 0), cB + kstep, voffB); PG8_STAGE(PG8_SA(1, 0), cA + kstep, voffA); PG8_STAGE(PG8_SB(1, 1), cB + hstB + kstep, voffB);
    PG8_WAIT_V(6); PG8_BAR;
    for (;;) {
        const bool has_next = S.next(ui + 1, nxt);
        const char* nA = has_next ? (const char*)g.A + (size_t)nxt.pm * tstA + nxt.aoff : cA; const char* nB = has_next ? (const char*)g.Bt + (size_t)nxt.pn * tstB : cB;
        for (int t = 0; t < nt; t += 2) {
            const bool last = (t == nt - 2);
            const char* a1 = cA + (size_t)(t + 1) * kstep;
            const char* a2 = last ? nA : cA + (size_t)(t + 2) * kstep; const char* b2 = last ? nB : cB + (size_t)(t + 2) * kstep;
            const char* a3 = a2 + kstep; const char* b3 = b2 + kstep;
            PG8_LDB(B0, 0, 0); PG8_LDB(B1, 0, 1); PG8_SCHED; PG8_LDA(At, 0, 0); PG8_STAGE(PG8_SA(1, 1), a1 + hstA, voffA);
            PG8_WAIT_V(8); PG8_WAIT_L(0); PG8_BAR; PG8_MMA(0, 0, At, B0); PG8_MMA(0, 1, At, B1); PG8_BAR; PG8_SCHED;
            PG8_LDA(At, 0, 1); PG8_STAGE(PG8_SB(0, 0), b2, voffB); PG8_STAGE(PG8_SB(0, 1), b2 + hstB, voffB); PG8_STAGE(PG8_SA(0, 0), a2, voffA);
            PG8_WAIT_V(8); PG8_WAIT_L(0); PG8_BAR; PG8_MMA(1, 0, At, B0); PG8_MMA(1, 1, At, B1); PG8_BAR; PG8_SCHED;
            PG8_LDB(B0, 1, 0); PG8_LDB(B1, 1, 1); PG8_SCHED; PG8_LDA(At, 1, 0); PG8_STAGE(PG8_SA(0, 1), a2 + hstA, voffA);
            PG8_WAIT_V(8); PG8_WAIT_L(0); PG8_BAR; PG8_MMA(0, 0, At, B0); PG8_MMA(0, 1, At, B1); PG8_BAR; PG8_SCHED;
            PG8_LDA(At, 1, 1); PG8_STAGE(PG8_SB(1, 0), b3, voffB); PG8_STAGE(PG8_SB(1, 1), b3 + hstB, voffB); PG8_STAGE(PG8_SA(1, 0), a3, voffA);
            PG8_WAIT_V(8); PG8_WAIT_L(0); PG8_BAR; PG8_MMA(1, 0, At, B0); PG8_MMA(1, 1, At, B1); PG8_BAR; PG8_SCHED;
        }
        if constexpr (ALIGN_EPI) { if (wr == 0) PG8_BAR; }
        E(acc, cur, wr, wc, fr, fq);
        if (!has_next) break;
#pragma unroll
        for (int a = 0; a < 2; ++a)
#pragma unroll
            for (int b = 0; b < 2; ++b)
#pragma unroll
                for (int m = 0; m < 4; ++m)
#pragma unroll
                    for (int n = 0; n < 2; ++n) acc[a][b][m][n] = (f32x4){0.f, 0.f, 0.f, 0.f};
        cur = nxt; cA = nA; cB = nB; ++ui;
        if constexpr (ALIGN_EPI) { if (wr == 1) PG8_BAR; }
    }
    PG8_WAIT_V(0);
    if constexpr (!ALIGN_EPI) { if (wr == 0) PG8_BAR; }
    PG8_BAR;
#undef PG8_SA
#undef PG8_SB
#undef PG8_STAGE
#undef PG8_LDA
#undef PG8_LDB
#undef PG8_MMA
#undef PG8_WAIT_V
#undef PG8_WAIT_L
#undef PG8_BAR
#undef PG8_SCHED
}
}

struct Args { const float* in[33]; float* out; unsigned char* ws; int ph_lo, ph_hi; };
enum { I_XP = 0, I_XS, I_PP, I_PS, I_RELB, I_NMIX, I_WIN, I_AQN, I_AKN, I_ALQ1, I_ALK1, I_ALQ2, I_ALK2, I_AON, I_BCQN, I_BCKVN, I_BWUQ, I_BWUKV, I_BQN, I_BKN,
       I_CQN, I_CKN, I_DQN, I_DKN, I_WG, I_WB, I_WO, I_NFFN, I_W1, I_W2, I_NPLE, I_WPG, I_WPP };

__device__ __forceinline__ int rel_bucket(int rel) {
    const int n = rel < 0 ? -rel : rel;
    const float nf = (float)(n > 1 ? n : 1);
    int large = 8 + (int)(logf(nf / 8.0f) / 4.852030263919617f * 8.0f);
    large = large < 15 ? large : 15;
    return (rel > 0 ? 16 : 0) + (n < 8 ? n : large);
}
__device__ __forceinline__ void build_tables(const float* relb, float* tabA, float* tabD, int gtid, int gthreads) {
    for (int i = gtid; i < 4 * TABA_N; i += gthreads) { const int h = i / TABA_N, d = i % TABA_N - TABA_OFF; tabA[i] = relb[rel_bucket(d) * 16 + h] * LOG2E; }
    for (int i = gtid; i < 12 * TABD_N; i += gthreads) { const int gh = i / TABD_N, d = i % TABD_N - TABD_OFF; const int g = gh >> 2; const int dil = g == 0 ? 1 : (g == 1 ? 4 : 16);
        const int ad = d < 0 ? -d : d; const bool ok = (ad % dil == 0) && (ad <= 64 * dil);
        tabD[i] = ok ? relb[rel_bucket(d) * 16 + 4 + gh] * LOG2E : -1e30f; }
}
__device__ __forceinline__ void transpose_item(const float* W, int N, int k0, int n0, bf16_t* dst, int K, LAS float* scr, int lane, int gate_b = -1) {
#pragma unroll 8
    for (int i = 0; i < 32; ++i) { const int kk = 2 * i + (lane >> 5); scr[kk * 33 + (lane & 31)] = W[(size_t)(k0 + kk) * N + n0 + (lane & 31)]; }
    asm volatile("s_waitcnt lgkmcnt(0)" ::: "memory");
    const int c = lane & 7;
#pragma unroll
    for (int j = 0; j < 4; ++j) { const int n = (lane >> 3) + 8 * j; const LAS float* s = scr + (8 * c) * 33 + n;
        u32x4 o; o.x = cvt_pk_bf16(s[0 * 33], s[1 * 33]); o.y = cvt_pk_bf16(s[2 * 33], s[3 * 33]); o.z = cvt_pk_bf16(s[4 * 33], s[5 * 33]); o.w = cvt_pk_bf16(s[6 * 33], s[7 * 33]);
        size_t drow = (size_t)n;
        if (gate_b >= 0) { const int nn = n0 + n, j = nn & 63; drow = (size_t)((nn >> 6) * 256 + 128 * (gate_b >> 1) + 32 * (j >> 4) + 8 * ((j >> 2) & 3) + 4 * (gate_b & 1) + (j & 3)); }
        *(u32x4*)(dst + drow * K + k0 + 8 * c) = o; }
    asm volatile("s_waitcnt lgkmcnt(0)" ::: "memory");
}
__device__ __forceinline__ int win_row(int n0) {
    if (n0 < 512) return PC_AQ + n0;
    if (n0 < 1024) return PC_AK + (n0 - 512);
    if (n0 < 1536) return -(0 + (n0 - 1024) + 1);
    if (n0 < 2048) return PC_BCQ + (n0 - 1536);
    if (n0 < 2560) return PC_BCKV + (n0 - 2048);
    if (n0 < 2624) return PC_BKR + (n0 - 2560);
    if (n0 < 3136) return PC_CQ + (n0 - 2624);
    if (n0 < 3392) return PC_CK + (n0 - 3136);
    if (n0 < 3648) return -(512 + (n0 - 3392) + 1);
    if (n0 < 5184) return PC_DQ + (n0 - 3648);
    if (n0 < 5696) return PC_DK + (n0 - 5184);
    return -(768 + (n0 - 5696) + 1);
}
__device__ __forceinline__ void convert_weights(const Args& a, int layer, unsigned char* W, LAS float* scr, int gw, int ngw, int lane) {
    constexpr int I_IN = 32 * 194, I_G = 4 * 32 * 64, I_B = 4 * 8 * 64, I_O = 32 * 64, I_1 = 32 * 256, I_2 = 128 * 64, I_PG = 32 * 64, I_PPn = 4 * 64, I_UQ = 8 * 24, I_UKV = 8 * 32;
    constexpr int NIT = I_IN + I_G + I_B + I_O + I_1 + I_2 + I_PG + I_PPn + I_UQ + I_UKV;
    for (int it = gw; it < NIT; it += ngw) {
        int r = it;
        if (r < I_IN) { const int kb = r / 194, nb = r % 194; const int dr = win_row(nb * 32);
            bf16_t* dst = dr >= 0 ? (bf16_t*)(W + WO_IN) + (size_t)dr * 2048 : (bf16_t*)(W + WO_INV) + (size_t)(-dr - 1) * 2048;
            transpose_item(a.in[I_WIN] + (size_t)layer * 2048 * 6208, 6208, kb * 64, nb * 32, dst, 2048, scr, lane); continue; } r -= I_IN;
        if (r < I_G) { const int b = r / 2048, q = r % 2048, kb = q / 64, nb = q % 64;
            transpose_item(a.in[I_WG] + ((size_t)layer * 4 + b) * 2048 * 2048, 2048, kb * 64, nb * 32, (bf16_t*)(W + WO_G), 2048, scr, lane, b); continue; } r -= I_G;
        if (r < I_B) { const int b = r / 512, q = r % 512, kb = q / 64, nb = q % 64;
            transpose_item(a.in[I_WB] + ((size_t)layer * 4 + b) * 512 * 2048, 2048, kb * 64, nb * 32, (bf16_t*)(W + WO_B) + ((size_t)b * 2048 + nb * 32) * 512, 512, scr, lane); continue; } r -= I_B;
        if (r < I_O) { const int kb = r / 64, nb = r % 64;
            transpose_item(a.in[I_WO] + (size_t)layer * 2048 * 2048, 2048, kb * 64, nb * 32, (bf16_t*)(W + WO_O) + (size_t)(nb * 32) * 2048, 2048, scr, lane); continue; } r -= I_O;
        if (r < I_1) { const int kb = r / 256, nb = r % 256;
            transpose_item(a.in[I_W1] + (size_t)layer * 2048 * 8192, 8192, kb * 64, nb * 32, (bf16_t*)(W + WO_1) + (size_t)(nb * 32) * 2048, 2048, scr, lane); continue; } r -= I_1;
        if (r < I_2) { const int kb = r / 64, nb = r % 64;
            transpose_item(a.in[I_W2] + (size_t)layer * 8192 * 2048, 2048, kb * 64, nb * 32, (bf16_t*)(W + WO_2) + (size_t)(nb * 32) * 8192, 8192, scr, lane); continue; } r -= I_2;
        if (r < I_PG) { const int kb = r / 64, nb = r % 64;
            transpose_item(a.in[I_WPG] + (size_t)layer * 2048 * 2048, 2048, kb * 64, nb * 32, (bf16_t*)(W + WO_PG) + (size_t)(nb * 32) * 2048, 2048, scr, lane); continue; } r -= I_PG;
        if (r < I_PPn) { const int kb = r / 64, nb = r % 64;
            transpose_item(a.in[I_WPP] + (size_t)layer * 256 * 2048, 2048, kb * 64, nb * 32, (bf16_t*)(W + WO_PP) + (size_t)(nb * 32) * 256, 256, scr, lane); continue; } r -= I_PPn;
        if (r < I_UQ) { const int kb = r / 24, nb = r % 24;
            transpose_item(a.in[I_BWUQ] + (size_t)layer * 512 * 768, 768, kb * 64, nb * 32, (bf16_t*)(W + WO_UQ) + (size_t)(nb * 32) * 512, 512, scr, lane); continue; } r -= I_UQ;
        { const int kb = r / 32, nb = r % 32; const int n0 = nb * 32, h = n0 >> 8, j0 = n0 & 255;
            bf16_t* dst = j0 < 128 ? (bf16_t*)(W + WO_UKN) + (size_t)(h * 128 + j0) * 512 : (bf16_t*)(W + WO_UKV) + (size_t)(h * 128 + j0 - 128) * 512;
            transpose_item(a.in[I_BWUKV] + (size_t)layer * 512 * 1024, 1024, kb * 64, n0, dst, 512, scr, lane); }
    }
}

__device__ __forceinline__ void norm_row(const float* x, const float* g, bf16_t* out, int lane) {
    f32x4 v[8]; float s = 0.f;
#pragma unroll
    for (int j = 0; j < 8; ++j) { v[j] = *(const f32x4*)(x + 4 * lane + 256 * j); s += (v[j][0] * v[j][0] + v[j][1] * v[j][1]) + (v[j][2] * v[j][2] + v[j][3] * v[j][3]); }
    const float rs = 1.0f / sqrtf(wave_sum(s) * (1.0f / 2048.0f) + EPS);
#pragma unroll
    for (int j = 0; j < 8; ++j) { const f32x4 gg = *(const f32x4*)(g + 4 * lane + 256 * j);
        u32x2 w; w.x = cvt_pk_bf16(v[j][0] * rs * gg[0], v[j][1] * rs * gg[1]); w.y = cvt_pk_bf16(v[j][2] * rs * gg[2], v[j][3] * rs * gg[3]);
        *(u32x2*)(out + 4 * lane + 256 * j) = w; }
}
__device__ __forceinline__ void load8(const bf16_t* p, float (&f)[8]) { const u32x4 v = *(const u32x4*)p; f[0] = bf_lo(v.x); f[1] = bf_hi(v.x); f[2] = bf_lo(v.y); f[3] = bf_hi(v.y); f[4] = bf_lo(v.z); f[5] = bf_hi(v.z); f[6] = bf_lo(v.w); f[7] = bf_hi(v.w); }
__device__ __forceinline__ void store8(bf16_t* p, const float (&f)[8]) { u32x4 w; w.x = cvt_pk_bf16(f[0], f[1]); w.y = cvt_pk_bf16(f[2], f[3]); w.z = cvt_pk_bf16(f[4], f[5]); w.w = cvt_pk_bf16(f[6], f[7]); *(u32x4*)p = w; }
template <int GRP> __device__ __forceinline__ void norm8(float (&f)[8], const float* g, float scale, int lane) {
    float s = 0.f;
#pragma unroll
    for (int e = 0; e < 8; ++e) s += f[e] * f[e];
#pragma unroll
    for (int o = 1; o < GRP; o <<= 1) s += __shfl_xor(s, o);
    const float rs = scale / sqrtf(s * (1.0f / (GRP * 8)) + EPS);
    const int gi = (lane & (GRP - 1)) * 8;
#pragma unroll
    for (int e = 0; e < 8; ++e) f[e] = f[e] * rs * g[gi + e];
}
__device__ __forceinline__ float rope_inv(int i) { return __builtin_amdgcn_exp2f(-(float)i * (13.287712379549449f / 32.0f)) * 0.15915494309189535f; }
__device__ __forceinline__ void sincos_rev(float rev, float& sn, float& cs) { rev -= rintf(rev); sn = __builtin_amdgcn_sinf(rev); cs = __builtin_amdgcn_cosf(rev); }
__device__ __forceinline__ void axial_rope8(float (&f)[8], float rowpos, float colpos, int lane) {
    const int j = lane & 15, hf = j >> 3, jj = j & 7; const float pos = hf ? colpos : rowpos; const float sgn = jj < 4 ? -1.f : 1.f; const int i0 = 8 * (jj & 3);
#pragma unroll
    for (int e = 0; e < 8; ++e) { const float pv = __shfl_xor(f[e], 4); float sn, cs; sincos_rev(pos * rope_inv(i0 + e), sn, cs); f[e] = f[e] * cs + sgn * pv * sn; }
}
__device__ __forceinline__ void post1_row(const Args& a, int layer, bf16_t* P, int tseq, int lane) {
    float f[8];
    const float sA = 0.125f * LOG2E, sC = 0.08838834764831845f * LOG2E;
    load8(P + PC_AQ + 8 * lane, f); norm8<8>(f, a.in[I_AQN] + layer * 64, sA, lane); store8(P + PC_AQ + 8 * lane, f);
    load8(P + PC_AK + 8 * lane, f); norm8<8>(f, a.in[I_AKN] + layer * 64, 1.f, lane); store8(P + PC_AK + 8 * lane, f);
    load8(P + PC_BCQ + 8 * lane, f); norm8<64>(f, a.in[I_BCQN] + layer * 512, 1.f, lane); store8(P + PC_BCQ + 8 * lane, f);
    load8(P + PC_BCKV + 8 * lane, f); norm8<64>(f, a.in[I_BCKVN] + layer * 512, 1.f, lane); store8(P + PC_BCKV + 8 * lane, f);
    const float rowpos = (float)(tseq >> 6), colpos = (float)(tseq & 63);
    load8(P + PC_CQ + 8 * lane, f); norm8<16>(f, a.in[I_CQN] + layer * 128, sC, lane); axial_rope8(f, rowpos, colpos, lane); store8(P + PC_CQ + 8 * lane, f);
    { const int l2 = lane & 31; load8(P + PC_CK + 8 * l2, f); norm8<16>(f, a.in[I_CKN] + layer * 128, 1.f, lane); axial_rope8(f, rowpos, colpos, lane); if (lane < 32) store8(P + PC_CK + 8 * l2, f); }
#pragma unroll
    for (int p = 0; p < 3; ++p) { load8(P + PC_DQ + 512 * p + 8 * lane, f); norm8<16>(f, a.in[I_DQN] + layer * 128, sC, lane); store8(P + PC_DQ + 512 * p + 8 * lane, f); }
    load8(P + PC_DK + 8 * lane, f); norm8<16>(f, a.in[I_DKN] + layer * 128, 1.f, lane); store8(P + PC_DK + 8 * lane, f);
}
__device__ __forceinline__ void mla_norm_rope(float (&f)[8], float (&r)[4], const float* g, float scale, float pos, int lane) {
    const int j = lane & 15;
    float s = 0.f;
#pragma unroll
    for (int e = 0; e < 8; ++e) s += f[e] * f[e];
#pragma unroll
    for (int e = 0; e < 4; ++e) s += r[e] * r[e];
#pragma unroll
    for (int o = 1; o < 16; o <<= 1) s += __shfl_xor(s, o);
    const float rs = scale / sqrtf(s * (1.0f / 192.0f) + EPS);
#pragma unroll
    for (int e = 0; e < 8; ++e) f[e] = f[e] * rs * g[8 * j + e];
#pragma unroll
    for (int e = 0; e < 4; ++e) r[e] = r[e] * rs * g[128 + 4 * j + e];
    const float sgn = j < 8 ? -1.f : 1.f; const int i0 = 4 * (j & 7);
#pragma unroll
    for (int e = 0; e < 4; ++e) { const float pv = __shfl_xor(r[e], 8); float sn, cs; sincos_rev(pos * rope_inv(i0 + e), sn, cs); r[e] = r[e] * cs + sgn * pv * sn; }
}
__device__ __forceinline__ void post2_row(const Args& a, int layer, bf16_t* Q, bf16_t* Kr, const bf16_t* P, int tseq, int lane) {
    const int h = lane >> 4, j = lane & 15; const float pos = (float)tseq;
    float f[8], r[4];
    { bf16_t* q = Q + h * 192; load8(q + 8 * j, f); const u32x2 v = *(const u32x2*)(q + 128 + 4 * j); r[0] = bf_lo(v.x); r[1] = bf_hi(v.x); r[2] = bf_lo(v.y); r[3] = bf_hi(v.y);
      mla_norm_rope(f, r, a.in[I_BQN] + layer * 192, 0.07216878364870323f * LOG2E, pos, lane);
      store8(q + 8 * j, f); u32x2 w; w.x = cvt_pk_bf16(r[0], r[1]); w.y = cvt_pk_bf16(r[2], r[3]); *(u32x2*)(q + 128 + 4 * j) = w; }
    { bf16_t* k = Kr + h * 192; load8(k + 8 * j, f); const u32x2 v = *(const u32x2*)(P + PC_BKR + 4 * j); r[0] = bf_lo(v.x); r[1] = bf_hi(v.x); r[2] = bf_lo(v.y); r[3] = bf_hi(v.y);
      mla_norm_rope(f, r, a.in[I_BKN] + layer * 192, 1.f, pos, lane);
      store8(k + 8 * j, f); u32x2 w; w.x = cvt_pk_bf16(r[0], r[1]); w.y = cvt_pk_bf16(r[2], r[3]); *(u32x2*)(k + 128 + 4 * j) = w; }
}

struct AState { float m, l; f32x16 o[4]; };
__device__ __forceinline__ void astate_init(AState& st) { st.m = -3.0e38f; st.l = 0.f;
#pragma unroll
    for (int d = 0; d < 4; ++d)
#pragma unroll
        for (int r = 0; r < 16; ++r) st.o[d][r] = 0.f; }
template <int DK, bool TAB, bool QLDS = false>
__device__ __forceinline__ void attn_pass(AState& st, const bf16_t* qp, const bf16_t* kp, long ldk, const bf16_t* vp, long ldv, int kbeg, int kend, const float* tp, LAS bf16x8* qst = nullptr) {
    constexpr int NS = DK / 16;
    bf16x8 qf[QLDS ? 1 : NS], kf[NS];
    if (QLDS) {
#pragma unroll
        for (int s = 0; s < NS; ++s) qst[s * 64] = *(const bf16x8*)(qp + 16 * s);
    } else {
#pragma unroll
        for (int s = 0; s < NS; ++s) qf[s] = *(const bf16x8*)(qp + 16 * s);
    }
    { const bf16_t* k0p = kp + (long)kbeg * ldk;
#pragma unroll
      for (int s = 0; s < NS; ++s) kf[s] = *(const bf16x8*)(k0p + 16 * s); }
    for (int k0 = kbeg; k0 < kend; k0 += 32) {
        bf16x8 vf[4][2];
#pragma unroll
        for (int d = 0; d < 4; ++d)
#pragma unroll
            for (int s = 0; s < 2; ++s) vf[d][s] = *(const bf16x8*)(vp + (long)(32 * d) * ldv + k0 + 16 * s);
        f32x4 tb[4];
        if (TAB) {
#pragma unroll
            for (int s = 0; s < 2; ++s) { tb[2 * s] = *(const f32x4u*)(tp + k0 + 16 * s); tb[2 * s + 1] = *(const f32x4u*)(tp + k0 + 16 * s + 4); } }
        f32x16 sc;
#pragma unroll
        for (int r = 0; r < 16; ++r) sc[r] = 0.f;
#pragma unroll
        for (int s = 0; s < NS; ++s) sc = __builtin_amdgcn_mfma_f32_32x32x16_bf16(kf[s], QLDS ? qst[s * 64] : qf[QLDS ? 0 : s], sc, 0, 0, 0);
        if (k0 + 32 < kend) { const bf16_t* knp = kp + (long)(k0 + 32) * ldk;
#pragma unroll
            for (int s = 0; s < NS; ++s) kf[s] = *(const bf16x8*)(knp + 16 * s); }
        if (TAB) {
#pragma unroll
            for (int r = 0; r < 16; ++r) sc[r] += tb[r >> 2][r & 3]; }
        float mx = sc[0];
#pragma unroll
        for (int r = 1; r < 16; ++r) mx = fmaxf(mx, sc[r]);
        mx = fmaxf(mx, __shfl_xor(mx, 32));
        const float mn = fmaxf(st.m, mx);
        const float alpha = __builtin_amdgcn_exp2f(st.m - mn);
        st.m = mn;
        float ps = 0.f;
#pragma unroll
        for (int r = 0; r < 16; ++r) { sc[r] = __builtin_amdgcn_exp2f(sc[r] - mn); ps += sc[r]; }
        st.l = st.l * alpha + ps;
#pragma unroll
        for (int d = 0; d < 4; ++d)
#pragma unroll
            for (int r = 0; r < 16; ++r) st.o[d][r] *= alpha;
        u32x4 p0, p1;
        p0.x = cvt_pk_bf16(sc[0], sc[1]); p0.y = cvt_pk_bf16(sc[2], sc[3]); p0.z = cvt_pk_bf16(sc[4], sc[5]); p0.w = cvt_pk_bf16(sc[6], sc[7]);
        p1.x = cvt_pk_bf16(sc[8], sc[9]); p1.y = cvt_pk_bf16(sc[10], sc[11]); p1.z = cvt_pk_bf16(sc[12], sc[13]); p1.w = cvt_pk_bf16(sc[14], sc[15]);
        const bf16x8 pf0 = __builtin_bit_cast(bf16x8, p0), pf1 = __builtin_bit_cast(bf16x8, p1);
#pragma unroll
        for (int d = 0; d < 4; ++d) { st.o[d] = __builtin_amdgcn_mfma_f32_32x32x16_bf16(vf[d][0], pf0, st.o[d], 0, 0, 0); st.o[d] = __builtin_amdgcn_mfma_f32_32x32x16_bf16(vf[d][1], pf1, st.o[d], 0, 0, 0); }
    }
}
__device__ __forceinline__ void astate_finish(AState& st) {
    const float l = st.l + __shfl_xor(st.l, 32); const float inv = 1.0f / l;
#pragma unroll
    for (int d = 0; d < 4; ++d)
#pragma unroll
        for (int r = 0; r < 16; ++r) st.o[d][r] *= inv;
}
__device__ __forceinline__ void store_o(const f32x16 (&o)[4], bf16_t* op) {
#pragma unroll
    for (int d = 0; d < 4; ++d)
#pragma unroll
        for (int g = 0; g < 4; ++g) { u32x2 w; w.x = cvt_pk_bf16(o[d][4 * g], o[d][4 * g + 1]); w.y = cvt_pk_bf16(o[d][4 * g + 2], o[d][4 * g + 3]); *(u32x2*)(op + 32 * d + 8 * g) = w; }
}
__device__ __forceinline__ int pi32(int n) { return (n & ~12) | ((n & 4) << 1) | ((n & 8) >> 1); }

struct AttnBufs { const bf16_t* PROJ; const bf16_t* VT; const bf16_t* QB; const bf16_t* KB; const bf16_t* VTB; bf16_t* BR; const float* tabA; const float* tabD; };

__device__ __forceinline__ void attn_unit(const Args& a, const AttnBufs& B, int layer, int mixer, int head, int row0  , int S, int q0  , int lane, LAS float* stash) {
#define ATT_LANE_SETUP int ln_ = lane; asm volatile("" : "+v"(ln_)); const int n = ln_ & 31, hi = ln_ >> 5, pr = pi32(n); const long qrow = (long)row0 + q0 + n; bf16_t* op = B.BR + qrow * 2048 + 4 * hi;
#ifdef ONLY_MIXER
    mixer = ONLY_MIXER;
#endif
    if (mixer == 0) {
        ATT_LANE_SETUP
        const float lam_init = layer == 0 ? 0.2f : 0.35550906759f;
        const float d1 = wave_sum(a.in[I_ALQ1][layer * 64 + lane] * a.in[I_ALK1][layer * 64 + lane]);
        const float d2 = wave_sum(a.in[I_ALQ2][layer * 64 + lane] * a.in[I_ALK2][layer * 64 + lane]);
        const float lam = expf(d1) - expf(d2) + lam_init;
        const bf16_t* vp = B.VT + (long)(head * 128 + n) * TCM + row0 + 8 * hi;
        const float* tp = B.tabA + head * TABA_N + TABA_OFF - (q0 + n) + 8 * hi;
        { AState st; astate_init(st);
          attn_pass<64, true>(st, B.PROJ + qrow * NP + PC_AQ + head * 128 + 8 * hi, B.PROJ + (long)(row0 + pr) * NP + PC_AK + head * 128 + 8 * hi, NP, vp, TCM, 0, S, tp);
          astate_finish(st);
#pragma unroll
          for (int d = 0; d < 4; ++d)
#pragma unroll
              for (int r = 0; r < 16; ++r) stash[(d * 16 + r) * 64 + lane] = st.o[d][r]; }
        AState st; astate_init(st);
        attn_pass<64, true>(st, B.PROJ + qrow * NP + PC_AQ + head * 128 + 64 + 8 * hi, B.PROJ + (long)(row0 + pr) * NP + PC_AK + head * 128 + 64 + 8 * hi, NP, vp, TCM, 0, S, tp);
        astate_finish(st);
        float ss = 0.f;
#pragma unroll
        for (int d = 0; d < 4; ++d)
#pragma unroll
            for (int r = 0; r < 16; ++r) { const float v = stash[(d * 16 + r) * 64 + lane] - lam * st.o[d][r]; st.o[d][r] = v; ss += v * v; }
        ss += __shfl_xor(ss, 32);
        const float rs = (1.0f - lam_init) / sqrtf(ss * (1.0f / 128.0f) + EPS);
        const float* gn = a.in[I_AON] + layer * 128 + 4 * hi;
#pragma unroll
        for (int d = 0; d < 4; ++d)
#pragma unroll
            for (int g = 0; g < 4; ++g) { const f32x4 gg = *(const f32x4*)(gn + 32 * d + 8 * g);
#pragma unroll
                for (int e = 0; e < 4; ++e) st.o[d][4 * g + e] *= rs * gg[e]; }
        store_o(st.o, op + head * 128);
    } else if (mixer == 1) {
        ATT_LANE_SETUP
        AState st; astate_init(st);
        attn_pass<192, false, true>(st, B.QB + qrow * 768 + head * 192 + 8 * hi, B.KB + (long)(row0 + pr) * 768 + head * 192 + 8 * hi, 768,
                              B.VTB + (long)(head * 128 + n) * TCM + row0 + 8 * hi, TCM, 0, S, nullptr, (LAS bf16x8*)stash + lane);
        astate_finish(st); store_o(st.o, op + 512 + head * 128);
    } else if (mixer == 2) {
        ATT_LANE_SETUP
        const int kv = head >> 1;
        AState st; astate_init(st);
        attn_pass<128, false>(st, B.PROJ + qrow * NP + PC_CQ + head * 128 + 8 * hi, B.PROJ + (long)(row0 + pr) * NP + PC_CK + kv * 128 + 8 * hi, NP,
                              B.VT + (long)(512 + kv * 128 + n) * TCM + row0 + 8 * hi, TCM, 0, S, nullptr);
        astate_finish(st); store_o(st.o, op + 1024 + head * 128);
    } else {
        ATT_LANE_SETUP
        AState st; astate_init(st);
        const bf16_t* kp = B.PROJ + (long)(row0 + pr) * NP + PC_DK + head * 128 + 8 * hi;
        const bf16_t* vp = B.VT + (long)(768 + head * 128 + n) * TCM + row0 + 8 * hi;
#pragma unroll 1
        for (int g = 0; g < 3; ++g) { const int W = g == 0 ? 64 : (g == 1 ? 256 : 1024);
            const int kb = q0 - W > 0 ? q0 - W : 0, ke = q0 + 32 + W < S ? q0 + 32 + W : S;
            attn_pass<128, true>(st, B.PROJ + qrow * NP + PC_DQ + (g * 4 + head) * 128 + 8 * hi, kp, NP, vp, TCM, kb, ke, B.tabD + (g * 4 + head) * TABD_N + TABD_OFF - (q0 + n) + 8 * hi); }
        astate_finish(st); store_o(st.o, op + 1536 + head * 128);
    }
}
__device__ __forceinline__ void attn_phase(const Args& a, const AttnBufs& B, int layer, int chunk, unsigned* ctr, int lane, LAS float* stash) {
    const int npr = chunk == 0 ? 1 : 0, nsm = chunk == 0 ? 4 : 12, TC = chunk == 0 ? 16384 : 24576;
    const int nP = npr * 1024, nS = nsm * 256, nD = TC / 8, total = 3 * nP + 3 * nS + nD;
    for (;;) {
        unsigned uu = 0; if (lane == 0) uu = atomicAdd(ctr, 1u);
        int u = __builtin_amdgcn_readfirstlane((int)uu);
        if (u >= total) break;
        int mixer, head, row0, S, q0;
        if (u < 3 * nP) { mixer = u / nP; const int r = u % nP; q0 = (r % 256) * 32; head = r / 256; row0 = 0; S = TP; }
        else { u -= 3 * nP;
            if (u < 3 * nS) { mixer = u / nS; const int r = u % nS; q0 = (r % 64) * 32; head = (r / 64) % 4; row0 = npr * TP + (r / 256) * SS; S = SS; }
            else { u -= 3 * nS; mixer = 3; const int qb = u % (TC / 32); head = u / (TC / 32); const int q = qb * 32;
                if (npr && q < TP) { row0 = 0; S = TP; } else { row0 = npr * TP + ((q - npr * TP) / SS) * SS; S = SS; }
                q0 = q - row0; } }
#ifdef ONLY_MIXER
        if (mixer != ONLY_MIXER) continue;
#endif
        attn_unit(a, B, layer, mixer, head, row0, S, q0, lane, stash);
    }
}


constexpr int A2_RSV = 144, A2_BUFSZ = 64 * 400 + 128 * A2_RSV;
static_assert(2 * A2_BUFSZ <= 131072 && 2 * A2_BUFSZ >= 65536, "attention LDS");
template <int DKL, int DK, bool TAB>
__device__ __forceinline__ void attn2_pass(AState& st, LAS unsigned char* buf, const bf16_t* qp, int koff, const bf16_t* Kg, long ldk, const bf16_t* Vg, long ldv,
                                           int kbeg, int kend, const float* tp, int wlo, int whi, int tid_in, int lane) {
    constexpr int NS = DK / 16, PR = DKL / 8, NKP = DKL / 64, RSK = DKL * 2 + 16, KBYTES = 64 * RSK;
    int tid = tid_in; asm volatile("" : "+v"(tid));
    const int n = lane & 31, hi = lane >> 5, pr = pi32(n);
    bf16x8 qf[NS];
#pragma unroll
    for (int s = 0; s < NS; ++s) qf[s] = *(const bf16x8*)(qp + 16 * s);
    u32x4 kreg[NKP], vreg[2];
    int krow[NKP], kc[NKP];
#pragma unroll
    for (int i = 0; i < NKP; ++i) { const int p = tid + 512 * i; krow[i] = p / PR; kc[i] = p % PR; }
#define A2_GLOAD(k0_) do { _Pragma("unroll") for (int i = 0; i < NKP; ++i) kreg[i] = *(const u32x4*)(Kg + (long)((k0_) + krow[i]) * ldk + 8 * kc[i]); \
        _Pragma("unroll") for (int i = 0; i < 2; ++i) { const int p = tid + 512 * i; vreg[i] = *(const u32x4*)(Vg + (long)(p >> 3) * ldv + (k0_) + 8 * (p & 7)); } } while (0)
#define A2_LSTORE(b_) do { _Pragma("unroll") for (int i = 0; i < NKP; ++i) *(LAS u32x4*)(buf + (b_) * A2_BUFSZ + krow[i] * RSK + kc[i] * 16) = kreg[i]; \
        _Pragma("unroll") for (int i = 0; i < 2; ++i) { const int p = tid + 512 * i; *(LAS u32x4*)(buf + (b_) * A2_BUFSZ + KBYTES + (p >> 3) * A2_RSV + (p & 7) * 16) = vreg[i]; } } while (0)
    A2_GLOAD(kbeg); A2_LSTORE(0); __syncthreads();
    int b = 0;
    const int kfo = pr * RSK + koff + hi * 16, vfo = KBYTES + n * A2_RSV + hi * 16;
    for (int k0 = kbeg; k0 < kend; k0 += 64) {
        const bool more = k0 + 64 < kend;
        if (more) A2_GLOAD(k0 + 64);
        LAS unsigned char* bb = buf + b * A2_BUFSZ;
#pragma unroll
        for (int sb = 0; sb < 2; ++sb) {
            const int ks = k0 + 32 * sb;
            if (ks + 32 <= wlo || ks >= whi) continue;
            f32x4 tb[4];
            if (TAB) {
#pragma unroll
                for (int s = 0; s < 2; ++s) { tb[2 * s] = *(const f32x4u*)(tp + ks + 16 * s); tb[2 * s + 1] = *(const f32x4u*)(tp + ks + 16 * s + 4); } }
            f32x16 sc;
#pragma unroll
            for (int r = 0; r < 16; ++r) sc[r] = 0.f;
#pragma unroll
            for (int s = 0; s < NS; ++s) { const bf16x8 kf = *(const LAS bf16x8*)(bb + kfo + (32 * sb) * RSK + 32 * s); sc = __builtin_amdgcn_mfma_f32_32x32x16_bf16(kf, qf[s], sc, 0, 0, 0); }
            if (TAB) {
#pragma unroll
                for (int r = 0; r < 16; ++r) sc[r] += tb[r >> 2][r & 3]; }
            float mx = sc[0];
#pragma unroll
            for (int r = 1; r < 16; ++r) mx = fmaxf(mx, sc[r]);
            mx = fmaxf(mx, __shfl_xor(mx, 32));
            if (__any(mx > st.m + 8.0f)) {
                const float mn = fmaxf(st.m, mx); const float alpha = __builtin_amdgcn_exp2f(st.m - mn); st.m = mn; st.l *= alpha;
#pragma unroll
                for (int d = 0; d < 4; ++d)
#pragma unroll
                    for (int r = 0; r < 16; ++r) st.o[d][r] *= alpha;
            }
            float ps = 0.f;
#pragma unroll
            for (int r = 0; r < 16; ++r) { sc[r] = __builtin_amdgcn_exp2f(sc[r] - st.m); ps += sc[r]; }
            st.l += ps;
            u32x4 p0, p1;
            p0.x = cvt_pk_bf16(sc[0], sc[1]); p0.y = cvt_pk_bf16(sc[2], sc[3]); p0.z = cvt_pk_bf16(sc[4], sc[5]); p0.w = cvt_pk_bf16(sc[6], sc[7]);
            p1.x = cvt_pk_bf16(sc[8], sc[9]); p1.y = cvt_pk_bf16(sc[10], sc[11]); p1.z = cvt_pk_bf16(sc[12], sc[13]); p1.w = cvt_pk_bf16(sc[14], sc[15]);
            const bf16x8 pf0 = __builtin_bit_cast(bf16x8, p0), pf1 = __builtin_bit_cast(bf16x8, p1);
#pragma unroll
            for (int d = 0; d < 4; ++d) {
                const bf16x8 v0 = *(const LAS bf16x8*)(bb + vfo + (32 * d) * A2_RSV + 64 * sb), v1 = *(const LAS bf16x8*)(bb + vfo + (32 * d) * A2_RSV + 64 * sb + 32);
                st.o[d] = __builtin_amdgcn_mfma_f32_32x32x16_bf16(v0, pf0, st.o[d], 0, 0, 0); st.o[d] = __builtin_amdgcn_mfma_f32_32x32x16_bf16(v1, pf1, st.o[d], 0, 0, 0); }
        }
        if (more) A2_LSTORE(b ^ 1);
        __syncthreads();
        b ^= 1;
    }
#undef A2_GLOAD
#undef A2_LSTORE
}

__device__ __forceinline__ void attn2_unit(const Args& a, const AttnBufs& B, int layer, int mixer, int head, int row0, int S, int q0, int tid, int lane, int wave, LAS unsigned char* buf) {
#ifdef ONLY_MIXER2
    mixer = ONLY_MIXER2;
#endif
    if (mixer == 0) {
        int ln_ = lane; asm volatile("" : "+v"(ln_)); const int n = ln_ & 31, hi = ln_ >> 5;
        const int half = wave >> 2, qw = q0 + 32 * (wave & 3); const long qrow = (long)row0 + qw + n;
        const float lam_init = layer == 0 ? 0.2f : 0.35550906759f;
        AState st; astate_init(st);
        attn2_pass<128, 64, true>(st, buf, B.PROJ + qrow * NP + PC_AQ + head * 128 + 64 * half + 8 * hi, 128 * half, B.PROJ + (long)row0 * NP + PC_AK + head * 128, NP,
                                  B.VT + (long)(head * 128) * TCM + row0, TCM, 0, S, B.tabA + head * TABA_N + TABA_OFF - (qw + n) + 8 * hi, 0, S, tid, ln_);
        astate_finish(st);
        LAS float* xb = (LAS float*)buf + (wave & 3) * 4096;
        if (half == 1) {
#pragma unroll
            for (int d = 0; d < 4; ++d)
#pragma unroll
                for (int r = 0; r < 16; ++r) xb[(d * 16 + r) * 64 + ln_] = st.o[d][r]; }
        __syncthreads();
        if (half == 0) {
            const float d1 = wave_sum(a.in[I_ALQ1][layer * 64 + ln_] * a.in[I_ALK1][layer * 64 + ln_]);
            const float d2 = wave_sum(a.in[I_ALQ2][layer * 64 + ln_] * a.in[I_ALK2][layer * 64 + ln_]);
            const float lam = expf(d1) - expf(d2) + lam_init;
            float ss = 0.f;
#pragma unroll
            for (int d = 0; d < 4; ++d)
#pragma unroll
                for (int r = 0; r < 16; ++r) { const float v = st.o[d][r] - lam * xb[(d * 16 + r) * 64 + ln_]; st.o[d][r] = v; ss += v * v; }
            ss += __shfl_xor(ss, 32);
            const float rs = (1.0f - lam_init) / sqrtf(ss * (1.0f / 128.0f) + EPS);
            const float* gn = a.in[I_AON] + layer * 128 + 4 * hi;
#pragma unroll
            for (int d = 0; d < 4; ++d)
#pragma unroll
                for (int g = 0; g < 4; ++g) { const f32x4 gg = *(const f32x4*)(gn + 32 * d + 8 * g);
#pragma unroll
                    for (int e = 0; e < 4; ++e) st.o[d][4 * g + e] *= rs * gg[e]; }
            store_o(st.o, B.BR + qrow * 2048 + 4 * hi + head * 128);
        }
    } else if (mixer == 1) {
        int ln_ = lane; asm volatile("" : "+v"(ln_)); const int n = ln_ & 31, hi = ln_ >> 5;
        const int qw = q0 + 32 * wave; const long qrow = (long)row0 + qw + n;
        AState st; astate_init(st);
        attn2_pass<192, 192, false>(st, buf, B.QB + qrow * 768 + head * 192 + 8 * hi, 0, B.KB + (long)row0 * 768 + head * 192, 768,
                                    B.VTB + (long)(head * 128) * TCM + row0, TCM, 0, S, nullptr, 0, S, tid, ln_);
        astate_finish(st); store_o(st.o, B.BR + qrow * 2048 + 4 * hi + 512 + head * 128);
    } else if (mixer == 2) {
        int ln_ = lane; asm volatile("" : "+v"(ln_)); const int n = ln_ & 31, hi = ln_ >> 5;
        const int qw = q0 + 32 * wave; const long qrow = (long)row0 + qw + n; const int kv = head >> 1;
        AState st; astate_init(st);
        attn2_pass<128, 128, false>(st, buf, B.PROJ + qrow * NP + PC_CQ + head * 128 + 8 * hi, 0, B.PROJ + (long)row0 * NP + PC_CK + kv * 128, NP,
                                    B.VT + (long)(512 + kv * 128) * TCM + row0, TCM, 0, S, nullptr, 0, S, tid, ln_);
        astate_finish(st); store_o(st.o, B.BR + qrow * 2048 + 4 * hi + 1024 + head * 128);
    } else {
        int ln_ = lane; asm volatile("" : "+v"(ln_)); const int n = ln_ & 31, hi = ln_ >> 5;
        const int qw = q0 + 32 * wave; const long qrow = (long)row0 + qw + n;
        AState st; astate_init(st);
#pragma unroll 1
        for (int g = 0; g < 3; ++g) { const int W = g == 0 ? 64 : (g == 1 ? 256 : 1024);
            const int kb = q0 - W > 0 ? q0 - W : 0, ke = q0 + 256 + W < S ? q0 + 256 + W : S;
            attn2_pass<128, 128, true>(st, buf, B.PROJ + qrow * NP + PC_DQ + (g * 4 + head) * 128 + 8 * hi, 0, B.PROJ + (long)row0 * NP + PC_DK + head * 128, NP,
                                       B.VT + (long)(768 + head * 128) * TCM + row0, TCM, kb, ke, B.tabD + (g * 4 + head) * TABD_N + TABD_OFF - (qw + n) + 8 * hi, qw - W, qw + 32 + W, tid, ln_); }
        astate_finish(st); store_o(st.o, B.BR + qrow * 2048 + 4 * hi + 1536 + head * 128);
    }
}
__device__ __forceinline__ void attn2_phase(const Args& a, const AttnBufs& B, int layer, int chunk, unsigned* ctr, int tid, int lane, int wave, LAS unsigned char* lds) {
    const int npr = chunk == 0 ? 1 : 0, nsm = chunk == 0 ? 4 : 12, TC = chunk == 0 ? 16384 : 24576;
    const int c0 = npr * 128, c1 = npr * 128, c2 = npr * 256, c3 = TC / 64, c4 = nsm * 32, c5 = nsm * 32, c6 = nsm * 64;
    const int total = c0 + c1 + c2 + c3 + c4 + c5 + c6;
    volatile LAS int* uw = (volatile LAS int*)(lds + 131072);
    for (;;) {
        __syncthreads();
        if (tid == 0) *uw = (int)atomicAdd(ctr, 1u);
        __syncthreads();
        int u = __builtin_amdgcn_readfirstlane(*uw);
        if (u >= total) break;
        int mixer, head, row0, S, q0;
        if (u < c0 + c1 + c2) { row0 = 0; S = TP;
            if (u < c0) { mixer = 1; q0 = (u % 32) * 256; head = u / 32; }
            else if (u < c0 + c1) { u -= c0; mixer = 2; q0 = (u % 32) * 256; head = u / 32; }
            else { u -= c0 + c1; mixer = 0; q0 = (u % 64) * 128; head = u / 64; }
        } else { u -= c0 + c1 + c2;
            if (u < c3) { mixer = 3; const int nb = TC / 256; const int q = (u % nb) * 256; head = u / nb;
                if (npr && q < TP) { row0 = 0; S = TP; } else { row0 = npr * TP + ((q - npr * TP) / SS) * SS; S = SS; }
                q0 = q - row0; }
            else { u -= c3; S = SS;
                if (u < c4) { mixer = 1; q0 = (u % 8) * 256; head = (u / 8) % 4; row0 = npr * TP + (u / 32) * SS; }
                else if (u < c4 + c5) { u -= c4; mixer = 2; q0 = (u % 8) * 256; head = (u / 8) % 4; row0 = npr * TP + (u / 32) * SS; }
                else { u -= c4 + c5; mixer = 0; q0 = (u % 16) * 128; head = (u / 16) % 4; row0 = npr * TP + (u / 64) * SS; } } }
        attn2_unit(a, B, layer, mixer, head, row0, S, q0, tid, lane, wave, lds);
    }
}


#define XB_TMO      128
#define XB_XCNT(j)  (256  + 64 * (j))
#define XB_XSUB(j)  (1280 + 64 * (j))
#define XB_XGEN(j)  (2304 + 64 * (j))
#define XB_TOP      3328
#define XB_TOPGEN   3392
#define XCD_BAR_WORDS 3456
#define XB_SPIN_CAP (1u << 22)
__device__ __forceinline__ unsigned xb_ld(unsigned* p)              { return __hip_atomic_load(p, __ATOMIC_RELAXED, __HIP_MEMORY_SCOPE_AGENT); }
__device__ __forceinline__ unsigned xb_add(unsigned* p, unsigned v) { return __hip_atomic_fetch_add(p, v, __ATOMIC_RELAXED, __HIP_MEMORY_SCOPE_AGENT); }
__device__ __forceinline__ unsigned xb_xcc_id() { return (unsigned)__builtin_amdgcn_s_getreg((3 << 11) | 20) & 0xFu; }
#define XB_SPIN(cond, bar) do { unsigned _sp = 0; while (cond) { __builtin_amdgcn_s_sleep(1); \
    if ((++_sp & 255u) == 0u) { if (xb_ld(&(bar)[XB_TMO])) break; if (_sp > XB_SPIN_CAP) { atomicAdd(&(bar)[XB_TMO], 1u); break; } } } } while (0)
struct XcdBarrier { unsigned* bar; unsigned x; volatile LAS unsigned* st; };
__device__ __forceinline__ XcdBarrier xcd_barrier_post(unsigned* bar, volatile LAS unsigned* st) {
    XcdBarrier b; b.bar = bar; b.x = xb_xcc_id(); b.st = st;
    if (threadIdx.x == 0) (void)xb_add(&bar[XB_XCNT(b.x)], 1u);
    return b;
}
__device__ __forceinline__ void xcd_barrier_complete(unsigned* bar, unsigned x, unsigned& nloc, unsigned& nx) {
    const unsigned G = gridDim.x * gridDim.y * gridDim.z;
    unsigned sum, cnt, mine, sp = 0u;
    for (;;) {
        sum = 0u; cnt = 0u; mine = 0u;
#pragma unroll
        for (unsigned j = 0; j < 16; ++j) { const unsigned c = xb_ld(&bar[XB_XCNT(j)]); sum += c; cnt += (c > 0u) ? 1u : 0u; mine = (j == x) ? c : mine; }
        if (sum == G) break;
        __builtin_amdgcn_s_sleep(1);
        if ((++sp & 255u) == 0u) { if (xb_ld(&bar[XB_TMO])) break; if (sp > XB_SPIN_CAP) { atomicAdd(&bar[XB_TMO], 1u); break; } }
    }
    nloc = mine > 0u ? mine : 1u; nx = cnt > 0u ? cnt : 1u;
}
__device__ __forceinline__ void xcd_barrier(const XcdBarrier& b) {
    asm volatile("s_waitcnt vmcnt(0)" ::: "memory");
    __syncthreads();
    if (threadIdx.x == 0) {
        unsigned* bar = b.bar;
        __builtin_amdgcn_s_waitcnt(0);
        unsigned nloc = b.st[0], nx = b.st[1];
        if (nloc == 0u) { xcd_barrier_complete(bar, b.x, nloc, nx); b.st[0] = nloc; b.st[1] = nx; }
        const unsigned old = xb_add(&bar[XB_XSUB(b.x)], 1u);
        const unsigned gen = old / nloc;
        if (old + 1u == (gen + 1u) * nloc) {
            __builtin_amdgcn_fence(__ATOMIC_RELEASE, "agent");
            asm volatile("s_waitcnt vmcnt(0)" ::: "memory");
            const unsigned og = xb_add(&bar[XB_TOP], 1u);
            const unsigned tg = og / nx;
            if (og + 1u == (tg + 1u) * nx) xb_add(&bar[XB_TOPGEN], 1u);
            else XB_SPIN(xb_ld(&bar[XB_TOPGEN]) == tg, bar);
            __builtin_amdgcn_fence(__ATOMIC_ACQUIRE, "agent");
            xb_add(&bar[XB_XGEN(b.x)], 1u);
            asm volatile("s_waitcnt vmcnt(0)" ::: "memory");
        } else {
            XB_SPIN(xb_ld(&bar[XB_XGEN(b.x)]) == gen, bar);
            __builtin_amdgcn_fence(__ATOMIC_ACQUIRE, "agent");
            asm volatile("s_waitcnt vmcnt(0)" ::: "memory");
        }
    }
    __syncthreads();
}

__global__ void __launch_bounds__(512, 2) mega(Args a) {
    extern __shared__ __attribute__((aligned(16))) unsigned char lds_raw[];
    LAS unsigned char* lds = (LAS unsigned char*)lds_raw;
    const int G = gridDim.x, bx = blockIdx.x;
    unsigned char* ws = a.ws;
    unsigned* ctl = (unsigned*)(ws + WS_CTL);
    float* tabA = (float*)(ws + WS_TABA); float* tabD = (float*)(ws + WS_TABD);
    unsigned char* W = ws + WS_W;
    bf16_t* H = (bf16_t*)(ws + WS_H);
    bf16_t* PROJ = (bf16_t*)(ws + WS_R1 + R1_PROJ); bf16_t* VT = (bf16_t*)(ws + WS_R1 + R1_VT); bf16_t* QB = (bf16_t*)(ws + WS_R1 + R1_QB);
    bf16_t* KB = (bf16_t*)(ws + WS_R1 + R1_KB); bf16_t* VTB = (bf16_t*)(ws + WS_R1 + R1_VTB);
    bf16_t* Y = (bf16_t*)(ws + WS_R1); bf16_t* FFH = (bf16_t*)(ws + WS_R1);
    bf16_t* BR = (bf16_t*)(ws + WS_R2); float* PART = (float*)(ws + WS_R2); bf16_t* U = (bf16_t*)(ws + WS_R2);
    bf16_t* MERGED = (bf16_t*)(ws + WS_R3); bf16_t* P16 = (bf16_t*)(ws + WS_R3);
    cg::grid_group grid = cg::this_grid();
    volatile LAS unsigned* bst = (volatile LAS unsigned*)(lds + 131072 + 64);
    if (threadIdx.x < 2) bst[threadIdx.x] = 0u;
    __syncthreads();
    XcdBarrier xbar = xcd_barrier_post(ctl + 1024, bst);

    for (int pid = a.ph_lo; pid < a.ph_hi; ++pid) {
        int tid = threadIdx.x; asm volatile("" : "+v"(tid));
        const int lane = tid & 63, wave = __builtin_amdgcn_readfirstlane(tid >> 6);
        const int gw = bx * 8 + wave, ngw = G * 8;
        const int layer = pid / 31, q = pid % 31;
        if (q == 0) {
            if (layer == 0) build_tables(a.in[I_RELB], tabA, tabD, bx * 512 + tid, G * 512);
#ifndef NO_CONV
            convert_weights(a, layer, W, (LAS float*)(lds + wave * 16384), gw, ngw, lane);
#endif
        } else {
            const int chunk = (q - 1) / 15, k = (q - 1) % 15 + 1;
            const int m0 = chunk == 0 ? 0 : 16384, TC = chunk == 0 ? 16384 : 24576, nMt = TC / 256;
            const float* xs0 = layer == 0 ? a.in[I_XP] : a.out; const float* xs1 = layer == 0 ? a.in[I_XS] : a.out + (size_t)TP * DM;
#ifdef NO_ROWS
            if (0) {
#else
            if (k == 1 || k == 10 || k == 13) {
#endif
                if (k == 1 || k == 10) { if (k == 10) { xs0 = a.out; xs1 = a.out + (size_t)TP * DM; }
                    const float* g = (k == 1 ? a.in[I_NMIX] : a.in[I_NFFN]) + layer * DM;
                    for (int r = gw; r < TC; r += ngw) norm_row(xrow_ptr(xs0, xs1, m0 + r), g, H + (size_t)r * DM, lane);
                } else {
                    const float* g = a.in[I_NPLE] + layer * DM;
                    for (int r = gw; r < TC; r += ngw) { const int m = m0 + r; norm_row(a.out + (size_t)m * DM, g, H + (size_t)r * DM, lane);
                        const float* pr = m < TP ? a.in[I_PP] + ((size_t)layer * TP + m) * 256 : a.in[I_PS] + ((size_t)layer * 32768 + (m - TP)) * 256;
                        const f32x4 v = *(const f32x4*)(pr + 4 * lane); u32x2 w; w.x = cvt_pk_bf16(v[0], v[1]); w.y = cvt_pk_bf16(v[2], v[3]); *(u32x2*)(P16 + (size_t)r * 256 + 4 * lane) = w; }
                }
#ifdef NO_ROWS
            } else if (0) {
#else
            } else if (k == 3 || k == 5) {
#endif
                for (int r = gw; r < TC; r += ngw) { const int m = m0 + r; const int tseq = m < TP ? m : (m - TP) % SS;
                    if (k == 3) post1_row(a, layer, PROJ + (size_t)r * NP, tseq, lane);
                    else post2_row(a, layer, QB + (size_t)r * 768, KB + (size_t)r * 768, PROJ + (size_t)r * NP, tseq, lane); }
            } else if (k == 6) {
                AttnBufs B{PROJ, VT, QB, KB, VTB, BR, tabA, tabD};
#ifndef NO_ATTN
                #if ATTN_V2
                attn2_phase(a, B, layer, chunk, ctl + 64 * (layer * 2 + chunk), tid, lane, wave, lds);
#else
                attn_phase(a, B, layer, chunk, ctl + 64 * (layer * 2 + chunk), lane, (LAS float*)(lds + wave * 16384));
#endif
#endif
            } else {
                const int njobs = (k == 2) ? 2 : (k == 4 ? 3 : 1);
                int coff = 0;
                for (int j = 0; j < njobs; ++j) {
                    pg8::Gemm g; pg8::Epi E; int nM = nMt, nN = 8, rep = 1, adiv = 1 << 30; long astep = 0;
                    E.kind = pg8::EK_BF16; E.O = nullptr; E.ldc = 0; E.Y = nullptr; E.part = nullptr; E.xs0 = xs0; E.xs1 = xs1; E.xout = a.out; E.m0 = m0;
                    g.A = H; g.Bt = (const bf16_t*)(W + WO_IN); g.lda = 2048; g.ldb = 2048; g.K = 2048;
                    if (k == 2 && j == 0) { nN = NP / 256; E.O = PROJ; E.ldc = NP; }
                    else if (k == 2) { g.A = (const bf16_t*)(W + WO_INV); g.Bt = H; nM = NVT / 256; nN = nMt; E.O = VT; E.ldc = TCM; }
                    else if (k == 4 && j == 0) { g.A = PROJ + PC_BCQ; g.lda = NP; g.Bt = (const bf16_t*)(W + WO_UQ); g.ldb = 512; g.K = 512; nN = 3; E.O = QB; E.ldc = 768; }
                    else if (k == 4 && j == 1) { g.A = PROJ + PC_BCKV; g.lda = NP; g.Bt = (const bf16_t*)(W + WO_UKN); g.ldb = 512; g.K = 512; nN = 2; E.kind = pg8::EK_SPLIT192; E.O = KB; E.ldc = 768; }
                    else if (k == 4) { g.A = (const bf16_t*)(W + WO_UKV); g.lda = 512; g.Bt = PROJ + PC_BCKV; g.ldb = NP; g.K = 512; nM = 2; nN = nMt; E.O = VTB; E.ldc = TCM; }
                    else if (k == 7) { g.A = BR; g.Bt = (const bf16_t*)(W + WO_B); g.ldb = 512; g.K = 512; nN = 32; adiv = 8; astep = 1024; E.O = Y; E.ldc = 8192; }
                    else if (k == 8) { g.Bt = (const bf16_t*)(W + WO_G); nN = 32; E.kind = pg8::EK_GATE; E.O = MERGED; E.Y = Y; }
                    else if (k == 9) { g.A = MERGED; g.Bt = (const bf16_t*)(W + WO_O); E.kind = pg8::EK_RES; }
                    else if (k == 11) { g.Bt = (const bf16_t*)(W + WO_1); nN = 32; E.kind = pg8::EK_RELU2; E.O = FFH; E.ldc = 8192; }
                    else if (k == 12) { g.A = FFH; g.lda = 8192; g.Bt = (const bf16_t*)(W + WO_2); g.ldb = 8192; g.K = 8192; E.kind = pg8::EK_RES; E.xs0 = a.out; E.xs1 = a.out + (size_t)TP * DM; }
                    else if (k == 14) { g.A = P16; g.lda = 256; g.Bt = (const bf16_t*)(W + WO_PP); g.ldb = 256; g.K = 256; E.O = U; E.ldc = 2048; }
                    else { g.Bt = (const bf16_t*)(W + WO_PG); E.kind = pg8::EK_PLE; E.Y = U; E.xs0 = a.out; E.xs1 = a.out + (size_t)TP * DM; }
                    pg8::Order S; S.init(nM, nN, G, (bx + G - coff) % G, rep, adiv, astep);
#ifndef NO_GEMM
                    pg8::gemm_phase<true>(lds, g, S, E, tid);
#endif
                    coff = (coff + (nM * nN) % G) % G;
                }
            }
        }
        if (pid + 1 < a.ph_hi) { if (pid == a.ph_lo) grid.sync(); else xcd_barrier(xbar); }
    }
}

extern "C" void kernel_launch(void* const* d_in, const int* in_sizes, int n_in, void* d_out, int out_size, void* d_ws, size_t ws_size, hipStream_t stream) {
    static int grid = 0;
    if (grid == 0) {
        if (n_in != 33 || out_size != TALL * DM || ws_size < WS_END) { fprintf(stderr, "kernel_launch: unexpected shapes (n_in %d out %d ws %zu need %zu)\n", n_in, out_size, ws_size, (size_t)WS_END); grid = -1; return; }
        int dev = 0, cus = 0, per_cu = 0;
        hipGetDevice(&dev); hipDeviceGetAttribute(&cus, hipDeviceAttributeMultiprocessorCount, dev);
        if (hipFuncSetAttribute((const void*)mega, hipFuncAttributeMaxDynamicSharedMemorySize, LDS_BYTES) != hipSuccess) { fprintf(stderr, "kernel_launch: hipFuncSetAttribute failed\n"); grid = -1; return; }
        if (hipOccupancyMaxActiveBlocksPerMultiprocessor(&per_cu, (const void*)mega, 512, LDS_BYTES) != hipSuccess || per_cu < 1) per_cu = 1;
        (void)hipGetLastError();
        grid = cus * per_cu;
        if (grid <= 0) grid = 256;
    }
    if (grid < 0) return;
    hipMemsetAsync((char*)d_ws + WS_CTL, 0, 32768, stream);
    Args a{};
    for (int i = 0; i < 33; ++i) a.in[i] = (const float*)d_in[i];
    a.out = (float*)d_out; a.ws = (unsigned char*)d_ws;
    constexpr int NPH = 62;
#if COOP
    a.ph_lo = 0; a.ph_hi = NPH;
    void* args[] = {&a};
    hipError_t e = hipLaunchCooperativeKernel((const void*)mega, dim3(grid), dim3(512), args, LDS_BYTES, stream);
    if (e != hipSuccess) fprintf(stderr, "cooperative launch failed: %s (grid %d)\n", hipGetErrorString(e), grid);
#else
    for (int p = 0; p < NPH; ++p) { a.ph_lo = p; a.ph_hi = p + 1; hipLaunchKernelGGL(mega, dim3(grid), dim3(512), LDS_BYTES, stream, a); }
#endif
}
```

```cpp
#include <hip/hip_runtime.h>
#include <hip/hip_cooperative_groups.h>
#include <cstdio>
#include <cstdint>
namespace cg = cooperative_groups;

#ifndef COOP
#define COOP 1
#endif
#ifndef ATTN_V2
#define ATTN_V2 1
#endif

#define LAS __attribute__((address_space(3)))
typedef unsigned short bf16_t;
typedef short bf16x8 __attribute__((ext_vector_type(8)));
typedef float f32x4 __attribute__((ext_vector_type(4)));
typedef float f32x16 __attribute__((ext_vector_type(16)));
typedef unsigned u32x4 __attribute__((ext_vector_type(4)));
typedef unsigned u32x2 __attribute__((ext_vector_type(2)));
typedef float f32x4u __attribute__((ext_vector_type(4), aligned(4)));

constexpr int DM = 2048, TALL = 40960, TP = 8192, SS = 2048;
constexpr int NP = 5120;
constexpr int TCM = 24576;
constexpr int NVT = 1280;
constexpr int DFF = 8192;
constexpr int PC_AQ = 0, PC_AK = 512, PC_BCQ = 1024, PC_BCKV = 1536, PC_CQ = 2048, PC_CK = 2560, PC_DQ = 2816, PC_DK = 4352, PC_BKR = 4864;
constexpr float LOG2E = 1.4426950408889634f;
constexpr float EPS = 1e-6f;
constexpr int TABA_N = 16384, TABA_OFF = 8192, TABD_N = 2304, TABD_OFF = 1152;

constexpr size_t MiB = 1u << 20;
constexpr size_t WS_CTL = 0;
constexpr size_t WS_TABA = 64 * 1024;
constexpr size_t WS_TABD = 384 * 1024;
constexpr size_t WS_W = 1 * MiB;
constexpr size_t WO_IN = 0;
constexpr size_t WO_INV = WO_IN + (size_t)NP * 2048 * 2;
constexpr size_t WO_G = WO_INV + (size_t)NVT * 2048 * 2;
constexpr size_t WO_B = WO_G + (size_t)8192 * 2048 * 2;
constexpr size_t WO_O = WO_B + (size_t)8192 * 512 * 2;
constexpr size_t WO_1 = WO_O + (size_t)2048 * 2048 * 2;
constexpr size_t WO_2 = WO_1 + (size_t)8192 * 2048 * 2;
constexpr size_t WO_PG = WO_2 + (size_t)2048 * 8192 * 2;
constexpr size_t WO_PP = WO_PG + (size_t)2048 * 2048 * 2;
constexpr size_t WO_UQ = WO_PP + (size_t)2048 * 256 * 2;
constexpr size_t WO_UKN = WO_UQ + (size_t)768 * 512 * 2;
constexpr size_t WO_UKV = WO_UKN + (size_t)512 * 512 * 2;
constexpr size_t WO_END = WO_UKV + (size_t)512 * 512 * 2;
static_assert(WO_END <= 148 * MiB, "weights");
constexpr size_t WS_H = WS_W + 148 * MiB;
constexpr size_t WS_R1 = WS_H + (size_t)TCM * 2048 * 2;
constexpr size_t R1_PROJ = 0;
constexpr size_t R1_VT = R1_PROJ + (size_t)TCM * NP * 2;
constexpr size_t R1_QB = R1_VT + (size_t)NVT * TCM * 2;
constexpr size_t R1_KB = R1_QB + (size_t)TCM * 768 * 2;
constexpr size_t R1_VTB = R1_KB + (size_t)TCM * 768 * 2;
constexpr size_t R1_END = R1_VTB + (size_t)512 * TCM * 2;
static_assert(R1_END >= (size_t)TCM * 8192 * 2, "Y / FFH overlay");
constexpr size_t WS_R2 = WS_R1 + R1_END;
constexpr size_t WS_R3 = WS_R2 + (size_t)TCM * 2048 * 4;
constexpr size_t WS_END = WS_R3 + (size_t)TCM * 2048 * 2;

constexpr int LDS_BYTES = 147456;

typedef float f32x2_t __attribute__((ext_vector_type(2))); typedef __bf16 bf16x2_t __attribute__((ext_vector_type(2)));
__device__ __forceinline__ unsigned cvt_pk_bf16(float lo, float hi) { f32x2_t v = {lo, hi}; bf16x2_t b = __builtin_convertvector(v, bf16x2_t); return __builtin_bit_cast(unsigned, b); }
__device__ __forceinline__ float bf_lo(unsigned u) { return __uint_as_float(u << 16); }
__device__ __forceinline__ float bf_hi(unsigned u) { return __uint_as_float(u & 0xffff0000u); }
__device__ __forceinline__ float wave_sum(float v) {
#pragma unroll
    for (int o = 1; o < 64; o <<= 1) v += __shfl_xor(v, o);
    return v;
}
__device__ __forceinline__ float sigmoidf_fast(float x) { return __builtin_amdgcn_rcpf(1.0f + __builtin_amdgcn_exp2f(-x * LOG2E)); }
__device__ __forceinline__ const float* xrow_ptr(const float* s0, const float* s1, int m) { return m < TP ? s0 + (size_t)m * DM : s1 + (size_t)(m - TP) * DM; }

namespace pg8 {
constexpr int BM = 256, BK = 64, HALF = 128, HTB = HALF * BK * 2, STAGE_BYTES = 8 * HTB, NXCD = 8, WGM = 8;
__host__ __device__ __forceinline__ int lds_byte(int r, int c) { const int st = (r >> 4) * 2 + (c >> 5), rr = r & 15, cc = c & 31, ob = rr * 64 + cc * 2; return st * 1024 + (ob ^ (((ob >> 9) & 1) << 5)); }
__host__ __device__ __forceinline__ void stage_rc(int b, int& R, int& C) { const int st = b / 1024, sb = b % 1024, swz = sb ^ (((sb >> 9) & 1) << 5); R = (st >> 1) * 16 + swz / 64; C = (st & 1) * 32 + (swz % 64) / 2; }
__host__ __device__ __forceinline__ int perm32(int rho) { const int n = rho >> 4, i = rho & 15; return 8 * (i >> 2) + 4 * n + (i & 3); }

struct Unit { int pm, pn; long aoff; };
struct Gemm { const bf16_t* A; const bf16_t* Bt; int lda, ldb, K; };

struct Order {
    int nM, nN, nwg, G, c, rep, adiv; long astep;
    __device__ void init(int nM_, int nN_, int G_, int c_, int rep_, int adiv_, long astep_) { nM = nM_; nN = nN_; nwg = nM * nN; G = G_; c = c_; rep = rep_; adiv = adiv_; astep = astep_; }
    __device__ bool next(int i, Unit& u) const {
        const int t = i / rep, sub = i - t * rep;
        const long L = (long)t * G + c; if (L >= nwg) return false;
        int wgid = (int)L; { const int q = nwg / NXCD, r = nwg % NXCD, xcd = wgid % NXCD, off = wgid / NXCD; wgid = (xcd < r ? xcd * (q + 1) : r * (q + 1) + (xcd - r) * q) + off; }
        const int nig = WGM * nN, gid = wgid / nig, fm = gid * WGM, gsz = (nM - fm) < WGM ? (nM - fm) : WGM;
        u.pm = fm + ((wgid % nig) % gsz); const int pn = (wgid % nig) / gsz; u.pn = pn + sub * nN; u.aoff = (long)(pn / adiv) * astep; return true;
    }
};

enum { EK_BF16 = 0, EK_SPLIT192 = 1, EK_RELU2 = 2, EK_GATE = 3, EK_RES = 4, EK_PLE = 5 };
struct Epi {
    static constexpr bool PERM = true;
    int kind; bf16_t* O; long ldc; const bf16_t* Y; float* part; const float* xs0; const float* xs1; float* xout; int m0;
    __device__ __forceinline__ void operator()(const f32x4 (&acc)[2][2][4][2], const Unit& u, int wr, int wc, int fr, int fq) const {
        const int row0 = u.pm * BM + wr * 64 + fr, col0 = u.pn * BM + wc * 32 + 8 * fq;
        if (kind <= EK_RELU2) {
#pragma unroll
            for (int ai = 0; ai < 2; ++ai)
#pragma unroll
                for (int m = 0; m < 4; ++m) { const int row = row0 + ai * HALF + m * 16;
#pragma unroll
                    for (int bj = 0; bj < 2; ++bj) { int col = col0 + bj * HALF; f32x4 v0 = acc[ai][bj][m][0], v1 = acc[ai][bj][m][1];
                        if (kind == EK_RELU2) {
#pragma unroll
                            for (int e = 0; e < 4; ++e) { float a = fmaxf(v0[e], 0.f), b = fmaxf(v1[e], 0.f); v0[e] = a * a; v1[e] = b * b; } }
                        if (kind == EK_SPLIT192) col = (col >> 7) * 192 + (col & 127);
                        u32x4 w; w.x = cvt_pk_bf16(v0[0], v0[1]); w.y = cvt_pk_bf16(v0[2], v0[3]); w.z = cvt_pk_bf16(v1[0], v1[1]); w.w = cvt_pk_bf16(v1[2], v1[3]);
                        *(u32x4*)(O + (size_t)row * ldc + col) = w; } }
        } else if (kind == EK_GATE) {
            const int oc = u.pn * 64 + wc * 16 + 4 * fq;
#pragma unroll
            for (int ai = 0; ai < 2; ++ai)
#pragma unroll
                for (int m = 0; m < 4; ++m) { const int row = row0 + ai * HALF + m * 16;
                    const bf16_t* yp = Y + (size_t)row * 8192 + oc;
                    f32x4 r = (f32x4){0.f, 0.f, 0.f, 0.f};
#pragma unroll
                    for (int b = 0; b < 4; ++b) { const u32x2 y = *(const u32x2*)(yp + b * 2048); const f32x4 v = acc[ai][b >> 1][m][b & 1];
                        r[0] += sigmoidf_fast(v[0]) * bf_lo(y.x); r[1] += sigmoidf_fast(v[1]) * bf_hi(y.x); r[2] += sigmoidf_fast(v[2]) * bf_lo(y.y); r[3] += sigmoidf_fast(v[3]) * bf_hi(y.y); }
                    u32x2 w; w.x = cvt_pk_bf16(r[0], r[1]); w.y = cvt_pk_bf16(r[2], r[3]);
                    *(u32x2*)(O + (size_t)row * 2048 + oc) = w; }
        } else {
#pragma unroll
            for (int ai = 0; ai < 2; ++ai)
#pragma unroll
                for (int m = 0; m < 4; ++m) { const int row = row0 + ai * HALF + m * 16; const int gm = m0 + row;
                    const float* xs = xrow_ptr(xs0, xs1, gm); float* xo = xout + (size_t)gm * DM;
#pragma unroll
                    for (int bj = 0; bj < 2; ++bj) { const int col = col0 + bj * HALF; f32x4 v0 = acc[ai][bj][m][0], v1 = acc[ai][bj][m][1];
                        const f32x4 x0 = *(const f32x4*)(xs + col), x1 = *(const f32x4*)(xs + col + 4);
                        if (kind == EK_PLE) { const u32x4 y = *(const u32x4*)(Y + (size_t)row * 2048 + col);
                            v0[0] = sigmoidf_fast(v0[0]) * bf_lo(y.x); v0[1] = sigmoidf_fast(v0[1]) * bf_hi(y.x); v0[2] = sigmoidf_fast(v0[2]) * bf_lo(y.y); v0[3] = sigmoidf_fast(v0[3]) * bf_hi(y.y);
                            v1[0] = sigmoidf_fast(v1[0]) * bf_lo(y.z); v1[1] = sigmoidf_fast(v1[1]) * bf_hi(y.z); v1[2] = sigmoidf_fast(v1[2]) * bf_lo(y.w); v1[3] = sigmoidf_fast(v1[3]) * bf_hi(y.w); }
                        *(f32x4*)(xo + col) = x0 + v0; *(f32x4*)(xo + col + 4) = x1 + v1; } }
        }
    }
};

template <bool ALIGN_EPI = true>
__device__ __forceinline__ void gemm_phase(LAS unsigned char* lds, const Gemm g, const Order& S, const Epi& E, const int tid) {
    const int wid = __builtin_amdgcn_readfirstlane(tid >> 6), lane = tid & 63, wr = wid >> 2, wc = wid & 3, fr = lane & 15, fq = lane >> 4;
    const int K = g.K, nt = K / BK;
    unsigned voffA[2], voffB[2];
#pragma unroll
    for (int i = 0; i < 2; ++i) { int R, C; stage_rc(tid * 16 + i * 8192, R, C); const int Rb = Epi::PERM ? ((R & ~31) + perm32(R & 31)) : R;
        voffA[i] = (unsigned)(R * g.lda + C) * 2u; voffB[i] = (unsigned)(Rb * g.ldb + C) * 2u; }
    const size_t kstep = (size_t)(BK * 2);
    const size_t hstA = (size_t)HALF * g.lda * 2, hstB = (size_t)HALF * g.ldb * 2;
    const size_t tstA = 2 * hstA, tstB = 2 * hstB;
    const unsigned ldsw = (unsigned)wid * 1024u;
    const int aoff = lds_byte(wr * 64 + fr, fq * 8), boff = lds_byte(wc * 32 + fr, fq * 8);
#define PG8_SA(b, h) (((b) * 2 + (h)) * HTB)
#define PG8_SB(b, h) ((4 + (b) * 2 + (h)) * HTB)
#define PG8_STAGE(bufoff, gbase, voff) do { _Pragma("unroll") for (int _i = 0; _i < 2; ++_i) \
        __builtin_amdgcn_global_load_lds((const unsigned*)((const char*)(gbase) + (voff)[_i]), (LAS unsigned*)(lds + (bufoff) + ldsw + _i * 8192), 16, 0, 0); } while (0)
#define PG8_LDA(dst, b, h) do { _Pragma("unroll") for (int m = 0; m < 4; ++m) _Pragma("unroll") for (int k = 0; k < 2; ++k) dst[m][k] = *(const LAS bf16x8*)(lds + PG8_SA(b, h) + aoff + m * 2048 + k * 1024); } while (0)
#define PG8_LDB(dst, b, h) do { _Pragma("unroll") for (int n = 0; n < 2; ++n) _Pragma("unroll") for (int k = 0; k < 2; ++k) dst[n][k] = *(const LAS bf16x8*)(lds + PG8_SB(b, h) + boff + n * 2048 + k * 1024); } while (0)
#define PG8_MMA(ai, bj, At, Bt) do { __builtin_amdgcn_s_setprio(1); _Pragma("unroll") for (int m = 0; m < 4; ++m) _Pragma("unroll") for (int n = 0; n < 2; ++n) _Pragma("unroll") for (int k = 0; k < 2; ++k) \
        acc[ai][bj][m][n] = __builtin_amdgcn_mfma_f32_16x16x32_bf16(Bt[n][k], At[m][k], acc[ai][bj][m][n], 0, 0, 0); __builtin_amdgcn_s_setprio(0); } while (0)
#define PG8_WAIT_V(n) asm volatile("s_waitcnt vmcnt(" #n ")" ::: "memory")
#define PG8_WAIT_L(n) asm volatile("s_waitcnt lgkmcnt(" #n ")" ::: "memory")
#define PG8_BAR __builtin_amdgcn_s_barrier()
#define PG8_SCHED __builtin_amdgcn_sched_barrier(0)
    Unit cur, nxt; int ui = 0;
    if (!S.next(0, cur)) return;
    f32x4 acc[2][2][4][2];
#pragma unroll
    for (int a = 0; a < 2; ++a)
#pragma unroll
        for (int b = 0; b < 2; ++b)
#pragma unroll
            for (int m = 0; m < 4; ++m)
#pragma unroll
                for (int n = 0; n < 2; ++n) acc[a][b][m][n] = (f32x4){0.f, 0.f, 0.f, 0.f};
    bf16x8 At[4][2], B0[2][2], B1[2][2];
    const char* cA = (const char*)g.A + (size_t)cur.pm * tstA + cur.aoff; const char* cB = (const char*)g.Bt + (size_t)cur.pn * tstB;
    PG8_STAGE(PG8_SB(0, 0), cB, voffB); PG8_STAGE(PG8_SB(0, 1), cB + hstB, voffB); PG8_STAGE(PG8_SA(0, 0), cA, voffA); PG8_STAGE(PG8_SA(0, 1), cA + hstA, voffA);
    if (wr == 1) PG8_BAR;
    PG8_WAIT_V(2); PG8_BAR;
    PG8_STAGE(PG8_SB(1, 0), cB + kstep, voffB); PG8_STAGE(PG8_SA(1, 0), cA + kstep, voffA); PG8_STAGE(PG8_SB(1, 1), cB + hstB + kstep, voffB);
    PG8_WAIT_V(6); PG8_BAR;
    for (;;) {
        const bool has_next = S.next(ui + 1, nxt);
        const char* nA = has_next ? (const char*)g.A + (size_t)nxt.pm * tstA + nxt.aoff : cA; const char* nB = has_next ? (const char*)g.Bt + (size_t)nxt.pn * tstB : cB;
        for (int t = 0; t < nt; t += 2) {
            const bool last = (t == nt - 2);
            const char* a1 = cA + (size_t)(t + 1) * kstep;
            const char* a2 = last ? nA : cA + (size_t)(t + 2) * kstep; const char* b2 = last ? nB : cB + (size_t)(t + 2) * kstep;
            const char* a3 = a2 + kstep; const char* b3 = b2 + kstep;
            PG8_LDB(B0, 0, 0); PG8_LDB(B1, 0, 1); PG8_SCHED; PG8_LDA(At, 0, 0); PG8_STAGE(PG8_SA(1, 1), a1 + hstA, voffA);
            PG8_WAIT_V(8); PG8_WAIT_L(0); PG8_BAR; PG8_MMA(0, 0, At, B0); PG8_MMA(0, 1, At, B1); PG8_BAR; PG8_SCHED;
            PG8_LDA(At, 0, 1); PG8_STAGE(PG8_SB(0, 0), b2, voffB); PG8_STAGE(PG8_SB(0, 1), b2 + hstB, voffB); PG8_STAGE(PG8_SA(0, 0), a2, voffA);
            PG8_WAIT_V(8); PG8_WAIT_L(0); PG8_BAR; PG8_MMA(1, 0, At, B0); PG8_MMA(1, 1, At, B1); PG8_BAR; PG8_SCHED;
            PG8_LDB(B0, 1, 0); PG8_LDB(B1, 1, 1); PG8_SCHED; PG8_LDA(At, 1, 0); PG8_STAGE(PG8_SA(0, 1), a2 + hstA, voffA);
            PG8_WAIT_V(8); PG8_WAIT_L(0); PG8_BAR; PG8_MMA(0, 0, At, B0); PG8_MMA(0, 1, At, B1); PG8_BAR; PG8_SCHED;
            PG8_LDA(At, 1, 1); PG8_STAGE(PG8_SB(1, 0), b3, voffB); PG8_STAGE(PG8_SB(1, 1), b3 + hstB, voffB); PG8_STAGE(PG8_SA(1, 0), a3, voffA);
            PG8_WAIT_V(8); PG8_WAIT_L(0); PG8_BAR; PG8_MMA(1, 0, At, B0); PG8_MMA(1, 1, At, B1); PG8_BAR; PG8_SCHED;
        }
        if constexpr (ALIGN_EPI) { if (wr == 0) PG8_BAR; }
        E(acc, cur, wr, wc, fr, fq);
        if (!has_next) break;
#pragma unroll
        for (int a = 0; a < 2; ++a)
#pragma unroll
            for (int b = 0; b < 2; ++b)
#pragma unroll
                for (int m = 0; m < 4; ++m)
#pragma unroll
                    for (int n = 0; n < 2; ++n) acc[a][b][m][n] = (f32x4){0.f, 0.f, 0.f, 0.f};
        cur = nxt; cA = nA; cB = nB; ++ui;
        if constexpr (ALIGN_EPI) { if (wr == 1) PG8_BAR; }
    }
    PG8_WAIT_V(0);
    if constexpr (!ALIGN_EPI) { if (wr == 0) PG8_BAR; }
    PG8_BAR;
#undef PG8_SA
#undef PG8_SB
#undef PG8_STAGE
#undef PG8_LDA
#undef PG8_LDB
#undef PG8_MMA
#undef PG8_WAIT_V
#undef PG8_WAIT_L
#undef PG8_BAR
#undef PG8_SCHED
}
}

struct Args { const float* in[33]; float* out; unsigned char* ws; int ph_lo, ph_hi; };
enum { I_XP = 0, I_XS, I_PP, I_PS, I_RELB, I_NMIX, I_WIN, I_AQN, I_AKN, I_ALQ1, I_ALK1, I_ALQ2, I_ALK2, I_AON, I_BCQN, I_BCKVN, I_BWUQ, I_BWUKV, I_BQN, I_BKN,
       I_CQN, I_CKN, I_DQN, I_DKN, I_WG, I_WB, I_WO, I_NFFN, I_W1, I_W2, I_NPLE, I_WPG, I_WPP };

__device__ __forceinline__ int rel_bucket(int rel) {
    const int n = rel < 0 ? -rel : rel;
    const float nf = (float)(n > 1 ? n : 1);
    int large = 8 + (int)(logf(nf / 8.0f) / 4.852030263919617f * 8.0f);
    large = large < 15 ? large : 15;
    return (rel > 0 ? 16 : 0) + (n < 8 ? n : large);
}
__device__ __forceinline__ void build_tables(const float* relb, float* tabA, float* tabD, int gtid, int gthreads) {
    for (int i = gtid; i < 4 * TABA_N; i += gthreads) { const int h = i / TABA_N, d = i % TABA_N - TABA_OFF; tabA[i] = relb[rel_bucket(d) * 16 + h] * LOG2E; }
    for (int i = gtid; i < 12 * TABD_N; i += gthreads) { const int gh = i / TABD_N, d = i % TABD_N - TABD_OFF; const int g = gh >> 2; const int dil = g == 0 ? 1 : (g == 1 ? 4 : 16);
        const int ad = d < 0 ? -d : d; const bool ok = (ad % dil == 0) && (ad <= 64 * dil);
        tabD[i] = ok ? relb[rel_bucket(d) * 16 + 4 + gh] * LOG2E : -1e30f; }
}
__device__ __forceinline__ void transpose_item(const float* W, int N, int k0, int n0, bf16_t* dst, int K, LAS float* scr, int lane, int gate_b = -1) {
#pragma unroll 8
    for (int i = 0; i < 32; ++i) { const int kk = 2 * i + (lane >> 5); scr[kk * 33 + (lane & 31)] = W[(size_t)(k0 + kk) * N + n0 + (lane & 31)]; }
    asm volatile("s_waitcnt lgkmcnt(0)" ::: "memory");
    const int c = lane & 7;
#pragma unroll
    for (int j = 0; j < 4; ++j) { const int n = (lane >> 3) + 8 * j; const LAS float* s = scr + (8 * c) * 33 + n;
        u32x4 o; o.x = cvt_pk_bf16(s[0 * 33], s[1 * 33]); o.y = cvt_pk_bf16(s[2 * 33], s[3 * 33]); o.z = cvt_pk_bf16(s[4 * 33], s[5 * 33]); o.w = cvt_pk_bf16(s[6 * 33], s[7 * 33]);
        size_t drow = (size_t)n;
        if (gate_b >= 0) { const int nn = n0 + n, j = nn & 63; drow = (size_t)((nn >> 6) * 256 + 128 * (gate_b >> 1) + 32 * (j >> 4) + 8 * ((j >> 2) & 3) + 4 * (gate_b & 1) + (j & 3)); }
        *(u32x4*)(dst + drow * K + k0 + 8 * c) = o; }
    asm volatile("s_waitcnt lgkmcnt(0)" ::: "memory");
}
__device__ __forceinline__ int win_row(int n0) {
    if (n0 < 512) return PC_AQ + n0;
    if (n0 < 1024) return PC_AK + (n0 - 512);
    if (n0 < 1536) return -(0 + (n0 - 1024) + 1);
    if (n0 < 2048) return PC_BCQ + (n0 - 1536);
    if (n0 < 2560) return PC_BCKV + (n0 - 2048);
    if (n0 < 2624) return PC_BKR + (n0 - 2560);
    if (n0 < 3136) return PC_CQ + (n0 - 2624);
    if (n0 < 3392) return PC_CK + (n0 - 3136);
    if (n0 < 3648) return -(512 + (n0 - 3392) + 1);
    if (n0 < 5184) return PC_DQ + (n0 - 3648);
    if (n0 < 5696) return PC_DK + (n0 - 5184);
    return -(768 + (n0 - 5696) + 1);
}
__device__ __forceinline__ void convert_weights(const Args& a, int layer, unsigned char* W, LAS float* scr, int gw, int ngw, int lane) {
    constexpr int I_IN = 32 * 194, I_G = 4 * 32 * 64, I_B = 4 * 8 * 64, I_O = 32 * 64, I_1 = 32 * 256, I_2 = 128 * 64, I_PG = 32 * 64, I_PPn = 4 * 64, I_UQ = 8 * 24, I_UKV = 8 * 32;
    constexpr int NIT = I_IN + I_G + I_B + I_O + I_1 + I_2 + I_PG + I_PPn + I_UQ + I_UKV;
    for (int it = gw; it < NIT; it += ngw) {
        int r = it;
        if (r < I_IN) { const int kb = r / 194, nb = r % 194; const int dr = win_row(nb * 32);
            bf16_t* dst = dr >= 0 ? (bf16_t*)(W + WO_IN) + (size_t)dr * 2048 : (bf16_t*)(W + WO_INV) + (size_t)(-dr - 1) * 2048;
            transpose_item(a.in[I_WIN] + (size_t)layer * 2048 * 6208, 6208, kb * 64, nb * 32, dst, 2048, scr, lane); continue; } r -= I_IN;
        if (r < I_G) { const int b = r / 2048, q = r % 2048, kb = q / 64, nb = q % 64;
            transpose_item(a.in[I_WG] + ((size_t)layer * 4 + b) * 2048 * 2048, 2048, kb * 64, nb * 32, (bf16_t*)(W + WO_G), 2048, scr, lane, b); continue; } r -= I_G;
        if (r < I_B) { const int b = r / 512, q = r % 512, kb = q / 64, nb = q % 64;
            transpose_item(a.in[I_WB] + ((size_t)layer * 4 + b) * 512 * 2048, 2048, kb * 64, nb * 32, (bf16_t*)(W + WO_B) + ((size_t)b * 2048 + nb * 32) * 512, 512, scr, lane); continue; } r -= I_B;
        if (r < I_O) { const int kb = r / 64, nb = r % 64;
            transpose_item(a.in[I_WO] + (size_t)layer * 2048 * 2048, 2048, kb * 64, nb * 32, (bf16_t*)(W + WO_O) + (size_t)(nb * 32) * 2048, 2048, scr, lane); continue; } r -= I_O;
        if (r < I_1) { const int kb = r / 256, nb = r % 256;
            transpose_item(a.in[I_W1] + (size_t)layer * 2048 * 8192, 8192, kb * 64, nb * 32, (bf16_t*)(W + WO_1) + (size_t)(nb * 32) * 2048, 2048, scr, lane); continue; } r -= I_1;
        if (r < I_2) { const int kb = r / 64, nb = r % 64;
            transpose_item(a.in[I_W2] + (size_t)layer * 8192 * 2048, 2048, kb * 64, nb * 32, (bf16_t*)(W + WO_2) + (size_t)(nb * 32) * 8192, 8192, scr, lane); continue; } r -= I_2;
        if (r < I_PG) { const int kb = r / 64, nb = r % 64;
            transpose_item(a.in[I_WPG] + (size_t)layer * 2048 * 2048, 2048, kb * 64, nb * 32, (bf16_t*)(W + WO_PG) + (size_t)(nb * 32) * 2048, 2048, scr, lane); continue; } r -= I_PG;
        if (r < I_PPn) { const int kb = r / 64, nb = r % 64;
            transpose_item(a.in[I_WPP] + (size_t)layer * 256 * 2048, 2048, kb * 64, nb * 32, (bf16_t*)(W + WO_PP) + (size_t)(nb * 32) * 256, 256, scr, lane); continue; } r -= I_PPn;
        if (r < I_UQ) { const int kb = r / 24, nb = r % 24;
            transpose_item(a.in[I_BWUQ] + (size_t)layer * 512 * 768, 768, kb * 64, nb * 32, (bf16_t*)(W + WO_UQ) + (size_t)(nb * 32) * 512, 512, scr, lane); continue; } r -= I_UQ;
        { const int kb = r / 32, nb = r % 32; const int n0 = nb * 32, h = n0 >> 8, j0 = n0 & 255;
            bf16_t* dst = j0 < 128 ? (bf16_t*)(W + WO_UKN) + (size_t)(h * 128 + j0) * 512 : (bf16_t*)(W + WO_UKV) + (size_t)(h * 128 + j0 - 128) * 512;
            transpose_item(a.in[I_BWUKV] + (size_t)layer * 512 * 1024, 1024, kb * 64, n0, dst, 512, scr, lane); }
    }
}

__device__ __forceinline__ void norm_row(const float* x, const float* g, bf16_t* out, int lane) {
    f32x4 v[8]; float s = 0.f;
#pragma unroll
    for (int j = 0; j < 8; ++j) { v[j] = *(const f32x4*)(x + 4 * lane + 256 * j); s += (v[j][0] * v[j][0] + v[j][1] * v[j][1]) + (v[j][2] * v[j][2] + v[j][3] * v[j][3]); }
    const float rs = 1.0f / sqrtf(wave_sum(s) * (1.0f / 2048.0f) + EPS);
#pragma unroll
    for (int j = 0; j < 8; ++j) { const f32x4 gg = *(const f32x4*)(g + 4 * lane + 256 * j);
        u32x2 w; w.x = cvt_pk_bf16(v[j][0] * rs * gg[0], v[j][1] * rs * gg[1]); w.y = cvt_pk_bf16(v[j][2] * rs * gg[2], v[j][3] * rs * gg[3]);
        *(u32x2*)(out + 4 * lane + 256 * j) = w; }
}
__device__ __forceinline__ void load8(const bf16_t* p, float (&f)[8]) { const u32x4 v = *(const u32x4*)p; f[0] = bf_lo(v.x); f[1] = bf_hi(v.x); f[2] = bf_lo(v.y); f[3] = bf_hi(v.y); f[4] = bf_lo(v.z); f[5] = bf_hi(v.z); f[6] = bf_lo(v.w); f[7] = bf_hi(v.w); }
__device__ __forceinline__ void store8(bf16_t* p, const float (&f)[8]) { u32x4 w; w.x = cvt_pk_bf16(f[0], f[1]); w.y = cvt_pk_bf16(f[2], f[3]); w.z = cvt_pk_bf16(f[4], f[5]); w.w = cvt_pk_bf16(f[6], f[7]); *(u32x4*)p = w; }
template <int GRP> __device__ __forceinline__ void norm8(float (&f)[8], const float* g, float scale, int lane) {
    float s = 0.f;
#pragma unroll
    for (int e = 0; e < 8; ++e) s += f[e] * f[e];
#pragma unroll
    for (int o = 1; o < GRP; o <<= 1) s += __shfl_xor(s, o);
    const float rs = scale / sqrtf(s * (1.0f / (GRP * 8)) + EPS);
    const int gi = (lane & (GRP - 1)) * 8;
#pragma unroll
    for (int e = 0; e < 8; ++e) f[e] = f[e] * rs * g[gi + e];
}
__device__ __forceinline__ float rope_inv(int i) { return __builtin_amdgcn_exp2f(-(float)i * (13.287712379549449f / 32.0f)) * 0.15915494309189535f; }
__device__ __forceinline__ void sincos_rev(float rev, float& sn, float& cs) { rev -= rintf(rev); sn = __builtin_amdgcn_sinf(rev); cs = __builtin_amdgcn_cosf(rev); }
__device__ __forceinline__ void axial_rope8(float (&f)[8], float rowpos, float colpos, int lane) {
    const int j = lane & 15, hf = j >> 3, jj = j & 7; const float pos = hf ? colpos : rowpos; const float sgn = jj < 4 ? -1.f : 1.f; const int i0 = 8 * (jj & 3);
#pragma unroll
    for (int e = 0; e < 8; ++e) { const float pv = __shfl_xor(f[e], 4); float sn, cs; sincos_rev(pos * rope_inv(i0 + e), sn, cs); f[e] = f[e] * cs + sgn * pv * sn; }
}
__device__ __forceinline__ void post1_row(const Args& a, int layer, bf16_t* P, int tseq, int lane) {
    float f[8];
    const float sA = 0.125f * LOG2E, sC = 0.08838834764831845f * LOG2E;
    load8(P + PC_AQ + 8 * lane, f); norm8<8>(f, a.in[I_AQN] + layer * 64, sA, lane); store8(P + PC_AQ + 8 * lane, f);
    load8(P + PC_AK + 8 * lane, f); norm8<8>(f, a.in[I_AKN] + layer * 64, 1.f, lane); store8(P + PC_AK + 8 * lane, f);
    load8(P + PC_BCQ + 8 * lane, f); norm8<64>(f, a.in[I_BCQN] + layer * 512, 1.f, lane); store8(P + PC_BCQ + 8 * lane, f);
    load8(P + PC_BCKV + 8 * lane, f); norm8<64>(f, a.in[I_BCKVN] + layer * 512, 1.f, lane); store8(P + PC_BCKV + 8 * lane, f);
    const float rowpos = (float)(tseq >> 6), colpos = (float)(tseq & 63);
    load8(P + PC_CQ + 8 * lane, f); norm8<16>(f, a.in[I_CQN] + layer * 128, sC, lane); axial_rope8(f, rowpos, colpos, lane); store8(P + PC_CQ + 8 * lane, f);
    { const int l2 = lane & 31; load8(P + PC_CK + 8 * l2, f); norm8<16>(f, a.in[I_CKN] + layer * 128, 1.f, lane); axial_rope8(f, rowpos, colpos, lane); if (lane < 32) store8(P + PC_CK + 8 * l2, f); }
#pragma unroll
    for (int p = 0; p < 3; ++p) { load8(P + PC_DQ + 512 * p + 8 * lane, f); norm8<16>(f, a.in[I_DQN] + layer * 128, sC, lane); store8(P + PC_DQ + 512 * p + 8 * lane, f); }
    load8(P + PC_DK + 8 * lane, f); norm8<16>(f, a.in[I_DKN] + layer * 128, 1.f, lane); store8(P + PC_DK + 8 * lane, f);
}
__device__ __forceinline__ void mla_norm_rope(float (&f)[8], float (&r)[4], const float* g, float scale, float pos, int lane) {
    const int j = lane & 15;
    float s = 0.f;
#pragma unroll
    for (int e = 0; e < 8; ++e) s += f[e] * f[e];
#pragma unroll
    for (int e = 0; e < 4; ++e) s += r[e] * r[e];
#pragma unroll
    for (int o = 1; o < 16; o <<= 1) s += __shfl_xor(s, o);
    const float rs = scale / sqrtf(s * (1.0f / 192.0f) + EPS);
#pragma unroll
    for (int e = 0; e < 8; ++e) f[e] = f[e] * rs * g[8 * j + e];
#pragma unroll
    for (int e = 0; e < 4; ++e) r[e] = r[e] * rs * g[128 + 4 * j + e];
    const float sgn = j < 8 ? -1.f : 1.f; const int i0 = 4 * (j & 7);
#pragma unroll
    for (int e = 0; e < 4; ++e) { const float pv = __shfl_xor(r[e], 8); float sn, cs; sincos_rev(pos * rope_inv(i0 + e), sn, cs); r[e] = r[e] * cs + sgn * pv * sn; }
}
__device__ __forceinline__ void post2_row(const Args& a, int layer, bf16_t* Q, bf16_t* Kr, const bf16_t* P, int tseq, int lane) {
    const int h = lane >> 4, j = lane & 15; const float pos = (float)tseq;
    float f[8], r[4];
    { bf16_t* q = Q + h * 192; load8(q + 8 * j, f); const u32x2 v = *(const u32x2*)(q + 128 + 4 * j); r[0] = bf_lo(v.x); r[1] = bf_hi(v.x); r[2] = bf_lo(v.y); r[3] = bf_hi(v.y);
      mla_norm_rope(f, r, a.in[I_BQN] + layer * 192, 0.07216878364870323f * LOG2E, pos, lane);
      store8(q + 8 * j, f); u32x2 w; w.x = cvt_pk_bf16(r[0], r[1]); w.y = cvt_pk_bf16(r[2], r[3]); *(u32x2*)(q + 128 + 4 * j) = w; }
    { bf16_t* k = Kr + h * 192; load8(k + 8 * j, f); const u32x2 v = *(const u32x2*)(P + PC_BKR + 4 * j); r[0] = bf_lo(v.x); r[1] = bf_hi(v.x); r[2] = bf_lo(v.y); r[3] = bf_hi(v.y);
      mla_norm_rope(f, r, a.in[I_BKN] + layer * 192, 1.f, pos, lane);
      store8(k + 8 * j, f); u32x2 w; w.x = cvt_pk_bf16(r[0], r[1]); w.y = cvt_pk_bf16(r[2], r[3]); *(u32x2*)(k + 128 + 4 * j) = w; }
}

struct AState { float m, l; f32x16 o[4]; };
__device__ __forceinline__ void astate_init(AState& st) { st.m = -3.0e38f; st.l = 0.f;
#pragma unroll
    for (int d = 0; d < 4; ++d)
#pragma unroll
        for (int r = 0; r < 16; ++r) st.o[d][r] = 0.f; }
template <int DK, bool TAB, bool QLDS = false>
__device__ __forceinline__ void attn_pass(AState& st, const bf16_t* qp, const bf16_t* kp, long ldk, const bf16_t* vp, long ldv, int kbeg, int kend, const float* tp, LAS bf16x8* qst = nullptr) {
    constexpr int NS = DK / 16;
    bf16x8 qf[QLDS ? 1 : NS], kf[NS];
    if (QLDS) {
#pragma unroll
        for (int s = 0; s < NS; ++s) qst[s * 64] = *(const bf16x8*)(qp + 16 * s);
    } else {
#pragma unroll
        for (int s = 0; s < NS; ++s) qf[s] = *(const bf16x8*)(qp + 16 * s);
    }
    { const bf16_t* k0p = kp + (long)kbeg * ldk;
#pragma unroll
      for (int s = 0; s < NS; ++s) kf[s] = *(const bf16x8*)(k0p + 16 * s); }
    for (int k0 = kbeg; k0 < kend; k0 += 32) {
        bf16x8 vf[4][2];
#pragma unroll
        for (int d = 0; d < 4; ++d)
#pragma unroll
            for (int s = 0; s < 2; ++s) vf[d][s] = *(const bf16x8*)(vp + (long)(32 * d) * ldv + k0 + 16 * s);
        f32x4 tb[4];
        if (TAB) {
#pragma unroll
            for (int s = 0; s < 2; ++s) { tb[2 * s] = *(const f32x4u*)(tp + k0 + 16 * s); tb[2 * s + 1] = *(const f32x4u*)(tp + k0 + 16 * s + 4); } }
        f32x16 sc;
#pragma unroll
        for (int r = 0; r < 16; ++r) sc[r] = 0.f;
#pragma unroll
        for (int s = 0; s < NS; ++s) sc = __builtin_amdgcn_mfma_f32_32x32x16_bf16(kf[s], QLDS ? qst[s * 64] : qf[QLDS ? 0 : s], sc, 0, 0, 0);
        if (k0 + 32 < kend) { const bf16_t* knp = kp + (long)(k0 + 32) * ldk;
#pragma unroll
            for (int s = 0; s < NS; ++s) kf[s] = *(const bf16x8*)(knp + 16 * s); }
        if (TAB) {
#pragma unroll
            for (int r = 0; r < 16; ++r) sc[r] += tb[r >> 2][r & 3]; }
        float mx = sc[0];
#pragma unroll
        for (int r = 1; r < 16; ++r) mx = fmaxf(mx, sc[r]);
        mx = fmaxf(mx, __shfl_xor(mx, 32));
        const float mn = fmaxf(st.m, mx);
        const float alpha = __builtin_amdgcn_exp2f(st.m - mn);
        st.m = mn;
        float ps = 0.f;
#pragma unroll
        for (int r = 0; r < 16; ++r) { sc[r] = __builtin_amdgcn_exp2f(sc[r] - mn); ps += sc[r]; }
        st.l = st.l * alpha + ps;
#pragma unroll
        for (int d = 0; d < 4; ++d)
#pragma unroll
            for (int r = 0; r < 16; ++r) st.o[d][r] *= alpha;
        u32x4 p0, p1;
        p0.x = cvt_pk_bf16(sc[0], sc[1]); p0.y = cvt_pk_bf16(sc[2], sc[3]); p0.z = cvt_pk_bf16(sc[4], sc[5]); p0.w = cvt_pk_bf16(sc[6], sc[7]);
        p1.x = cvt_pk_bf16(sc[8], sc[9]); p1.y = cvt_pk_bf16(sc[10], sc[11]); p1.z = cvt_pk_bf16(sc[12], sc[13]); p1.w = cvt_pk_bf16(sc[14], sc[15]);
        const bf16x8 pf0 = __builtin_bit_cast(bf16x8, p0), pf1 = __builtin_bit_cast(bf16x8, p1);
#pragma unroll
        for (int d = 0; d < 4; ++d) { st.o[d] = __builtin_amdgcn_mfma_f32_32x32x16_bf16(vf[d][0], pf0, st.o[d], 0, 0, 0); st.o[d] = __builtin_amdgcn_mfma_f32_32x32x16_bf16(vf[d][1], pf1, st.o[d], 0, 0, 0); }
    }
}
__device__ __forceinline__ void astate_finish(AState& st) {
    const float l = st.l + __shfl_xor(st.l, 32); const float inv = 1.0f / l;
#pragma unroll
    for (int d = 0; d < 4; ++d)
#pragma unroll
        for (int r = 0; r < 16; ++r) st.o[d][r] *= inv;
}
__device__ __forceinline__ void store_o(const f32x16 (&o)[4], bf16_t* op) {
#pragma unroll
    for (int d = 0; d < 4; ++d)
#pragma unroll
        for (int g = 0; g < 4; ++g) { u32x2 w; w.x = cvt_pk_bf16(o[d][4 * g], o[d][4 * g + 1]); w.y = cvt_pk_bf16(o[d][4 * g + 2], o[d][4 * g + 3]); *(u32x2*)(op + 32 * d + 8 * g) = w; }
}
__device__ __forceinline__ int pi32(int n) { return (n & ~12) | ((n & 4) << 1) | ((n & 8) >> 1); }

struct AttnBufs { const bf16_t* PROJ; const bf16_t* VT; const bf16_t* QB; const bf16_t* KB; const bf16_t* VTB; bf16_t* BR; const float* tabA; const float* tabD; };

__device__ __forceinline__ void attn_unit(const Args& a, const AttnBufs& B, int layer, int mixer, int head, int row0  , int S, int q0  , int lane, LAS float* stash) {
#define ATT_LANE_SETUP int ln_ = lane; asm volatile("" : "+v"(ln_)); const int n = ln_ & 31, hi = ln_ >> 5, pr = pi32(n); const long qrow = (long)row0 + q0 + n; bf16_t* op = B.BR + qrow * 2048 + 4 * hi;
#ifdef ONLY_MIXER
    mixer = ONLY_MIXER;
#endif
    if (mixer == 0) {
        ATT_LANE_SETUP
        const float lam_init = layer == 0 ? 0.2f : 0.35550906759f;
        const float d1 = wave_sum(a.in[I_ALQ1][layer * 64 + lane] * a.in[I_ALK1][layer * 64 + lane]);
        const float d2 = wave_sum(a.in[I_ALQ2][layer * 64 + lane] * a.in[I_ALK2][layer * 64 + lane]);
        const float lam = expf(d1) - expf(d2) + lam_init;
        const bf16_t* vp = B.VT + (long)(head * 128 + n) * TCM + row0 + 8 * hi;
        const float* tp = B.tabA + head * TABA_N + TABA_OFF - (q0 + n) + 8 * hi;
        { AState st; astate_init(st);
          attn_pass<64, true>(st, B.PROJ + qrow * NP + PC_AQ + head * 128 + 8 * hi, B.PROJ + (long)(row0 + pr) * NP + PC_AK + head * 128 + 8 * hi, NP, vp, TCM, 0, S, tp);
          astate_finish(st);
#pragma unroll
          for (int d = 0; d < 4; ++d)
#pragma unroll
              for (int r = 0; r < 16; ++r) stash[(d * 16 + r) * 64 + lane] = st.o[d][r]; }
        AState st; astate_init(st);
        attn_pass<64, true>(st, B.PROJ + qrow * NP + PC_AQ + head * 128 + 64 + 8 * hi, B.PROJ + (long)(row0 + pr) * NP + PC_AK + head * 128 + 64 + 8 * hi, NP, vp, TCM, 0, S, tp);
        astate_finish(st);
        float ss = 0.f;
#pragma unroll
        for (int d = 0; d < 4; ++d)
#pragma unroll
            for (int r = 0; r < 16; ++r) { const float v = stash[(d * 16 + r) * 64 + lane] - lam * st.o[d][r]; st.o[d][r] = v; ss += v * v; }
        ss += __shfl_xor(ss, 32);
        const float rs = (1.0f - lam_init) / sqrtf(ss * (1.0f / 128.0f) + EPS);
        const float* gn = a.in[I_AON] + layer * 128 + 4 * hi;
#pragma unroll
        for (int d = 0; d < 4; ++d)
#pragma unroll
            for (int g = 0; g < 4; ++g) { const f32x4 gg = *(const f32x4*)(gn + 32 * d + 8 * g);
#pragma unroll
                for (int e = 0; e < 4; ++e) st.o[d][4 * g + e] *= rs * gg[e]; }
        store_o(st.o, op + head * 128);
    } else if (mixer == 1) {
        ATT_LANE_SETUP
        AState st; astate_init(st);
        attn_pass<192, false, true>(st, B.QB + qrow * 768 + head * 192 + 8 * hi, B.KB + (long)(row0 + pr) * 768 + head * 192 + 8 * hi, 768,
                              B.VTB + (long)(head * 128 + n) * TCM + row0 + 8 * hi, TCM, 0, S, nullptr, (LAS bf16x8*)stash + lane);
        astate_finish(st); store_o(st.o, op + 512 + head * 128);
    } else if (mixer == 2) {
        ATT_LANE_SETUP
        const int kv = head >> 1;
        AState st; astate_init(st);
        attn_pass<128, false>(st, B.PROJ + qrow * NP + PC_CQ + head * 128 + 8 * hi, B.PROJ + (long)(row0 + pr) * NP + PC_CK + kv * 128 + 8 * hi, NP,
                              B.VT + (long)(512 + kv * 128 + n) * TCM + row0 + 8 * hi, TCM, 0, S, nullptr);
        astate_finish(st); store_o(st.o, op + 1024 + head * 128);
    } else {
        ATT_LANE_SETUP
        AState st; astate_init(st);
        const bf16_t* kp = B.PROJ + (long)(row0 + pr) * NP + PC_DK + head * 128 + 8 * hi;
        const bf16_t* vp = B.VT + (long)(768 + head * 128 + n) * TCM + row0 + 8 * hi;
#pragma unroll 1
        for (int g = 0; g < 3; ++g) { const int W = g == 0 ? 64 : (g == 1 ? 256 : 1024);
            const int kb = q0 - W > 0 ? q0 - W : 0, ke = q0 + 32 + W < S ? q0 + 32 + W : S;
            attn_pass<128, true>(st, B.PROJ + qrow * NP + PC_DQ + (g * 4 + head) * 128 + 8 * hi, kp, NP, vp, TCM, kb, ke, B.tabD + (g * 4 + head) * TABD_N + TABD_OFF - (q0 + n) + 8 * hi); }
        astate_finish(st); store_o(st.o, op + 1536 + head * 128);
    }
}
__device__ __forceinline__ void attn_phase(const Args& a, const AttnBufs& B, int layer, int chunk, unsigned* ctr, int lane, LAS float* stash) {
    const int npr = chunk == 0 ? 1 : 0, nsm = chunk == 0 ? 4 : 12, TC = chunk == 0 ? 16384 : 24576;
    const int nP = npr * 1024, nS = nsm * 256, nD = TC / 8, total = 3 * nP + 3 * nS + nD;
    for (;;) {
        unsigned uu = 0; if (lane == 0) uu = atomicAdd(ctr, 1u);
        int u = __builtin_amdgcn_readfirstlane((int)uu);
        if (u >= total) break;
        int mixer, head, row0, S, q0;
        if (u < 3 * nP) { mixer = u / nP; const int r = u % nP; q0 = (r % 256) * 32; head = r / 256; row0 = 0; S = TP; }
        else { u -= 3 * nP;
            if (u < 3 * nS) { mixer = u / nS; const int r = u % nS; q0 = (r % 64) * 32; head = (r / 64) % 4; row0 = npr * TP + (r / 256) * SS; S = SS; }
            else { u -= 3 * nS; mixer = 3; const int qb = u % (TC / 32); head = u / (TC / 32); const int q = qb * 32;
                if (npr && q < TP) { row0 = 0; S = TP; } else { row0 = npr * TP + ((q - npr * TP) / SS) * SS; S = SS; }
                q0 = q - row0; } }
#ifdef ONLY_MIXER
        if (mixer != ONLY_MIXER) continue;
#endif
        attn_unit(a, B, layer, mixer, head, row0, S, q0, lane, stash);
    }
}


constexpr int A2_RSV = 144, A2_BUFSZ = 64 * 400 + 128 * A2_RSV;
static_assert(2 * A2_BUFSZ <= 131072 && 2 * A2_BUFSZ >= 65536, "attention LDS");
template <int DKL, int DK, bool TAB>
__device__ __forceinline__ void attn2_pass(AState& st, LAS unsigned char* buf, const bf16_t* qp, int koff, const bf16_t* Kg, long ldk, const bf16_t* Vg, long ldv,
                                           int kbeg, int kend, const float* tp, int wlo, int whi, int tid_in, int lane) {
    constexpr int NS = DK / 16, PR = DKL / 8, NKP = DKL / 64, RSK = DKL * 2 + 16, KBYTES = 64 * RSK;
    int tid = tid_in; asm volatile("" : "+v"(tid));
    const int n = lane & 31, hi = lane >> 5, pr = pi32(n);
    bf16x8 qf[NS];
#pragma unroll
    for (int s = 0; s < NS; ++s) qf[s] = *(const bf16x8*)(qp + 16 * s);
    u32x4 kreg[NKP], vreg[2];
    int krow[NKP], kc[NKP];
#pragma unroll
    for (int i = 0; i < NKP; ++i) { const int p = tid + 512 * i; krow[i] = p / PR; kc[i] = p % PR; }
#define A2_GLOAD(k0_) do { _Pragma("unroll") for (int i = 0; i < NKP; ++i) kreg[i] = *(const u32x4*)(Kg + (long)((k0_) + krow[i]) * ldk + 8 * kc[i]); \
        _Pragma("unroll") for (int i = 0; i < 2; ++i) { const int p = tid + 512 * i; vreg[i] = *(const u32x4*)(Vg + (long)(p >> 3) * ldv + (k0_) + 8 * (p & 7)); } } while (0)
#define A2_LSTORE(b_) do { _Pragma("unroll") for (int i = 0; i < NKP; ++i) *(LAS u32x4*)(buf + (b_) * A2_BUFSZ + krow[i] * RSK + kc[i] * 16) = kreg[i]; \
        _Pragma("unroll") for (int i = 0; i < 2; ++i) { const int p = tid + 512 * i; *(LAS u32x4*)(buf + (b_) * A2_BUFSZ + KBYTES + (p >> 3) * A2_RSV + (p & 7) * 16) = vreg[i]; } } while (0)
    A2_GLOAD(kbeg); A2_LSTORE(0); __syncthreads();
    int b = 0;
    const int kfo = pr * RSK + koff + hi * 16, vfo = KBYTES + n * A2_RSV + hi * 16;
    if (st.m < -1.0e38f) {
        f32x16 sc;
#pragma unroll
        for (int r = 0; r < 16; ++r) sc[r] = 0.f;
#pragma unroll
        for (int s = 0; s < NS; ++s) { const bf16x8 kf0 = *(const LAS bf16x8*)(buf + kfo + 32 * s); sc = __builtin_amdgcn_mfma_f32_32x32x16_bf16(kf0, qf[s], sc, 0, 0, 0); }
        float mx = sc[0];
#pragma unroll
        for (int r = 1; r < 16; ++r) mx = fmaxf(mx, sc[r]);
        mx = fmaxf(mx, __shfl_xor(mx, 32));
        st.m = fmaxf(mx, -60.0f);
    }
    for (int k0 = kbeg; k0 < kend; k0 += 64) {
        const bool more = k0 + 64 < kend;
        if (more) A2_GLOAD(k0 + 64);
        LAS unsigned char* bb = buf + b * A2_BUFSZ;
        if (!(k0 + 64 <= wlo || k0 >= whi)) {
#define A2_SB() __builtin_amdgcn_sched_barrier(0x0124)
            f32x4 tb[8];
            if (TAB) {
#pragma unroll
                for (int s = 0; s < 4; ++s) { tb[2 * s] = *(const f32x4u*)(tp + k0 + 16 * s); tb[2 * s + 1] = *(const f32x4u*)(tp + k0 + 16 * s + 4); } }
            f32x16 sc0, sc1;
#pragma unroll
            for (int r = 0; r < 16; ++r) { sc0[r] = 0.f; sc1[r] = 0.f; }
            u32x4 pw[4];
            float mx = -3.0e38f, ps = 0.f;
            const float mref = st.m;
#pragma unroll
            for (int s = 0; s < NS; ++s) { const bf16x8 kf0 = *(const LAS bf16x8*)(bb + kfo + 32 * s); sc0 = __builtin_amdgcn_mfma_f32_32x32x16_bf16(kf0, qf[s], sc0, 0, 0, 0); }
            A2_SB();
#pragma unroll
            for (int s = 0; s < NS; ++s) {
                const bf16x8 kf1 = *(const LAS bf16x8*)(bb + kfo + 32 * RSK + 32 * s);
                sc1 = __builtin_amdgcn_mfma_f32_32x32x16_bf16(kf1, qf[s], sc1, 0, 0, 0);
                A2_SB();
#pragma unroll
                for (int pp = (8 * s) / NS; pp < (8 * (s + 1)) / NS; ++pp) {
                    float x0 = sc0[2 * pp], x1 = sc0[2 * pp + 1];
                    if (TAB) { x0 += tb[(2 * pp) >> 2][(2 * pp) & 3]; x1 += tb[(2 * pp + 1) >> 2][(2 * pp + 1) & 3]; }
                    mx = fmaxf(mx, fmaxf(x0, x1));
                    const float e0 = __builtin_amdgcn_exp2f(x0 - mref), e1 = __builtin_amdgcn_exp2f(x1 - mref);
                    ps += e0 + e1; pw[pp >> 2][pp & 3] = cvt_pk_bf16(e0, e1); }
                A2_SB();
            }
            {
                const bf16x8 pf0 = __builtin_bit_cast(bf16x8, pw[0]), pf1 = __builtin_bit_cast(bf16x8, pw[1]);
#pragma unroll
                for (int i = 0; i < 8; ++i) { const int h = i >> 2, d = i & 3;
                    const bf16x8 v = *(const LAS bf16x8*)(bb + vfo + (32 * d) * A2_RSV + 32 * h);
                    st.o[d] = __builtin_amdgcn_mfma_f32_32x32x16_bf16(v, h ? pf1 : pf0, st.o[d], 0, 0, 0);
                    A2_SB();
                    { const int pp = i; float x0 = sc1[2 * pp], x1 = sc1[2 * pp + 1];
                      if (TAB) { x0 += tb[4 + ((2 * pp) >> 2)][(2 * pp) & 3]; x1 += tb[4 + ((2 * pp + 1) >> 2)][(2 * pp + 1) & 3]; }
                      mx = fmaxf(mx, fmaxf(x0, x1));
                      const float e0 = __builtin_amdgcn_exp2f(x0 - mref), e1 = __builtin_amdgcn_exp2f(x1 - mref);
                      ps += e0 + e1; pw[2 + (pp >> 2)][pp & 3] = cvt_pk_bf16(e0, e1); }
                    A2_SB(); }
            }
            {
                const bf16x8 pf2 = __builtin_bit_cast(bf16x8, pw[2]), pf3 = __builtin_bit_cast(bf16x8, pw[3]);
#pragma unroll
                for (int i = 0; i < 8; ++i) { const int h = i >> 2, d = i & 3;
                    const bf16x8 v = *(const LAS bf16x8*)(bb + vfo + (32 * d) * A2_RSV + 64 + 32 * h);
                    st.o[d] = __builtin_amdgcn_mfma_f32_32x32x16_bf16(v, h ? pf3 : pf2, st.o[d], 0, 0, 0); }
            }
            st.l += ps;
            mx = fmaxf(mx, __shfl_xor(mx, 32));
            if (__any(mx > st.m + 8.0f)) {
                const float mn = fmaxf(st.m, mx); const float alpha = __builtin_amdgcn_exp2f(st.m - mn); st.m = mn; st.l *= alpha;
#pragma unroll
                for (int d = 0; d < 4; ++d)
#pragma unroll
                    for (int r = 0; r < 16; ++r) st.o[d][r] *= alpha;
            }
#undef A2_SB
        }
        if (more) A2_LSTORE(b ^ 1);
        __syncthreads();
        b ^= 1;
    }
#undef A2_GLOAD
#undef A2_LSTORE
}

__device__ __forceinline__ void attn2_unit(const Args& a, const AttnBufs& B, int layer, int mixer, int head, int row0, int S, int q0, int tid, int lane, int wave, LAS unsigned char* buf) {
#ifdef ONLY_MIXER2
    mixer = ONLY_MIXER2;
#endif
    if (mixer == 0) {
        int ln_ = lane; asm volatile("" : "+v"(ln_)); const int n = ln_ & 31, hi = ln_ >> 5;
        const int half = wave >> 2, qw = q0 + 32 * (wave & 3); const long qrow = (long)row0 + qw + n;
        const float lam_init = layer == 0 ? 0.2f : 0.35550906759f;
        AState st; astate_init(st);
        attn2_pass<128, 64, true>(st, buf, B.PROJ + qrow * NP + PC_AQ + head * 128 + 64 * half + 8 * hi, 128 * half, B.PROJ + (long)row0 * NP + PC_AK + head * 128, NP,
                                  B.VT + (long)(head * 128) * TCM + row0, TCM, 0, S, B.tabA + head * TABA_N + TABA_OFF - (qw + n) + 8 * hi, 0, S, tid, ln_);
        astate_finish(st);
        LAS float* xb = (LAS float*)buf + (wave & 3) * 4096;
        if (half == 1) {
#pragma unroll
            for (int d = 0; d < 4; ++d)
#pragma unroll
                for (int r = 0; r < 16; ++r) xb[(d * 16 + r) * 64 + ln_] = st.o[d][r]; }
        __syncthreads();
        if (half == 0) {
            const float d1 = wave_sum(a.in[I_ALQ1][layer * 64 + ln_] * a.in[I_ALK1][layer * 64 + ln_]);
            const float d2 = wave_sum(a.in[I_ALQ2][layer * 64 + ln_] * a.in[I_ALK2][layer * 64 + ln_]);
            const float lam = expf(d1) - expf(d2) + lam_init;
            float ss = 0.f;
#pragma unroll
            for (int d = 0; d < 4; ++d)
#pragma unroll
                for (int r = 0; r < 16; ++r) { const float v = st.o[d][r] - lam * xb[(d * 16 + r) * 64 + ln_]; st.o[d][r] = v; ss += v * v; }
            ss += __shfl_xor(ss, 32);
            const float rs = (1.0f - lam_init) / sqrtf(ss * (1.0f / 128.0f) + EPS);
            const float* gn = a.in[I_AON] + layer * 128 + 4 * hi;
#pragma unroll
            for (int d = 0; d < 4; ++d)
#pragma unroll
                for (int g = 0; g < 4; ++g) { const f32x4 gg = *(const f32x4*)(gn + 32 * d + 8 * g);
#pragma unroll
                    for (int e = 0; e < 4; ++e) st.o[d][4 * g + e] *= rs * gg[e]; }
            store_o(st.o, B.BR + qrow * 2048 + 4 * hi + head * 128);
        }
    } else if (mixer == 1) {
        int ln_ = lane; asm volatile("" : "+v"(ln_)); const int n = ln_ & 31, hi = ln_ >> 5;
        const int qw = q0 + 32 * wave; const long qrow = (long)row0 + qw + n;
        AState st; astate_init(st);
        attn2_pass<192, 192, false>(st, buf, B.QB + qrow * 768 + head * 192 + 8 * hi, 0, B.KB + (long)row0 * 768 + head * 192, 768,
                                    B.VTB + (long)(head * 128) * TCM + row0, TCM, 0, S, nullptr, 0, S, tid, ln_);
        astate_finish(st); store_o(st.o, B.BR + qrow * 2048 + 4 * hi + 512 + head * 128);
    } else if (mixer == 2) {
        int ln_ = lane; asm volatile("" : "+v"(ln_)); const int n = ln_ & 31, hi = ln_ >> 5;
        const int qw = q0 + 32 * wave; const long qrow = (long)row0 + qw + n; const int kv = head >> 1;
        AState st; astate_init(st);
        attn2_pass<128, 128, false>(st, buf, B.PROJ + qrow * NP + PC_CQ + head * 128 + 8 * hi, 0, B.PROJ + (long)row0 * NP + PC_CK + kv * 128, NP,
                                    B.VT + (long)(512 + kv * 128) * TCM + row0, TCM, 0, S, nullptr, 0, S, tid, ln_);
        astate_finish(st); store_o(st.o, B.BR + qrow * 2048 + 4 * hi + 1024 + head * 128);
    } else {
        int ln_ = lane; asm volatile("" : "+v"(ln_)); const int n = ln_ & 31, hi = ln_ >> 5;
        const int qw = q0 + 32 * wave; const long qrow = (long)row0 + qw + n;
        AState st; astate_init(st);
#pragma unroll 1
        for (int g = 0; g < 3; ++g) { const int W = g == 0 ? 64 : (g == 1 ? 256 : 1024);
            const int kb = q0 - W > 0 ? q0 - W : 0, ke = q0 + 256 + W < S ? q0 + 256 + W : S;
            attn2_pass<128, 128, true>(st, buf, B.PROJ + qrow * NP + PC_DQ + (g * 4 + head) * 128 + 8 * hi, 0, B.PROJ + (long)row0 * NP + PC_DK + head * 128, NP,
                                       B.VT + (long)(768 + head * 128) * TCM + row0, TCM, kb, ke, B.tabD + (g * 4 + head) * TABD_N + TABD_OFF - (qw + n) + 8 * hi, qw - W, qw + 32 + W, tid, ln_); }
        astate_finish(st); store_o(st.o, B.BR + qrow * 2048 + 4 * hi + 1536 + head * 128);
    }
}
__device__ __forceinline__ void attn2_phase(const Args& a, const AttnBufs& B, int layer, int chunk, unsigned* ctr, int tid, int lane, int wave, LAS unsigned char* lds) {
    const int npr = chunk == 0 ? 1 : 0, nsm = chunk == 0 ? 4 : 12, TC = chunk == 0 ? 16384 : 24576;
    const int c0 = npr * 128, c1 = npr * 128, c2 = npr * 256, c3 = TC / 64, c4 = nsm * 32, c5 = nsm * 32, c6 = nsm * 64;
    const int total = c0 + c1 + c2 + c3 + c4 + c5 + c6;
    volatile LAS int* uw = (volatile LAS int*)(lds + 131072);
    for (;;) {
        __syncthreads();
        if (tid == 0) *uw = (int)atomicAdd(ctr, 1u);
        __syncthreads();
        int u = __builtin_amdgcn_readfirstlane(*uw);
        if (u >= total) break;
        int mixer, head, row0, S, q0;
        if (u < c0 + c1 + c2) { row0 = 0; S = TP;
            if (u < c0) { mixer = 1; q0 = (u % 32) * 256; head = u / 32; }
            else if (u < c0 + c1) { u -= c0; mixer = 2; q0 = (u % 32) * 256; head = u / 32; }
            else { u -= c0 + c1; mixer = 0; q0 = (u % 64) * 128; head = u / 64; }
        } else { u -= c0 + c1 + c2;
            if (u < c3) { mixer = 3; const int nb = TC / 256; const int q = (u % nb) * 256; head = u / nb;
                if (npr && q < TP) { row0 = 0; S = TP; } else { row0 = npr * TP + ((q - npr * TP) / SS) * SS; S = SS; }
                q0 = q - row0; }
            else { u -= c3; S = SS;
                if (u < c4) { mixer = 1; q0 = (u % 8) * 256; head = (u / 8) % 4; row0 = npr * TP + (u / 32) * SS; }
                else if (u < c4 + c5) { u -= c4; mixer = 2; q0 = (u % 8) * 256; head = (u / 8) % 4; row0 = npr * TP + (u / 32) * SS; }
                else { u -= c4 + c5; mixer = 0; q0 = (u % 16) * 128; head = (u / 16) % 4; row0 = npr * TP + (u / 64) * SS; } } }
        attn2_unit(a, B, layer, mixer, head, row0, S, q0, tid, lane, wave, lds);
    }
}


#define XB_TMO      128
#define XB_XCNT(j)  (256  + 64 * (j))
#define XB_XSUB(j)  (1280 + 64 * (j))
#define XB_XGEN(j)  (2304 + 64 * (j))
#define XB_TOP      3328
#define XB_TOPGEN   3392
#define XCD_BAR_WORDS 3456
#define XB_SPIN_CAP (1u << 22)
__device__ __forceinline__ unsigned xb_ld(unsigned* p)              { return __hip_atomic_load(p, __ATOMIC_RELAXED, __HIP_MEMORY_SCOPE_AGENT); }
__device__ __forceinline__ unsigned xb_add(unsigned* p, unsigned v) { return __hip_atomic_fetch_add(p, v, __ATOMIC_RELAXED, __HIP_MEMORY_SCOPE_AGENT); }
__device__ __forceinline__ unsigned xb_xcc_id() { return (unsigned)__builtin_amdgcn_s_getreg((3 << 11) | 20) & 0xFu; }
#define XB_SPIN(cond, bar) do { unsigned _sp = 0; while (cond) { __builtin_amdgcn_s_sleep(1); \
    if ((++_sp & 255u) == 0u) { if (xb_ld(&(bar)[XB_TMO])) break; if (_sp > XB_SPIN_CAP) { atomicAdd(&(bar)[XB_TMO], 1u); break; } } } } while (0)
struct XcdBarrier { unsigned* bar; unsigned x; volatile LAS unsigned* st; };
__device__ __forceinline__ XcdBarrier xcd_barrier_post(unsigned* bar, volatile LAS unsigned* st) {
    XcdBarrier b; b.bar = bar; b.x = xb_xcc_id(); b.st = st;
    if (threadIdx.x == 0) (void)xb_add(&bar[XB_XCNT(b.x)], 1u);
    return b;
}
__device__ __forceinline__ void xcd_barrier_complete(unsigned* bar, unsigned x, unsigned& nloc, unsigned& nx) {
    const unsigned G = gridDim.x * gridDim.y * gridDim.z;
    unsigned sum, cnt, mine, sp = 0u;
    for (;;) {
        sum = 0u; cnt = 0u; mine = 0u;
#pragma unroll
        for (unsigned j = 0; j < 16; ++j) { const unsigned c = xb_ld(&bar[XB_XCNT(j)]); sum += c; cnt += (c > 0u) ? 1u : 0u; mine = (j == x) ? c : mine; }
        if (sum == G) break;
        __builtin_amdgcn_s_sleep(1);
        if ((++sp & 255u) == 0u) { if (xb_ld(&bar[XB_TMO])) break; if (sp > XB_SPIN_CAP) { atomicAdd(&bar[XB_TMO], 1u); break; } }
    }
    nloc = mine > 0u ? mine : 1u; nx = cnt > 0u ? cnt : 1u;
}
__device__ __forceinline__ void xcd_barrier(const XcdBarrier& b) {
    asm volatile("s_waitcnt vmcnt(0)" ::: "memory");
    __syncthreads();
    if (threadIdx.x == 0) {
        unsigned* bar = b.bar;
        __builtin_amdgcn_s_waitcnt(0);
        unsigned nloc = b.st[0], nx = b.st[1];
        if (nloc == 0u) { xcd_barrier_complete(bar, b.x, nloc, nx); b.st[0] = nloc; b.st[1] = nx; }
        const unsigned old = xb_add(&bar[XB_XSUB(b.x)], 1u);
        const unsigned gen = old / nloc;
        if (old + 1u == (gen + 1u) * nloc) {
            __builtin_amdgcn_fence(__ATOMIC_RELEASE, "agent");
            asm volatile("s_waitcnt vmcnt(0)" ::: "memory");
            const unsigned og = xb_add(&bar[XB_TOP], 1u);
            const unsigned tg = og / nx;
            if (og + 1u == (tg + 1u) * nx) xb_add(&bar[XB_TOPGEN], 1u);
            else XB_SPIN(xb_ld(&bar[XB_TOPGEN]) == tg, bar);
            __builtin_amdgcn_fence(__ATOMIC_ACQUIRE, "agent");
            xb_add(&bar[XB_XGEN(b.x)], 1u);
            asm volatile("s_waitcnt vmcnt(0)" ::: "memory");
        } else {
            XB_SPIN(xb_ld(&bar[XB_XGEN(b.x)]) == gen, bar);
            __builtin_amdgcn_fence(__ATOMIC_ACQUIRE, "agent");
            asm volatile("s_waitcnt vmcnt(0)" ::: "memory");
        }
    }
    __syncthreads();
}

__global__ void __launch_bounds__(512, 2) mega(Args a) {
    extern __shared__ __attribute__((aligned(16))) unsigned char lds_raw[];
    LAS unsigned char* lds = (LAS unsigned char*)lds_raw;
    const int G = gridDim.x, bx = blockIdx.x;
    unsigned char* ws = a.ws;
    unsigned* ctl = (unsigned*)(ws + WS_CTL);
    float* tabA = (float*)(ws + WS_TABA); float* tabD = (float*)(ws + WS_TABD);
    unsigned char* W = ws + WS_W;
    bf16_t* H = (bf16_t*)(ws + WS_H);
    bf16_t* PROJ = (bf16_t*)(ws + WS_R1 + R1_PROJ); bf16_t* VT = (bf16_t*)(ws + WS_R1 + R1_VT); bf16_t* QB = (bf16_t*)(ws + WS_R1 + R1_QB);
    bf16_t* KB = (bf16_t*)(ws + WS_R1 + R1_KB); bf16_t* VTB = (bf16_t*)(ws + WS_R1 + R1_VTB);
    bf16_t* Y = (bf16_t*)(ws + WS_R1); bf16_t* FFH = (bf16_t*)(ws + WS_R1);
    bf16_t* BR = (bf16_t*)(ws + WS_R2); float* PART = (float*)(ws + WS_R2); bf16_t* U = (bf16_t*)(ws + WS_R2);
    bf16_t* MERGED = (bf16_t*)(ws + WS_R3); bf16_t* P16 = (bf16_t*)(ws + WS_R3);
    cg::grid_group grid = cg::this_grid();
    volatile LAS unsigned* bst = (volatile LAS unsigned*)(lds + 131072 + 64);
    if (threadIdx.x < 2) bst[threadIdx.x] = 0u;
    __syncthreads();
    XcdBarrier xbar = xcd_barrier_post(ctl + 1024, bst);

    for (int pid = a.ph_lo; pid < a.ph_hi; ++pid) {
        int tid = threadIdx.x; asm volatile("" : "+v"(tid));
        const int lane = tid & 63, wave = __builtin_amdgcn_readfirstlane(tid >> 6);
        const int gw = bx * 8 + wave, ngw = G * 8;
        const int layer = pid / 31, q = pid % 31;
        if (q == 0) {
            if (layer == 0) build_tables(a.in[I_RELB], tabA, tabD, bx * 512 + tid, G * 512);
#ifndef NO_CONV
            convert_weights(a, layer, W, (LAS float*)(lds + wave * 16384), gw, ngw, lane);
#endif
        } else {
            const int chunk = (q - 1) / 15, k = (q - 1) % 15 + 1;
            const int m0 = chunk == 0 ? 0 : 16384, TC = chunk == 0 ? 16384 : 24576, nMt = TC / 256;
            const float* xs0 = layer == 0 ? a.in[I_XP] : a.out; const float* xs1 = layer == 0 ? a.in[I_XS] : a.out + (size_t)TP * DM;
#ifdef NO_ROWS
            if (0) {
#else
            if (k == 1 || k == 10 || k == 13) {
#endif
                if (k == 1 || k == 10) { if (k == 10) { xs0 = a.out; xs1 = a.out + (size_t)TP * DM; }
                    const float* g = (k == 1 ? a.in[I_NMIX] : a.in[I_NFFN]) + layer * DM;
                    for (int r = gw; r < TC; r += ngw) norm_row(xrow_ptr(xs0, xs1, m0 + r), g, H + (size_t)r * DM, lane);
                } else {
                    const float* g = a.in[I_NPLE] + layer * DM;
                    for (int r = gw; r < TC; r += ngw) { const int m = m0 + r; norm_row(a.out + (size_t)m * DM, g, H + (size_t)r * DM, lane);
                        const float* pr = m < TP ? a.in[I_PP] + ((size_t)layer * TP + m) * 256 : a.in[I_PS] + ((size_t)layer * 32768 + (m - TP)) * 256;
                        const f32x4 v = *(const f32x4*)(pr + 4 * lane); u32x2 w; w.x = cvt_pk_bf16(v[0], v[1]); w.y = cvt_pk_bf16(v[2], v[3]); *(u32x2*)(P16 + (size_t)r * 256 + 4 * lane) = w; }
                }
#ifdef NO_ROWS
            } else if (0) {
#else
            } else if (k == 3 || k == 5) {
#endif
                for (int r = gw; r < TC; r += ngw) { const int m = m0 + r; const int tseq = m < TP ? m : (m - TP) % SS;
                    if (k == 3) post1_row(a, layer, PROJ + (size_t)r * NP, tseq, lane);
                    else post2_row(a, layer, QB + (size_t)r * 768, KB + (size_t)r * 768, PROJ + (size_t)r * NP, tseq, lane); }
            } else if (k == 6) {
                AttnBufs B{PROJ, VT, QB, KB, VTB, BR, tabA, tabD};
#ifndef NO_ATTN
                #if ATTN_V2
                attn2_phase(a, B, layer, chunk, ctl + 64 * (layer * 2 + chunk), tid, lane, wave, lds);
#else
                attn_phase(a, B, layer, chunk, ctl + 64 * (layer * 2 + chunk), lane, (LAS float*)(lds + wave * 16384));
#endif
#endif
            } else {
                const int njobs = (k == 2) ? 2 : (k == 4 ? 3 : 1);
                int coff = 0;
                for (int j = 0; j < njobs; ++j) {
                    pg8::Gemm g; pg8::Epi E; int nM = nMt, nN = 8, rep = 1, adiv = 1 << 30; long astep = 0;
                    E.kind = pg8::EK_BF16; E.O = nullptr; E.ldc = 0; E.Y = nullptr; E.part = nullptr; E.xs0 = xs0; E.xs1 = xs1; E.xout = a.out; E.m0 = m0;
                    g.A = H; g.Bt = (const bf16_t*)(W + WO_IN); g.lda = 2048; g.ldb = 2048; g.K = 2048;
                    if (k == 2 && j == 0) { nN = NP / 256; E.O = PROJ; E.ldc = NP; }
                    else if (k == 2) { g.A = (const bf16_t*)(W + WO_INV); g.Bt = H; nM = NVT / 256; nN = nMt; E.O = VT; E.ldc = TCM; }
                    else if (k == 4 && j == 0) { g.A = PROJ + PC_BCQ; g.lda = NP; g.Bt = (const bf16_t*)(W + WO_UQ); g.ldb = 512; g.K = 512; nN = 3; E.O = QB; E.ldc = 768; }
                    else if (k == 4 && j == 1) { g.A = PROJ + PC_BCKV; g.lda = NP; g.Bt = (const bf16_t*)(W + WO_UKN); g.ldb = 512; g.K = 512; nN = 2; E.kind = pg8::EK_SPLIT192; E.O = KB; E.ldc = 768; }
                    else if (k == 4) { g.A = (const bf16_t*)(W + WO_UKV); g.lda = 512; g.Bt = PROJ + PC_BCKV; g.ldb = NP; g.K = 512; nM = 2; nN = nMt; E.O = VTB; E.ldc = TCM; }
                    else if (k == 7) { g.A = BR; g.Bt = (const bf16_t*)(W + WO_B); g.ldb = 512; g.K = 512; nN = 32; adiv = 8; astep = 1024; E.O = Y; E.ldc = 8192; }
                    else if (k == 8) { g.Bt = (const bf16_t*)(W + WO_G); nN = 32; E.kind = pg8::EK_GATE; E.O = MERGED; E.Y = Y; }
                    else if (k == 9) { g.A = MERGED; g.Bt = (const bf16_t*)(W + WO_O); E.kind = pg8::EK_RES; }
                    else if (k == 11) { g.Bt = (const bf16_t*)(W + WO_1); nN = 32; E.kind = pg8::EK_RELU2; E.O = FFH; E.ldc = 8192; }
                    else if (k == 12) { g.A = FFH; g.lda = 8192; g.Bt = (const bf16_t*)(W + WO_2); g.ldb = 8192; g.K = 8192; E.kind = pg8::EK_RES; E.xs0 = a.out; E.xs1 = a.out + (size_t)TP * DM; }
                    else if (k == 14) { g.A = P16; g.lda = 256; g.Bt = (const bf16_t*)(W + WO_PP); g.ldb = 256; g.K = 256; E.O = U; E.ldc = 2048; }
                    else { g.Bt = (const bf16_t*)(W + WO_PG); E.kind = pg8::EK_PLE; E.Y = U; E.xs0 = a.out; E.xs1 = a.out + (size_t)TP * DM; }
                    pg8::Order S; S.init(nM, nN, G, (bx + G - coff) % G, rep, adiv, astep);
#ifndef NO_GEMM
                    pg8::gemm_phase<true>(lds, g, S, E, tid);
#endif
                    coff = (coff + (nM * nN) % G) % G;
                }
            }
        }
        if (pid + 1 < a.ph_hi) { if (pid == a.ph_lo) grid.sync(); else xcd_barrier(xbar); }
    }
}

extern "C" void kernel_launch(void* const* d_in, const int* in_sizes, int n_in, void* d_out, int out_size, void* d_ws, size_t ws_size, hipStream_t stream) {
    static int grid = 0;
    if (grid == 0) {
        if (n_in != 33 || out_size != TALL * DM || ws_size < WS_END) { fprintf(stderr, "kernel_launch: unexpected shapes (n_in %d out %d ws %zu need %zu)\n", n_in, out_size, ws_size, (size_t)WS_END); grid = -1; return; }
        int dev = 0, cus = 0, per_cu = 0;
        hipGetDevice(&dev); hipDeviceGetAttribute(&cus, hipDeviceAttributeMultiprocessorCount, dev);
        if (hipFuncSetAttribute((const void*)mega, hipFuncAttributeMaxDynamicSharedMemorySize, LDS_BYTES) != hipSuccess) { fprintf(stderr, "kernel_launch: hipFuncSetAttribute failed\n"); grid = -1; return; }
        if (hipOccupancyMaxActiveBlocksPerMultiprocessor(&per_cu, (const void*)mega, 512, LDS_BYTES) != hipSuccess || per_cu < 1) per_cu = 1;
        (void)hipGetLastError();
        grid = cus * per_cu;
        if (grid <= 0) grid = 256;
    }
    if (grid < 0) return;
    hipMemsetAsync((char*)d_ws + WS_CTL, 0, 32768, stream);
    Args a{};
    for (int i = 0; i < 33; ++i) a.in[i] = (const float*)d_in[i];
    a.out = (float*)d_out; a.ws = (unsigned char*)d_ws;
    constexpr int NPH = 62;
#if COOP
    a.ph_lo = 0; a.ph_hi = NPH;
    void* args[] = {&a};
    hipError_t e = hipLaunchCooperativeKernel((const void*)mega, dim3(grid), dim3(512), args, LDS_BYTES, stream);
    if (e != hipSuccess) fprintf(stderr, "cooperative launch failed: %s (grid %d)\n", hipGetErrorString(e), grid);
#else
    for (int p = 0; p < NPH; ++p) { a.ph_lo = p; a.ph_hi = p + 1; hipLaunchKernelGGL(mega, dim3(grid), dim3(512), LDS_BYTES, stream, a); }
#endif
}
```

```cpp
#include <hip/hip_runtime.h>
#include <hip/hip_cooperative_groups.h>
#include <cstdio>
#include <cstdint>
namespace cg = cooperative_groups;

#ifndef COOP
#define COOP 1
#endif
#ifndef ATTN_V2
#define ATTN_V2 1
#endif

#define LAS __attribute__((address_space(3)))
typedef unsigned short bf16_t;
typedef short bf16x8 __attribute__((ext_vector_type(8)));
typedef float f32x4 __attribute__((ext_vector_type(4)));
typedef float f32x16 __attribute__((ext_vector_type(16)));
typedef unsigned u32x4 __attribute__((ext_vector_type(4)));
typedef unsigned u32x2 __attribute__((ext_vector_type(2)));
typedef float f32x4u __attribute__((ext_vector_type(4), aligned(4)));

constexpr int DM = 2048, TALL = 40960, TP = 8192, SS = 2048;
constexpr int NP = 5120;
constexpr int TCM = 24576;
constexpr int NVT = 1280;
constexpr int DFF = 8192;
constexpr int PC_AQ = 0, PC_AK = 512, PC_BCQ = 1024, PC_BCKV = 1536, PC_CQ = 2048, PC_CK = 2560, PC_DQ = 2816, PC_DK = 4352, PC_BKR = 4864;
constexpr float LOG2E = 1.4426950408889634f;
constexpr float EPS = 1e-6f;
constexpr int TABA_N = 16384, TABA_OFF = 8192, TABD_N = 2304, TABD_OFF = 1152;

constexpr size_t MiB = 1u << 20;
constexpr size_t WS_CTL = 0;
constexpr size_t WS_TABA = 64 * 1024;
constexpr size_t WS_TABD = 384 * 1024;
constexpr size_t WS_SS = 512 * 1024;
constexpr size_t WS_W = 1 * MiB;
constexpr size_t WO_IN = 0;
constexpr size_t WO_INV = WO_IN + (size_t)NP * 2048 * 2;
constexpr size_t WO_G = WO_INV + (size_t)NVT * 2048 * 2;
constexpr size_t WO_B = WO_G + (size_t)8192 * 2048 * 2;
constexpr size_t WO_O = WO_B + (size_t)8192 * 512 * 2;
constexpr size_t WO_1 = WO_O + (size_t)2048 * 2048 * 2;
constexpr size_t WO_2 = WO_1 + (size_t)8192 * 2048 * 2;
constexpr size_t WO_PG = WO_2 + (size_t)2048 * 8192 * 2;
constexpr size_t WO_PP = WO_PG + (size_t)2048 * 2048 * 2;
constexpr size_t WO_UQ = WO_PP + (size_t)2048 * 256 * 2;
constexpr size_t WO_UKN = WO_UQ + (size_t)768 * 512 * 2;
constexpr size_t WO_UKV = WO_UKN + (size_t)512 * 512 * 2;
constexpr size_t WO_END = WO_UKV + (size_t)512 * 512 * 2;
static_assert(WO_END <= 148 * MiB, "weights");
constexpr size_t WS_H = WS_W + 148 * MiB;
constexpr size_t WS_R1 = WS_H + (size_t)TCM * 2048 * 2;
constexpr size_t R1_PROJ = 0;
constexpr size_t R1_VT = R1_PROJ + (size_t)TCM * NP * 2;
constexpr size_t R1_QB = R1_VT + (size_t)NVT * TCM * 2;
constexpr size_t R1_KB = R1_QB + (size_t)TCM * 768 * 2;
constexpr size_t R1_VTB = R1_KB + (size_t)TCM * 768 * 2;
constexpr size_t R1_END = R1_VTB + (size_t)512 * TCM * 2;
static_assert(R1_END >= (size_t)TCM * 8192 * 2, "Y / FFH overlay");
constexpr size_t WS_R2 = WS_R1 + R1_END;
constexpr size_t WS_R3 = WS_R2 + (size_t)TCM * 2048 * 4;
constexpr size_t WS_END = WS_R3 + (size_t)TCM * 2048 * 2;

constexpr int LDS_BYTES = 147456;

typedef float f32x2_t __attribute__((ext_vector_type(2))); typedef __bf16 bf16x2_t __attribute__((ext_vector_type(2)));
__device__ __forceinline__ unsigned cvt_pk_bf16(float lo, float hi) { f32x2_t v = {lo, hi}; bf16x2_t b = __builtin_convertvector(v, bf16x2_t); return __builtin_bit_cast(unsigned, b); }
__device__ __forceinline__ float bf_lo(unsigned u) { return __uint_as_float(u << 16); }
__device__ __forceinline__ float bf_hi(unsigned u) { return __uint_as_float(u & 0xffff0000u); }
__device__ __forceinline__ float wave_sum(float v) {
#pragma unroll
    for (int o = 1; o < 64; o <<= 1) v += __shfl_xor(v, o);
    return v;
}
__device__ __forceinline__ float sigmoidf_fast(float x) { return __builtin_amdgcn_rcpf(1.0f + __builtin_amdgcn_exp2f(-x * LOG2E)); }
__device__ __forceinline__ const float* xrow_ptr(const float* s0, const float* s1, int m) { return m < TP ? s0 + (size_t)m * DM : s1 + (size_t)(m - TP) * DM; }

namespace pg8 {
constexpr int BM = 256, BK = 64, HALF = 128, HTB = HALF * BK * 2, STAGE_BYTES = 8 * HTB, NXCD = 8, WGM = 8;
__host__ __device__ __forceinline__ int lds_byte(int r, int c) { const int st = (r >> 4) * 2 + (c >> 5), rr = r & 15, cc = c & 31, ob = rr * 64 + cc * 2; return st * 1024 + (ob ^ (((ob >> 9) & 1) << 5)); }
__host__ __device__ __forceinline__ void stage_rc(int b, int& R, int& C) { const int st = b / 1024, sb = b % 1024, swz = sb ^ (((sb >> 9) & 1) << 5); R = (st >> 1) * 16 + swz / 64; C = (st & 1) * 32 + (swz % 64) / 2; }
__host__ __device__ __forceinline__ int perm32(int rho) { const int n = rho >> 4, i = rho & 15; return 8 * (i >> 2) + 4 * n + (i & 3); }

struct Unit { int pm, pn; long aoff; };
struct Gemm { const bf16_t* A; const bf16_t* Bt; int lda, ldb, K; };

struct Order {
    int nM, nN, nwg, G, c, rep, adiv; long astep;
    __device__ void init(int nM_, int nN_, int G_, int c_, int rep_, int adiv_, long astep_) { nM = nM_; nN = nN_; nwg = nM * nN; G = G_; c = c_; rep = rep_; adiv = adiv_; astep = astep_; }
    __device__ bool next(int i, Unit& u) const {
        const int t = i / rep, sub = i - t * rep;
        const long L = (long)t * G + c; if (L >= nwg) return false;
        int wgid = (int)L; { const int q = nwg / NXCD, r = nwg % NXCD, xcd = wgid % NXCD, off = wgid / NXCD; wgid = (xcd < r ? xcd * (q + 1) : r * (q + 1) + (xcd - r) * q) + off; }
        const int nig = WGM * nN, gid = wgid / nig, fm = gid * WGM, gsz = (nM - fm) < WGM ? (nM - fm) : WGM;
        u.pm = fm + ((wgid % nig) % gsz); const int pn = (wgid % nig) / gsz; u.pn = pn + sub * nN; u.aoff = (long)(pn / adiv) * astep; return true;
    }
};

enum { EK_BF16 = 0, EK_SPLIT192 = 1, EK_RELU2 = 2, EK_GATE = 3, EK_RES = 4, EK_PLE = 5 };
struct Epi {
    static constexpr bool PERM = true;
    int kind; bf16_t* O; long ldc; const bf16_t* Y; float* part; const float* xs0; const float* xs1; float* xout; int m0;
    bf16_t* Hout; float* ssq; const float* rsq;
    __device__ __forceinline__ void operator()(const f32x4 (&acc)[2][2][4][2], const Unit& u, int wr, int wc, int fr, int fq) const {
        const int row0 = u.pm * BM + wr * 64 + fr, col0 = u.pn * BM + wc * 32 + 8 * fq;
        if (kind <= EK_RELU2) {
#pragma unroll
            for (int ai = 0; ai < 2; ++ai)
#pragma unroll
                for (int m = 0; m < 4; ++m) { const int row = row0 + ai * HALF + m * 16;
                    float rs = 1.f; if (kind == EK_RELU2) rs = 1.0f / sqrtf(rsq[row] * (1.0f / 2048.0f) + EPS);
#pragma unroll
                    for (int bj = 0; bj < 2; ++bj) { int col = col0 + bj * HALF; f32x4 v0 = acc[ai][bj][m][0], v1 = acc[ai][bj][m][1];
                        if (kind == EK_RELU2) {
#pragma unroll
                            for (int e = 0; e < 4; ++e) { float a = fmaxf(v0[e], 0.f) * rs, b = fmaxf(v1[e], 0.f) * rs; v0[e] = a * a; v1[e] = b * b; } }
                        if (kind == EK_SPLIT192) col = (col >> 7) * 192 + (col & 127);
                        u32x4 w; w.x = cvt_pk_bf16(v0[0], v0[1]); w.y = cvt_pk_bf16(v0[2], v0[3]); w.z = cvt_pk_bf16(v1[0], v1[1]); w.w = cvt_pk_bf16(v1[2], v1[3]);
                        *(u32x4*)(O + (size_t)row * ldc + col) = w; } }
        } else if (kind == EK_GATE) {
            const int oc = u.pn * 64 + wc * 16 + 4 * fq;
#pragma unroll
            for (int ai = 0; ai < 2; ++ai)
#pragma unroll
                for (int m = 0; m < 4; ++m) { const int row = row0 + ai * HALF + m * 16;
                    const bf16_t* yp = Y + (size_t)row * 8192 + oc;
                    f32x4 r = (f32x4){0.f, 0.f, 0.f, 0.f};
#pragma unroll
                    for (int b = 0; b < 4; ++b) { const u32x2 y = *(const u32x2*)(yp + b * 2048); const f32x4 v = acc[ai][b >> 1][m][b & 1];
                        r[0] += sigmoidf_fast(v[0]) * bf_lo(y.x); r[1] += sigmoidf_fast(v[1]) * bf_hi(y.x); r[2] += sigmoidf_fast(v[2]) * bf_lo(y.y); r[3] += sigmoidf_fast(v[3]) * bf_hi(y.y); }
                    u32x2 w; w.x = cvt_pk_bf16(r[0], r[1]); w.y = cvt_pk_bf16(r[2], r[3]);
                    *(u32x2*)(O + (size_t)row * 2048 + oc) = w; }
        } else {
#pragma unroll
            for (int ai = 0; ai < 2; ++ai)
#pragma unroll
                for (int m = 0; m < 4; ++m) { const int row = row0 + ai * HALF + m * 16; const int gm = m0 + row;
                    const float* xs = xrow_ptr(xs0, xs1, gm); float* xo = xout + (size_t)gm * DM;
                    float rs = 1.f, sq = 0.f; if (kind == EK_PLE) rs = 1.0f / sqrtf(rsq[row] * (1.0f / 2048.0f) + EPS);
#pragma unroll
                    for (int bj = 0; bj < 2; ++bj) { const int col = col0 + bj * HALF; f32x4 v0 = acc[ai][bj][m][0], v1 = acc[ai][bj][m][1];
                        const f32x4 x0 = *(const f32x4*)(xs + col), x1 = *(const f32x4*)(xs + col + 4);
                        if (kind == EK_PLE) { const u32x4 y = *(const u32x4*)(Y + (size_t)row * 2048 + col); v0 = v0 * rs; v1 = v1 * rs;
                            v0[0] = sigmoidf_fast(v0[0]) * bf_lo(y.x); v0[1] = sigmoidf_fast(v0[1]) * bf_hi(y.x); v0[2] = sigmoidf_fast(v0[2]) * bf_lo(y.y); v0[3] = sigmoidf_fast(v0[3]) * bf_hi(y.y);
                            v1[0] = sigmoidf_fast(v1[0]) * bf_lo(y.z); v1[1] = sigmoidf_fast(v1[1]) * bf_hi(y.z); v1[2] = sigmoidf_fast(v1[2]) * bf_lo(y.w); v1[3] = sigmoidf_fast(v1[3]) * bf_hi(y.w); }
                        const f32x4 n0 = x0 + v0, n1 = x1 + v1;
                        *(f32x4*)(xo + col) = n0; *(f32x4*)(xo + col + 4) = n1;
                        if (Hout) { u32x4 w; w.x = cvt_pk_bf16(n0[0], n0[1]); w.y = cvt_pk_bf16(n0[2], n0[3]); w.z = cvt_pk_bf16(n1[0], n1[1]); w.w = cvt_pk_bf16(n1[2], n1[3]);
                            *(u32x4*)(Hout + (size_t)row * DM + col) = w;
                            sq += (n0[0] * n0[0] + n0[1] * n0[1]) + (n0[2] * n0[2] + n0[3] * n0[3]) + (n1[0] * n1[0] + n1[1] * n1[1]) + (n1[2] * n1[2] + n1[3] * n1[3]); } }
                    if (Hout) { sq += __shfl_xor(sq, 16); sq += __shfl_xor(sq, 32); if (fq == 0) atomicAdd(ssq + row, sq); } }
        }
    }
};

template <bool ALIGN_EPI = true>
__device__ __forceinline__ void gemm_phase(LAS unsigned char* lds, const Gemm g, const Order& S, const Epi& E, const int tid) {
    const int wid = __builtin_amdgcn_readfirstlane(tid >> 6), lane = tid & 63, wr = wid >> 2, wc = wid & 3, fr = lane & 15, fq = lane >> 4;
    const int K = g.K, nt = K / BK;
    unsigned voffA[2], voffB[2];
#pragma unroll
    for (int i = 0; i < 2; ++i) { int R, C; stage_rc(tid * 16 + i * 8192, R, C); const int Rb = Epi::PERM ? ((R & ~31) + perm32(R & 31)) : R;
        voffA[i] = (unsigned)(R * g.lda + C) * 2u; voffB[i] = (unsigned)(Rb * g.ldb + C) * 2u; }
    const size_t kstep = (size_t)(BK * 2);
    const size_t hstA = (size_t)HALF * g.lda * 2, hstB = (size_t)HALF * g.ldb * 2;
    const size_t tstA = 2 * hstA, tstB = 2 * hstB;
    const unsigned ldsw = (unsigned)wid * 1024u;
    const int aoff = lds_byte(wr * 64 + fr, fq * 8), boff = lds_byte(wc * 32 + fr, fq * 8);
#define PG8_SA(b, h) (((b) * 2 + (h)) * HTB)
#define PG8_SB(b, h) ((4 + (b) * 2 + (h)) * HTB)
#define PG8_STAGE(bufoff, gbase, voff) do { _Pragma("unroll") for (int _i = 0; _i < 2; ++_i) \
        __builtin_amdgcn_global_load_lds((const unsigned*)((const char*)(gbase) + (voff)[_i]), (LAS unsigned*)(lds + (bufoff) + ldsw + _i * 8192), 16, 0, 0); } while (0)
#define PG8_LDA(dst, b, h) do { _Pragma("unroll") for (int m = 0; m < 4; ++m) _Pragma("unroll") for (int k = 0; k < 2; ++k) dst[m][k] = *(const LAS bf16x8*)(lds + PG8_SA(b, h) + aoff + m * 2048 + k * 1024); } while (0)
#define PG8_LDB(dst, b, h) do { _Pragma("unroll") for (int n = 0; n < 2; ++n) _Pragma("unroll") for (int k = 0; k < 2; ++k) dst[n][k] = *(const LAS bf16x8*)(lds + PG8_SB(b, h) + boff + n * 2048 + k * 1024); } while (0)
#define PG8_MMA(ai, bj, At, Bt) do { __builtin_amdgcn_s_setprio(1); _Pragma("unroll") for (int m = 0; m < 4; ++m) _Pragma("unroll") for (int n = 0; n < 2; ++n) _Pragma("unroll") for (int k = 0; k < 2; ++k) \
        acc[ai][bj][m][n] = __builtin_amdgcn_mfma_f32_16x16x32_bf16(Bt[n][k], At[m][k], acc[ai][bj][m][n], 0, 0, 0); __builtin_amdgcn_s_setprio(0); } while (0)
#define PG8_WAIT_V(n) asm volatile("s_waitcnt vmcnt(" #n ")" ::: "memory")
#define PG8_WAIT_L(n) asm volatile("s_waitcnt lgkmcnt(" #n ")" ::: "memory")
#define PG8_BAR __builtin_amdgcn_s_barrier()
#define PG8_SCHED __builtin_amdgcn_sched_barrier(0)
    Unit cur, nxt; int ui = 0;
    if (!S.next(0, cur)) return;
    f32x4 acc[2][2][4][2];
#pragma unroll
    for (int a = 0; a < 2; ++a)
#pragma unroll
        for (int b = 0; b < 2; ++b)
#pragma unroll
            for (int m = 0; m < 4; ++m)
#pragma unroll
                for (int n = 0; n < 2; ++n) acc[a][b][m][n] = (f32x4){0.f, 0.f, 0.f, 0.f};
    bf16x8 At[4][2], B0[2][2], B1[2][2];
    const char* cA = (const char*)g.A + (size_t)cur.pm * tstA + cur.aoff; const char* cB = (const char*)g.Bt + (size_t)cur.pn * tstB;
    PG8_STAGE(PG8_SB(0, 0), cB, voffB); PG8_STAGE(PG8_SB(0, 1), cB + hstB, voffB); PG8_STAGE(PG8_SA(0, 0), cA, voffA); PG8_STAGE(PG8_SA(0, 1), cA + hstA, voffA);
    if (wr == 1) PG8_BAR;
    PG8_WAIT_V(2); PG8_BAR;
    PG8_STAGE(PG8_SB(1, 0), cB + kstep, voffB); PG8_STAGE(PG8_SA(1, 0), cA + kstep, voffA); PG8_STAGE(PG8_SB(1, 1), cB + hstB + kstep, voffB);
    PG8_WAIT_V(6); PG8_BAR;
    for (;;) {
        const bool has_next = S.next(ui + 1, nxt);
        const char* nA = has_next ? (const char*)g.A + (size_t)nxt.pm * tstA + nxt.aoff : cA; const char* nB = has_next ? (const char*)g.Bt + (size_t)nxt.pn * tstB : cB;
        for (int t = 0; t < nt; t += 2) {
            const bool last = (t == nt - 2);
            const char* a1 = cA + (size_t)(t + 1) * kstep;
            const char* a2 = last ? nA : cA + (size_t)(t + 2) * kstep; const char* b2 = last ? nB : cB + (size_t)(t + 2) * kstep;
            const char* a3 = a2 + kstep; const char* b3 = b2 + kstep;
            PG8_LDB(B0, 0, 0); PG8_LDB(B1, 0, 1); PG8_SCHED; PG8_LDA(At, 0, 0); PG8_STAGE(PG8_SA(1, 1), a1 + hstA, voffA);
            PG8_WAIT_V(8); PG8_WAIT_L(0); PG8_BAR; PG8_MMA(0, 0, At, B0); PG8_MMA(0, 1, At, B1); PG8_BAR; PG8_SCHED;
            PG8_LDA(At, 0, 1); PG8_STAGE(PG8_SB(0, 0), b2, voffB); PG8_STAGE(PG8_SB(0, 1), b2 + hstB, voffB); PG8_STAGE(PG8_SA(0, 0), a2, voffA);
            PG8_WAIT_V(8); PG8_WAIT_L(0); PG8_BAR; PG8_MMA(1, 0, At, B0); PG8_MMA(1, 1, At, B1); PG8_BAR; PG8_SCHED;
            PG8_LDB(B0, 1, 0); PG8_LDB(B1, 1, 1); PG8_SCHED; PG8_LDA(At, 1, 0); PG8_STAGE(PG8_SA(0, 1), a2 + hstA, voffA);
            PG8_WAIT_V(8); PG8_WAIT_L(0); PG8_BAR; PG8_MMA(0, 0, At, B0); PG8_MMA(0, 1, At, B1); PG8_BAR; PG8_SCHED;
            PG8_LDA(At, 1, 1); PG8_STAGE(PG8_SB(1, 0), b3, voffB); PG8_STAGE(PG8_SB(1, 1), b3 + hstB, voffB); PG8_STAGE(PG8_SA(1, 0), a3, voffA);
            PG8_WAIT_V(8); PG8_WAIT_L(0); PG8_BAR; PG8_MMA(1, 0, At, B0); PG8_MMA(1, 1, At, B1); PG8_BAR; PG8_SCHED;
        }
        if constexpr (ALIGN_EPI) { if (wr == 0) PG8_BAR; }
        E(acc, cur, wr, wc, fr, fq);
        if (!has_next) break;
#pragma unroll
        for (int a = 0; a < 2; ++a)
#pragma unroll
            for (int b = 0; b < 2; ++b)
#pragma unroll
                for (int m = 0; m < 4; ++m)
#pragma unroll
                    for (int n = 0; n < 2; ++n) acc[a][b][m][n] = (f32x4){0.f, 0.f, 0.f, 0.f};
        cur = nxt; cA = nA; cB = nB; ++ui;
        if constexpr (ALIGN_EPI) { if (wr == 1) PG8_BAR; }
    }
    PG8_WAIT_V(0);
    if constexpr (!ALIGN_EPI) { if (wr == 0) PG8_BAR; }
    PG8_BAR;
#undef PG8_SA
#undef PG8_SB
#undef PG8_STAGE
#undef PG8_LDA
#undef PG8_LDB
#undef PG8_MMA
#undef PG8_WAIT_V
#undef PG8_WAIT_L
#undef PG8_BAR
#undef PG8_SCHED
}
}

struct Args { const float* in[33]; float* out; unsigned char* ws; int ph_lo, ph_hi; };
enum { I_XP = 0, I_XS, I_PP, I_PS, I_RELB, I_NMIX, I_WIN, I_AQN, I_AKN, I_ALQ1, I_ALK1, I_ALQ2, I_ALK2, I_AON, I_BCQN, I_BCKVN, I_BWUQ, I_BWUKV, I_BQN, I_BKN,
       I_CQN, I_CKN, I_DQN, I_DKN, I_WG, I_WB, I_WO, I_NFFN, I_W1, I_W2, I_NPLE, I_WPG, I_WPP };

__device__ __forceinline__ int rel_bucket(int rel) {
    const int n = rel < 0 ? -rel : rel;
    const float nf = (float)(n > 1 ? n : 1);
    int large = 8 + (int)(logf(nf / 8.0f) / 4.852030263919617f * 8.0f);
    large = large < 15 ? large : 15;
    return (rel > 0 ? 16 : 0) + (n < 8 ? n : large);
}
__device__ __forceinline__ void build_tables(const float* relb, float* tabA, float* tabD, int gtid, int gthreads) {
    for (int i = gtid; i < 4 * TABA_N; i += gthreads) { const int h = i / TABA_N, d = i % TABA_N - TABA_OFF; tabA[i] = relb[rel_bucket(d) * 16 + h] * LOG2E; }
    for (int i = gtid; i < 12 * TABD_N; i += gthreads) { const int gh = i / TABD_N, d = i % TABD_N - TABD_OFF; const int g = gh >> 2; const int dil = g == 0 ? 1 : (g == 1 ? 4 : 16);
        const int ad = d < 0 ? -d : d; const bool ok = (ad % dil == 0) && (ad <= 64 * dil);
        tabD[i] = ok ? relb[rel_bucket(d) * 16 + 4 + gh] * LOG2E : -1e30f; }
}
__device__ __forceinline__ void transpose_item(const float* W, int N, int k0, int n0, bf16_t* dst, int K, LAS float* scr, int lane, int gate_b = -1, const float* gsc = nullptr) {
#pragma unroll 8
    for (int i = 0; i < 32; ++i) { const int kk = 2 * i + (lane >> 5); float w = W[(size_t)(k0 + kk) * N + n0 + (lane & 31)]; if (gsc) w *= gsc[k0 + kk]; scr[kk * 33 + (lane & 31)] = w; }
    asm volatile("s_waitcnt lgkmcnt(0)" ::: "memory");
    const int c = lane & 7;
#pragma unroll
    for (int j = 0; j < 4; ++j) { const int n = (lane >> 3) + 8 * j; const LAS float* s = scr + (8 * c) * 33 + n;
        u32x4 o; o.x = cvt_pk_bf16(s[0 * 33], s[1 * 33]); o.y = cvt_pk_bf16(s[2 * 33], s[3 * 33]); o.z = cvt_pk_bf16(s[4 * 33], s[5 * 33]); o.w = cvt_pk_bf16(s[6 * 33], s[7 * 33]);
        size_t drow = (size_t)n;
        if (gate_b >= 0) { const int nn = n0 + n, j = nn & 63; drow = (size_t)((nn >> 6) * 256 + 128 * (gate_b >> 1) + 32 * (j >> 4) + 8 * ((j >> 2) & 3) + 4 * (gate_b & 1) + (j & 3)); }
        *(u32x4*)(dst + drow * K + k0 + 8 * c) = o; }
    asm volatile("s_waitcnt lgkmcnt(0)" ::: "memory");
}
__device__ __forceinline__ int win_row(int n0) {
    if (n0 < 512) return PC_AQ + n0;
    if (n0 < 1024) return PC_AK + (n0 - 512);
    if (n0 < 1536) return -(0 + (n0 - 1024) + 1);
    if (n0 < 2048) return PC_BCQ + (n0 - 1536);
    if (n0 < 2560) return PC_BCKV + (n0 - 2048);
    if (n0 < 2624) return PC_BKR + (n0 - 2560);
    if (n0 < 3136) return PC_CQ + (n0 - 2624);
    if (n0 < 3392) return PC_CK + (n0 - 3136);
    if (n0 < 3648) return -(512 + (n0 - 3392) + 1);
    if (n0 < 5184) return PC_DQ + (n0 - 3648);
    if (n0 < 5696) return PC_DK + (n0 - 5184);
    return -(768 + (n0 - 5696) + 1);
}
__device__ __forceinline__ void convert_weights(const Args& a, int layer, unsigned char* W, LAS float* scr, int gw, int ngw, int lane) {
    constexpr int I_IN = 32 * 194, I_G = 4 * 32 * 64, I_B = 4 * 8 * 64, I_O = 32 * 64, I_1 = 32 * 256, I_2 = 128 * 64, I_PG = 32 * 64, I_PPn = 4 * 64, I_UQ = 8 * 24, I_UKV = 8 * 32;
    constexpr int NIT = I_IN + I_G + I_B + I_O + I_1 + I_2 + I_PG + I_PPn + I_UQ + I_UKV;
    for (int it = gw; it < NIT; it += ngw) {
        int r = it;
        if (r < I_IN) { const int kb = r / 194, nb = r % 194; const int dr = win_row(nb * 32);
            bf16_t* dst = dr >= 0 ? (bf16_t*)(W + WO_IN) + (size_t)dr * 2048 : (bf16_t*)(W + WO_INV) + (size_t)(-dr - 1) * 2048;
            transpose_item(a.in[I_WIN] + (size_t)layer * 2048 * 6208, 6208, kb * 64, nb * 32, dst, 2048, scr, lane); continue; } r -= I_IN;
        if (r < I_G) { const int b = r / 2048, q = r % 2048, kb = q / 64, nb = q % 64;
            transpose_item(a.in[I_WG] + ((size_t)layer * 4 + b) * 2048 * 2048, 2048, kb * 64, nb * 32, (bf16_t*)(W + WO_G), 2048, scr, lane, b); continue; } r -= I_G;
        if (r < I_B) { const int b = r / 512, q = r % 512, kb = q / 64, nb = q % 64;
            transpose_item(a.in[I_WB] + ((size_t)layer * 4 + b) * 512 * 2048, 2048, kb * 64, nb * 32, (bf16_t*)(W + WO_B) + ((size_t)b * 2048 + nb * 32) * 512, 512, scr, lane); continue; } r -= I_B;
        if (r < I_O) { const int kb = r / 64, nb = r % 64;
            transpose_item(a.in[I_WO] + (size_t)layer * 2048 * 2048, 2048, kb * 64, nb * 32, (bf16_t*)(W + WO_O) + (size_t)(nb * 32) * 2048, 2048, scr, lane); continue; } r -= I_O;
        if (r < I_1) { const int kb = r / 256, nb = r % 256;
            transpose_item(a.in[I_W1] + (size_t)layer * 2048 * 8192, 8192, kb * 64, nb * 32, (bf16_t*)(W + WO_1) + (size_t)(nb * 32) * 2048, 2048, scr, lane, -1, a.in[I_NFFN] + layer * DM); continue; } r -= I_1;
        if (r < I_2) { const int kb = r / 64, nb = r % 64;
            transpose_item(a.in[I_W2] + (size_t)layer * 8192 * 2048, 2048, kb * 64, nb * 32, (bf16_t*)(W + WO_2) + (size_t)(nb * 32) * 8192, 8192, scr, lane); continue; } r -= I_2;
        if (r < I_PG) { const int kb = r / 64, nb = r % 64;
            transpose_item(a.in[I_WPG] + (size_t)layer * 2048 * 2048, 2048, kb * 64, nb * 32, (bf16_t*)(W + WO_PG) + (size_t)(nb * 32) * 2048, 2048, scr, lane, -1, a.in[I_NPLE] + layer * DM); continue; } r -= I_PG;
        if (r < I_PPn) { const int kb = r / 64, nb = r % 64;
            transpose_item(a.in[I_WPP] + (size_t)layer * 256 * 2048, 2048, kb * 64, nb * 32, (bf16_t*)(W + WO_PP) + (size_t)(nb * 32) * 256, 256, scr, lane); continue; } r -= I_PPn;
        if (r < I_UQ) { const int kb = r / 24, nb = r % 24;
            transpose_item(a.in[I_BWUQ] + (size_t)layer * 512 * 768, 768, kb * 64, nb * 32, (bf16_t*)(W + WO_UQ) + (size_t)(nb * 32) * 512, 512, scr, lane); continue; } r -= I_UQ;
        { const int kb = r / 32, nb = r % 32; const int n0 = nb * 32, h = n0 >> 8, j0 = n0 & 255;
            bf16_t* dst = j0 < 128 ? (bf16_t*)(W + WO_UKN) + (size_t)(h * 128 + j0) * 512 : (bf16_t*)(W + WO_UKV) + (size_t)(h * 128 + j0 - 128) * 512;
            transpose_item(a.in[I_BWUKV] + (size_t)layer * 512 * 1024, 1024, kb * 64, n0, dst, 512, scr, lane); }
    }
}

__device__ __forceinline__ void norm_row(const float* x, const float* g, bf16_t* out, int lane) {
    f32x4 v[8]; float s = 0.f;
#pragma unroll
    for (int j = 0; j < 8; ++j) { v[j] = *(const f32x4*)(x + 4 * lane + 256 * j); s += (v[j][0] * v[j][0] + v[j][1] * v[j][1]) + (v[j][2] * v[j][2] + v[j][3] * v[j][3]); }
    const float rs = 1.0f / sqrtf(wave_sum(s) * (1.0f / 2048.0f) + EPS);
#pragma unroll
    for (int j = 0; j < 8; ++j) { const f32x4 gg = *(const f32x4*)(g + 4 * lane + 256 * j);
        u32x2 w; w.x = cvt_pk_bf16(v[j][0] * rs * gg[0], v[j][1] * rs * gg[1]); w.y = cvt_pk_bf16(v[j][2] * rs * gg[2], v[j][3] * rs * gg[3]);
        *(u32x2*)(out + 4 * lane + 256 * j) = w; }
}
__device__ __forceinline__ void load8(const bf16_t* p, float (&f)[8]) { const u32x4 v = *(const u32x4*)p; f[0] = bf_lo(v.x); f[1] = bf_hi(v.x); f[2] = bf_lo(v.y); f[3] = bf_hi(v.y); f[4] = bf_lo(v.z); f[5] = bf_hi(v.z); f[6] = bf_lo(v.w); f[7] = bf_hi(v.w); }
__device__ __forceinline__ void store8(bf16_t* p, const float (&f)[8]) { u32x4 w; w.x = cvt_pk_bf16(f[0], f[1]); w.y = cvt_pk_bf16(f[2], f[3]); w.z = cvt_pk_bf16(f[4], f[5]); w.w = cvt_pk_bf16(f[6], f[7]); *(u32x4*)p = w; }
template <int GRP> __device__ __forceinline__ void norm8(float (&f)[8], const float* g, float scale, int lane) {
    float s = 0.f;
#pragma unroll
    for (int e = 0; e < 8; ++e) s += f[e] * f[e];
#pragma unroll
    for (int o = 1; o < GRP; o <<= 1) s += __shfl_xor(s, o);
    const float rs = scale / sqrtf(s * (1.0f / (GRP * 8)) + EPS);
    const int gi = (lane & (GRP - 1)) * 8;
#pragma unroll
    for (int e = 0; e < 8; ++e) f[e] = f[e] * rs * g[gi + e];
}
__device__ __forceinline__ float rope_inv(int i) { return __builtin_amdgcn_exp2f(-(float)i * (13.287712379549449f / 32.0f)) * 0.15915494309189535f; }
__device__ __forceinline__ void sincos_rev(float rev, float& sn, float& cs) { rev -= rintf(rev); sn = __builtin_amdgcn_sinf(rev); cs = __builtin_amdgcn_cosf(rev); }
__device__ __forceinline__ void axial_rope8(float (&f)[8], float rowpos, float colpos, int lane) {
    const int j = lane & 15, hf = j >> 3, jj = j & 7; const float pos = hf ? colpos : rowpos; const float sgn = jj < 4 ? -1.f : 1.f; const int i0 = 8 * (jj & 3);
#pragma unroll
    for (int e = 0; e < 8; ++e) { const float pv = __shfl_xor(f[e], 4); float sn, cs; sincos_rev(pos * rope_inv(i0 + e), sn, cs); f[e] = f[e] * cs + sgn * pv * sn; }
}
__device__ __forceinline__ void post1_row(const Args& a, int layer, bf16_t* P, int tseq, int lane) {
    float f[8];
    const float sA = 0.125f * LOG2E, sC = 0.08838834764831845f * LOG2E;
    load8(P + PC_AQ + 8 * lane, f); norm8<8>(f, a.in[I_AQN] + layer * 64, sA, lane); store8(P + PC_AQ + 8 * lane, f);
    load8(P + PC_AK + 8 * lane, f); norm8<8>(f, a.in[I_AKN] + layer * 64, 1.f, lane); store8(P + PC_AK + 8 * lane, f);
    load8(P + PC_BCQ + 8 * lane, f); norm8<64>(f, a.in[I_BCQN] + layer * 512, 1.f, lane); store8(P + PC_BCQ + 8 * lane, f);
    load8(P + PC_BCKV + 8 * lane, f); norm8<64>(f, a.in[I_BCKVN] + layer * 512, 1.f, lane); store8(P + PC_BCKV + 8 * lane, f);
    const float rowpos = (float)(tseq >> 6), colpos = (float)(tseq & 63);
    load8(P + PC_CQ + 8 * lane, f); norm8<16>(f, a.in[I_CQN] + layer * 128, sC, lane); axial_rope8(f, rowpos, colpos, lane); store8(P + PC_CQ + 8 * lane, f);
    { const int l2 = lane & 31; load8(P + PC_CK + 8 * l2, f); norm8<16>(f, a.in[I_CKN] + layer * 128, 1.f, lane); axial_rope8(f, rowpos, colpos, lane); if (lane < 32) store8(P + PC_CK + 8 * l2, f); }
#pragma unroll
    for (int p = 0; p < 3; ++p) { load8(P + PC_DQ + 512 * p + 8 * lane, f); norm8<16>(f, a.in[I_DQN] + layer * 128, sC, lane); store8(P + PC_DQ + 512 * p + 8 * lane, f); }
    load8(P + PC_DK + 8 * lane, f); norm8<16>(f, a.in[I_DKN] + layer * 128, 1.f, lane); store8(P + PC_DK + 8 * lane, f);
}
__device__ __forceinline__ void mla_norm_rope(float (&f)[8], float (&r)[4], const float* g, float scale, float pos, int lane) {
    const int j = lane & 15;
    float s = 0.f;
#pragma unroll
    for (int e = 0; e < 8; ++e) s += f[e] * f[e];
#pragma unroll
    for (int e = 0; e < 4; ++e) s += r[e] * r[e];
#pragma unroll
    for (int o = 1; o < 16; o <<= 1) s += __shfl_xor(s, o);
    const float rs = scale / sqrtf(s * (1.0f / 192.0f) + EPS);
#pragma unroll
    for (int e = 0; e < 8; ++e) f[e] = f[e] * rs * g[8 * j + e];
#pragma unroll
    for (int e = 0; e < 4; ++e) r[e] = r[e] * rs * g[128 + 4 * j + e];
    const float sgn = j < 8 ? -1.f : 1.f; const int i0 = 4 * (j & 7);
#pragma unroll
    for (int e = 0; e < 4; ++e) { const float pv = __shfl_xor(r[e], 8); float sn, cs; sincos_rev(pos * rope_inv(i0 + e), sn, cs); r[e] = r[e] * cs + sgn * pv * sn; }
}
__device__ __forceinline__ void post2_row(const Args& a, int layer, bf16_t* Q, bf16_t* Kr, const bf16_t* P, int tseq, int lane) {
    const int h = lane >> 4, j = lane & 15; const float pos = (float)tseq;
    float f[8], r[4];
    { bf16_t* q = Q + h * 192; load8(q + 8 * j, f); const u32x2 v = *(const u32x2*)(q + 128 + 4 * j); r[0] = bf_lo(v.x); r[1] = bf_hi(v.x); r[2] = bf_lo(v.y); r[3] = bf_hi(v.y);
      mla_norm_rope(f, r, a.in[I_BQN] + layer * 192, 0.07216878364870323f * LOG2E, pos, lane);
      store8(q + 8 * j, f); u32x2 w; w.x = cvt_pk_bf16(r[0], r[1]); w.y = cvt_pk_bf16(r[2], r[3]); *(u32x2*)(q + 128 + 4 * j) = w; }
    { bf16_t* k = Kr + h * 192; load8(k + 8 * j, f); const u32x2 v = *(const u32x2*)(P + PC_BKR + 4 * j); r[0] = bf_lo(v.x); r[1] = bf_hi(v.x); r[2] = bf_lo(v.y); r[3] = bf_hi(v.y);
      mla_norm_rope(f, r, a.in[I_BKN] + layer * 192, 1.f, pos, lane);
      store8(k + 8 * j, f); u32x2 w; w.x = cvt_pk_bf16(r[0], r[1]); w.y = cvt_pk_bf16(r[2], r[3]); *(u32x2*)(k + 128 + 4 * j) = w; }
}

struct AState { float m, l; f32x16 o[4]; };
__device__ __forceinline__ void astate_init(AState& st) { st.m = -3.0e38f; st.l = 0.f;
#pragma unroll
    for (int d = 0; d < 4; ++d)
#pragma unroll
        for (int r = 0; r < 16; ++r) st.o[d][r] = 0.f; }
template <int DK, bool TAB, bool QLDS = false>
__device__ __forceinline__ void attn_pass(AState& st, const bf16_t* qp, const bf16_t* kp, long ldk, const bf16_t* vp, long ldv, int kbeg, int kend, const float* tp, LAS bf16x8* qst = nullptr) {
    constexpr int NS = DK / 16;
    bf16x8 qf[QLDS ? 1 : NS], kf[NS];
    if (QLDS) {
#pragma unroll
        for (int s = 0; s < NS; ++s) qst[s * 64] = *(const bf16x8*)(qp + 16 * s);
    } else {
#pragma unroll
        for (int s = 0; s < NS; ++s) qf[s] = *(const bf16x8*)(qp + 16 * s);
    }
    { const bf16_t* k0p = kp + (long)kbeg * ldk;
#pragma unroll
      for (int s = 0; s < NS; ++s) kf[s] = *(const bf16x8*)(k0p + 16 * s); }
    for (int k0 = kbeg; k0 < kend; k0 += 32) {
        bf16x8 vf[4][2];
#pragma unroll
        for (int d = 0; d < 4; ++d)
#pragma unroll
            for (int s = 0; s < 2; ++s) vf[d][s] = *(const bf16x8*)(vp + (long)(32 * d) * ldv + k0 + 16 * s);
        f32x4 tb[4];
        if (TAB) {
#pragma unroll
            for (int s = 0; s < 2; ++s) { tb[2 * s] = *(const f32x4u*)(tp + k0 + 16 * s); tb[2 * s + 1] = *(const f32x4u*)(tp + k0 + 16 * s + 4); } }
        f32x16 sc;
#pragma unroll
        for (int r = 0; r < 16; ++r) sc[r] = 0.f;
#pragma unroll
        for (int s = 0; s < NS; ++s) sc = __builtin_amdgcn_mfma_f32_32x32x16_bf16(kf[s], QLDS ? qst[s * 64] : qf[QLDS ? 0 : s], sc, 0, 0, 0);
        if (k0 + 32 < kend) { const bf16_t* knp = kp + (long)(k0 + 32) * ldk;
#pragma unroll
            for (int s = 0; s < NS; ++s) kf[s] = *(const bf16x8*)(knp + 16 * s); }
        if (TAB) {
#pragma unroll
            for (int r = 0; r < 16; ++r) sc[r] += tb[r >> 2][r & 3]; }
        float mx = sc[0];
#pragma unroll
        for (int r = 1; r < 16; ++r) mx = fmaxf(mx, sc[r]);
        mx = fmaxf(mx, __shfl_xor(mx, 32));
        const float mn = fmaxf(st.m, mx);
        const float alpha = __builtin_amdgcn_exp2f(st.m - mn);
        st.m = mn;
        float ps = 0.f;
#pragma unroll
        for (int r = 0; r < 16; ++r) { sc[r] = __builtin_amdgcn_exp2f(sc[r] - mn); ps += sc[r]; }
        st.l = st.l * alpha + ps;
#pragma unroll
        for (int d = 0; d < 4; ++d)
#pragma unroll
            for (int r = 0; r < 16; ++r) st.o[d][r] *= alpha;
        u32x4 p0, p1;
        p0.x = cvt_pk_bf16(sc[0], sc[1]); p0.y = cvt_pk_bf16(sc[2], sc[3]); p0.z = cvt_pk_bf16(sc[4], sc[5]); p0.w = cvt_pk_bf16(sc[6], sc[7]);
        p1.x = cvt_pk_bf16(sc[8], sc[9]); p1.y = cvt_pk_bf16(sc[10], sc[11]); p1.z = cvt_pk_bf16(sc[12], sc[13]); p1.w = cvt_pk_bf16(sc[14], sc[15]);
        const bf16x8 pf0 = __builtin_bit_cast(bf16x8, p0), pf1 = __builtin_bit_cast(bf16x8, p1);
#pragma unroll
        for (int d = 0; d < 4; ++d) { st.o[d] = __builtin_amdgcn_mfma_f32_32x32x16_bf16(vf[d][0], pf0, st.o[d], 0, 0, 0); st.o[d] = __builtin_amdgcn_mfma_f32_32x32x16_bf16(vf[d][1], pf1, st.o[d], 0, 0, 0); }
    }
}
__device__ __forceinline__ void astate_finish(AState& st) {
    const float l = st.l + __shfl_xor(st.l, 32); const float inv = 1.0f / l;
#pragma unroll
    for (int d = 0; d < 4; ++d)
#pragma unroll
        for (int r = 0; r < 16; ++r) st.o[d][r] *= inv;
}
__device__ __forceinline__ void store_o(const f32x16 (&o)[4], bf16_t* op) {
#pragma unroll
    for (int d = 0; d < 4; ++d)
#pragma unroll
        for (int g = 0; g < 4; ++g) { u32x2 w; w.x = cvt_pk_bf16(o[d][4 * g], o[d][4 * g + 1]); w.y = cvt_pk_bf16(o[d][4 * g + 2], o[d][4 * g + 3]); *(u32x2*)(op + 32 * d + 8 * g) = w; }
}
__device__ __forceinline__ int pi32(int n) { return (n & ~12) | ((n & 4) << 1) | ((n & 8) >> 1); }

struct AttnBufs { const bf16_t* PROJ; const bf16_t* VT; const bf16_t* QB; const bf16_t* KB; const bf16_t* VTB; bf16_t* BR; const float* tabA; const float* tabD; };

__device__ __forceinline__ void attn_unit(const Args& a, const AttnBufs& B, int layer, int mixer, int head, int row0  , int S, int q0  , int lane, LAS float* stash) {
#define ATT_LANE_SETUP int ln_ = lane; asm volatile("" : "+v"(ln_)); const int n = ln_ & 31, hi = ln_ >> 5, pr = pi32(n); const long qrow = (long)row0 + q0 + n; bf16_t* op = B.BR + qrow * 2048 + 4 * hi;
#ifdef ONLY_MIXER
    mixer = ONLY_MIXER;
#endif
    if (mixer == 0) {
        ATT_LANE_SETUP
        const float lam_init = layer == 0 ? 0.2f : 0.35550906759f;
        const float d1 = wave_sum(a.in[I_ALQ1][layer * 64 + lane] * a.in[I_ALK1][layer * 64 + lane]);
        const float d2 = wave_sum(a.in[I_ALQ2][layer * 64 + lane] * a.in[I_ALK2][layer * 64 + lane]);
        const float lam = expf(d1) - expf(d2) + lam_init;
        const bf16_t* vp = B.VT + (long)(head * 128 + n) * TCM + row0 + 8 * hi;
        const float* tp = B.tabA + head * TABA_N + TABA_OFF - (q0 + n) + 8 * hi;
        { AState st; astate_init(st);
          attn_pass<64, true>(st, B.PROJ + qrow * NP + PC_AQ + head * 128 + 8 * hi, B.PROJ + (long)(row0 + pr) * NP + PC_AK + head * 128 + 8 * hi, NP, vp, TCM, 0, S, tp);
          astate_finish(st);
#pragma unroll
          for (int d = 0; d < 4; ++d)
#pragma unroll
              for (int r = 0; r < 16; ++r) stash[(d * 16 + r) * 64 + lane] = st.o[d][r]; }
        AState st; astate_init(st);
        attn_pass<64, true>(st, B.PROJ + qrow * NP + PC_AQ + head * 128 + 64 + 8 * hi, B.PROJ + (long)(row0 + pr) * NP + PC_AK + head * 128 + 64 + 8 * hi, NP, vp, TCM, 0, S, tp);
        astate_finish(st);
        float ss = 0.f;
#pragma unroll
        for (int d = 0; d < 4; ++d)
#pragma unroll
            for (int r = 0; r < 16; ++r) { const float v = stash[(d * 16 + r) * 64 + lane] - lam * st.o[d][r]; st.o[d][r] = v; ss += v * v; }
        ss += __shfl_xor(ss, 32);
        const float rs = (1.0f - lam_init) / sqrtf(ss * (1.0f / 128.0f) + EPS);
        const float* gn = a.in[I_AON] + layer * 128 + 4 * hi;
#pragma unroll
        for (int d = 0; d < 4; ++d)
#pragma unroll
            for (int g = 0; g < 4; ++g) { const f32x4 gg = *(const f32x4*)(gn + 32 * d + 8 * g);
#pragma unroll
                for (int e = 0; e < 4; ++e) st.o[d][4 * g + e] *= rs * gg[e]; }
        store_o(st.o, op + head * 128);
    } else if (mixer == 1) {
        ATT_LANE_SETUP
        AState st; astate_init(st);
        attn_pass<192, false, true>(st, B.QB + qrow * 768 + head * 192 + 8 * hi, B.KB + (long)(row0 + pr) * 768 + head * 192 + 8 * hi, 768,
                              B.VTB + (long)(head * 128 + n) * TCM + row0 + 8 * hi, TCM, 0, S, nullptr, (LAS bf16x8*)stash + lane);
        astate_finish(st); store_o(st.o, op + 512 + head * 128);
    } else if (mixer == 2) {
        ATT_LANE_SETUP
        const int kv = head >> 1;
        AState st; astate_init(st);
        attn_pass<128, false>(st, B.PROJ + qrow * NP + PC_CQ + head * 128 + 8 * hi, B.PROJ + (long)(row0 + pr) * NP + PC_CK + kv * 128 + 8 * hi, NP,
                              B.VT + (long)(512 + kv * 128 + n) * TCM + row0 + 8 * hi, TCM, 0, S, nullptr);
        astate_finish(st); store_o(st.o, op + 1024 + head * 128);
    } else {
        ATT_LANE_SETUP
        AState st; astate_init(st);
        const bf16_t* kp = B.PROJ + (long)(row0 + pr) * NP + PC_DK + head * 128 + 8 * hi;
        const bf16_t* vp = B.VT + (long)(768 + head * 128 + n) * TCM + row0 + 8 * hi;
#pragma unroll 1
        for (int g = 0; g < 3; ++g) { const int W = g == 0 ? 64 : (g == 1 ? 256 : 1024);
            const int kb = q0 - W > 0 ? q0 - W : 0, ke = q0 + 32 + W < S ? q0 + 32 + W : S;
            attn_pass<128, true>(st, B.PROJ + qrow * NP + PC_DQ + (g * 4 + head) * 128 + 8 * hi, kp, NP, vp, TCM, kb, ke, B.tabD + (g * 4 + head) * TABD_N + TABD_OFF - (q0 + n) + 8 * hi); }
        astate_finish(st); store_o(st.o, op + 1536 + head * 128);
    }
}
__device__ __forceinline__ void attn_phase(const Args& a, const AttnBufs& B, int layer, int chunk, unsigned* ctr, int lane, LAS float* stash) {
    const int npr = chunk == 0 ? 1 : 0, nsm = chunk == 0 ? 4 : 12, TC = chunk == 0 ? 16384 : 24576;
    const int nP = npr * 1024, nS = nsm * 256, nD = TC / 8, total = 3 * nP + 3 * nS + nD;
    for (;;) {
        unsigned uu = 0; if (lane == 0) uu = atomicAdd(ctr, 1u);
        int u = __builtin_amdgcn_readfirstlane((int)uu);
        if (u >= total) break;
        int mixer, head, row0, S, q0;
        if (u < 3 * nP) { mixer = u / nP; const int r = u % nP; q0 = (r % 256) * 32; head = r / 256; row0 = 0; S = TP; }
        else { u -= 3 * nP;
            if (u < 3 * nS) { mixer = u / nS; const int r = u % nS; q0 = (r % 64) * 32; head = (r / 64) % 4; row0 = npr * TP + (r / 256) * SS; S = SS; }
            else { u -= 3 * nS; mixer = 3; const int qb = u % (TC / 32); head = u / (TC / 32); const int q = qb * 32;
                if (npr && q < TP) { row0 = 0; S = TP; } else { row0 = npr * TP + ((q - npr * TP) / SS) * SS; S = SS; }
                q0 = q - row0; } }
#ifdef ONLY_MIXER
        if (mixer != ONLY_MIXER) continue;
#endif
        attn_unit(a, B, layer, mixer, head, row0, S, q0, lane, stash);
    }
}


constexpr int A2_RSV = 144, A2_BUFSZ = 64 * 400 + 128 * A2_RSV;
static_assert(2 * A2_BUFSZ <= 131072 && 2 * A2_BUFSZ >= 65536, "attention LDS");
template <int DKL, int DK, bool TAB>
__device__ __forceinline__ void attn2_pass(AState& st, LAS unsigned char* buf, const bf16_t* qp, int koff, const bf16_t* Kg, long ldk, const bf16_t* Vg, long ldv,
                                           int kbeg, int kend, const float* tp, int wlo, int whi, int tid_in, int lane) {
    constexpr int NS = DK / 16, PR = DKL / 8, NKP = DKL / 64, RSK = DKL * 2 + 16, KBYTES = 64 * RSK;
    int tid = tid_in; asm volatile("" : "+v"(tid));
    const int n = lane & 31, hi = lane >> 5, pr = pi32(n);
    bf16x8 qf[NS];
#pragma unroll
    for (int s = 0; s < NS; ++s) qf[s] = *(const bf16x8*)(qp + 16 * s);
    u32x4 kreg[NKP], vreg[2];
    int krow[NKP], kc[NKP];
#pragma unroll
    for (int i = 0; i < NKP; ++i) { const int p = tid + 512 * i; krow[i] = p / PR; kc[i] = p % PR; }
#define A2_GLOAD(k0_) do { _Pragma("unroll") for (int i = 0; i < NKP; ++i) kreg[i] = *(const u32x4*)(Kg + (long)((k0_) + krow[i]) * ldk + 8 * kc[i]); \
        _Pragma("unroll") for (int i = 0; i < 2; ++i) { const int p = tid + 512 * i; vreg[i] = *(const u32x4*)(Vg + (long)(p >> 3) * ldv + (k0_) + 8 * (p & 7)); } } while (0)
#define A2_LSTORE(b_) do { _Pragma("unroll") for (int i = 0; i < NKP; ++i) *(LAS u32x4*)(buf + (b_) * A2_BUFSZ + krow[i] * RSK + kc[i] * 16) = kreg[i]; \
        _Pragma("unroll") for (int i = 0; i < 2; ++i) { const int p = tid + 512 * i; *(LAS u32x4*)(buf + (b_) * A2_BUFSZ + KBYTES + (p >> 3) * A2_RSV + (p & 7) * 16) = vreg[i]; } } while (0)
    A2_GLOAD(kbeg); A2_LSTORE(0); __syncthreads();
    int b = 0;
    const int kfo = pr * RSK + koff + hi * 16, vfo = KBYTES + n * A2_RSV + hi * 16;
    if (st.m < -1.0e38f) {
        f32x16 sc;
#pragma unroll
        for (int r = 0; r < 16; ++r) sc[r] = 0.f;
#pragma unroll
        for (int s = 0; s < NS; ++s) { const bf16x8 kf0 = *(const LAS bf16x8*)(buf + kfo + 32 * s); sc = __builtin_amdgcn_mfma_f32_32x32x16_bf16(kf0, qf[s], sc, 0, 0, 0); }
        float mx = sc[0];
#pragma unroll
        for (int r = 1; r < 16; ++r) mx = fmaxf(mx, sc[r]);
        mx = fmaxf(mx, __shfl_xor(mx, 32));
        st.m = fmaxf(mx, -60.0f);
    }
    for (int k0 = kbeg; k0 < kend; k0 += 64) {
        const bool more = k0 + 64 < kend;
        if (more) A2_GLOAD(k0 + 64);
        LAS unsigned char* bb = buf + b * A2_BUFSZ;
        if (!(k0 + 64 <= wlo || k0 >= whi)) {
#define A2_SB() __builtin_amdgcn_sched_barrier(0x0124)
            f32x4 tb[8];
            if (TAB) {
#pragma unroll
                for (int s = 0; s < 4; ++s) { tb[2 * s] = *(const f32x4u*)(tp + k0 + 16 * s); tb[2 * s + 1] = *(const f32x4u*)(tp + k0 + 16 * s + 4); } }
            f32x16 sc0, sc1;
#pragma unroll
            for (int r = 0; r < 16; ++r) { sc0[r] = 0.f; sc1[r] = 0.f; }
            u32x4 pw[4];
            float mx = -3.0e38f, ps = 0.f;
            const float mref = st.m;
#pragma unroll
            for (int s = 0; s < NS; ++s) { const bf16x8 kf0 = *(const LAS bf16x8*)(bb + kfo + 32 * s); sc0 = __builtin_amdgcn_mfma_f32_32x32x16_bf16(kf0, qf[s], sc0, 0, 0, 0); }
            A2_SB();
#pragma unroll
            for (int s = 0; s < NS; ++s) {
                const bf16x8 kf1 = *(const LAS bf16x8*)(bb + kfo + 32 * RSK + 32 * s);
                sc1 = __builtin_amdgcn_mfma_f32_32x32x16_bf16(kf1, qf[s], sc1, 0, 0, 0);
                A2_SB();
#pragma unroll
                for (int pp = (8 * s) / NS; pp < (8 * (s + 1)) / NS; ++pp) {
                    float x0 = sc0[2 * pp], x1 = sc0[2 * pp + 1];
                    if (TAB) { x0 += tb[(2 * pp) >> 2][(2 * pp) & 3]; x1 += tb[(2 * pp + 1) >> 2][(2 * pp + 1) & 3]; }
                    mx = fmaxf(mx, fmaxf(x0, x1));
                    const float e0 = __builtin_amdgcn_exp2f(x0 - mref), e1 = __builtin_amdgcn_exp2f(x1 - mref);
                    ps += e0 + e1; pw[pp >> 2][pp & 3] = cvt_pk_bf16(e0, e1); }
                A2_SB();
            }
            {
                const bf16x8 pf0 = __builtin_bit_cast(bf16x8, pw[0]), pf1 = __builtin_bit_cast(bf16x8, pw[1]);
#pragma unroll
                for (int i = 0; i < 8; ++i) { const int h = i >> 2, d = i & 3;
                    const bf16x8 v = *(const LAS bf16x8*)(bb + vfo + (32 * d) * A2_RSV + 32 * h);
                    st.o[d] = __builtin_amdgcn_mfma_f32_32x32x16_bf16(v, h ? pf1 : pf0, st.o[d], 0, 0, 0);
                    A2_SB();
                    { const int pp = i; float x0 = sc1[2 * pp], x1 = sc1[2 * pp + 1];
                      if (TAB) { x0 += tb[4 + ((2 * pp) >> 2)][(2 * pp) & 3]; x1 += tb[4 + ((2 * pp + 1) >> 2)][(2 * pp + 1) & 3]; }
                      mx = fmaxf(mx, fmaxf(x0, x1));
                      const float e0 = __builtin_amdgcn_exp2f(x0 - mref), e1 = __builtin_amdgcn_exp2f(x1 - mref);
                      ps += e0 + e1; pw[2 + (pp >> 2)][pp & 3] = cvt_pk_bf16(e0, e1); }
                    A2_SB(); }
            }
            {
                const bf16x8 pf2 = __builtin_bit_cast(bf16x8, pw[2]), pf3 = __builtin_bit_cast(bf16x8, pw[3]);
#pragma unroll
                for (int i = 0; i < 8; ++i) { const int h = i >> 2, d = i & 3;
                    const bf16x8 v = *(const LAS bf16x8*)(bb + vfo + (32 * d) * A2_RSV + 64 + 32 * h);
                    st.o[d] = __builtin_amdgcn_mfma_f32_32x32x16_bf16(v, h ? pf3 : pf2, st.o[d], 0, 0, 0); }
            }
            st.l += ps;
            mx = fmaxf(mx, __shfl_xor(mx, 32));
            if (__any(mx > st.m + 8.0f)) {
                const float mn = fmaxf(st.m, mx); const float alpha = __builtin_amdgcn_exp2f(st.m - mn); st.m = mn; st.l *= alpha;
#pragma unroll
                for (int d = 0; d < 4; ++d)
#pragma unroll
                    for (int r = 0; r < 16; ++r) st.o[d][r] *= alpha;
            }
#undef A2_SB
        }
        if (more) A2_LSTORE(b ^ 1);
        __syncthreads();
        b ^= 1;
    }
#undef A2_GLOAD
#undef A2_LSTORE
}

__device__ __forceinline__ void attn2_unit(const Args& a, const AttnBufs& B, int layer, int mixer, int head, int row0, int S, int q0, int tid, int lane, int wave, LAS unsigned char* buf) {
#ifdef ONLY_MIXER2
    mixer = ONLY_MIXER2;
#endif
    if (mixer == 0) {
        int ln_ = lane; asm volatile("" : "+v"(ln_)); const int n = ln_ & 31, hi = ln_ >> 5;
        const int half = wave >> 2, qw = q0 + 32 * (wave & 3); const long qrow = (long)row0 + qw + n;
        const float lam_init = layer == 0 ? 0.2f : 0.35550906759f;
        AState st; astate_init(st);
        attn2_pass<128, 64, true>(st, buf, B.PROJ + qrow * NP + PC_AQ + head * 128 + 64 * half + 8 * hi, 128 * half, B.PROJ + (long)row0 * NP + PC_AK + head * 128, NP,
                                  B.VT + (long)(head * 128) * TCM + row0, TCM, 0, S, B.tabA + head * TABA_N + TABA_OFF - (qw + n) + 8 * hi, 0, S, tid, ln_);
        astate_finish(st);
        LAS float* xb = (LAS float*)buf + (wave & 3) * 4096;
        if (half == 1) {
#pragma unroll
            for (int d = 0; d < 4; ++d)
#pragma unroll
                for (int r = 0; r < 16; ++r) xb[(d * 16 + r) * 64 + ln_] = st.o[d][r]; }
        __syncthreads();
        if (half == 0) {
            const float d1 = wave_sum(a.in[I_ALQ1][layer * 64 + ln_] * a.in[I_ALK1][layer * 64 + ln_]);
            const float d2 = wave_sum(a.in[I_ALQ2][layer * 64 + ln_] * a.in[I_ALK2][layer * 64 + ln_]);
            const float lam = expf(d1) - expf(d2) + lam_init;
            float ss = 0.f;
#pragma unroll
            for (int d = 0; d < 4; ++d)
#pragma unroll
                for (int r = 0; r < 16; ++r) { const float v = st.o[d][r] - lam * xb[(d * 16 + r) * 64 + ln_]; st.o[d][r] = v; ss += v * v; }
            ss += __shfl_xor(ss, 32);
            const float rs = (1.0f - lam_init) / sqrtf(ss * (1.0f / 128.0f) + EPS);
            const float* gn = a.in[I_AON] + layer * 128 + 4 * hi;
#pragma unroll
            for (int d = 0; d < 4; ++d)
#pragma unroll
                for (int g = 0; g < 4; ++g) { const f32x4 gg = *(const f32x4*)(gn + 32 * d + 8 * g);
#pragma unroll
                    for (int e = 0; e < 4; ++e) st.o[d][4 * g + e] *= rs * gg[e]; }
            store_o(st.o, B.BR + qrow * 2048 + 4 * hi + head * 128);
        }
    } else if (mixer == 1) {
        int ln_ = lane; asm volatile("" : "+v"(ln_)); const int n = ln_ & 31, hi = ln_ >> 5;
        const int qw = q0 + 32 * wave; const long qrow = (long)row0 + qw + n;
        AState st; astate_init(st);
        attn2_pass<192, 192, false>(st, buf, B.QB + qrow * 768 + head * 192 + 8 * hi, 0, B.KB + (long)row0 * 768 + head * 192, 768,
                                    B.VTB + (long)(head * 128) * TCM + row0, TCM, 0, S, nullptr, 0, S, tid, ln_);
        astate_finish(st); store_o(st.o, B.BR + qrow * 2048 + 4 * hi + 512 + head * 128);
    } else if (mixer == 2) {
        int ln_ = lane; asm volatile("" : "+v"(ln_)); const int n = ln_ & 31, hi = ln_ >> 5;
        const int qw = q0 + 32 * wave; const long qrow = (long)row0 + qw + n; const int kv = head >> 1;
        AState st; astate_init(st);
        attn2_pass<128, 128, false>(st, buf, B.PROJ + qrow * NP + PC_CQ + head * 128 + 8 * hi, 0, B.PROJ + (long)row0 * NP + PC_CK + kv * 128, NP,
                                    B.VT + (long)(512 + kv * 128) * TCM + row0, TCM, 0, S, nullptr, 0, S, tid, ln_);
        astate_finish(st); store_o(st.o, B.BR + qrow * 2048 + 4 * hi + 1024 + head * 128);
    } else {
        int ln_ = lane; asm volatile("" : "+v"(ln_)); const int n = ln_ & 31, hi = ln_ >> 5;
        const int qw = q0 + 32 * wave; const long qrow = (long)row0 + qw + n;
        AState st; astate_init(st);
#pragma unroll 1
        for (int g = 0; g < 3; ++g) { const int W = g == 0 ? 64 : (g == 1 ? 256 : 1024);
            const int kb = q0 - W > 0 ? q0 - W : 0, ke = q0 + 256 + W < S ? q0 + 256 + W : S;
            attn2_pass<128, 128, true>(st, buf, B.PROJ + qrow * NP + PC_DQ + (g * 4 + head) * 128 + 8 * hi, 0, B.PROJ + (long)row0 * NP + PC_DK + head * 128, NP,
                                       B.VT + (long)(768 + head * 128) * TCM + row0, TCM, kb, ke, B.tabD + (g * 4 + head) * TABD_N + TABD_OFF - (qw + n) + 8 * hi, qw - W, qw + 32 + W, tid, ln_); }
        astate_finish(st); store_o(st.o, B.BR + qrow * 2048 + 4 * hi + 1536 + head * 128);
    }
}
__device__ __forceinline__ void attn2_phase(const Args& a, const AttnBufs& B, int layer, int chunk, unsigned* ctr, int tid, int lane, int wave, LAS unsigned char* lds) {
    const int npr = chunk == 0 ? 1 : 0, nsm = chunk == 0 ? 4 : 12, TC = chunk == 0 ? 16384 : 24576;
    const int c0 = npr * 128, c1 = npr * 128, c2 = npr * 256, c3 = TC / 64, c4 = nsm * 32, c5 = nsm * 32, c6 = nsm * 64;
    const int total = c0 + c1 + c2 + c3 + c4 + c5 + c6;
    volatile LAS int* uw = (volatile LAS int*)(lds + 131072);
    for (;;) {
        __syncthreads();
        if (tid == 0) *uw = (int)atomicAdd(ctr, 1u);
        __syncthreads();
        int u = __builtin_amdgcn_readfirstlane(*uw);
        if (u >= total) break;
        int mixer, head, row0, S, q0;
        if (u < c0 + c1 + c2) { row0 = 0; S = TP;
            if (u < c0) { mixer = 1; q0 = (u % 32) * 256; head = u / 32; }
            else if (u < c0 + c1) { u -= c0; mixer = 2; q0 = (u % 32) * 256; head = u / 32; }
            else { u -= c0 + c1; mixer = 0; q0 = (u % 64) * 128; head = u / 64; }
        } else { u -= c0 + c1 + c2;
            if (u < c3) { mixer = 3; const int nb = TC / 256; const int q = (u % nb) * 256; head = u / nb;
                if (npr && q < TP) { row0 = 0; S = TP; } else { row0 = npr * TP + ((q - npr * TP) / SS) * SS; S = SS; }
                q0 = q - row0; }
            else { u -= c3; S = SS;
                if (u < c4) { mixer = 1; q0 = (u % 8) * 256; head = (u / 8) % 4; row0 = npr * TP + (u / 32) * SS; }
                else if (u < c4 + c5) { u -= c4; mixer = 2; q0 = (u % 8) * 256; head = (u / 8) % 4; row0 = npr * TP + (u / 32) * SS; }
                else { u -= c4 + c5; mixer = 0; q0 = (u % 16) * 128; head = (u / 16) % 4; row0 = npr * TP + (u / 64) * SS; } } }
        attn2_unit(a, B, layer, mixer, head, row0, S, q0, tid, lane, wave, lds);
    }
}


#define XB_TMO      128
#define XB_XCNT(j)  (256  + 64 * (j))
#define XB_XSUB(j)  (1280 + 64 * (j))
#define XB_XGEN(j)  (2304 + 64 * (j))
#define XB_TOP      3328
#define XB_TOPGEN   3392
#define XCD_BAR_WORDS 3456
#define XB_SPIN_CAP (1u << 22)
__device__ __forceinline__ unsigned xb_ld(unsigned* p)              { return __hip_atomic_load(p, __ATOMIC_RELAXED, __HIP_MEMORY_SCOPE_AGENT); }
__device__ __forceinline__ unsigned xb_add(unsigned* p, unsigned v) { return __hip_atomic_fetch_add(p, v, __ATOMIC_RELAXED, __HIP_MEMORY_SCOPE_AGENT); }
__device__ __forceinline__ unsigned xb_xcc_id() { return (unsigned)__builtin_amdgcn_s_getreg((3 << 11) | 20) & 0xFu; }
#define XB_SPIN(cond, bar) do { unsigned _sp = 0; while (cond) { __builtin_amdgcn_s_sleep(1); \
    if ((++_sp & 255u) == 0u) { if (xb_ld(&(bar)[XB_TMO])) break; if (_sp > XB_SPIN_CAP) { atomicAdd(&(bar)[XB_TMO], 1u); break; } } } } while (0)
struct XcdBarrier { unsigned* bar; unsigned x; volatile LAS unsigned* st; };
__device__ __forceinline__ XcdBarrier xcd_barrier_post(unsigned* bar, volatile LAS unsigned* st) {
    XcdBarrier b; b.bar = bar; b.x = xb_xcc_id(); b.st = st;
    if (threadIdx.x == 0) (void)xb_add(&bar[XB_XCNT(b.x)], 1u);
    return b;
}
__device__ __forceinline__ void xcd_barrier_complete(unsigned* bar, unsigned x, unsigned& nloc, unsigned& nx) {
    const unsigned G = gridDim.x * gridDim.y * gridDim.z;
    unsigned sum, cnt, mine, sp = 0u;
    for (;;) {
        sum = 0u; cnt = 0u; mine = 0u;
#pragma unroll
        for (unsigned j = 0; j < 16; ++j) { const unsigned c = xb_ld(&bar[XB_XCNT(j)]); sum += c; cnt += (c > 0u) ? 1u : 0u; mine = (j == x) ? c : mine; }
        if (sum == G) break;
        __builtin_amdgcn_s_sleep(1);
        if ((++sp & 255u) == 0u) { if (xb_ld(&bar[XB_TMO])) break; if (sp > XB_SPIN_CAP) { atomicAdd(&bar[XB_TMO], 1u); break; } }
    }
    nloc = mine > 0u ? mine : 1u; nx = cnt > 0u ? cnt : 1u;
}
__device__ __forceinline__ void xcd_barrier(const XcdBarrier& b) {
    asm volatile("s_waitcnt vmcnt(0)" ::: "memory");
    __syncthreads();
    if (threadIdx.x == 0) {
        unsigned* bar = b.bar;
        __builtin_amdgcn_s_waitcnt(0);
        unsigned nloc = b.st[0], nx = b.st[1];
        if (nloc == 0u) { xcd_barrier_complete(bar, b.x, nloc, nx); b.st[0] = nloc; b.st[1] = nx; }
        const unsigned old = xb_add(&bar[XB_XSUB(b.x)], 1u);
        const unsigned gen = old / nloc;
        if (old + 1u == (gen + 1u) * nloc) {
            __builtin_amdgcn_fence(__ATOMIC_RELEASE, "agent");
            asm volatile("s_waitcnt vmcnt(0)" ::: "memory");
            const unsigned og = xb_add(&bar[XB_TOP], 1u);
            const unsigned tg = og / nx;
            if (og + 1u == (tg + 1u) * nx) xb_add(&bar[XB_TOPGEN], 1u);
            else XB_SPIN(xb_ld(&bar[XB_TOPGEN]) == tg, bar);
            __builtin_amdgcn_fence(__ATOMIC_ACQUIRE, "agent");
            xb_add(&bar[XB_XGEN(b.x)], 1u);
            asm volatile("s_waitcnt vmcnt(0)" ::: "memory");
        } else {
            XB_SPIN(xb_ld(&bar[XB_XGEN(b.x)]) == gen, bar);
            __builtin_amdgcn_fence(__ATOMIC_ACQUIRE, "agent");
            asm volatile("s_waitcnt vmcnt(0)" ::: "memory");
        }
    }
    __syncthreads();
}

__global__ void __launch_bounds__(512, 2) mega(Args a) {
    extern __shared__ __attribute__((aligned(16))) unsigned char lds_raw[];
    LAS unsigned char* lds = (LAS unsigned char*)lds_raw;
    const int G = gridDim.x, bx = blockIdx.x;
    unsigned char* ws = a.ws;
    unsigned* ctl = (unsigned*)(ws + WS_CTL);
    float* tabA = (float*)(ws + WS_TABA); float* tabD = (float*)(ws + WS_TABD);
    unsigned char* W = ws + WS_W;
    bf16_t* H = (bf16_t*)(ws + WS_H);
    bf16_t* PROJ = (bf16_t*)(ws + WS_R1 + R1_PROJ); bf16_t* VT = (bf16_t*)(ws + WS_R1 + R1_VT); bf16_t* QB = (bf16_t*)(ws + WS_R1 + R1_QB);
    bf16_t* KB = (bf16_t*)(ws + WS_R1 + R1_KB); bf16_t* VTB = (bf16_t*)(ws + WS_R1 + R1_VTB);
    bf16_t* Y = (bf16_t*)(ws + WS_R1); bf16_t* FFH = (bf16_t*)(ws + WS_R1);
    bf16_t* BR = (bf16_t*)(ws + WS_R2); float* PART = (float*)(ws + WS_R2); bf16_t* U = (bf16_t*)(ws + WS_R2);
    bf16_t* MERGED = (bf16_t*)(ws + WS_R3); bf16_t* P16 = (bf16_t*)(ws + WS_R2 + 100 * MiB);
    float* ssA = (float*)(ws + WS_SS); float* ssB = ssA + TCM;
    cg::grid_group grid = cg::this_grid();
    volatile LAS unsigned* bst = (volatile LAS unsigned*)(lds + 131072 + 64);
    if (threadIdx.x < 2) bst[threadIdx.x] = 0u;
    __syncthreads();
    XcdBarrier xbar = xcd_barrier_post(ctl + 1024, bst);

    for (int pid = a.ph_lo; pid < a.ph_hi; ++pid) {
        int tid = threadIdx.x; asm volatile("" : "+v"(tid));
        const int lane = tid & 63, wave = __builtin_amdgcn_readfirstlane(tid >> 6);
        const int gw = bx * 8 + wave, ngw = G * 8;
        const int layer = pid / 25, q = pid % 25;
        if (q == 0) {
            if (layer == 0) build_tables(a.in[I_RELB], tabA, tabD, bx * 512 + tid, G * 512);
#ifndef NO_CONV
            convert_weights(a, layer, W, (LAS float*)(lds + wave * 16384), gw, ngw, lane);
#endif
        } else {
            const int chunk = (q - 1) / 12, kidx = (q - 1) % 12; const int k = kidx < 9 ? kidx + 1 : (kidx == 9 ? 11 : (kidx == 10 ? 12 : 15));
            const int m0 = chunk == 0 ? 0 : 16384, TC = chunk == 0 ? 16384 : 24576, nMt = TC / 256;
            const float* xs0 = layer == 0 ? a.in[I_XP] : a.out; const float* xs1 = layer == 0 ? a.in[I_XS] : a.out + (size_t)TP * DM;
#ifdef NO_ROWS
            if (0) {
#else
            if (k == 1) {
#endif
                const float* g = a.in[I_NMIX] + layer * DM;
                for (int r = gw; r < TC; r += ngw) { const int m = m0 + r; norm_row(xrow_ptr(xs0, xs1, m), g, H + (size_t)r * DM, lane);
                    const float* pr = m < TP ? a.in[I_PP] + ((size_t)layer * TP + m) * 256 : a.in[I_PS] + ((size_t)layer * 32768 + (m - TP)) * 256;
                    const f32x4 v = *(const f32x4*)(pr + 4 * lane); u32x2 w; w.x = cvt_pk_bf16(v[0], v[1]); w.y = cvt_pk_bf16(v[2], v[3]); *(u32x2*)(P16 + (size_t)r * 256 + 4 * lane) = w;
                    if (lane == 0) { ssA[r] = 0.f; ssB[r] = 0.f; } }
#ifdef NO_ROWS
            } else if (0) {
#else
            } else if (k == 3 || k == 5) {
#endif
                for (int r = gw; r < TC; r += ngw) { const int m = m0 + r; const int tseq = m < TP ? m : (m - TP) % SS;
                    if (k == 3) post1_row(a, layer, PROJ + (size_t)r * NP, tseq, lane);
                    else post2_row(a, layer, QB + (size_t)r * 768, KB + (size_t)r * 768, PROJ + (size_t)r * NP, tseq, lane); }
            } else if (k == 6) {
                AttnBufs B{PROJ, VT, QB, KB, VTB, BR, tabA, tabD};
#ifndef NO_ATTN
                #if ATTN_V2
                attn2_phase(a, B, layer, chunk, ctl + 64 * (layer * 2 + chunk), tid, lane, wave, lds);
#else
                attn_phase(a, B, layer, chunk, ctl + 64 * (layer * 2 + chunk), lane, (LAS float*)(lds + wave * 16384));
#endif
#endif
            } else {
                const int njobs = (k == 2 || k == 11) ? 2 : (k == 4 ? 3 : 1);
                int coff = 0;
                for (int j = 0; j < njobs; ++j) {
                    pg8::Gemm g; pg8::Epi E; int nM = nMt, nN = 8, rep = 1, adiv = 1 << 30; long astep = 0;
                    E.kind = pg8::EK_BF16; E.O = nullptr; E.ldc = 0; E.Y = nullptr; E.part = nullptr; E.xs0 = xs0; E.xs1 = xs1; E.xout = a.out; E.m0 = m0; E.Hout = nullptr; E.ssq = nullptr; E.rsq = nullptr;
                    g.A = H; g.Bt = (const bf16_t*)(W + WO_IN); g.lda = 2048; g.ldb = 2048; g.K = 2048;
                    if (k == 2 && j == 0) { nN = NP / 256; E.O = PROJ; E.ldc = NP; }
                    else if (k == 2) { g.A = (const bf16_t*)(W + WO_INV); g.Bt = H; nM = NVT / 256; nN = nMt; E.O = VT; E.ldc = TCM; }
                    else if (k == 4 && j == 0) { g.A = PROJ + PC_BCQ; g.lda = NP; g.Bt = (const bf16_t*)(W + WO_UQ); g.ldb = 512; g.K = 512; nN = 3; E.O = QB; E.ldc = 768; }
                    else if (k == 4 && j == 1) { g.A = PROJ + PC_BCKV; g.lda = NP; g.Bt = (const bf16_t*)(W + WO_UKN); g.ldb = 512; g.K = 512; nN = 2; E.kind = pg8::EK_SPLIT192; E.O = KB; E.ldc = 768; }
                    else if (k == 4) { g.A = (const bf16_t*)(W + WO_UKV); g.lda = 512; g.Bt = PROJ + PC_BCKV; g.ldb = NP; g.K = 512; nM = 2; nN = nMt; E.O = VTB; E.ldc = TCM; }
                    else if (k == 7) { g.A = BR; g.Bt = (const bf16_t*)(W + WO_B); g.ldb = 512; g.K = 512; nN = 32; adiv = 8; astep = 1024; E.O = Y; E.ldc = 8192; }
                    else if (k == 8) { g.Bt = (const bf16_t*)(W + WO_G); nN = 32; E.kind = pg8::EK_GATE; E.O = MERGED; E.Y = Y; }
                    else if (k == 9) { g.A = MERGED; g.Bt = (const bf16_t*)(W + WO_O); E.kind = pg8::EK_RES; E.Hout = H; E.ssq = ssA; }
                    else if (k == 11 && j == 0) { g.Bt = (const bf16_t*)(W + WO_1); nN = 32; E.kind = pg8::EK_RELU2; E.O = FFH; E.ldc = 8192; E.rsq = ssA; }
                    else if (k == 11) { g.A = P16; g.lda = 256; g.Bt = (const bf16_t*)(W + WO_PP); g.ldb = 256; g.K = 256; E.O = U; E.ldc = 2048; }
                    else if (k == 12) { g.A = FFH; g.lda = 8192; g.Bt = (const bf16_t*)(W + WO_2); g.ldb = 8192; g.K = 8192; E.kind = pg8::EK_RES; E.xs0 = a.out; E.xs1 = a.out + (size_t)TP * DM; E.Hout = H; E.ssq = ssB; }
                    else { g.Bt = (const bf16_t*)(W + WO_PG); E.kind = pg8::EK_PLE; E.Y = U; E.xs0 = a.out; E.xs1 = a.out + (size_t)TP * DM; E.rsq = ssB; }
                    pg8::Order S; S.init(nM, nN, G, (bx + G - coff) % G, rep, adiv, astep);
#ifndef NO_GEMM
                    pg8::gemm_phase<true>(lds, g, S, E, tid);
#endif
                    coff = (coff + (nM * nN) % G) % G;
                }
            }
        }
        if (pid + 1 < a.ph_hi) { if (pid == a.ph_lo) grid.sync(); else xcd_barrier(xbar); }
    }
}

extern "C" void kernel_launch(void* const* d_in, const int* in_sizes, int n_in, void* d_out, int out_size, void* d_ws, size_t ws_size, hipStream_t stream) {
    static int grid = 0;
    if (grid == 0) {
        if (n_in != 33 || out_size != TALL * DM || ws_size < WS_END) { fprintf(stderr, "kernel_launch: unexpected shapes (n_in %d out %d ws %zu need %zu)\n", n_in, out_size, ws_size, (size_t)WS_END); grid = -1; return; }
        int dev = 0, cus = 0, per_cu = 0;
        hipGetDevice(&dev); hipDeviceGetAttribute(&cus, hipDeviceAttributeMultiprocessorCount, dev);
        if (hipFuncSetAttribute((const void*)mega, hipFuncAttributeMaxDynamicSharedMemorySize, LDS_BYTES) != hipSuccess) { fprintf(stderr, "kernel_launch: hipFuncSetAttribute failed\n"); grid = -1; return; }
        if (hipOccupancyMaxActiveBlocksPerMultiprocessor(&per_cu, (const void*)mega, 512, LDS_BYTES) != hipSuccess || per_cu < 1) per_cu = 1;
        (void)hipGetLastError();
        grid = cus * per_cu;
        if (grid <= 0) grid = 256;
    }
    if (grid < 0) return;
    hipMemsetAsync((char*)d_ws + WS_CTL, 0, 32768, stream);
    Args a{};
    for (int i = 0; i < 33; ++i) a.in[i] = (const float*)d_in[i];
    a.out = (float*)d_out; a.ws = (unsigned char*)d_ws;
    constexpr int NPH = 50;
#if COOP
    a.ph_lo = 0; a.ph_hi = NPH;
    void* args[] = {&a};
    hipError_t e = hipLaunchCooperativeKernel((const void*)mega, dim3(grid), dim3(512), args, LDS_BYTES, stream);
    if (e != hipSuccess) fprintf(stderr, "cooperative launch failed: %s (grid %d)\n", hipGetErrorString(e), grid);
#else
    for (int p = 0; p < NPH; ++p) { a.ph_lo = p; a.ph_hi = p + 1; hipLaunchKernelGGL(mega, dim3(grid), dim3(512), LDS_BYTES, stream, a); }
#endif
}
```

```cpp
#include <hip/hip_runtime.h>
#include <hip/hip_cooperative_groups.h>
#include <cstdio>
#include <cstdint>
namespace cg = cooperative_groups;

#ifndef COOP
#define COOP 1
#endif
#ifndef ATTN_V2
#define ATTN_V2 1
#endif

#define LAS __attribute__((address_space(3)))
typedef unsigned short bf16_t;
typedef short bf16x8 __attribute__((ext_vector_type(8)));
typedef float f32x4 __attribute__((ext_vector_type(4)));
typedef float f32x16 __attribute__((ext_vector_type(16)));
typedef unsigned u32x4 __attribute__((ext_vector_type(4)));
typedef unsigned u32x2 __attribute__((ext_vector_type(2)));
typedef float f32x4u __attribute__((ext_vector_type(4), aligned(4)));

constexpr int DM = 2048, TALL = 40960, TP = 8192, SS = 2048;
constexpr int NP = 5120;
constexpr int TCM = 24576;
constexpr int NVT = 1280;
constexpr int DFF = 8192;
constexpr int PC_AQ = 0, PC_AK = 512, PC_BCQ = 1024, PC_BCKV = 1536, PC_CQ = 2048, PC_CK = 2560, PC_DQ = 2816, PC_DK = 4352, PC_BKR = 4864;
constexpr float LOG2E = 1.4426950408889634f;
constexpr float EPS = 1e-6f;
constexpr int TABA_N = 16384, TABA_OFF = 8192, TABD_N = 2304, TABD_OFF = 1152;

constexpr size_t MiB = 1u << 20;
constexpr size_t WS_CTL = 0;
constexpr size_t WS_TABA = 64 * 1024;
constexpr size_t WS_TABD = 384 * 1024;
constexpr size_t WS_SS = 512 * 1024;
constexpr size_t WS_W = 1 * MiB;
constexpr size_t WO_IN = 0;
constexpr size_t WO_INV = WO_IN + (size_t)NP * 2048 * 2;
constexpr size_t WO_G = WO_INV + (size_t)NVT * 2048 * 2;
constexpr size_t WO_B = WO_G + (size_t)8192 * 2048 * 2;
constexpr size_t WO_O = WO_B + (size_t)8192 * 512 * 2;
constexpr size_t WO_1 = WO_O + (size_t)2048 * 2048 * 2;
constexpr size_t WO_2 = WO_1 + (size_t)8192 * 2048 * 2;
constexpr size_t WO_PG = WO_2 + (size_t)2048 * 8192 * 2;
constexpr size_t WO_PP = WO_PG + (size_t)2048 * 2048 * 2;
constexpr size_t WO_UQ = WO_PP + (size_t)2048 * 256 * 2;
constexpr size_t WO_UKN = WO_UQ + (size_t)768 * 512 * 2;
constexpr size_t WO_UKV = WO_UKN + (size_t)512 * 512 * 2;
constexpr size_t WO_END = WO_UKV + (size_t)512 * 512 * 2;
static_assert(WO_END <= 148 * MiB, "weights");
constexpr size_t WS_H = WS_W + 148 * MiB;
constexpr size_t WS_R1 = WS_H + (size_t)TCM * 2048 * 2;
constexpr size_t R1_PROJ = 0;
constexpr size_t R1_VT = R1_PROJ + (size_t)TCM * NP * 2;
constexpr size_t R1_QB = R1_VT + (size_t)NVT * TCM * 2;
constexpr size_t R1_KB = R1_QB + (size_t)TCM * 768 * 2;
constexpr size_t R1_VTB = R1_KB + (size_t)TCM * 768 * 2;
constexpr size_t R1_END = R1_VTB + (size_t)512 * TCM * 2;
static_assert(R1_END >= (size_t)TCM * 8192 * 2, "Y / FFH overlay");
constexpr size_t WS_R2 = WS_R1 + R1_END;
constexpr size_t WS_R3 = WS_R2 + (size_t)TCM * 2048 * 4;
constexpr size_t WS_END = WS_R3 + (size_t)TCM * 2048 * 2;

constexpr int LDS_BYTES = 147456;

typedef float f32x2_t __attribute__((ext_vector_type(2))); typedef __bf16 bf16x2_t __attribute__((ext_vector_type(2)));
__device__ __forceinline__ unsigned cvt_pk_bf16(float lo, float hi) { f32x2_t v = {lo, hi}; bf16x2_t b = __builtin_convertvector(v, bf16x2_t); return __builtin_bit_cast(unsigned, b); }
__device__ __forceinline__ float bf_lo(unsigned u) { return __uint_as_float(u << 16); }
__device__ __forceinline__ float bf_hi(unsigned u) { return __uint_as_float(u & 0xffff0000u); }
__device__ __forceinline__ float wave_sum(float v) {
#pragma unroll
    for (int o = 1; o < 64; o <<= 1) v += __shfl_xor(v, o);
    return v;
}
__device__ __forceinline__ float sigmoidf_fast(float x) { return __builtin_amdgcn_rcpf(1.0f + __builtin_amdgcn_exp2f(-x * LOG2E)); }
__device__ __forceinline__ const float* xrow_ptr(const float* s0, const float* s1, int m) { return m < TP ? s0 + (size_t)m * DM : s1 + (size_t)(m - TP) * DM; }

namespace pg8 {
constexpr int BM = 256, BK = 64, HALF = 128, HTB = HALF * BK * 2, STAGE_BYTES = 8 * HTB, NXCD = 8, WGM = 8;
__host__ __device__ __forceinline__ int lds_byte(int r, int c) { const int st = (r >> 4) * 2 + (c >> 5), rr = r & 15, cc = c & 31, ob = rr * 64 + cc * 2; return st * 1024 + (ob ^ (((ob >> 9) & 1) << 5)); }
__host__ __device__ __forceinline__ void stage_rc(int b, int& R, int& C) { const int st = b / 1024, sb = b % 1024, swz = sb ^ (((sb >> 9) & 1) << 5); R = (st >> 1) * 16 + swz / 64; C = (st & 1) * 32 + (swz % 64) / 2; }
__host__ __device__ __forceinline__ int perm32(int rho) { const int n = rho >> 4, i = rho & 15; return 8 * (i >> 2) + 4 * n + (i & 3); }

struct Unit { int pm, pn; long aoff; };
struct Gemm { const bf16_t* A; const bf16_t* Bt; int lda, ldb, K; };

struct Order {
    int nM, nN, nwg, G, c, rep, adiv; long astep;
    __device__ void init(int nM_, int nN_, int G_, int c_, int rep_, int adiv_, long astep_) { nM = nM_; nN = nN_; nwg = nM * nN; G = G_; c = c_; rep = rep_; adiv = adiv_; astep = astep_; }
    __device__ bool next(int i, Unit& u) const {
        const int t = i / rep, sub = i - t * rep;
        const long L = (long)t * G + c; if (L >= nwg) return false;
        int wgid = (int)L; { const int q = nwg / NXCD, r = nwg % NXCD, xcd = wgid % NXCD, off = wgid / NXCD; wgid = (xcd < r ? xcd * (q + 1) : r * (q + 1) + (xcd - r) * q) + off; }
        const int nig = WGM * nN, gid = wgid / nig, fm = gid * WGM, gsz = (nM - fm) < WGM ? (nM - fm) : WGM;
        u.pm = fm + ((wgid % nig) % gsz); const int pn = (wgid % nig) / gsz; u.pn = pn + sub * nN; u.aoff = (long)(pn / adiv) * astep; return true;
    }
};

enum { EK_BF16 = 0, EK_SPLIT192 = 1, EK_RELU2 = 2, EK_GATE = 3, EK_RES = 4, EK_PLE = 5 };
struct Epi {
    static constexpr bool PERM = true;
    int kind; bf16_t* O; long ldc; const bf16_t* Y; float* part; const float* xs0; const float* xs1; float* xout; int m0;
    bf16_t* Hout; float* ssq; const float* rsq;
    __device__ __forceinline__ void operator()(const f32x4 (&acc)[2][2][4][2], const Unit& u, int wr, int wc, int fr, int fq) const {
        const int row0 = u.pm * BM + wr * 64 + fr, col0 = u.pn * BM + wc * 32 + 8 * fq;
        if (kind <= EK_RELU2) {
#pragma unroll
            for (int ai = 0; ai < 2; ++ai)
#pragma unroll
                for (int m = 0; m < 4; ++m) { const int row = row0 + ai * HALF + m * 16;
                    float rs = 1.f; if (kind == EK_RELU2) rs = 1.0f / sqrtf(rsq[row] * (1.0f / 2048.0f) + EPS);
#pragma unroll
                    for (int bj = 0; bj < 2; ++bj) { int col = col0 + bj * HALF; f32x4 v0 = acc[ai][bj][m][0], v1 = acc[ai][bj][m][1];
                        if (kind == EK_RELU2) {
#pragma unroll
                            for (int e = 0; e < 4; ++e) { float a = fmaxf(v0[e], 0.f) * rs, b = fmaxf(v1[e], 0.f) * rs; v0[e] = a * a; v1[e] = b * b; } }
                        if (kind == EK_SPLIT192) col = (col >> 7) * 192 + (col & 127);
                        u32x4 w; w.x = cvt_pk_bf16(v0[0], v0[1]); w.y = cvt_pk_bf16(v0[2], v0[3]); w.z = cvt_pk_bf16(v1[0], v1[1]); w.w = cvt_pk_bf16(v1[2], v1[3]);
                        *(u32x4*)(O + (size_t)row * ldc + col) = w; } }
        } else if (kind == EK_GATE) {
            const int oc = u.pn * 64 + wc * 16 + 4 * fq;
#pragma unroll
            for (int ai = 0; ai < 2; ++ai)
#pragma unroll
                for (int m = 0; m < 4; ++m) { const int row = row0 + ai * HALF + m * 16;
                    const bf16_t* yp = Y + (size_t)row * 8192 + oc;
                    f32x4 r = (f32x4){0.f, 0.f, 0.f, 0.f};
#pragma unroll
                    for (int b = 0; b < 4; ++b) { const u32x2 y = *(const u32x2*)(yp + b * 2048); const f32x4 v = acc[ai][b >> 1][m][b & 1];
                        r[0] += sigmoidf_fast(v[0]) * bf_lo(y.x); r[1] += sigmoidf_fast(v[1]) * bf_hi(y.x); r[2] += sigmoidf_fast(v[2]) * bf_lo(y.y); r[3] += sigmoidf_fast(v[3]) * bf_hi(y.y); }
                    u32x2 w; w.x = cvt_pk_bf16(r[0], r[1]); w.y = cvt_pk_bf16(r[2], r[3]);
                    *(u32x2*)(O + (size_t)row * 2048 + oc) = w; }
        } else {
#pragma unroll
            for (int ai = 0; ai < 2; ++ai)
#pragma unroll
                for (int m = 0; m < 4; ++m) { const int row = row0 + ai * HALF + m * 16; const int gm = m0 + row;
                    const float* xs = xrow_ptr(xs0, xs1, gm); float* xo = xout + (size_t)gm * DM;
                    float rs = 1.f, sq = 0.f; if (kind == EK_PLE) rs = 1.0f / sqrtf(rsq[row] * (1.0f / 2048.0f) + EPS);
#pragma unroll
                    for (int bj = 0; bj < 2; ++bj) { const int col = col0 + bj * HALF; f32x4 v0 = acc[ai][bj][m][0], v1 = acc[ai][bj][m][1];
                        const f32x4 x0 = *(const f32x4*)(xs + col), x1 = *(const f32x4*)(xs + col + 4);
                        if (kind == EK_PLE) { const u32x4 y = *(const u32x4*)(Y + (size_t)row * 2048 + col); v0 = v0 * rs; v1 = v1 * rs;
                            v0[0] = sigmoidf_fast(v0[0]) * bf_lo(y.x); v0[1] = sigmoidf_fast(v0[1]) * bf_hi(y.x); v0[2] = sigmoidf_fast(v0[2]) * bf_lo(y.y); v0[3] = sigmoidf_fast(v0[3]) * bf_hi(y.y);
                            v1[0] = sigmoidf_fast(v1[0]) * bf_lo(y.z); v1[1] = sigmoidf_fast(v1[1]) * bf_hi(y.z); v1[2] = sigmoidf_fast(v1[2]) * bf_lo(y.w); v1[3] = sigmoidf_fast(v1[3]) * bf_hi(y.w); }
                        const f32x4 n0 = x0 + v0, n1 = x1 + v1;
                        *(f32x4*)(xo + col) = n0; *(f32x4*)(xo + col + 4) = n1;
                        if (Hout) { u32x4 w; w.x = cvt_pk_bf16(n0[0], n0[1]); w.y = cvt_pk_bf16(n0[2], n0[3]); w.z = cvt_pk_bf16(n1[0], n1[1]); w.w = cvt_pk_bf16(n1[2], n1[3]);
                            *(u32x4*)(Hout + (size_t)row * DM + col) = w;
                            sq += (n0[0] * n0[0] + n0[1] * n0[1]) + (n0[2] * n0[2] + n0[3] * n0[3]) + (n1[0] * n1[0] + n1[1] * n1[1]) + (n1[2] * n1[2] + n1[3] * n1[3]); } }
                    if (Hout) { sq += __shfl_xor(sq, 16); sq += __shfl_xor(sq, 32); if (fq == 0) atomicAdd(ssq + row, sq); } }
        }
    }
};

template <bool ALIGN_EPI = true>
__device__ __forceinline__ void gemm_phase(LAS unsigned char* lds, const Gemm g, const Order& S, const Epi& E, const int tid) {
    const int wid = __builtin_amdgcn_readfirstlane(tid >> 6), lane = tid & 63, wr = wid >> 2, wc = wid & 3, fr = lane & 15, fq = lane >> 4;
    const int K = g.K, nt = K / BK;
    unsigned voffA[2], voffB[2];
#pragma unroll
    for (int i = 0; i < 2; ++i) { int R, C; stage_rc(tid * 16 + i * 8192, R, C); const int Rb = Epi::PERM ? ((R & ~31) + perm32(R & 31)) : R;
        voffA[i] = (unsigned)(R * g.lda + C) * 2u; voffB[i] = (unsigned)(Rb * g.ldb + C) * 2u; }
    const size_t kstep = (size_t)(BK * 2);
    const size_t hstA = (size_t)HALF * g.lda * 2, hstB = (size_t)HALF * g.ldb * 2;
    const size_t tstA = 2 * hstA, tstB = 2 * hstB;
    const unsigned ldsw = (unsigned)wid * 1024u;
    const int aoff = lds_byte(wr * 64 + fr, fq * 8), boff = lds_byte(wc * 32 + fr, fq * 8);
#define PG8_SA(b, h) (((b) * 2 + (h)) * HTB)
#define PG8_SB(b, h) ((4 + (b) * 2 + (h)) * HTB)
#define PG8_STAGE(bufoff, gbase, voff) do { _Pragma("unroll") for (int _i = 0; _i < 2; ++_i) \
        __builtin_amdgcn_global_load_lds((const unsigned*)((const char*)(gbase) + (voff)[_i]), (LAS unsigned*)(lds + (bufoff) + ldsw + _i * 8192), 16, 0, 0); } while (0)
#define PG8_LDA(dst, b, h) do { _Pragma("unroll") for (int m = 0; m < 4; ++m) _Pragma("unroll") for (int k = 0; k < 2; ++k) dst[m][k] = *(const LAS bf16x8*)(lds + PG8_SA(b, h) + aoff + m * 2048 + k * 1024); } while (0)
#define PG8_LDB(dst, b, h) do { _Pragma("unroll") for (int n = 0; n < 2; ++n) _Pragma("unroll") for (int k = 0; k < 2; ++k) dst[n][k] = *(const LAS bf16x8*)(lds + PG8_SB(b, h) + boff + n * 2048 + k * 1024); } while (0)
#define PG8_MMA(ai, bj, At, Bt) do { __builtin_amdgcn_s_setprio(1); _Pragma("unroll") for (int m = 0; m < 4; ++m) _Pragma("unroll") for (int n = 0; n < 2; ++n) _Pragma("unroll") for (int k = 0; k < 2; ++k) \
        acc[ai][bj][m][n] = __builtin_amdgcn_mfma_f32_16x16x32_bf16(Bt[n][k], At[m][k], acc[ai][bj][m][n], 0, 0, 0); __builtin_amdgcn_s_setprio(0); } while (0)
#define PG8_WAIT_V(n) asm volatile("s_waitcnt vmcnt(" #n ")" ::: "memory")
#define PG8_WAIT_L(n) asm volatile("s_waitcnt lgkmcnt(" #n ")" ::: "memory")
#define PG8_BAR __builtin_amdgcn_s_barrier()
#define PG8_SCHED __builtin_amdgcn_sched_barrier(0)
    Unit cur, nxt; int ui = 0;
    if (!S.next(0, cur)) return;
    f32x4 acc[2][2][4][2];
#pragma unroll
    for (int a = 0; a < 2; ++a)
#pragma unroll
        for (int b = 0; b < 2; ++b)
#pragma unroll
            for (int m = 0; m < 4; ++m)
#pragma unroll
                for (int n = 0; n < 2; ++n) acc[a][b][m][n] = (f32x4){0.f, 0.f, 0.f, 0.f};
    bf16x8 At[4][2], B0[2][2], B1[2][2];
    const char* cA = (const char*)g.A + (size_t)cur.pm * tstA + cur.aoff; const char* cB = (const char*)g.Bt + (size_t)cur.pn * tstB;
    PG8_STAGE(PG8_SB(0, 0), cB, voffB); PG8_STAGE(PG8_SB(0, 1), cB + hstB, voffB); PG8_STAGE(PG8_SA(0, 0), cA, voffA); PG8_STAGE(PG8_SA(0, 1), cA + hstA, voffA);
    if (wr == 1) PG8_BAR;
    PG8_WAIT_V(2); PG8_BAR;
    PG8_STAGE(PG8_SB(1, 0), cB + kstep, voffB); PG8_STAGE(PG8_SA(1, 0), cA + kstep, voffA); PG8_STAGE(PG8_SB(1, 1), cB + hstB + kstep, voffB);
    PG8_WAIT_V(6); PG8_BAR;
    for (;;) {
        const bool has_next = S.next(ui + 1, nxt);
        const char* nA = has_next ? (const char*)g.A + (size_t)nxt.pm * tstA + nxt.aoff : cA; const char* nB = has_next ? (const char*)g.Bt + (size_t)nxt.pn * tstB : cB;
        for (int t = 0; t < nt; t += 2) {
            const bool last = (t == nt - 2);
            const char* a1 = cA + (size_t)(t + 1) * kstep;
            const char* a2 = last ? nA : cA + (size_t)(t + 2) * kstep; const char* b2 = last ? nB : cB + (size_t)(t + 2) * kstep;
            const char* a3 = a2 + kstep; const char* b3 = b2 + kstep;
            PG8_LDB(B0, 0, 0); PG8_LDB(B1, 0, 1); PG8_SCHED; PG8_LDA(At, 0, 0); PG8_STAGE(PG8_SA(1, 1), a1 + hstA, voffA);
            PG8_WAIT_V(8); PG8_WAIT_L(0); PG8_BAR; PG8_MMA(0, 0, At, B0); PG8_MMA(0, 1, At, B1); PG8_BAR; PG8_SCHED;
            PG8_LDA(At, 0, 1); PG8_STAGE(PG8_SB(0, 0), b2, voffB); PG8_STAGE(PG8_SB(0, 1), b2 + hstB, voffB); PG8_STAGE(PG8_SA(0, 0), a2, voffA);
            PG8_WAIT_V(8); PG8_WAIT_L(0); PG8_BAR; PG8_MMA(1, 0, At, B0); PG8_MMA(1, 1, At, B1); PG8_BAR; PG8_SCHED;
            PG8_LDB(B0, 1, 0); PG8_LDB(B1, 1, 1); PG8_SCHED; PG8_LDA(At, 1, 0); PG8_STAGE(PG8_SA(0, 1), a2 + hstA, voffA);
            PG8_WAIT_V(8); PG8_WAIT_L(0); PG8_BAR; PG8_MMA(0, 0, At, B0); PG8_MMA(0, 1, At, B1); PG8_BAR; PG8_SCHED;
            PG8_LDA(At, 1, 1); PG8_STAGE(PG8_SB(1, 0), b3, voffB); PG8_STAGE(PG8_SB(1, 1), b3 + hstB, voffB); PG8_STAGE(PG8_SA(1, 0), a3, voffA);
            PG8_WAIT_V(8); PG8_WAIT_L(0); PG8_BAR; PG8_MMA(1, 0, At, B0); PG8_MMA(1, 1, At, B1); PG8_BAR; PG8_SCHED;
        }
        if constexpr (ALIGN_EPI) { if (wr == 0) PG8_BAR; }
        E(acc, cur, wr, wc, fr, fq);
        if (!has_next) break;
#pragma unroll
        for (int a = 0; a < 2; ++a)
#pragma unroll
            for (int b = 0; b < 2; ++b)
#pragma unroll
                for (int m = 0; m < 4; ++m)
#pragma unroll
                    for (int n = 0; n < 2; ++n) acc[a][b][m][n] = (f32x4){0.f, 0.f, 0.f, 0.f};
        cur = nxt; cA = nA; cB = nB; ++ui;
        if constexpr (ALIGN_EPI) { if (wr == 1) PG8_BAR; }
    }
    PG8_WAIT_V(0);
    if constexpr (!ALIGN_EPI) { if (wr == 0) PG8_BAR; }
    PG8_BAR;
#undef PG8_SA
#undef PG8_SB
#undef PG8_STAGE
#undef PG8_LDA
#undef PG8_LDB
#undef PG8_MMA
#undef PG8_WAIT_V
#undef PG8_WAIT_L
#undef PG8_BAR
#undef PG8_SCHED
}
}

struct Args { const float* in[33]; float* out; unsigned char* ws; int ph_lo, ph_hi; };
enum { I_XP = 0, I_XS, I_PP, I_PS, I_RELB, I_NMIX, I_WIN, I_AQN, I_AKN, I_ALQ1, I_ALK1, I_ALQ2, I_ALK2, I_AON, I_BCQN, I_BCKVN, I_BWUQ, I_BWUKV, I_BQN, I_BKN,
       I_CQN, I_CKN, I_DQN, I_DKN, I_WG, I_WB, I_WO, I_NFFN, I_W1, I_W2, I_NPLE, I_WPG, I_WPP };

__device__ __forceinline__ int rel_bucket(int rel) {
    const int n = rel < 0 ? -rel : rel;
    const float nf = (float)(n > 1 ? n : 1);
    int large = 8 + (int)(logf(nf / 8.0f) / 4.852030263919617f * 8.0f);
    large = large < 15 ? large : 15;
    return (rel > 0 ? 16 : 0) + (n < 8 ? n : large);
}
__device__ __forceinline__ void build_tables(const float* relb, float* tabA, float* tabD, int gtid, int gthreads) {
    for (int i = gtid; i < 4 * TABA_N; i += gthreads) { const int h = i / TABA_N, d = i % TABA_N - TABA_OFF; tabA[i] = relb[rel_bucket(d) * 16 + h] * LOG2E; }
    for (int i = gtid; i < 12 * TABD_N; i += gthreads) { const int gh = i / TABD_N, d = i % TABD_N - TABD_OFF; const int g = gh >> 2; const int dil = g == 0 ? 1 : (g == 1 ? 4 : 16);
        const int ad = d < 0 ? -d : d; const bool ok = (ad % dil == 0) && (ad <= 64 * dil);
        tabD[i] = ok ? relb[rel_bucket(d) * 16 + 4 + gh] * LOG2E : -1e30f; }
}
__device__ __forceinline__ void transpose_item(const float* W, int N, int k0, int n0, bf16_t* dst, int K, LAS float* scr, int lane, int gate_b = -1, const float* gsc = nullptr) {
#pragma unroll 8
    for (int i = 0; i < 32; ++i) { const int kk = 2 * i + (lane >> 5); float w = W[(size_t)(k0 + kk) * N + n0 + (lane & 31)]; if (gsc) w *= gsc[k0 + kk]; scr[kk * 33 + (lane & 31)] = w; }
    asm volatile("s_waitcnt lgkmcnt(0)" ::: "memory");
    const int c = lane & 7;
#pragma unroll
    for (int j = 0; j < 4; ++j) { const int n = (lane >> 3) + 8 * j; const LAS float* s = scr + (8 * c) * 33 + n;
        u32x4 o; o.x = cvt_pk_bf16(s[0 * 33], s[1 * 33]); o.y = cvt_pk_bf16(s[2 * 33], s[3 * 33]); o.z = cvt_pk_bf16(s[4 * 33], s[5 * 33]); o.w = cvt_pk_bf16(s[6 * 33], s[7 * 33]);
        size_t drow = (size_t)n;
        if (gate_b >= 0) { const int nn = n0 + n, j = nn & 63; drow = (size_t)((nn >> 6) * 256 + 128 * (gate_b >> 1) + 32 * (j >> 4) + 8 * ((j >> 2) & 3) + 4 * (gate_b & 1) + (j & 3)); }
        *(u32x4*)(dst + drow * K + k0 + 8 * c) = o; }
    asm volatile("s_waitcnt lgkmcnt(0)" ::: "memory");
}
__device__ __forceinline__ int win_row(int n0) {
    if (n0 < 512) return PC_AQ + n0;
    if (n0 < 1024) return PC_AK + (n0 - 512);
    if (n0 < 1536) return -(0 + (n0 - 1024) + 1);
    if (n0 < 2048) return PC_BCQ + (n0 - 1536);
    if (n0 < 2560) return PC_BCKV + (n0 - 2048);
    if (n0 < 2624) return PC_BKR + (n0 - 2560);
    if (n0 < 3136) return PC_CQ + (n0 - 2624);
    if (n0 < 3392) return PC_CK + (n0 - 3136);
    if (n0 < 3648) return -(512 + (n0 - 3392) + 1);
    if (n0 < 5184) return PC_DQ + (n0 - 3648);
    if (n0 < 5696) return PC_DK + (n0 - 5184);
    return -(768 + (n0 - 5696) + 1);
}
__device__ __forceinline__ void convert_weights(const Args& a, int layer, unsigned char* W, LAS float* scr, int gw, int ngw, int lane) {
    constexpr int I_IN = 32 * 194, I_G = 4 * 32 * 64, I_B = 4 * 8 * 64, I_O = 32 * 64, I_1 = 32 * 256, I_2 = 128 * 64, I_PG = 32 * 64, I_PPn = 4 * 64, I_UQ = 8 * 24, I_UKV = 8 * 32;
    constexpr int NIT = I_IN + I_G + I_B + I_O + I_1 + I_2 + I_PG + I_PPn + I_UQ + I_UKV;
    for (int it = gw; it < NIT; it += ngw) {
        int r = it;
        if (r < I_IN) { const int kb = r / 194, nb = r % 194; const int dr = win_row(nb * 32);
            bf16_t* dst = dr >= 0 ? (bf16_t*)(W + WO_IN) + (size_t)dr * 2048 : (bf16_t*)(W + WO_INV) + (size_t)(-dr - 1) * 2048;
            transpose_item(a.in[I_WIN] + (size_t)layer * 2048 * 6208, 6208, kb * 64, nb * 32, dst, 2048, scr, lane); continue; } r -= I_IN;
        if (r < I_G) { const int b = r / 2048, q = r % 2048, kb = q / 64, nb = q % 64;
            transpose_item(a.in[I_WG] + ((size_t)layer * 4 + b) * 2048 * 2048, 2048, kb * 64, nb * 32, (bf16_t*)(W + WO_G), 2048, scr, lane, b); continue; } r -= I_G;
        if (r < I_B) { const int b = r / 512, q = r % 512, kb = q / 64, nb = q % 64;
            transpose_item(a.in[I_WB] + ((size_t)layer * 4 + b) * 512 * 2048, 2048, kb * 64, nb * 32, (bf16_t*)(W + WO_B) + ((size_t)b * 2048 + nb * 32) * 512, 512, scr, lane); continue; } r -= I_B;
        if (r < I_O) { const int kb = r / 64, nb = r % 64;
            transpose_item(a.in[I_WO] + (size_t)layer * 2048 * 2048, 2048, kb * 64, nb * 32, (bf16_t*)(W + WO_O) + (size_t)(nb * 32) * 2048, 2048, scr, lane); continue; } r -= I_O;
        if (r < I_1) { const int kb = r / 256, nb = r % 256;
            transpose_item(a.in[I_W1] + (size_t)layer * 2048 * 8192, 8192, kb * 64, nb * 32, (bf16_t*)(W + WO_1) + (size_t)(nb * 32) * 2048, 2048, scr, lane, -1, a.in[I_NFFN] + layer * DM); continue; } r -= I_1;
        if (r < I_2) { const int kb = r / 64, nb = r % 64;
            transpose_item(a.in[I_W2] + (size_t)layer * 8192 * 2048, 2048, kb * 64, nb * 32, (bf16_t*)(W + WO_2) + (size_t)(nb * 32) * 8192, 8192, scr, lane); continue; } r -= I_2;
        if (r < I_PG) { const int kb = r / 64, nb = r % 64;
            transpose_item(a.in[I_WPG] + (size_t)layer * 2048 * 2048, 2048, kb * 64, nb * 32, (bf16_t*)(W + WO_PG) + (size_t)(nb * 32) * 2048, 2048, scr, lane, -1, a.in[I_NPLE] + layer * DM); continue; } r -= I_PG;
        if (r < I_PPn) { const int kb = r / 64, nb = r % 64;
            transpose_item(a.in[I_WPP] + (size_t)layer * 256 * 2048, 2048, kb * 64, nb * 32, (bf16_t*)(W + WO_PP) + (size_t)(nb * 32) * 256, 256, scr, lane); continue; } r -= I_PPn;
        if (r < I_UQ) { const int kb = r / 24, nb = r % 24;
            transpose_item(a.in[I_BWUQ] + (size_t)layer * 512 * 768, 768, kb * 64, nb * 32, (bf16_t*)(W + WO_UQ) + (size_t)(nb * 32) * 512, 512, scr, lane); continue; } r -= I_UQ;
        { const int kb = r / 32, nb = r % 32; const int n0 = nb * 32, h = n0 >> 8, j0 = n0 & 255;
            bf16_t* dst = j0 < 128 ? (bf16_t*)(W + WO_UKN) + (size_t)(h * 128 + j0) * 512 : (bf16_t*)(W + WO_UKV) + (size_t)(h * 128 + j0 - 128) * 512;
            transpose_item(a.in[I_BWUKV] + (size_t)layer * 512 * 1024, 1024, kb * 64, n0, dst, 512, scr, lane); }
    }
}

__device__ __forceinline__ void norm_row(const float* x, const float* g, bf16_t* out, int lane) {
    f32x4 v[8]; float s = 0.f;
#pragma unroll
    for (int j = 0; j < 8; ++j) { v[j] = *(const f32x4*)(x + 4 * lane + 256 * j); s += (v[j][0] * v[j][0] + v[j][1] * v[j][1]) + (v[j][2] * v[j][2] + v[j][3] * v[j][3]); }
    const float rs = 1.0f / sqrtf(wave_sum(s) * (1.0f / 2048.0f) + EPS);
#pragma unroll
    for (int j = 0; j < 8; ++j) { const f32x4 gg = *(const f32x4*)(g + 4 * lane + 256 * j);
        u32x2 w; w.x = cvt_pk_bf16(v[j][0] * rs * gg[0], v[j][1] * rs * gg[1]); w.y = cvt_pk_bf16(v[j][2] * rs * gg[2], v[j][3] * rs * gg[3]);
        *(u32x2*)(out + 4 * lane + 256 * j) = w; }
}
__device__ __forceinline__ void load8(const bf16_t* p, float (&f)[8]) { const u32x4 v = *(const u32x4*)p; f[0] = bf_lo(v.x); f[1] = bf_hi(v.x); f[2] = bf_lo(v.y); f[3] = bf_hi(v.y); f[4] = bf_lo(v.z); f[5] = bf_hi(v.z); f[6] = bf_lo(v.w); f[7] = bf_hi(v.w); }
__device__ __forceinline__ void store8(bf16_t* p, const float (&f)[8]) { u32x4 w; w.x = cvt_pk_bf16(f[0], f[1]); w.y = cvt_pk_bf16(f[2], f[3]); w.z = cvt_pk_bf16(f[4], f[5]); w.w = cvt_pk_bf16(f[6], f[7]); *(u32x4*)p = w; }
template <int GRP> __device__ __forceinline__ void norm8(float (&f)[8], const float* g, float scale, int lane) {
    float s = 0.f;
#pragma unroll
    for (int e = 0; e < 8; ++e) s += f[e] * f[e];
#pragma unroll
    for (int o = 1; o < GRP; o <<= 1) s += __shfl_xor(s, o);
    const float rs = scale / sqrtf(s * (1.0f / (GRP * 8)) + EPS);
    const int gi = (lane & (GRP - 1)) * 8;
#pragma unroll
    for (int e = 0; e < 8; ++e) f[e] = f[e] * rs * g[gi + e];
}
__device__ __forceinline__ float rope_inv(int i) { return __builtin_amdgcn_exp2f(-(float)i * (13.287712379549449f / 32.0f)) * 0.15915494309189535f; }
__device__ __forceinline__ void sincos_rev(float rev, float& sn, float& cs) { rev -= rintf(rev); sn = __builtin_amdgcn_sinf(rev); cs = __builtin_amdgcn_cosf(rev); }
__device__ __forceinline__ void axial_rope8(float (&f)[8], float rowpos, float colpos, int lane) {
    const int j = lane & 15, hf = j >> 3, jj = j & 7; const float pos = hf ? colpos : rowpos; const float sgn = jj < 4 ? -1.f : 1.f; const int i0 = 8 * (jj & 3);
#pragma unroll
    for (int e = 0; e < 8; ++e) { const float pv = __shfl_xor(f[e], 4); float sn, cs; sincos_rev(pos * rope_inv(i0 + e), sn, cs); f[e] = f[e] * cs + sgn * pv * sn; }
}
__device__ __forceinline__ void post1_row(const Args& a, int layer, bf16_t* P, int tseq, int lane) {
    float f[8];
    const float sA = 0.125f * LOG2E, sC = 0.08838834764831845f * LOG2E;
    load8(P + PC_AQ + 8 * lane, f); norm8<8>(f, a.in[I_AQN] + layer * 64, sA, lane); store8(P + PC_AQ + 8 * lane, f);
    load8(P + PC_AK + 8 * lane, f); norm8<8>(f, a.in[I_AKN] + layer * 64, 1.f, lane); store8(P + PC_AK + 8 * lane, f);
    load8(P + PC_BCQ + 8 * lane, f); norm8<64>(f, a.in[I_BCQN] + layer * 512, 1.f, lane); store8(P + PC_BCQ + 8 * lane, f);
    load8(P + PC_BCKV + 8 * lane, f); norm8<64>(f, a.in[I_BCKVN] + layer * 512, 1.f, lane); store8(P + PC_BCKV + 8 * lane, f);
    const float rowpos = (float)(tseq >> 6), colpos = (float)(tseq & 63);
    load8(P + PC_CQ + 8 * lane, f); norm8<16>(f, a.in[I_CQN] + layer * 128, sC, lane); axial_rope8(f, rowpos, colpos, lane); store8(P + PC_CQ + 8 * lane, f);
    { const int l2 = lane & 31; load8(P + PC_CK + 8 * l2, f); norm8<16>(f, a.in[I_CKN] + layer * 128, 1.f, lane); axial_rope8(f, rowpos, colpos, lane); if (lane < 32) store8(P + PC_CK + 8 * l2, f); }
#pragma unroll
    for (int p = 0; p < 3; ++p) { load8(P + PC_DQ + 512 * p + 8 * lane, f); norm8<16>(f, a.in[I_DQN] + layer * 128, sC, lane); store8(P + PC_DQ + 512 * p + 8 * lane, f); }
    load8(P + PC_DK + 8 * lane, f); norm8<16>(f, a.in[I_DKN] + layer * 128, 1.f, lane); store8(P + PC_DK + 8 * lane, f);
}
__device__ __forceinline__ void mla_norm_rope(float (&f)[8], float (&r)[4], const float* g, float scale, float pos, int lane) {
    const int j = lane & 15;
    float s = 0.f;
#pragma unroll
    for (int e = 0; e < 8; ++e) s += f[e] * f[e];
#pragma unroll
    for (int e = 0; e < 4; ++e) s += r[e] * r[e];
#pragma unroll
    for (int o = 1; o < 16; o <<= 1) s += __shfl_xor(s, o);
    const float rs = scale / sqrtf(s * (1.0f / 192.0f) + EPS);
#pragma unroll
    for (int e = 0; e < 8; ++e) f[e] = f[e] * rs * g[8 * j + e];
#pragma unroll
    for (int e = 0; e < 4; ++e) r[e] = r[e] * rs * g[128 + 4 * j + e];
    const float sgn = j < 8 ? -1.f : 1.f; const int i0 = 4 * (j & 7);
#pragma unroll
    for (int e = 0; e < 4; ++e) { const float pv = __shfl_xor(r[e], 8); float sn, cs; sincos_rev(pos * rope_inv(i0 + e), sn, cs); r[e] = r[e] * cs + sgn * pv * sn; }
}
__device__ __forceinline__ void post2_row(const Args& a, int layer, bf16_t* Q, bf16_t* Kr, const bf16_t* P, int tseq, int lane) {
    const int h = lane >> 4, j = lane & 15; const float pos = (float)tseq;
    float f[8], r[4];
    { bf16_t* q = Q + h * 192; load8(q + 8 * j, f); const u32x2 v = *(const u32x2*)(q + 128 + 4 * j); r[0] = bf_lo(v.x); r[1] = bf_hi(v.x); r[2] = bf_lo(v.y); r[3] = bf_hi(v.y);
      mla_norm_rope(f, r, a.in[I_BQN] + layer * 192, 0.07216878364870323f * LOG2E, pos, lane);
      store8(q + 8 * j, f); u32x2 w; w.x = cvt_pk_bf16(r[0], r[1]); w.y = cvt_pk_bf16(r[2], r[3]); *(u32x2*)(q + 128 + 4 * j) = w; }
    { bf16_t* k = Kr + h * 192; load8(k + 8 * j, f); const u32x2 v = *(const u32x2*)(P + PC_BKR + 4 * j); r[0] = bf_lo(v.x); r[1] = bf_hi(v.x); r[2] = bf_lo(v.y); r[3] = bf_hi(v.y);
      mla_norm_rope(f, r, a.in[I_BKN] + layer * 192, 1.f, pos, lane);
      store8(k + 8 * j, f); u32x2 w; w.x = cvt_pk_bf16(r[0], r[1]); w.y = cvt_pk_bf16(r[2], r[3]); *(u32x2*)(k + 128 + 4 * j) = w; }
}

struct AState { float m, l; f32x16 o[4]; };
__device__ __forceinline__ void astate_init(AState& st) { st.m = -3.0e38f; st.l = 0.f;
#pragma unroll
    for (int d = 0; d < 4; ++d)
#pragma unroll
        for (int r = 0; r < 16; ++r) st.o[d][r] = 0.f; }
template <int DK, bool TAB, bool QLDS = false>
__device__ __forceinline__ void attn_pass(AState& st, const bf16_t* qp, const bf16_t* kp, long ldk, const bf16_t* vp, long ldv, int kbeg, int kend, const float* tp, LAS bf16x8* qst = nullptr) {
    constexpr int NS = DK / 16;
    bf16x8 qf[QLDS ? 1 : NS], kf[NS];
    if (QLDS) {
#pragma unroll
        for (int s = 0; s < NS; ++s) qst[s * 64] = *(const bf16x8*)(qp + 16 * s);
    } else {
#pragma unroll
        for (int s = 0; s < NS; ++s) qf[s] = *(const bf16x8*)(qp + 16 * s);
    }
    { const bf16_t* k0p = kp + (long)kbeg * ldk;
#pragma unroll
      for (int s = 0; s < NS; ++s) kf[s] = *(const bf16x8*)(k0p + 16 * s); }
    for (int k0 = kbeg; k0 < kend; k0 += 32) {
        bf16x8 vf[4][2];
#pragma unroll
        for (int d = 0; d < 4; ++d)
#pragma unroll
            for (int s = 0; s < 2; ++s) vf[d][s] = *(const bf16x8*)(vp + (long)(32 * d) * ldv + k0 + 16 * s);
        f32x4 tb[4];
        if (TAB) {
#pragma unroll
            for (int s = 0; s < 2; ++s) { tb[2 * s] = *(const f32x4u*)(tp + k0 + 16 * s); tb[2 * s + 1] = *(const f32x4u*)(tp + k0 + 16 * s + 4); } }
        f32x16 sc;
#pragma unroll
        for (int r = 0; r < 16; ++r) sc[r] = 0.f;
#pragma unroll
        for (int s = 0; s < NS; ++s) sc = __builtin_amdgcn_mfma_f32_32x32x16_bf16(kf[s], QLDS ? qst[s * 64] : qf[QLDS ? 0 : s], sc, 0, 0, 0);
        if (k0 + 32 < kend) { const bf16_t* knp = kp + (long)(k0 + 32) * ldk;
#pragma unroll
            for (int s = 0; s < NS; ++s) kf[s] = *(const bf16x8*)(knp + 16 * s); }
        if (TAB) {
#pragma unroll
            for (int r = 0; r < 16; ++r) sc[r] += tb[r >> 2][r & 3]; }
        float mx = sc[0];
#pragma unroll
        for (int r = 1; r < 16; ++r) mx = fmaxf(mx, sc[r]);
        mx = fmaxf(mx, __shfl_xor(mx, 32));
        const float mn = fmaxf(st.m, mx);
        const float alpha = __builtin_amdgcn_exp2f(st.m - mn);
        st.m = mn;
        float ps = 0.f;
#pragma unroll
        for (int r = 0; r < 16; ++r) { sc[r] = __builtin_amdgcn_exp2f(sc[r] - mn); ps += sc[r]; }
        st.l = st.l * alpha + ps;
#pragma unroll
        for (int d = 0; d < 4; ++d)
#pragma unroll
            for (int r = 0; r < 16; ++r) st.o[d][r] *= alpha;
        u32x4 p0, p1;
        p0.x = cvt_pk_bf16(sc[0], sc[1]); p0.y = cvt_pk_bf16(sc[2], sc[3]); p0.z = cvt_pk_bf16(sc[4], sc[5]); p0.w = cvt_pk_bf16(sc[6], sc[7]);
        p1.x = cvt_pk_bf16(sc[8], sc[9]); p1.y = cvt_pk_bf16(sc[10], sc[11]); p1.z = cvt_pk_bf16(sc[12], sc[13]); p1.w = cvt_pk_bf16(sc[14], sc[15]);
        const bf16x8 pf0 = __builtin_bit_cast(bf16x8, p0), pf1 = __builtin_bit_cast(bf16x8, p1);
#pragma unroll
        for (int d = 0; d < 4; ++d) { st.o[d] = __builtin_amdgcn_mfma_f32_32x32x16_bf16(vf[d][0], pf0, st.o[d], 0, 0, 0); st.o[d] = __builtin_amdgcn_mfma_f32_32x32x16_bf16(vf[d][1], pf1, st.o[d], 0, 0, 0); }
    }
}
__device__ __forceinline__ void astate_finish(AState& st) {
    const float l = st.l + __shfl_xor(st.l, 32); const float inv = 1.0f / l;
#pragma unroll
    for (int d = 0; d < 4; ++d)
#pragma unroll
        for (int r = 0; r < 16; ++r) st.o[d][r] *= inv;
}
__device__ __forceinline__ void store_o(const f32x16 (&o)[4], bf16_t* op) {
#pragma unroll
    for (int d = 0; d < 4; ++d)
#pragma unroll
        for (int g = 0; g < 4; ++g) { u32x2 w; w.x = cvt_pk_bf16(o[d][4 * g], o[d][4 * g + 1]); w.y = cvt_pk_bf16(o[d][4 * g + 2], o[d][4 * g + 3]); *(u32x2*)(op + 32 * d + 8 * g) = w; }
}
__device__ __forceinline__ int pi32(int n) { return (n & ~12) | ((n & 4) << 1) | ((n & 8) >> 1); }

struct AttnBufs { const bf16_t* PROJ; const bf16_t* VT; const bf16_t* QB; const bf16_t* KB; const bf16_t* VTB; bf16_t* BR; const float* tabA; const float* tabD; };

__device__ __forceinline__ void attn_unit(const Args& a, const AttnBufs& B, int layer, int mixer, int head, int row0  , int S, int q0  , int lane, LAS float* stash) {
#define ATT_LANE_SETUP int ln_ = lane; asm volatile("" : "+v"(ln_)); const int n = ln_ & 31, hi = ln_ >> 5, pr = pi32(n); const long qrow = (long)row0 + q0 + n; bf16_t* op = B.BR + qrow * 2048 + 4 * hi;
#ifdef ONLY_MIXER
    mixer = ONLY_MIXER;
#endif
    if (mixer == 0) {
        ATT_LANE_SETUP
        const float lam_init = layer == 0 ? 0.2f : 0.35550906759f;
        const float d1 = wave_sum(a.in[I_ALQ1][layer * 64 + lane] * a.in[I_ALK1][layer * 64 + lane]);
        const float d2 = wave_sum(a.in[I_ALQ2][layer * 64 + lane] * a.in[I_ALK2][layer * 64 + lane]);
        const float lam = expf(d1) - expf(d2) + lam_init;
        const bf16_t* vp = B.VT + (long)(head * 128 + n) * TCM + row0 + 8 * hi;
        const float* tp = B.tabA + head * TABA_N + TABA_OFF - (q0 + n) + 8 * hi;
        { AState st; astate_init(st);
          attn_pass<64, true>(st, B.PROJ + qrow * NP + PC_AQ + head * 128 + 8 * hi, B.PROJ + (long)(row0 + pr) * NP + PC_AK + head * 128 + 8 * hi, NP, vp, TCM, 0, S, tp);
          astate_finish(st);
#pragma unroll
          for (int d = 0; d < 4; ++d)
#pragma unroll
              for (int r = 0; r < 16; ++r) stash[(d * 16 + r) * 64 + lane] = st.o[d][r]; }
        AState st; astate_init(st);
        attn_pass<64, true>(st, B.PROJ + qrow * NP + PC_AQ + head * 128 + 64 + 8 * hi, B.PROJ + (long)(row0 + pr) * NP + PC_AK + head * 128 + 64 + 8 * hi, NP, vp, TCM, 0, S, tp);
        astate_finish(st);
        float ss = 0.f;
#pragma unroll
        for (int d = 0; d < 4; ++d)
#pragma unroll
            for (int r = 0; r < 16; ++r) { const float v = stash[(d * 16 + r) * 64 + lane] - lam * st.o[d][r]; st.o[d][r] = v; ss += v * v; }
        ss += __shfl_xor(ss, 32);
        const float rs = (1.0f - lam_init) / sqrtf(ss * (1.0f / 128.0f) + EPS);
        const float* gn = a.in[I_AON] + layer * 128 + 4 * hi;
#pragma unroll
        for (int d = 0; d < 4; ++d)
#pragma unroll
            for (int g = 0; g < 4; ++g) { const f32x4 gg = *(const f32x4*)(gn + 32 * d + 8 * g);
#pragma unroll
                for (int e = 0; e < 4; ++e) st.o[d][4 * g + e] *= rs * gg[e]; }
        store_o(st.o, op + head * 128);
    } else if (mixer == 1) {
        ATT_LANE_SETUP
        AState st; astate_init(st);
        attn_pass<192, false, true>(st, B.QB + qrow * 768 + head * 192 + 8 * hi, B.KB + (long)(row0 + pr) * 768 + head * 192 + 8 * hi, 768,
                              B.VTB + (long)(head * 128 + n) * TCM + row0 + 8 * hi, TCM, 0, S, nullptr, (LAS bf16x8*)stash + lane);
        astate_finish(st); store_o(st.o, op + 512 + head * 128);
    } else if (mixer == 2) {
        ATT_LANE_SETUP
        const int kv = head >> 1;
        AState st; astate_init(st);
        attn_pass<128, false>(st, B.PROJ + qrow * NP + PC_CQ + head * 128 + 8 * hi, B.PROJ + (long)(row0 + pr) * NP + PC_CK + kv * 128 + 8 * hi, NP,
                              B.VT + (long)(512 + kv * 128 + n) * TCM + row0 + 8 * hi, TCM, 0, S, nullptr);
        astate_finish(st); store_o(st.o, op + 1024 + head * 128);
    } else {
        ATT_LANE_SETUP
        AState st; astate_init(st);
        const bf16_t* kp = B.PROJ + (long)(row0 + pr) * NP + PC_DK + head * 128 + 8 * hi;
        const bf16_t* vp = B.VT + (long)(768 + head * 128 + n) * TCM + row0 + 8 * hi;
#pragma unroll 1
        for (int g = 0; g < 3; ++g) { const int W = g == 0 ? 64 : (g == 1 ? 256 : 1024);
            const int kb = q0 - W > 0 ? q0 - W : 0, ke = q0 + 32 + W < S ? q0 + 32 + W : S;
            attn_pass<128, true>(st, B.PROJ + qrow * NP + PC_DQ + (g * 4 + head) * 128 + 8 * hi, kp, NP, vp, TCM, kb, ke, B.tabD + (g * 4 + head) * TABD_N + TABD_OFF - (q0 + n) + 8 * hi); }
        astate_finish(st); store_o(st.o, op + 1536 + head * 128);
    }
}
__device__ __forceinline__ void attn_phase(const Args& a, const AttnBufs& B, int layer, int chunk, unsigned* ctr, int lane, LAS float* stash) {
    const int npr = chunk == 0 ? 1 : 0, nsm = chunk == 0 ? 4 : 12, TC = chunk == 0 ? 16384 : 24576;
    const int nP = npr * 1024, nS = nsm * 256, nD = TC / 8, total = 3 * nP + 3 * nS + nD;
    for (;;) {
        unsigned uu = 0; if (lane == 0) uu = atomicAdd(ctr, 1u);
        int u = __builtin_amdgcn_readfirstlane((int)uu);
        if (u >= total) break;
        int mixer, head, row0, S, q0;
        if (u < 3 * nP) { mixer = u / nP; const int r = u % nP; q0 = (r % 256) * 32; head = r / 256; row0 = 0; S = TP; }
        else { u -= 3 * nP;
            if (u < 3 * nS) { mixer = u / nS; const int r = u % nS; q0 = (r % 64) * 32; head = (r / 64) % 4; row0 = npr * TP + (r / 256) * SS; S = SS; }
            else { u -= 3 * nS; mixer = 3; const int qb = u % (TC / 32); head = u / (TC / 32); const int q = qb * 32;
                if (npr && q < TP) { row0 = 0; S = TP; } else { row0 = npr * TP + ((q - npr * TP) / SS) * SS; S = SS; }
                q0 = q - row0; } }
#ifdef ONLY_MIXER
        if (mixer != ONLY_MIXER) continue;
#endif
        attn_unit(a, B, layer, mixer, head, row0, S, q0, lane, stash);
    }
}


constexpr int A2_RSV = 144, A2_BUFSZ = 64 * 400 + 128 * A2_RSV;
static_assert(2 * A2_BUFSZ <= 131072 && 2 * A2_BUFSZ >= 65536, "attention LDS");

template <int NS, int RSK, bool USETAB>
__device__ __forceinline__ void a2_tile(AState& st, LAS unsigned char* bb, int kfo, int vfo, const bf16x8 (&qf)[NS], const float* tpk, float iv) {
#define A2_SB() __builtin_amdgcn_sched_barrier(0x0124)
    f32x4 tb[8];
    if (USETAB) {
#pragma unroll
        for (int s = 0; s < 4; ++s) { tb[2 * s] = *(const f32x4u*)(tpk + 16 * s); tb[2 * s + 1] = *(const f32x4u*)(tpk + 16 * s + 4); } }
    f32x16 ini, sc0, sc1;
#pragma unroll
    for (int r = 0; r < 16; ++r) ini[r] = iv;
    u32x4 pw[4];
    float mx = -3.0e38f, ps = 0.f;
#pragma unroll
    for (int s = 0; s < NS; ++s) { const bf16x8 kf0 = *(const LAS bf16x8*)(bb + kfo + 32 * s); sc0 = __builtin_amdgcn_mfma_f32_32x32x16_bf16(kf0, qf[s], s == 0 ? ini : sc0, 0, 0, 0); }
    A2_SB();
#pragma unroll
    for (int s = 0; s < NS; ++s) {
        const bf16x8 kf1 = *(const LAS bf16x8*)(bb + kfo + 32 * RSK + 32 * s);
        sc1 = __builtin_amdgcn_mfma_f32_32x32x16_bf16(kf1, qf[s], s == 0 ? ini : sc1, 0, 0, 0);
        A2_SB();
#pragma unroll
        for (int pp = (8 * s) / NS; pp < (8 * (s + 1)) / NS; ++pp) {
            float x0 = sc0[2 * pp], x1 = sc0[2 * pp + 1];
            if (USETAB) { x0 += tb[(2 * pp) >> 2][(2 * pp) & 3]; x1 += tb[(2 * pp + 1) >> 2][(2 * pp + 1) & 3]; }
            mx = fmaxf(mx, fmaxf(x0, x1));
            const float e0 = __builtin_amdgcn_exp2f(x0), e1 = __builtin_amdgcn_exp2f(x1);
            ps += e0 + e1; pw[pp >> 2][pp & 3] = cvt_pk_bf16(e0, e1); }
        A2_SB();
    }
    {
        const bf16x8 pf0 = __builtin_bit_cast(bf16x8, pw[0]), pf1 = __builtin_bit_cast(bf16x8, pw[1]);
#pragma unroll
        for (int i = 0; i < 8; ++i) { const int h = i >> 2, d = i & 3;
            const bf16x8 v = *(const LAS bf16x8*)(bb + vfo + (32 * d) * A2_RSV + 32 * h);
            st.o[d] = __builtin_amdgcn_mfma_f32_32x32x16_bf16(v, h ? pf1 : pf0, st.o[d], 0, 0, 0);
            A2_SB();
            { const int pp = i; float x0 = sc1[2 * pp], x1 = sc1[2 * pp + 1];
              if (USETAB) { x0 += tb[4 + ((2 * pp) >> 2)][(2 * pp) & 3]; x1 += tb[4 + ((2 * pp + 1) >> 2)][(2 * pp + 1) & 3]; }
              mx = fmaxf(mx, fmaxf(x0, x1));
              const float e0 = __builtin_amdgcn_exp2f(x0), e1 = __builtin_amdgcn_exp2f(x1);
              ps += e0 + e1; pw[2 + (pp >> 2)][pp & 3] = cvt_pk_bf16(e0, e1); }
            A2_SB(); }
    }
    {
        const bf16x8 pf2 = __builtin_bit_cast(bf16x8, pw[2]), pf3 = __builtin_bit_cast(bf16x8, pw[3]);
#pragma unroll
        for (int i = 0; i < 8; ++i) { const int h = i >> 2, d = i & 3;
            const bf16x8 v = *(const LAS bf16x8*)(bb + vfo + (32 * d) * A2_RSV + 64 + 32 * h);
            st.o[d] = __builtin_amdgcn_mfma_f32_32x32x16_bf16(v, h ? pf3 : pf2, st.o[d], 0, 0, 0); }
    }
    st.l += ps;
    mx = fmaxf(mx, __shfl_xor(mx, 32));
    if (__any(mx > 8.0f)) {
        const float dm = fmaxf(mx, 0.f); const float alpha = __builtin_amdgcn_exp2f(-dm); st.m += dm; st.l *= alpha;
#pragma unroll
        for (int d = 0; d < 4; ++d)
#pragma unroll
            for (int r = 0; r < 16; ++r) st.o[d][r] *= alpha;
    }
#undef A2_SB
}
template <int DKL, int DK, bool TAB, bool FARC = false>
__device__ __forceinline__ void attn2_pass(AState& st, LAS unsigned char* buf, const bf16_t* qp, int koff, const bf16_t* Kg, long ldk, const bf16_t* Vg, long ldv,
                                           int kbeg, int kend, const float* tp, int wlo, int whi, int tid_in, int lane, int qw = 0, float cneg = 0.f, float cpos = 0.f) {
    constexpr int NS = DK / 16, PR = DKL / 8, NKP = DKL / 64, RSK = DKL * 2 + 16, KBYTES = 64 * RSK;
    int tid = tid_in; asm volatile("" : "+v"(tid));
    const int n = lane & 31, hi = lane >> 5, pr = pi32(n);
    bf16x8 qf[NS];
#pragma unroll
    for (int s = 0; s < NS; ++s) qf[s] = *(const bf16x8*)(qp + 16 * s);
    u32x4 kreg[NKP], vreg[2];
    int krow[NKP], kc[NKP];
#pragma unroll
    for (int i = 0; i < NKP; ++i) { const int p = tid + 512 * i; krow[i] = p / PR; kc[i] = p % PR; }
#define A2_GLOAD(k0_) do { _Pragma("unroll") for (int i = 0; i < NKP; ++i) kreg[i] = *(const u32x4*)(Kg + (long)((k0_) + krow[i]) * ldk + 8 * kc[i]); \
        _Pragma("unroll") for (int i = 0; i < 2; ++i) { const int p = tid + 512 * i; vreg[i] = *(const u32x4*)(Vg + (long)(p >> 3) * ldv + (k0_) + 8 * (p & 7)); } } while (0)
#define A2_LSTORE(b_) do { _Pragma("unroll") for (int i = 0; i < NKP; ++i) *(LAS u32x4*)(buf + (b_) * A2_BUFSZ + krow[i] * RSK + kc[i] * 16) = kreg[i]; \
        _Pragma("unroll") for (int i = 0; i < 2; ++i) { const int p = tid + 512 * i; *(LAS u32x4*)(buf + (b_) * A2_BUFSZ + KBYTES + (p >> 3) * A2_RSV + (p & 7) * 16) = vreg[i]; } } while (0)
    A2_GLOAD(kbeg); A2_LSTORE(0); __syncthreads();
    int b = 0;
    const int kfo = pr * RSK + koff + hi * 16, vfo = KBYTES + n * A2_RSV + hi * 16;
    if (st.m < -1.0e38f) {
        f32x16 sc;
#pragma unroll
        for (int r = 0; r < 16; ++r) sc[r] = 0.f;
#pragma unroll
        for (int s = 0; s < NS; ++s) { const bf16x8 kf0 = *(const LAS bf16x8*)(buf + kfo + 32 * s); sc = __builtin_amdgcn_mfma_f32_32x32x16_bf16(kf0, qf[s], sc, 0, 0, 0); }
        float mx = sc[0];
#pragma unroll
        for (int r = 1; r < 16; ++r) mx = fmaxf(mx, sc[r]);
        mx = fmaxf(mx, __shfl_xor(mx, 32));
        st.m = fmaxf(mx, -60.0f);
    }
    for (int k0 = kbeg; k0 < kend; k0 += 64) {
        const bool more = k0 + 64 < kend;
        if (more) A2_GLOAD(k0 + 64);
        LAS unsigned char* bb = buf + b * A2_BUFSZ;
        if (!(k0 + 64 <= wlo || k0 >= whi)) {
            float iv = -st.m; bool usetab = TAB;
            if (FARC) { if (k0 + 63 - qw <= -576) { iv += cneg; usetab = false; } else if (k0 - qw - 31 >= 576) { iv += cpos; usetab = false; } }
            if (TAB && usetab) a2_tile<NS, RSK, true>(st, bb, kfo, vfo, qf, tp + k0, iv);
            else a2_tile<NS, RSK, false>(st, bb, kfo, vfo, qf, tp, iv);
        }
        if (more) A2_LSTORE(b ^ 1);
        __syncthreads();
        b ^= 1;
    }
#undef A2_GLOAD
#undef A2_LSTORE
}

__device__ __forceinline__ void attn2_unit(const Args& a, const AttnBufs& B, int layer, int mixer, int head, int row0, int S, int q0, int tid, int lane, int wave, LAS unsigned char* buf) {
#ifdef ONLY_MIXER2
    mixer = ONLY_MIXER2;
#endif
    if (mixer == 0) {
        int ln_ = lane; asm volatile("" : "+v"(ln_)); const int n = ln_ & 31, hi = ln_ >> 5;
        const int half = wave >> 2, qw = q0 + 32 * (wave & 3); const long qrow = (long)row0 + qw + n;
        const float lam_init = layer == 0 ? 0.2f : 0.35550906759f;
        AState st; astate_init(st);
        attn2_pass<128, 64, true, true>(st, buf, B.PROJ + qrow * NP + PC_AQ + head * 128 + 64 * half + 8 * hi, 128 * half, B.PROJ + (long)row0 * NP + PC_AK + head * 128, NP,
                                  B.VT + (long)(head * 128) * TCM + row0, TCM, 0, S, B.tabA + head * TABA_N + TABA_OFF - (qw + n) + 8 * hi, 0, S, tid, ln_,
                                  qw, B.tabA[head * TABA_N + TABA_OFF - 700], B.tabA[head * TABA_N + TABA_OFF + 700]);
        astate_finish(st);
        LAS float* xb = (LAS float*)buf + (wave & 3) * 4096;
        if (half == 1) {
#pragma unroll
            for (int d = 0; d < 4; ++d)
#pragma unroll
                for (int r = 0; r < 16; ++r) xb[(d * 16 + r) * 64 + ln_] = st.o[d][r]; }
        __syncthreads();
        if (half == 0) {
            const float d1 = wave_sum(a.in[I_ALQ1][layer * 64 + ln_] * a.in[I_ALK1][layer * 64 + ln_]);
            const float d2 = wave_sum(a.in[I_ALQ2][layer * 64 + ln_] * a.in[I_ALK2][layer * 64 + ln_]);
            const float lam = expf(d1) - expf(d2) + lam_init;
            float ss = 0.f;
#pragma unroll
            for (int d = 0; d < 4; ++d)
#pragma unroll
                for (int r = 0; r < 16; ++r) { const float v = st.o[d][r] - lam * xb[(d * 16 + r) * 64 + ln_]; st.o[d][r] = v; ss += v * v; }
            ss += __shfl_xor(ss, 32);
            const float rs = (1.0f - lam_init) / sqrtf(ss * (1.0f / 128.0f) + EPS);
            const float* gn = a.in[I_AON] + layer * 128 + 4 * hi;
#pragma unroll
            for (int d = 0; d < 4; ++d)
#pragma unroll
                for (int g = 0; g < 4; ++g) { const f32x4 gg = *(const f32x4*)(gn + 32 * d + 8 * g);
#pragma unroll
                    for (int e = 0; e < 4; ++e) st.o[d][4 * g + e] *= rs * gg[e]; }
            store_o(st.o, B.BR + qrow * 2048 + 4 * hi + head * 128);
        }
    } else if (mixer == 1) {
        int ln_ = lane; asm volatile("" : "+v"(ln_)); const int n = ln_ & 31, hi = ln_ >> 5;
        const int qw = q0 + 32 * wave; const long qrow = (long)row0 + qw + n;
        AState st; astate_init(st);
        attn2_pass<192, 192, false>(st, buf, B.QB + qrow * 768 + head * 192 + 8 * hi, 0, B.KB + (long)row0 * 768 + head * 192, 768,
                                    B.VTB + (long)(head * 128) * TCM + row0, TCM, 0, S, nullptr, 0, S, tid, ln_);
        astate_finish(st); store_o(st.o, B.BR + qrow * 2048 + 4 * hi + 512 + head * 128);
    } else if (mixer == 2) {
        int ln_ = lane; asm volatile("" : "+v"(ln_)); const int n = ln_ & 31, hi = ln_ >> 5;
        const int qw = q0 + 32 * wave; const long qrow = (long)row0 + qw + n; const int kv = head >> 1;
        AState st; astate_init(st);
        attn2_pass<128, 128, false>(st, buf, B.PROJ + qrow * NP + PC_CQ + head * 128 + 8 * hi, 0, B.PROJ + (long)row0 * NP + PC_CK + kv * 128, NP,
                                    B.VT + (long)(512 + kv * 128) * TCM + row0, TCM, 0, S, nullptr, 0, S, tid, ln_);
        astate_finish(st); store_o(st.o, B.BR + qrow * 2048 + 4 * hi + 1024 + head * 128);
    } else {
        int ln_ = lane; asm volatile("" : "+v"(ln_)); const int n = ln_ & 31, hi = ln_ >> 5;
        const int qw = q0 + 32 * wave; const long qrow = (long)row0 + qw + n;
        AState st; astate_init(st);
#pragma unroll 1
        for (int g = 0; g < 3; ++g) { const int W = g == 0 ? 64 : (g == 1 ? 256 : 1024);
            const int kb = q0 - W > 0 ? q0 - W : 0, ke = q0 + 256 + W < S ? q0 + 256 + W : S;
            attn2_pass<128, 128, true>(st, buf, B.PROJ + qrow * NP + PC_DQ + (g * 4 + head) * 128 + 8 * hi, 0, B.PROJ + (long)row0 * NP + PC_DK + head * 128, NP,
                                       B.VT + (long)(768 + head * 128) * TCM + row0, TCM, kb, ke, B.tabD + (g * 4 + head) * TABD_N + TABD_OFF - (qw + n) + 8 * hi, qw - W, qw + 32 + W, tid, ln_); }
        astate_finish(st); store_o(st.o, B.BR + qrow * 2048 + 4 * hi + 1536 + head * 128);
    }
}
__device__ __forceinline__ void attn2_phase(const Args& a, const AttnBufs& B, int layer, int chunk, unsigned* ctr, int tid, int lane, int wave, LAS unsigned char* lds) {
    const int npr = chunk == 0 ? 1 : 0, nsm = chunk == 0 ? 4 : 12, TC = chunk == 0 ? 16384 : 24576;
    const int c0 = npr * 128, c1 = npr * 128, c2 = npr * 256, c3 = TC / 64, c4 = nsm * 32, c5 = nsm * 32, c6 = nsm * 64;
    const int total = c0 + c1 + c2 + c3 + c4 + c5 + c6;
    volatile LAS int* uw = (volatile LAS int*)(lds + 131072);
    for (;;) {
        __syncthreads();
        if (tid == 0) *uw = (int)atomicAdd(ctr, 1u);
        __syncthreads();
        int u = __builtin_amdgcn_readfirstlane(*uw);
        if (u >= total) break;
        int mixer, head, row0, S, q0;
        if (u < c0 + c1 + c2) { row0 = 0; S = TP;
            if (u < c0) { mixer = 1; q0 = (u % 32) * 256; head = u / 32; }
            else if (u < c0 + c1) { u -= c0; mixer = 2; q0 = (u % 32) * 256; head = u / 32; }
            else { u -= c0 + c1; mixer = 0; q0 = (u % 64) * 128; head = u / 64; }
        } else { u -= c0 + c1 + c2;
            if (u < c3) { mixer = 3; const int nb = TC / 256; const int q = (u % nb) * 256; head = u / nb;
                if (npr && q < TP) { row0 = 0; S = TP; } else { row0 = npr * TP + ((q - npr * TP) / SS) * SS; S = SS; }
                q0 = q - row0; }
            else { u -= c3; S = SS;
                if (u < c4) { mixer = 1; q0 = (u % 8) * 256; head = (u / 8) % 4; row0 = npr * TP + (u / 32) * SS; }
                else if (u < c4 + c5) { u -= c4; mixer = 2; q0 = (u % 8) * 256; head = (u / 8) % 4; row0 = npr * TP + (u / 32) * SS; }
                else { u -= c4 + c5; mixer = 0; q0 = (u % 16) * 128; head = (u / 16) % 4; row0 = npr * TP + (u / 64) * SS; } } }
        attn2_unit(a, B, layer, mixer, head, row0, S, q0, tid, lane, wave, lds);
    }
}


#define XB_TMO      128
#define XB_XCNT(j)  (256  + 64 * (j))
#define XB_XSUB(j)  (1280 + 64 * (j))
#define XB_XGEN(j)  (2304 + 64 * (j))
#define XB_TOP      3328
#define XB_TOPGEN   3392
#define XCD_BAR_WORDS 3456
#define XB_SPIN_CAP (1u << 22)
__device__ __forceinline__ unsigned xb_ld(unsigned* p)              { return __hip_atomic_load(p, __ATOMIC_RELAXED, __HIP_MEMORY_SCOPE_AGENT); }
__device__ __forceinline__ unsigned xb_add(unsigned* p, unsigned v) { return __hip_atomic_fetch_add(p, v, __ATOMIC_RELAXED, __HIP_MEMORY_SCOPE_AGENT); }
__device__ __forceinline__ unsigned xb_xcc_id() { return (unsigned)__builtin_amdgcn_s_getreg((3 << 11) | 20) & 0xFu; }
#define XB_SPIN(cond, bar) do { unsigned _sp = 0; while (cond) { __builtin_amdgcn_s_sleep(1); \
    if ((++_sp & 255u) == 0u) { if (xb_ld(&(bar)[XB_TMO])) break; if (_sp > XB_SPIN_CAP) { atomicAdd(&(bar)[XB_TMO], 1u); break; } } } } while (0)
struct XcdBarrier { unsigned* bar; unsigned x; volatile LAS unsigned* st; };
__device__ __forceinline__ XcdBarrier xcd_barrier_post(unsigned* bar, volatile LAS unsigned* st) {
    XcdBarrier b; b.bar = bar; b.x = xb_xcc_id(); b.st = st;
    if (threadIdx.x == 0) (void)xb_add(&bar[XB_XCNT(b.x)], 1u);
    return b;
}
__device__ __forceinline__ void xcd_barrier_complete(unsigned* bar, unsigned x, unsigned& nloc, unsigned& nx) {
    const unsigned G = gridDim.x * gridDim.y * gridDim.z;
    unsigned sum, cnt, mine, sp = 0u;
    for (;;) {
        sum = 0u; cnt = 0u; mine = 0u;
#pragma unroll
        for (unsigned j = 0; j < 16; ++j) { const unsigned c = xb_ld(&bar[XB_XCNT(j)]); sum += c; cnt += (c > 0u) ? 1u : 0u; mine = (j == x) ? c : mine; }
        if (sum == G) break;
        __builtin_amdgcn_s_sleep(1);
        if ((++sp & 255u) == 0u) { if (xb_ld(&bar[XB_TMO])) break; if (sp > XB_SPIN_CAP) { atomicAdd(&bar[XB_TMO], 1u); break; } }
    }
    nloc = mine > 0u ? mine : 1u; nx = cnt > 0u ? cnt : 1u;
}
__device__ __forceinline__ void xcd_barrier(const XcdBarrier& b) {
    asm volatile("s_waitcnt vmcnt(0)" ::: "memory");
    __syncthreads();
    if (threadIdx.x == 0) {
        unsigned* bar = b.bar;
        __builtin_amdgcn_s_waitcnt(0);
        unsigned nloc = b.st[0], nx = b.st[1];
        if (nloc == 0u) { xcd_barrier_complete(bar, b.x, nloc, nx); b.st[0] = nloc; b.st[1] = nx; }
        const unsigned old = xb_add(&bar[XB_XSUB(b.x)], 1u);
        const unsigned gen = old / nloc;
        if (old + 1u == (gen + 1u) * nloc) {
            __builtin_amdgcn_fence(__ATOMIC_RELEASE, "agent");
            asm volatile("s_waitcnt vmcnt(0)" ::: "memory");
            const unsigned og = xb_add(&bar[XB_TOP], 1u);
            const unsigned tg = og / nx;
            if (og + 1u == (tg + 1u) * nx) xb_add(&bar[XB_TOPGEN], 1u);
            else XB_SPIN(xb_ld(&bar[XB_TOPGEN]) == tg, bar);
            __builtin_amdgcn_fence(__ATOMIC_ACQUIRE, "agent");
            xb_add(&bar[XB_XGEN(b.x)], 1u);
            asm volatile("s_waitcnt vmcnt(0)" ::: "memory");
        } else {
            XB_SPIN(xb_ld(&bar[XB_XGEN(b.x)]) == gen, bar);
            __builtin_amdgcn_fence(__ATOMIC_ACQUIRE, "agent");
            asm volatile("s_waitcnt vmcnt(0)" ::: "memory");
        }
    }
    __syncthreads();
}

__global__ void __launch_bounds__(512, 2) mega(Args a) {
    extern __shared__ __attribute__((aligned(16))) unsigned char lds_raw[];
    LAS unsigned char* lds = (LAS unsigned char*)lds_raw;
    const int G = gridDim.x, bx = blockIdx.x;
    unsigned char* ws = a.ws;
    unsigned* ctl = (unsigned*)(ws + WS_CTL);
    float* tabA = (float*)(ws + WS_TABA); float* tabD = (float*)(ws + WS_TABD);
    unsigned char* W = ws + WS_W;
    bf16_t* H = (bf16_t*)(ws + WS_H);
    bf16_t* PROJ = (bf16_t*)(ws + WS_R1 + R1_PROJ); bf16_t* VT = (bf16_t*)(ws + WS_R1 + R1_VT); bf16_t* QB = (bf16_t*)(ws + WS_R1 + R1_QB);
    bf16_t* KB = (bf16_t*)(ws + WS_R1 + R1_KB); bf16_t* VTB = (bf16_t*)(ws + WS_R1 + R1_VTB);
    bf16_t* Y = (bf16_t*)(ws + WS_R1); bf16_t* FFH = (bf16_t*)(ws + WS_R1);
    bf16_t* BR = (bf16_t*)(ws + WS_R2); float* PART = (float*)(ws + WS_R2); bf16_t* U = (bf16_t*)(ws + WS_R2);
    bf16_t* MERGED = (bf16_t*)(ws + WS_R3); bf16_t* P16 = (bf16_t*)(ws + WS_R2 + 100 * MiB);
    float* ssA = (float*)(ws + WS_SS); float* ssB = ssA + TCM;
    cg::grid_group grid = cg::this_grid();
    volatile LAS unsigned* bst = (volatile LAS unsigned*)(lds + 131072 + 64);
    if (threadIdx.x < 2) bst[threadIdx.x] = 0u;
    __syncthreads();
    XcdBarrier xbar = xcd_barrier_post(ctl + 1024, bst);

    for (int pid = a.ph_lo; pid < a.ph_hi; ++pid) {
        int tid = threadIdx.x; asm volatile("" : "+v"(tid));
        const int lane = tid & 63, wave = __builtin_amdgcn_readfirstlane(tid >> 6);
        const int gw = bx * 8 + wave, ngw = G * 8;
        const int layer = pid / 25, q = pid % 25;
        if (q == 0) {
            if (layer == 0) build_tables(a.in[I_RELB], tabA, tabD, bx * 512 + tid, G * 512);
#ifndef NO_CONV
            convert_weights(a, layer, W, (LAS float*)(lds + wave * 16384), gw, ngw, lane);
#endif
        } else {
            const int chunk = (q - 1) / 12, kidx = (q - 1) % 12; const int k = kidx < 9 ? kidx + 1 : (kidx == 9 ? 11 : (kidx == 10 ? 12 : 15));
            const int m0 = chunk == 0 ? 0 : 16384, TC = chunk == 0 ? 16384 : 24576, nMt = TC / 256;
            const float* xs0 = layer == 0 ? a.in[I_XP] : a.out; const float* xs1 = layer == 0 ? a.in[I_XS] : a.out + (size_t)TP * DM;
#ifdef NO_ROWS
            if (0) {
#else
            if (k == 1) {
#endif
                const float* g = a.in[I_NMIX] + layer * DM;
                for (int r = gw; r < TC; r += ngw) { const int m = m0 + r; norm_row(xrow_ptr(xs0, xs1, m), g, H + (size_t)r * DM, lane);
                    const float* pr = m < TP ? a.in[I_PP] + ((size_t)layer * TP + m) * 256 : a.in[I_PS] + ((size_t)layer * 32768 + (m - TP)) * 256;
                    const f32x4 v = *(const f32x4*)(pr + 4 * lane); u32x2 w; w.x = cvt_pk_bf16(v[0], v[1]); w.y = cvt_pk_bf16(v[2], v[3]); *(u32x2*)(P16 + (size_t)r * 256 + 4 * lane) = w;
                    if (lane == 0) { ssA[r] = 0.f; ssB[r] = 0.f; } }
#ifdef NO_ROWS
            } else if (0) {
#else
            } else if (k == 3 || k == 5) {
#endif
                for (int r = gw; r < TC; r += ngw) { const int m = m0 + r; const int tseq = m < TP ? m : (m - TP) % SS;
                    if (k == 3) post1_row(a, layer, PROJ + (size_t)r * NP, tseq, lane);
                    else post2_row(a, layer, QB + (size_t)r * 768, KB + (size_t)r * 768, PROJ + (size_t)r * NP, tseq, lane); }
            } else if (k == 6) {
                AttnBufs B{PROJ, VT, QB, KB, VTB, BR, tabA, tabD};
#ifndef NO_ATTN
                #if ATTN_V2
                attn2_phase(a, B, layer, chunk, ctl + 64 * (layer * 2 + chunk), tid, lane, wave, lds);
#else
                attn_phase(a, B, layer, chunk, ctl + 64 * (layer * 2 + chunk), lane, (LAS float*)(lds + wave * 16384));
#endif
#endif
            } else {
                const int njobs = (k == 2 || k == 11) ? 2 : (k == 4 ? 3 : 1);
                int coff = 0;
                for (int j = 0; j < njobs; ++j) {
                    pg8::Gemm g; pg8::Epi E; int nM = nMt, nN = 8, rep = 1, adiv = 1 << 30; long astep = 0;
                    E.kind = pg8::EK_BF16; E.O = nullptr; E.ldc = 0; E.Y = nullptr; E.part = nullptr; E.xs0 = xs0; E.xs1 = xs1; E.xout = a.out; E.m0 = m0; E.Hout = nullptr; E.ssq = nullptr; E.rsq = nullptr;
                    g.A = H; g.Bt = (const bf16_t*)(W + WO_IN); g.lda = 2048; g.ldb = 2048; g.K = 2048;
                    if (k == 2 && j == 0) { nN = NP / 256; E.O = PROJ; E.ldc = NP; }
                    else if (k == 2) { g.A = (const bf16_t*)(W + WO_INV); g.Bt = H; nM = NVT / 256; nN = nMt; E.O = VT; E.ldc = TCM; }
                    else if (k == 4 && j == 0) { g.A = PROJ + PC_BCQ; g.lda = NP; g.Bt = (const bf16_t*)(W + WO_UQ); g.ldb = 512; g.K = 512; nN = 3; E.O = QB; E.ldc = 768; }
                    else if (k == 4 && j == 1) { g.A = PROJ + PC_BCKV; g.lda = NP; g.Bt = (const bf16_t*)(W + WO_UKN); g.ldb = 512; g.K = 512; nN = 2; E.kind = pg8::EK_SPLIT192; E.O = KB; E.ldc = 768; }
                    else if (k == 4) { g.A = (const bf16_t*)(W + WO_UKV); g.lda = 512; g.Bt = PROJ + PC_BCKV; g.ldb = NP; g.K = 512; nM = 2; nN = nMt; E.O = VTB; E.ldc = TCM; }
                    else if (k == 7) { g.A = BR; g.Bt = (const bf16_t*)(W + WO_B); g.ldb = 512; g.K = 512; nN = 32; adiv = 8; astep = 1024; E.O = Y; E.ldc = 8192; }
                    else if (k == 8) { g.Bt = (const bf16_t*)(W + WO_G); nN = 32; E.kind = pg8::EK_GATE; E.O = MERGED; E.Y = Y; }
                    else if (k == 9) { g.A = MERGED; g.Bt = (const bf16_t*)(W + WO_O); E.kind = pg8::EK_RES; E.Hout = H; E.ssq = ssA; }
                    else if (k == 11 && j == 0) { g.Bt = (const bf16_t*)(W + WO_1); nN = 32; E.kind = pg8::EK_RELU2; E.O = FFH; E.ldc = 8192; E.rsq = ssA; }
                    else if (k == 11) { g.A = P16; g.lda = 256; g.Bt = (const bf16_t*)(W + WO_PP); g.ldb = 256; g.K = 256; E.O = U; E.ldc = 2048; }
                    else if (k == 12) { g.A = FFH; g.lda = 8192; g.Bt = (const bf16_t*)(W + WO_2); g.ldb = 8192; g.K = 8192; E.kind = pg8::EK_RES; E.xs0 = a.out; E.xs1 = a.out + (size_t)TP * DM; E.Hout = H; E.ssq = ssB; }
                    else { g.Bt = (const bf16_t*)(W + WO_PG); E.kind = pg8::EK_PLE; E.Y = U; E.xs0 = a.out; E.xs1 = a.out + (size_t)TP * DM; E.rsq = ssB; }
                    pg8::Order S; S.init(nM, nN, G, (bx + G - coff) % G, rep, adiv, astep);
#ifndef NO_GEMM
                    pg8::gemm_phase<true>(lds, g, S, E, tid);
#endif
                    coff = (coff + (nM * nN) % G) % G;
                }
            }
        }
        if (pid + 1 < a.ph_hi) { if (pid == a.ph_lo) grid.sync(); else xcd_barrier(xbar); }
    }
}

extern "C" void kernel_launch(void* const* d_in, const int* in_sizes, int n_in, void* d_out, int out_size, void* d_ws, size_t ws_size, hipStream_t stream) {
    static int grid = 0;
    if (grid == 0) {
        if (n_in != 33 || out_size != TALL * DM || ws_size < WS_END) { fprintf(stderr, "kernel_launch: unexpected shapes (n_in %d out %d ws %zu need %zu)\n", n_in, out_size, ws_size, (size_t)WS_END); grid = -1; return; }
        int dev = 0, cus = 0, per_cu = 0;
        hipGetDevice(&dev); hipDeviceGetAttribute(&cus, hipDeviceAttributeMultiprocessorCount, dev);
        if (hipFuncSetAttribute((const void*)mega, hipFuncAttributeMaxDynamicSharedMemorySize, LDS_BYTES) != hipSuccess) { fprintf(stderr, "kernel_launch: hipFuncSetAttribute failed\n"); grid = -1; return; }
        if (hipOccupancyMaxActiveBlocksPerMultiprocessor(&per_cu, (const void*)mega, 512, LDS_BYTES) != hipSuccess || per_cu < 1) per_cu = 1;
        (void)hipGetLastError();
        grid = cus * per_cu;
        if (grid <= 0) grid = 256;
    }
    if (grid < 0) return;
    hipMemsetAsync((char*)d_ws + WS_CTL, 0, 32768, stream);
    Args a{};
    for (int i = 0; i < 33; ++i) a.in[i] = (const float*)d_in[i];
    a.out = (float*)d_out; a.ws = (unsigned char*)d_ws;
    constexpr int NPH = 50;
#if COOP
    a.ph_lo = 0; a.ph_hi = NPH;
    void* args[] = {&a};
    hipError_t e = hipLaunchCooperativeKernel((const void*)mega, dim3(grid), dim3(512), args, LDS_BYTES, stream);
    if (e != hipSuccess) fprintf(stderr, "cooperative launch failed: %s (grid %d)\n", hipGetErrorString(e), grid);
#else
    for (int p = 0; p < NPH; ++p) { a.ph_lo = p; a.ph_hi = p + 1; hipLaunchKernelGGL(mega, dim3(grid), dim3(512), LDS_BYTES, stream, a); }
#endif
}
```

```cpp
#include <hip/hip_runtime.h>
#include <hip/hip_cooperative_groups.h>
#include <cstdio>
#include <cstdint>
namespace cg = cooperative_groups;

#ifndef COOP
#define COOP 1
#endif
#ifndef ATTN_V2
#define ATTN_V2 1
#endif

#define LAS __attribute__((address_space(3)))
typedef unsigned short bf16_t;
typedef short bf16x8 __attribute__((ext_vector_type(8)));
typedef float f32x4 __attribute__((ext_vector_type(4)));
typedef float f32x16 __attribute__((ext_vector_type(16)));
typedef unsigned u32x4 __attribute__((ext_vector_type(4)));
typedef unsigned u32x2 __attribute__((ext_vector_type(2)));
typedef float f32x4u __attribute__((ext_vector_type(4), aligned(4)));

constexpr int DM = 2048, TALL = 40960, TP = 8192, SS = 2048;
constexpr int NP = 5120;
constexpr int TCM = 24576;
constexpr int NVT = 1280;
constexpr int DFF = 8192;
constexpr int PC_AQ = 0, PC_AK = 512, PC_BCQ = 1024, PC_BCKV = 1536, PC_CQ = 2048, PC_CK = 2560, PC_DQ = 2816, PC_DK = 4352, PC_BKR = 4864;
constexpr float LOG2E = 1.4426950408889634f;
constexpr float EPS = 1e-6f;
constexpr int TABA_N = 16384, TABA_OFF = 8192, TABD_N = 2304, TABD_OFF = 1152;

constexpr size_t MiB = 1u << 20;
constexpr size_t WS_CTL = 0;
constexpr size_t WS_TABA = 64 * 1024;
constexpr size_t WS_TABD = 384 * 1024;
constexpr size_t WS_SS = 512 * 1024;
constexpr size_t WS_W = 1 * MiB;
constexpr size_t WO_IN = 0;
constexpr size_t WO_INV = WO_IN + (size_t)NP * 2048 * 2;
constexpr size_t WO_G = WO_INV + (size_t)NVT * 2048 * 2;
constexpr size_t WO_B = WO_G + (size_t)8192 * 2048 * 2;
constexpr size_t WO_O = WO_B + (size_t)8192 * 512 * 2;
constexpr size_t WO_1 = WO_O + (size_t)2048 * 2048 * 2;
constexpr size_t WO_2 = WO_1 + (size_t)8192 * 2048 * 2;
constexpr size_t WO_PG = WO_2 + (size_t)2048 * 8192 * 2;
constexpr size_t WO_PP = WO_PG + (size_t)2048 * 2048 * 2;
constexpr size_t WO_UQ = WO_PP + (size_t)2048 * 256 * 2;
constexpr size_t WO_UKN = WO_UQ + (size_t)768 * 512 * 2;
constexpr size_t WO_UKV = WO_UKN + (size_t)512 * 512 * 2;
constexpr size_t WO_END = WO_UKV + (size_t)512 * 512 * 2;
static_assert(WO_END <= 148 * MiB, "weights");
constexpr size_t WS_H = WS_W + 148 * MiB;
constexpr size_t WS_R1 = WS_H + (size_t)TCM * 2048 * 2;
constexpr size_t R1_PROJ = 0;
constexpr size_t R1_VT = R1_PROJ + (size_t)TCM * NP * 2;
constexpr size_t R1_QB = R1_VT + (size_t)NVT * TCM * 2;
constexpr size_t R1_KB = R1_QB + (size_t)TCM * 768 * 2;
constexpr size_t R1_VTB = R1_KB + (size_t)TCM * 768 * 2;
constexpr size_t R1_END = R1_VTB + (size_t)512 * TCM * 2;
static_assert(R1_END >= (size_t)TCM * 8192 * 2, "Y / FFH overlay");
constexpr size_t WS_R2 = WS_R1 + R1_END;
constexpr size_t WS_XB = WS_R2 + (size_t)TCM * 2048 * 4;
constexpr size_t WS_SSP = WS_XB + (size_t)TALL * 2048 * 2;
constexpr size_t WS_END = WS_SSP + 2 * (size_t)TCM * 32 * 4;

constexpr int LDS_BYTES = 147456;

typedef float f32x2_t __attribute__((ext_vector_type(2))); typedef __bf16 bf16x2_t __attribute__((ext_vector_type(2)));
__device__ __forceinline__ unsigned cvt_pk_bf16(float lo, float hi) { f32x2_t v = {lo, hi}; bf16x2_t b = __builtin_convertvector(v, bf16x2_t); return __builtin_bit_cast(unsigned, b); }
__device__ __forceinline__ float bf_lo(unsigned u) { return __uint_as_float(u << 16); }
__device__ __forceinline__ float bf_hi(unsigned u) { return __uint_as_float(u & 0xffff0000u); }
__device__ __forceinline__ float wave_sum(float v) {
#pragma unroll
    for (int o = 1; o < 64; o <<= 1) v += __shfl_xor(v, o);
    return v;
}
__device__ __forceinline__ float sigmoidf_fast(float x) { return __builtin_amdgcn_rcpf(1.0f + __builtin_amdgcn_exp2f(-x * LOG2E)); }
__device__ __forceinline__ const float* xrow_ptr(const float* s0, const float* s1, int m) { return m < TP ? s0 + (size_t)m * DM : s1 + (size_t)(m - TP) * DM; }

namespace pg8 {
constexpr int BM = 256, BK = 64, HALF = 128, HTB = HALF * BK * 2, STAGE_BYTES = 8 * HTB, NXCD = 8, WGM = 8;
__host__ __device__ __forceinline__ int lds_byte(int r, int c) { const int st = (r >> 4) * 2 + (c >> 5), rr = r & 15, cc = c & 31, ob = rr * 64 + cc * 2; return st * 1024 + (ob ^ (((ob >> 9) & 1) << 5)); }
__host__ __device__ __forceinline__ void stage_rc(int b, int& R, int& C) { const int st = b / 1024, sb = b % 1024, swz = sb ^ (((sb >> 9) & 1) << 5); R = (st >> 1) * 16 + swz / 64; C = (st & 1) * 32 + (swz % 64) / 2; }
__host__ __device__ __forceinline__ int perm32(int rho) { const int n = rho >> 4, i = rho & 15; return 8 * (i >> 2) + 4 * n + (i & 3); }

struct Unit { int pm, pn; long aoff; };
struct Gemm { const bf16_t* A; const bf16_t* Bt; int lda, ldb, K; };

struct Order {
    int nM, nN, nwg, G, c, rep, adiv; long astep;
    __device__ void init(int nM_, int nN_, int G_, int c_, int rep_, int adiv_, long astep_) { nM = nM_; nN = nN_; nwg = nM * nN; G = G_; c = c_; rep = rep_; adiv = adiv_; astep = astep_; }
    __device__ bool next(int i, Unit& u) const {
        const int t = i / rep, sub = i - t * rep;
        const long L = (long)t * G + c; if (L >= nwg) return false;
        int wgid = (int)L; { const int q = nwg / NXCD, r = nwg % NXCD, xcd = wgid % NXCD, off = wgid / NXCD; wgid = (xcd < r ? xcd * (q + 1) : r * (q + 1) + (xcd - r) * q) + off; }
        const int nig = WGM * nN, gid = wgid / nig, fm = gid * WGM, gsz = (nM - fm) < WGM ? (nM - fm) : WGM;
        u.pm = fm + ((wgid % nig) % gsz); const int pn = (wgid % nig) / gsz; u.pn = pn + sub * nN; u.aoff = (long)(pn / adiv) * astep; return true;
    }
};

__device__ __forceinline__ float row_rs(const float* p, int fq) {
    const f32x4 v0 = *(const f32x4*)(p + 8 * fq), v1 = *(const f32x4*)(p + 8 * fq + 4);
    float t = ((v0[0] + v0[1]) + (v0[2] + v0[3])) + ((v1[0] + v1[1]) + (v1[2] + v1[3]));
    t += __shfl_xor(t, 16); t += __shfl_xor(t, 32);
    return 1.0f / sqrtf(t * (1.0f / 2048.0f) + EPS);
}
enum { EK_BF16 = 0, EK_SPLIT192 = 1, EK_RELU2 = 2, EK_GATE = 3, EK_RES = 4, EK_PLE = 5 };
struct Epi {
    static constexpr bool PERM = true;
    int kind; bf16_t* O; long ldc; const bf16_t* Y;
    const bf16_t* xin; bf16_t* xob; float* xof; float* ssq; const float* rsq;
    __device__ __forceinline__ void operator()(const f32x4 (&acc)[2][2][4][2], const Unit& u, int wr, int wc, int fr, int fq) const {
        const int row0 = u.pm * BM + wr * 64 + fr, col0 = u.pn * BM + wc * 32 + 8 * fq;
        if (kind <= EK_RELU2) {
            float rsv[2][4];
#pragma unroll
            for (int ai = 0; ai < 2; ++ai)
#pragma unroll
                for (int m = 0; m < 4; ++m) rsv[ai][m] = (kind == EK_RELU2) ? row_rs(rsq + (size_t)(row0 + ai * HALF + m * 16) * 32, fq) : 1.f;
#pragma unroll
            for (int ai = 0; ai < 2; ++ai)
#pragma unroll
                for (int m = 0; m < 4; ++m) { const int row = row0 + ai * HALF + m * 16; const float rs = rsv[ai][m];
#pragma unroll
                    for (int bj = 0; bj < 2; ++bj) { int col = col0 + bj * HALF; f32x4 v0 = acc[ai][bj][m][0], v1 = acc[ai][bj][m][1];
                        if (kind == EK_RELU2) {
#pragma unroll
                            for (int e = 0; e < 4; ++e) { float a = fmaxf(v0[e], 0.f) * rs, b = fmaxf(v1[e], 0.f) * rs; v0[e] = a * a; v1[e] = b * b; } }
                        if (kind == EK_SPLIT192) col = (col >> 7) * 192 + (col & 127);
                        u32x4 w; w.x = cvt_pk_bf16(v0[0], v0[1]); w.y = cvt_pk_bf16(v0[2], v0[3]); w.z = cvt_pk_bf16(v1[0], v1[1]); w.w = cvt_pk_bf16(v1[2], v1[3]);
                        *(u32x4*)(O + (size_t)row * ldc + col) = w; } }
        } else if (kind == EK_GATE) {
            const int oc = u.pn * 64 + wc * 16 + 4 * fq;
#pragma unroll
            for (int ai = 0; ai < 2; ++ai) {
                u32x2 yv[4][4];
#pragma unroll
                for (int m = 0; m < 4; ++m) { const bf16_t* yp = Y + (size_t)(row0 + ai * HALF + m * 16) * 8192 + oc;
#pragma unroll
                    for (int b = 0; b < 4; ++b) yv[m][b] = *(const u32x2*)(yp + b * 2048); }
#pragma unroll
                for (int m = 0; m < 4; ++m) { const int row = row0 + ai * HALF + m * 16;
                    f32x4 r = (f32x4){0.f, 0.f, 0.f, 0.f};
#pragma unroll
                    for (int b = 0; b < 4; ++b) { const u32x2 y = yv[m][b]; const f32x4 v = acc[ai][b >> 1][m][b & 1];
                        r[0] += sigmoidf_fast(v[0]) * bf_lo(y.x); r[1] += sigmoidf_fast(v[1]) * bf_hi(y.x); r[2] += sigmoidf_fast(v[2]) * bf_lo(y.y); r[3] += sigmoidf_fast(v[3]) * bf_hi(y.y); }
                    u32x2 w; w.x = cvt_pk_bf16(r[0], r[1]); w.y = cvt_pk_bf16(r[2], r[3]);
                    *(u32x2*)(O + (size_t)row * 2048 + oc) = w; }
            }
        } else {
#pragma unroll
            for (int aq = 0; aq < 4; ++aq) { const int ai = aq >> 1, mb = (aq & 1) * 2;
                u32x4 xv[4][2], yv[4][2]; float rsv[4];
#pragma unroll
                for (int m = mb; m < mb + 2; ++m) { const int row = row0 + ai * HALF + m * 16;
                    rsv[m] = (kind == EK_PLE) ? row_rs(rsq + (size_t)row * 32, fq) : 1.f;
#pragma unroll
                    for (int bj = 0; bj < 2; ++bj) { const int col = col0 + bj * HALF; xv[m][bj] = *(const u32x4*)(xin + (size_t)row * DM + col);
                        if (kind == EK_PLE) yv[m][bj] = *(const u32x4*)(Y + (size_t)row * 2048 + col); } }
#pragma unroll
                for (int m = mb; m < mb + 2; ++m) { const int row = row0 + ai * HALF + m * 16; const float rs = rsv[m]; float sq = 0.f;
#pragma unroll
                    for (int bj = 0; bj < 2; ++bj) { const int col = col0 + bj * HALF; f32x4 v0 = acc[ai][bj][m][0], v1 = acc[ai][bj][m][1];
                        const u32x4 xb = xv[m][bj];
                        if (kind == EK_PLE) { const u32x4 y = yv[m][bj]; v0 = v0 * rs; v1 = v1 * rs;
                            v0[0] = sigmoidf_fast(v0[0]) * bf_lo(y.x); v0[1] = sigmoidf_fast(v0[1]) * bf_hi(y.x); v0[2] = sigmoidf_fast(v0[2]) * bf_lo(y.y); v0[3] = sigmoidf_fast(v0[3]) * bf_hi(y.y);
                            v1[0] = sigmoidf_fast(v1[0]) * bf_lo(y.z); v1[1] = sigmoidf_fast(v1[1]) * bf_hi(y.z); v1[2] = sigmoidf_fast(v1[2]) * bf_lo(y.w); v1[3] = sigmoidf_fast(v1[3]) * bf_hi(y.w); }
                        f32x4 n0, n1;
                        n0[0] = bf_lo(xb.x) + v0[0]; n0[1] = bf_hi(xb.x) + v0[1]; n0[2] = bf_lo(xb.y) + v0[2]; n0[3] = bf_hi(xb.y) + v0[3];
                        n1[0] = bf_lo(xb.z) + v1[0]; n1[1] = bf_hi(xb.z) + v1[1]; n1[2] = bf_lo(xb.w) + v1[2]; n1[3] = bf_hi(xb.w) + v1[3];
                        if (xof) { *(f32x4*)(xof + (size_t)row * DM + col) = n0; *(f32x4*)(xof + (size_t)row * DM + col + 4) = n1; }
                        else { u32x4 w; w.x = cvt_pk_bf16(n0[0], n0[1]); w.y = cvt_pk_bf16(n0[2], n0[3]); w.z = cvt_pk_bf16(n1[0], n1[1]); w.w = cvt_pk_bf16(n1[2], n1[3]);
                            *(u32x4*)(xob + (size_t)row * DM + col) = w; }
                        if (ssq) sq += (n0[0] * n0[0] + n0[1] * n0[1]) + (n0[2] * n0[2] + n0[3] * n0[3]) + (n1[0] * n1[0] + n1[1] * n1[1]) + (n1[2] * n1[2] + n1[3] * n1[3]); }
                    if (ssq) { sq += __shfl_xor(sq, 16); sq += __shfl_xor(sq, 32); if (fq == 0) ssq[(size_t)row * 32 + u.pn * 4 + wc] = sq; } }
            }
        }
    }
};

template <bool ALIGN_EPI = true>
__device__ __forceinline__ void gemm_phase(LAS unsigned char* lds, const Gemm g, const Order& S, const Epi& E, const int tid) {
    const int wid = __builtin_amdgcn_readfirstlane(tid >> 6), lane = tid & 63, wr = wid >> 2, wc = wid & 3, fr = lane & 15, fq = lane >> 4;
    const int K = g.K, nt = K / BK;
    unsigned voffA[2], voffB[2];
#pragma unroll
    for (int i = 0; i < 2; ++i) { int R, C; stage_rc(tid * 16 + i * 8192, R, C); const int Rb = Epi::PERM ? ((R & ~31) + perm32(R & 31)) : R;
        voffA[i] = (unsigned)(R * g.lda + C) * 2u; voffB[i] = (unsigned)(Rb * g.ldb + C) * 2u; }
    const size_t kstep = (size_t)(BK * 2);
    const size_t hstA = (size_t)HALF * g.lda * 2, hstB = (size_t)HALF * g.ldb * 2;
    const size_t tstA = 2 * hstA, tstB = 2 * hstB;
    const unsigned ldsw = (unsigned)wid * 1024u;
    const int aoff = lds_byte(wr * 64 + fr, fq * 8), boff = lds_byte(wc * 32 + fr, fq * 8);
#define PG8_SA(b, h) (((b) * 2 + (h)) * HTB)
#define PG8_SB(b, h) ((4 + (b) * 2 + (h)) * HTB)
#define PG8_STAGE(bufoff, gbase, voff) do { _Pragma("unroll") for (int _i = 0; _i < 2; ++_i) \
        __builtin_amdgcn_global_load_lds((const unsigned*)((const char*)(gbase) + (voff)[_i]), (LAS unsigned*)(lds + (bufoff) + ldsw + _i * 8192), 16, 0, 0); } while (0)
#define PG8_LDA(dst, b, h) do { _Pragma("unroll") for (int m = 0; m < 4; ++m) _Pragma("unroll") for (int k = 0; k < 2; ++k) dst[m][k] = *(const LAS bf16x8*)(lds + PG8_SA(b, h) + aoff + m * 2048 + k * 1024); } while (0)
#define PG8_LDB(dst, b, h) do { _Pragma("unroll") for (int n = 0; n < 2; ++n) _Pragma("unroll") for (int k = 0; k < 2; ++k) dst[n][k] = *(const LAS bf16x8*)(lds + PG8_SB(b, h) + boff + n * 2048 + k * 1024); } while (0)
#define PG8_MMA(ai, bj, At, Bt) do { __builtin_amdgcn_s_setprio(1); _Pragma("unroll") for (int m = 0; m < 4; ++m) _Pragma("unroll") for (int n = 0; n < 2; ++n) _Pragma("unroll") for (int k = 0; k < 2; ++k) \
        acc[ai][bj][m][n] = __builtin_amdgcn_mfma_f32_16x16x32_bf16(Bt[n][k], At[m][k], acc[ai][bj][m][n], 0, 0, 0); __builtin_amdgcn_s_setprio(0); } while (0)
#define PG8_WAIT_V(n) asm volatile("s_waitcnt vmcnt(" #n ")" ::: "memory")
#define PG8_WAIT_L(n) asm volatile("s_waitcnt lgkmcnt(" #n ")" ::: "memory")
#define PG8_BAR __builtin_amdgcn_s_barrier()
#define PG8_SCHED __builtin_amdgcn_sched_barrier(0)
    Unit cur, nxt; int ui = 0;
    if (!S.next(0, cur)) return;
    f32x4 acc[2][2][4][2];
#pragma unroll
    for (int a = 0; a < 2; ++a)
#pragma unroll
        for (int b = 0; b < 2; ++b)
#pragma unroll
            for (int m = 0; m < 4; ++m)
#pragma unroll
                for (int n = 0; n < 2; ++n) acc[a][b][m][n] = (f32x4){0.f, 0.f, 0.f, 0.f};
    bf16x8 At[4][2], B0[2][2], B1[2][2];
    const char* cA = (const char*)g.A + (size_t)cur.pm * tstA + cur.aoff; const char* cB = (const char*)g.Bt + (size_t)cur.pn * tstB;
    PG8_STAGE(PG8_SB(0, 0), cB, voffB); PG8_STAGE(PG8_SB(0, 1), cB + hstB, voffB); PG8_STAGE(PG8_SA(0, 0), cA, voffA); PG8_STAGE(PG8_SA(0, 1), cA + hstA, voffA);
    if (wr == 1) PG8_BAR;
    PG8_WAIT_V(2); PG8_BAR;
    PG8_STAGE(PG8_SB(1, 0), cB + kstep, voffB); PG8_STAGE(PG8_SA(1, 0), cA + kstep, voffA); PG8_STAGE(PG8_SB(1, 1), cB + hstB + kstep, voffB);
    PG8_WAIT_V(6); PG8_BAR;
    for (;;) {
        const bool has_next = S.next(ui + 1, nxt);
        const char* nA = has_next ? (const char*)g.A + (size_t)nxt.pm * tstA + nxt.aoff : cA; const char* nB = has_next ? (const char*)g.Bt + (size_t)nxt.pn * tstB : cB;
        for (int t = 0; t < nt; t += 2) {
            const bool last = (t == nt - 2);
            const char* a1 = cA + (size_t)(t + 1) * kstep;
            const char* a2 = last ? nA : cA + (size_t)(t + 2) * kstep; const char* b2 = last ? nB : cB + (size_t)(t + 2) * kstep;
            const char* a3 = a2 + kstep; const char* b3 = b2 + kstep;
            PG8_LDB(B0, 0, 0); PG8_LDB(B1, 0, 1); PG8_SCHED; PG8_LDA(At, 0, 0); PG8_STAGE(PG8_SA(1, 1), a1 + hstA, voffA);
            PG8_WAIT_V(8); PG8_WAIT_L(0); PG8_BAR; PG8_MMA(0, 0, At, B0); PG8_MMA(0, 1, At, B1); PG8_BAR; PG8_SCHED;
            PG8_LDA(At, 0, 1); PG8_STAGE(PG8_SB(0, 0), b2, voffB); PG8_STAGE(PG8_SB(0, 1), b2 + hstB, voffB); PG8_STAGE(PG8_SA(0, 0), a2, voffA);
            PG8_WAIT_V(8); PG8_WAIT_L(0); PG8_BAR; PG8_MMA(1, 0, At, B0); PG8_MMA(1, 1, At, B1); PG8_BAR; PG8_SCHED;
            PG8_LDB(B0, 1, 0); PG8_LDB(B1, 1, 1); PG8_SCHED; PG8_LDA(At, 1, 0); PG8_STAGE(PG8_SA(0, 1), a2 + hstA, voffA);
            PG8_WAIT_V(8); PG8_WAIT_L(0); PG8_BAR; PG8_MMA(0, 0, At, B0); PG8_MMA(0, 1, At, B1); PG8_BAR; PG8_SCHED;
            PG8_LDA(At, 1, 1); PG8_STAGE(PG8_SB(1, 0), b3, voffB); PG8_STAGE(PG8_SB(1, 1), b3 + hstB, voffB); PG8_STAGE(PG8_SA(1, 0), a3, voffA);
            PG8_WAIT_V(8); PG8_WAIT_L(0); PG8_BAR; PG8_MMA(1, 0, At, B0); PG8_MMA(1, 1, At, B1); PG8_BAR; PG8_SCHED;
        }
        if constexpr (ALIGN_EPI) { if (wr == 0) PG8_BAR; }
        E(acc, cur, wr, wc, fr, fq);
        if (!has_next) break;
#pragma unroll
        for (int a = 0; a < 2; ++a)
#pragma unroll
            for (int b = 0; b < 2; ++b)
#pragma unroll
                for (int m = 0; m < 4; ++m)
#pragma unroll
                    for (int n = 0; n < 2; ++n) acc[a][b][m][n] = (f32x4){0.f, 0.f, 0.f, 0.f};
        cur = nxt; cA = nA; cB = nB; ++ui;
        if constexpr (ALIGN_EPI) { if (wr == 1) PG8_BAR; }
    }
    PG8_WAIT_V(0);
    if constexpr (!ALIGN_EPI) { if (wr == 0) PG8_BAR; }
    PG8_BAR;
#undef PG8_SA
#undef PG8_SB
#undef PG8_STAGE
#undef PG8_LDA
#undef PG8_LDB
#undef PG8_MMA
#undef PG8_WAIT_V
#undef PG8_WAIT_L
#undef PG8_BAR
#undef PG8_SCHED
}
}

struct Args { const float* in[33]; float* out; unsigned char* ws; int ph_lo, ph_hi; };
enum { I_XP = 0, I_XS, I_PP, I_PS, I_RELB, I_NMIX, I_WIN, I_AQN, I_AKN, I_ALQ1, I_ALK1, I_ALQ2, I_ALK2, I_AON, I_BCQN, I_BCKVN, I_BWUQ, I_BWUKV, I_BQN, I_BKN,
       I_CQN, I_CKN, I_DQN, I_DKN, I_WG, I_WB, I_WO, I_NFFN, I_W1, I_W2, I_NPLE, I_WPG, I_WPP };

__device__ __forceinline__ int rel_bucket(int rel) {
    const int n = rel < 0 ? -rel : rel;
    const float nf = (float)(n > 1 ? n : 1);
    int large = 8 + (int)(logf(nf / 8.0f) / 4.852030263919617f * 8.0f);
    large = large < 15 ? large : 15;
    return (rel > 0 ? 16 : 0) + (n < 8 ? n : large);
}
__device__ __forceinline__ void build_tables(const float* relb, float* tabA, float* tabD, int gtid, int gthreads) {
    for (int i = gtid; i < 4 * TABA_N; i += gthreads) { const int h = i / TABA_N, d = i % TABA_N - TABA_OFF; tabA[i] = relb[rel_bucket(d) * 16 + h] * LOG2E; }
    for (int i = gtid; i < 12 * TABD_N; i += gthreads) { const int gh = i / TABD_N, d = i % TABD_N - TABD_OFF; const int g = gh >> 2; const int dil = g == 0 ? 1 : (g == 1 ? 4 : 16);
        const int ad = d < 0 ? -d : d; const bool ok = (ad % dil == 0) && (ad <= 64 * dil);
        tabD[i] = ok ? relb[rel_bucket(d) * 16 + 4 + gh] * LOG2E : -1e30f; }
}
__device__ __forceinline__ void transpose_item(const float* W, int N, int k0, int n0, bf16_t* dst, int K, LAS float* scr, int lane, int gate_b = -1, const float* gsc = nullptr) {
#pragma unroll 8
    for (int i = 0; i < 32; ++i) { const int kk = 2 * i + (lane >> 5); float w = W[(size_t)(k0 + kk) * N + n0 + (lane & 31)]; if (gsc) w *= gsc[k0 + kk]; scr[kk * 33 + (lane & 31)] = w; }
    asm volatile("s_waitcnt lgkmcnt(0)" ::: "memory");
    const int c = lane & 7;
#pragma unroll
    for (int j = 0; j < 4; ++j) { const int n = (lane >> 3) + 8 * j; const LAS float* s = scr + (8 * c) * 33 + n;
        u32x4 o; o.x = cvt_pk_bf16(s[0 * 33], s[1 * 33]); o.y = cvt_pk_bf16(s[2 * 33], s[3 * 33]); o.z = cvt_pk_bf16(s[4 * 33], s[5 * 33]); o.w = cvt_pk_bf16(s[6 * 33], s[7 * 33]);
        size_t drow = (size_t)n;
        if (gate_b >= 0) { const int nn = n0 + n, j = nn & 63; drow = (size_t)((nn >> 6) * 256 + 128 * (gate_b >> 1) + 32 * (j >> 4) + 8 * ((j >> 2) & 3) + 4 * (gate_b & 1) + (j & 3)); }
        *(u32x4*)(dst + drow * K + k0 + 8 * c) = o; }
    asm volatile("s_waitcnt lgkmcnt(0)" ::: "memory");
}
__device__ __forceinline__ int win_row(int n0) {
    if (n0 < 512) return PC_AQ + n0;
    if (n0 < 1024) return PC_AK + (n0 - 512);
    if (n0 < 1536) return -(0 + (n0 - 1024) + 1);
    if (n0 < 2048) return PC_BCQ + (n0 - 1536);
    if (n0 < 2560) return PC_BCKV + (n0 - 2048);
    if (n0 < 2624) return PC_BKR + (n0 - 2560);
    if (n0 < 3136) return PC_CQ + (n0 - 2624);
    if (n0 < 3392) return PC_CK + (n0 - 3136);
    if (n0 < 3648) return -(512 + (n0 - 3392) + 1);
    if (n0 < 5184) return PC_DQ + (n0 - 3648);
    if (n0 < 5696) return PC_DK + (n0 - 5184);
    return -(768 + (n0 - 5696) + 1);
}
__device__ __forceinline__ void convert_weights(const Args& a, int layer, unsigned char* W, LAS float* scr, int gw, int ngw, int lane) {
    constexpr int I_IN = 32 * 194, I_G = 4 * 32 * 64, I_B = 4 * 8 * 64, I_O = 32 * 64, I_1 = 32 * 256, I_2 = 128 * 64, I_PG = 32 * 64, I_PPn = 4 * 64, I_UQ = 8 * 24, I_UKV = 8 * 32;
    constexpr int NIT = I_IN + I_G + I_B + I_O + I_1 + I_2 + I_PG + I_PPn + I_UQ + I_UKV;
    for (int it = gw; it < NIT; it += ngw) {
        int r = it;
        if (r < I_IN) { const int kb = r / 194, nb = r % 194; const int dr = win_row(nb * 32);
            bf16_t* dst = dr >= 0 ? (bf16_t*)(W + WO_IN) + (size_t)dr * 2048 : (bf16_t*)(W + WO_INV) + (size_t)(-dr - 1) * 2048;
            transpose_item(a.in[I_WIN] + (size_t)layer * 2048 * 6208, 6208, kb * 64, nb * 32, dst, 2048, scr, lane); continue; } r -= I_IN;
        if (r < I_G) { const int b = r / 2048, q = r % 2048, kb = q / 64, nb = q % 64;
            transpose_item(a.in[I_WG] + ((size_t)layer * 4 + b) * 2048 * 2048, 2048, kb * 64, nb * 32, (bf16_t*)(W + WO_G), 2048, scr, lane, b); continue; } r -= I_G;
        if (r < I_B) { const int b = r / 512, q = r % 512, kb = q / 64, nb = q % 64;
            transpose_item(a.in[I_WB] + ((size_t)layer * 4 + b) * 512 * 2048, 2048, kb * 64, nb * 32, (bf16_t*)(W + WO_B) + ((size_t)b * 2048 + nb * 32) * 512, 512, scr, lane); continue; } r -= I_B;
        if (r < I_O) { const int kb = r / 64, nb = r % 64;
            transpose_item(a.in[I_WO] + (size_t)layer * 2048 * 2048, 2048, kb * 64, nb * 32, (bf16_t*)(W + WO_O) + (size_t)(nb * 32) * 2048, 2048, scr, lane); continue; } r -= I_O;
        if (r < I_1) { const int kb = r / 256, nb = r % 256;
            transpose_item(a.in[I_W1] + (size_t)layer * 2048 * 8192, 8192, kb * 64, nb * 32, (bf16_t*)(W + WO_1) + (size_t)(nb * 32) * 2048, 2048, scr, lane, -1, a.in[I_NFFN] + layer * DM); continue; } r -= I_1;
        if (r < I_2) { const int kb = r / 64, nb = r % 64;
            transpose_item(a.in[I_W2] + (size_t)layer * 8192 * 2048, 2048, kb * 64, nb * 32, (bf16_t*)(W + WO_2) + (size_t)(nb * 32) * 8192, 8192, scr, lane); continue; } r -= I_2;
        if (r < I_PG) { const int kb = r / 64, nb = r % 64;
            transpose_item(a.in[I_WPG] + (size_t)layer * 2048 * 2048, 2048, kb * 64, nb * 32, (bf16_t*)(W + WO_PG) + (size_t)(nb * 32) * 2048, 2048, scr, lane, -1, a.in[I_NPLE] + layer * DM); continue; } r -= I_PG;
        if (r < I_PPn) { const int kb = r / 64, nb = r % 64;
            transpose_item(a.in[I_WPP] + (size_t)layer * 256 * 2048, 2048, kb * 64, nb * 32, (bf16_t*)(W + WO_PP) + (size_t)(nb * 32) * 256, 256, scr, lane); continue; } r -= I_PPn;
        if (r < I_UQ) { const int kb = r / 24, nb = r % 24;
            transpose_item(a.in[I_BWUQ] + (size_t)layer * 512 * 768, 768, kb * 64, nb * 32, (bf16_t*)(W + WO_UQ) + (size_t)(nb * 32) * 512, 512, scr, lane); continue; } r -= I_UQ;
        { const int kb = r / 32, nb = r % 32; const int n0 = nb * 32, h = n0 >> 8, j0 = n0 & 255;
            bf16_t* dst = j0 < 128 ? (bf16_t*)(W + WO_UKN) + (size_t)(h * 128 + j0) * 512 : (bf16_t*)(W + WO_UKV) + (size_t)(h * 128 + j0 - 128) * 512;
            transpose_item(a.in[I_BWUKV] + (size_t)layer * 512 * 1024, 1024, kb * 64, n0, dst, 512, scr, lane); }
    }
}

__device__ __forceinline__ void norm_row_bf(const bf16_t* x, const float* g, bf16_t* out, int lane) {
    f32x4 v[8]; float s = 0.f;
#pragma unroll
    for (int j = 0; j < 8; ++j) { const u32x2 u = *(const u32x2*)(x + 4 * lane + 256 * j); v[j][0] = bf_lo(u.x); v[j][1] = bf_hi(u.x); v[j][2] = bf_lo(u.y); v[j][3] = bf_hi(u.y);
        s += (v[j][0] * v[j][0] + v[j][1] * v[j][1]) + (v[j][2] * v[j][2] + v[j][3] * v[j][3]); }
    const float rs = 1.0f / sqrtf(wave_sum(s) * (1.0f / 2048.0f) + EPS);
#pragma unroll
    for (int j = 0; j < 8; ++j) { const f32x4 gg = *(const f32x4*)(g + 4 * lane + 256 * j);
        u32x2 w; w.x = cvt_pk_bf16(v[j][0] * rs * gg[0], v[j][1] * rs * gg[1]); w.y = cvt_pk_bf16(v[j][2] * rs * gg[2], v[j][3] * rs * gg[3]);
        *(u32x2*)(out + 4 * lane + 256 * j) = w; }
}
__device__ __forceinline__ void norm_row(const float* x, const float* g, bf16_t* out, int lane, bf16_t* xb) {
    f32x4 v[8]; float s = 0.f;
#pragma unroll
    for (int j = 0; j < 8; ++j) { v[j] = *(const f32x4*)(x + 4 * lane + 256 * j); s += (v[j][0] * v[j][0] + v[j][1] * v[j][1]) + (v[j][2] * v[j][2] + v[j][3] * v[j][3]);
        u32x2 w; w.x = cvt_pk_bf16(v[j][0], v[j][1]); w.y = cvt_pk_bf16(v[j][2], v[j][3]); *(u32x2*)(xb + 4 * lane + 256 * j) = w; }
    const float rs = 1.0f / sqrtf(wave_sum(s) * (1.0f / 2048.0f) + EPS);
#pragma unroll
    for (int j = 0; j < 8; ++j) { const f32x4 gg = *(const f32x4*)(g + 4 * lane + 256 * j);
        u32x2 w; w.x = cvt_pk_bf16(v[j][0] * rs * gg[0], v[j][1] * rs * gg[1]); w.y = cvt_pk_bf16(v[j][2] * rs * gg[2], v[j][3] * rs * gg[3]);
        *(u32x2*)(out + 4 * lane + 256 * j) = w; }
}
__device__ __forceinline__ void load8(const bf16_t* p, float (&f)[8]) { const u32x4 v = *(const u32x4*)p; f[0] = bf_lo(v.x); f[1] = bf_hi(v.x); f[2] = bf_lo(v.y); f[3] = bf_hi(v.y); f[4] = bf_lo(v.z); f[5] = bf_hi(v.z); f[6] = bf_lo(v.w); f[7] = bf_hi(v.w); }
__device__ __forceinline__ void store8(bf16_t* p, const float (&f)[8]) { u32x4 w; w.x = cvt_pk_bf16(f[0], f[1]); w.y = cvt_pk_bf16(f[2], f[3]); w.z = cvt_pk_bf16(f[4], f[5]); w.w = cvt_pk_bf16(f[6], f[7]); *(u32x4*)p = w; }
template <int GRP> __device__ __forceinline__ void norm8(float (&f)[8], const float* g, float scale, int lane) {
    float s = 0.f;
#pragma unroll
    for (int e = 0; e < 8; ++e) s += f[e] * f[e];
#pragma unroll
    for (int o = 1; o < GRP; o <<= 1) s += __shfl_xor(s, o);
    const float rs = scale / sqrtf(s * (1.0f / (GRP * 8)) + EPS);
    const int gi = (lane & (GRP - 1)) * 8;
#pragma unroll
    for (int e = 0; e < 8; ++e) f[e] = f[e] * rs * g[gi + e];
}
__device__ __forceinline__ float rope_inv(int i) { return __builtin_amdgcn_exp2f(-(float)i * (13.287712379549449f / 32.0f)) * 0.15915494309189535f; }
__device__ __forceinline__ void sincos_rev(float rev, float& sn, float& cs) { rev -= rintf(rev); sn = __builtin_amdgcn_sinf(rev); cs = __builtin_amdgcn_cosf(rev); }
__device__ __forceinline__ void axial_rope8(float (&f)[8], float rowpos, float colpos, int lane) {
    const int j = lane & 15, hf = j >> 3, jj = j & 7; const float pos = hf ? colpos : rowpos; const float sgn = jj < 4 ? -1.f : 1.f; const int i0 = 8 * (jj & 3);
#pragma unroll
    for (int e = 0; e < 8; ++e) { const float pv = __shfl_xor(f[e], 4); float sn, cs; sincos_rev(pos * rope_inv(i0 + e), sn, cs); f[e] = f[e] * cs + sgn * pv * sn; }
}
__device__ __forceinline__ void post1_row(const Args& a, int layer, bf16_t* P, int tseq, int lane) {
    float f[8];
    const float sA = 0.125f * LOG2E, sC = 0.08838834764831845f * LOG2E;
    load8(P + PC_AQ + 8 * lane, f); norm8<8>(f, a.in[I_AQN] + layer * 64, sA, lane); store8(P + PC_AQ + 8 * lane, f);
    load8(P + PC_AK + 8 * lane, f); norm8<8>(f, a.in[I_AKN] + layer * 64, 1.f, lane); store8(P + PC_AK + 8 * lane, f);
    load8(P + PC_BCQ + 8 * lane, f); norm8<64>(f, a.in[I_BCQN] + layer * 512, 1.f, lane); store8(P + PC_BCQ + 8 * lane, f);
    load8(P + PC_BCKV + 8 * lane, f); norm8<64>(f, a.in[I_BCKVN] + layer * 512, 1.f, lane); store8(P + PC_BCKV + 8 * lane, f);
    const float rowpos = (float)(tseq >> 6), colpos = (float)(tseq & 63);
    load8(P + PC_CQ + 8 * lane, f); norm8<16>(f, a.in[I_CQN] + layer * 128, sC, lane); axial_rope8(f, rowpos, colpos, lane); store8(P + PC_CQ + 8 * lane, f);
    { const int l2 = lane & 31; load8(P + PC_CK + 8 * l2, f); norm8<16>(f, a.in[I_CKN] + layer * 128, 1.f, lane); axial_rope8(f, rowpos, colpos, lane); if (lane < 32) store8(P + PC_CK + 8 * l2, f); }
#pragma unroll
    for (int p = 0; p < 3; ++p) { load8(P + PC_DQ + 512 * p + 8 * lane, f); norm8<16>(f, a.in[I_DQN] + layer * 128, sC, lane); store8(P + PC_DQ + 512 * p + 8 * lane, f); }
    load8(P + PC_DK + 8 * lane, f); norm8<16>(f, a.in[I_DKN] + layer * 128, 1.f, lane); store8(P + PC_DK + 8 * lane, f);
}
__device__ __forceinline__ void mla_norm_rope(float (&f)[8], float (&r)[4], const float* g, float scale, float pos, int lane) {
    const int j = lane & 15;
    float s = 0.f;
#pragma unroll
    for (int e = 0; e < 8; ++e) s += f[e] * f[e];
#pragma unroll
    for (int e = 0; e < 4; ++e) s += r[e] * r[e];
#pragma unroll
    for (int o = 1; o < 16; o <<= 1) s += __shfl_xor(s, o);
    const float rs = scale / sqrtf(s * (1.0f / 192.0f) + EPS);
#pragma unroll
    for (int e = 0; e < 8; ++e) f[e] = f[e] * rs * g[8 * j + e];
#pragma unroll
    for (int e = 0; e < 4; ++e) r[e] = r[e] * rs * g[128 + 4 * j + e];
    const float sgn = j < 8 ? -1.f : 1.f; const int i0 = 4 * (j & 7);
#pragma unroll
    for (int e = 0; e < 4; ++e) { const float pv = __shfl_xor(r[e], 8); float sn, cs; sincos_rev(pos * rope_inv(i0 + e), sn, cs); r[e] = r[e] * cs + sgn * pv * sn; }
}
__device__ __forceinline__ void post2_row(const Args& a, int layer, bf16_t* Q, bf16_t* Kr, const bf16_t* P, int tseq, int lane) {
    const int h = lane >> 4, j = lane & 15; const float pos = (float)tseq;
    float f[8], r[4];
    { bf16_t* q = Q + h * 192; load8(q + 8 * j, f); const u32x2 v = *(const u32x2*)(q + 128 + 4 * j); r[0] = bf_lo(v.x); r[1] = bf_hi(v.x); r[2] = bf_lo(v.y); r[3] = bf_hi(v.y);
      mla_norm_rope(f, r, a.in[I_BQN] + layer * 192, 0.07216878364870323f * LOG2E, pos, lane);
      store8(q + 8 * j, f); u32x2 w; w.x = cvt_pk_bf16(r[0], r[1]); w.y = cvt_pk_bf16(r[2], r[3]); *(u32x2*)(q + 128 + 4 * j) = w; }
    { bf16_t* k = Kr + h * 192; load8(k + 8 * j, f); const u32x2 v = *(const u32x2*)(P + PC_BKR + 4 * j); r[0] = bf_lo(v.x); r[1] = bf_hi(v.x); r[2] = bf_lo(v.y); r[3] = bf_hi(v.y);
      mla_norm_rope(f, r, a.in[I_BKN] + layer * 192, 1.f, pos, lane);
      store8(k + 8 * j, f); u32x2 w; w.x = cvt_pk_bf16(r[0], r[1]); w.y = cvt_pk_bf16(r[2], r[3]); *(u32x2*)(k + 128 + 4 * j) = w; }
}

struct AState { float m, l; f32x16 o[4]; };
__device__ __forceinline__ void astate_init(AState& st) { st.m = -3.0e38f; st.l = 0.f;
#pragma unroll
    for (int d = 0; d < 4; ++d)
#pragma unroll
        for (int r = 0; r < 16; ++r) st.o[d][r] = 0.f; }
template <int DK, bool TAB, bool QLDS = false>
__device__ __forceinline__ void attn_pass(AState& st, const bf16_t* qp, const bf16_t* kp, long ldk, const bf16_t* vp, long ldv, int kbeg, int kend, const float* tp, LAS bf16x8* qst = nullptr) {
    constexpr int NS = DK / 16;
    bf16x8 qf[QLDS ? 1 : NS], kf[NS];
    if (QLDS) {
#pragma unroll
        for (int s = 0; s < NS; ++s) qst[s * 64] = *(const bf16x8*)(qp + 16 * s);
    } else {
#pragma unroll
        for (int s = 0; s < NS; ++s) qf[s] = *(const bf16x8*)(qp + 16 * s);
    }
    { const bf16_t* k0p = kp + (long)kbeg * ldk;
#pragma unroll
      for (int s = 0; s < NS; ++s) kf[s] = *(const bf16x8*)(k0p + 16 * s); }
    for (int k0 = kbeg; k0 < kend; k0 += 32) {
        bf16x8 vf[4][2];
#pragma unroll
        for (int d = 0; d < 4; ++d)
#pragma unroll
            for (int s = 0; s < 2; ++s) vf[d][s] = *(const bf16x8*)(vp + (long)(32 * d) * ldv + k0 + 16 * s);
        f32x4 tb[4];
        if (TAB) {
#pragma unroll
            for (int s = 0; s < 2; ++s) { tb[2 * s] = *(const f32x4u*)(tp + k0 + 16 * s); tb[2 * s + 1] = *(const f32x4u*)(tp + k0 + 16 * s + 4); } }
        f32x16 sc;
#pragma unroll
        for (int r = 0; r < 16; ++r) sc[r] = 0.f;
#pragma unroll
        for (int s = 0; s < NS; ++s) sc = __builtin_amdgcn_mfma_f32_32x32x16_bf16(kf[s], QLDS ? qst[s * 64] : qf[QLDS ? 0 : s], sc, 0, 0, 0);
        if (k0 + 32 < kend) { const bf16_t* knp = kp + (long)(k0 + 32) * ldk;
#pragma unroll
            for (int s = 0; s < NS; ++s) kf[s] = *(const bf16x8*)(knp + 16 * s); }
        if (TAB) {
#pragma unroll
            for (int r = 0; r < 16; ++r) sc[r] += tb[r >> 2][r & 3]; }
        float mx = sc[0];
#pragma unroll
        for (int r = 1; r < 16; ++r) mx = fmaxf(mx, sc[r]);
        mx = fmaxf(mx, __shfl_xor(mx, 32));
        const float mn = fmaxf(st.m, mx);
        const float alpha = __builtin_amdgcn_exp2f(st.m - mn);
        st.m = mn;
        float ps = 0.f;
#pragma unroll
        for (int r = 0; r < 16; ++r) { sc[r] = __builtin_amdgcn_exp2f(sc[r] - mn); ps += sc[r]; }
        st.l = st.l * alpha + ps;
#pragma unroll
        for (int d = 0; d < 4; ++d)
#pragma unroll
            for (int r = 0; r < 16; ++r) st.o[d][r] *= alpha;
        u32x4 p0, p1;
        p0.x = cvt_pk_bf16(sc[0], sc[1]); p0.y = cvt_pk_bf16(sc[2], sc[3]); p0.z = cvt_pk_bf16(sc[4], sc[5]); p0.w = cvt_pk_bf16(sc[6], sc[7]);
        p1.x = cvt_pk_bf16(sc[8], sc[9]); p1.y = cvt_pk_bf16(sc[10], sc[11]); p1.z = cvt_pk_bf16(sc[12], sc[13]); p1.w = cvt_pk_bf16(sc[14], sc[15]);
        const bf16x8 pf0 = __builtin_bit_cast(bf16x8, p0), pf1 = __builtin_bit_cast(bf16x8, p1);
#pragma unroll
        for (int d = 0; d < 4; ++d) { st.o[d] = __builtin_amdgcn_mfma_f32_32x32x16_bf16(vf[d][0], pf0, st.o[d], 0, 0, 0); st.o[d] = __builtin_amdgcn_mfma_f32_32x32x16_bf16(vf[d][1], pf1, st.o[d], 0, 0, 0); }
    }
}
__device__ __forceinline__ void astate_finish(AState& st) {
    const float l = st.l + __shfl_xor(st.l, 32); const float inv = 1.0f / l;
#pragma unroll
    for (int d = 0; d < 4; ++d)
#pragma unroll
        for (int r = 0; r < 16; ++r) st.o[d][r] *= inv;
}
__device__ __forceinline__ void store_o(const f32x16 (&o)[4], bf16_t* op) {
#pragma unroll
    for (int d = 0; d < 4; ++d)
#pragma unroll
        for (int g = 0; g < 4; ++g) { u32x2 w; w.x = cvt_pk_bf16(o[d][4 * g], o[d][4 * g + 1]); w.y = cvt_pk_bf16(o[d][4 * g + 2], o[d][4 * g + 3]); *(u32x2*)(op + 32 * d + 8 * g) = w; }
}
__device__ __forceinline__ int pi32(int n) { return (n & ~12) | ((n & 4) << 1) | ((n & 8) >> 1); }

struct AttnBufs { const bf16_t* PROJ; const bf16_t* VT; const bf16_t* QB; const bf16_t* KB; const bf16_t* VTB; bf16_t* BR; const float* tabA; const float* tabD; };

__device__ __forceinline__ void attn_unit(const Args& a, const AttnBufs& B, int layer, int mixer, int head, int row0  , int S, int q0  , int lane, LAS float* stash) {
#define ATT_LANE_SETUP int ln_ = lane; asm volatile("" : "+v"(ln_)); const int n = ln_ & 31, hi = ln_ >> 5, pr = pi32(n); const long qrow = (long)row0 + q0 + n; bf16_t* op = B.BR + qrow * 2048 + 4 * hi;
#ifdef ONLY_MIXER
    mixer = ONLY_MIXER;
#endif
    if (mixer == 0) {
        ATT_LANE_SETUP
        const float lam_init = layer == 0 ? 0.2f : 0.35550906759f;
        const float d1 = wave_sum(a.in[I_ALQ1][layer * 64 + lane] * a.in[I_ALK1][layer * 64 + lane]);
        const float d2 = wave_sum(a.in[I_ALQ2][layer * 64 + lane] * a.in[I_ALK2][layer * 64 + lane]);
        const float lam = expf(d1) - expf(d2) + lam_init;
        const bf16_t* vp = B.VT + (long)(head * 128 + n) * TCM + row0 + 8 * hi;
        const float* tp = B.tabA + head * TABA_N + TABA_OFF - (q0 + n) + 8 * hi;
        { AState st; astate_init(st);
          attn_pass<64, true>(st, B.PROJ + qrow * NP + PC_AQ + head * 128 + 8 * hi, B.PROJ + (long)(row0 + pr) * NP + PC_AK + head * 128 + 8 * hi, NP, vp, TCM, 0, S, tp);
          astate_finish(st);
#pragma unroll
          for (int d = 0; d < 4; ++d)
#pragma unroll
              for (int r = 0; r < 16; ++r) stash[(d * 16 + r) * 64 + lane] = st.o[d][r]; }
        AState st; astate_init(st);
        attn_pass<64, true>(st, B.PROJ + qrow * NP + PC_AQ + head * 128 + 64 + 8 * hi, B.PROJ + (long)(row0 + pr) * NP + PC_AK + head * 128 + 64 + 8 * hi, NP, vp, TCM, 0, S, tp);
        astate_finish(st);
        float ss = 0.f;
#pragma unroll
        for (int d = 0; d < 4; ++d)
#pragma unroll
            for (int r = 0; r < 16; ++r) { const float v = stash[(d * 16 + r) * 64 + lane] - lam * st.o[d][r]; st.o[d][r] = v; ss += v * v; }
        ss += __shfl_xor(ss, 32);
        const float rs = (1.0f - lam_init) / sqrtf(ss * (1.0f / 128.0f) + EPS);
        const float* gn = a.in[I_AON] + layer * 128 + 4 * hi;
#pragma unroll
        for (int d = 0; d < 4; ++d)
#pragma unroll
            for (int g = 0; g < 4; ++g) { const f32x4 gg = *(const f32x4*)(gn + 32 * d + 8 * g);
#pragma unroll
                for (int e = 0; e < 4; ++e) st.o[d][4 * g + e] *= rs * gg[e]; }
        store_o(st.o, op + head * 128);
    } else if (mixer == 1) {
        ATT_LANE_SETUP
        AState st; astate_init(st);
        attn_pass<192, false, true>(st, B.QB + qrow * 768 + head * 192 + 8 * hi, B.KB + (long)(row0 + pr) * 768 + head * 192 + 8 * hi, 768,
                              B.VTB + (long)(head * 128 + n) * TCM + row0 + 8 * hi, TCM, 0, S, nullptr, (LAS bf16x8*)stash + lane);
        astate_finish(st); store_o(st.o, op + 512 + head * 128);
    } else if (mixer == 2) {
        ATT_LANE_SETUP
        const int kv = head >> 1;
        AState st; astate_init(st);
        attn_pass<128, false>(st, B.PROJ + qrow * NP + PC_CQ + head * 128 + 8 * hi, B.PROJ + (long)(row0 + pr) * NP + PC_CK + kv * 128 + 8 * hi, NP,
                              B.VT + (long)(512 + kv * 128 + n) * TCM + row0 + 8 * hi, TCM, 0, S, nullptr);
        astate_finish(st); store_o(st.o, op + 1024 + head * 128);
    } else {
        ATT_LANE_SETUP
        AState st; astate_init(st);
        const bf16_t* kp = B.PROJ + (long)(row0 + pr) * NP + PC_DK + head * 128 + 8 * hi;
        const bf16_t* vp = B.VT + (long)(768 + head * 128 + n) * TCM + row0 + 8 * hi;
#pragma unroll 1
        for (int g = 0; g < 3; ++g) { const int W = g == 0 ? 64 : (g == 1 ? 256 : 1024);
            const int kb = q0 - W > 0 ? q0 - W : 0, ke = q0 + 32 + W < S ? q0 + 32 + W : S;
            attn_pass<128, true>(st, B.PROJ + qrow * NP + PC_DQ + (g * 4 + head) * 128 + 8 * hi, kp, NP, vp, TCM, kb, ke, B.tabD + (g * 4 + head) * TABD_N + TABD_OFF - (q0 + n) + 8 * hi); }
        astate_finish(st); store_o(st.o, op + 1536 + head * 128);
    }
}
__device__ __forceinline__ void attn_phase(const Args& a, const AttnBufs& B, int layer, int chunk, unsigned* ctr, int lane, LAS float* stash) {
    const int npr = chunk == 0 ? 1 : 0, nsm = chunk == 0 ? 4 : 12, TC = chunk == 0 ? 16384 : 24576;
    const int nP = npr * 1024, nS = nsm * 256, nD = TC / 8, total = 3 * nP + 3 * nS + nD;
    for (;;) {
        unsigned uu = 0; if (lane == 0) uu = atomicAdd(ctr, 1u);
        int u = __builtin_amdgcn_readfirstlane((int)uu);
        if (u >= total) break;
        int mixer, head, row0, S, q0;
        if (u < 3 * nP) { mixer = u / nP; const int r = u % nP; q0 = (r % 256) * 32; head = r / 256; row0 = 0; S = TP; }
        else { u -= 3 * nP;
            if (u < 3 * nS) { mixer = u / nS; const int r = u % nS; q0 = (r % 64) * 32; head = (r / 64) % 4; row0 = npr * TP + (r / 256) * SS; S = SS; }
            else { u -= 3 * nS; mixer = 3; const int qb = u % (TC / 32); head = u / (TC / 32); const int q = qb * 32;
                if (npr && q < TP) { row0 = 0; S = TP; } else { row0 = npr * TP + ((q - npr * TP) / SS) * SS; S = SS; }
                q0 = q - row0; } }
#ifdef ONLY_MIXER
        if (mixer != ONLY_MIXER) continue;
#endif
        attn_unit(a, B, layer, mixer, head, row0, S, q0, lane, stash);
    }
}


constexpr int A2_RSV = 144, A2_BUFSZ = 64 * 400 + 128 * A2_RSV;
static_assert(2 * A2_BUFSZ <= 131072 && 2 * A2_BUFSZ >= 65536, "attention LDS");

template <int NS, int RSK, bool USETAB>
__device__ __forceinline__ void a2_tile(AState& st, LAS unsigned char* bb, int kfo, int vfo, const bf16x8 (&qf)[NS], const float* tpk, float iv) {
#define A2_SB() __builtin_amdgcn_sched_barrier(0x0124)
    f32x4 tb[8];
    if (USETAB) {
#pragma unroll
        for (int s = 0; s < 4; ++s) { tb[2 * s] = *(const f32x4u*)(tpk + 16 * s); tb[2 * s + 1] = *(const f32x4u*)(tpk + 16 * s + 4); } }
    f32x16 ini, sc0, sc1;
#pragma unroll
    for (int r = 0; r < 16; ++r) ini[r] = iv;
    u32x4 pw[4];
    float mx = -3.0e38f, ps = 0.f;
#pragma unroll
    for (int s = 0; s < NS; ++s) { const bf16x8 kf0 = *(const LAS bf16x8*)(bb + kfo + 32 * s); sc0 = __builtin_amdgcn_mfma_f32_32x32x16_bf16(kf0, qf[s], s == 0 ? ini : sc0, 0, 0, 0); }
    A2_SB();
#pragma unroll
    for (int s = 0; s < NS; ++s) {
        const bf16x8 kf1 = *(const LAS bf16x8*)(bb + kfo + 32 * RSK + 32 * s);
        sc1 = __builtin_amdgcn_mfma_f32_32x32x16_bf16(kf1, qf[s], s == 0 ? ini : sc1, 0, 0, 0);
        A2_SB();
#pragma unroll
        for (int pp = (8 * s) / NS; pp < (8 * (s + 1)) / NS; ++pp) {
            float x0 = sc0[2 * pp], x1 = sc0[2 * pp + 1];
            if (USETAB) { x0 += tb[(2 * pp) >> 2][(2 * pp) & 3]; x1 += tb[(2 * pp + 1) >> 2][(2 * pp + 1) & 3]; }
            mx = fmaxf(mx, fmaxf(x0, x1));
            const float e0 = __builtin_amdgcn_exp2f(x0), e1 = __builtin_amdgcn_exp2f(x1);
            ps += e0 + e1; pw[pp >> 2][pp & 3] = cvt_pk_bf16(e0, e1); }
        A2_SB();
    }
    {
        const bf16x8 pf0 = __builtin_bit_cast(bf16x8, pw[0]), pf1 = __builtin_bit_cast(bf16x8, pw[1]);
#pragma unroll
        for (int i = 0; i < 8; ++i) { const int h = i >> 2, d = i & 3;
            const bf16x8 v = *(const LAS bf16x8*)(bb + vfo + (32 * d) * A2_RSV + 32 * h);
            st.o[d] = __builtin_amdgcn_mfma_f32_32x32x16_bf16(v, h ? pf1 : pf0, st.o[d], 0, 0, 0);
            A2_SB();
            { const int pp = i; float x0 = sc1[2 * pp], x1 = sc1[2 * pp + 1];
              if (USETAB) { x0 += tb[4 + ((2 * pp) >> 2)][(2 * pp) & 3]; x1 += tb[4 + ((2 * pp + 1) >> 2)][(2 * pp + 1) & 3]; }
              mx = fmaxf(mx, fmaxf(x0, x1));
              const float e0 = __builtin_amdgcn_exp2f(x0), e1 = __builtin_amdgcn_exp2f(x1);
              ps += e0 + e1; pw[2 + (pp >> 2)][pp & 3] = cvt_pk_bf16(e0, e1); }
            A2_SB(); }
    }
    {
        const bf16x8 pf2 = __builtin_bit_cast(bf16x8, pw[2]), pf3 = __builtin_bit_cast(bf16x8, pw[3]);
#pragma unroll
        for (int i = 0; i < 8; ++i) { const int h = i >> 2, d = i & 3;
            const bf16x8 v = *(const LAS bf16x8*)(bb + vfo + (32 * d) * A2_RSV + 64 + 32 * h);
            st.o[d] = __builtin_amdgcn_mfma_f32_32x32x16_bf16(v, h ? pf3 : pf2, st.o[d], 0, 0, 0); }
    }
    st.l += ps;
    mx = fmaxf(mx, __shfl_xor(mx, 32));
    if (__any(mx > 8.0f)) {
        const float dm = fmaxf(mx, 0.f); const float alpha = __builtin_amdgcn_exp2f(-dm); st.m += dm; st.l *= alpha;
#pragma unroll
        for (int d = 0; d < 4; ++d)
#pragma unroll
            for (int r = 0; r < 16; ++r) st.o[d][r] *= alpha;
    }
#undef A2_SB
}
template <int DKL, int DK, bool TAB, bool FARC = false>
__device__ __forceinline__ void attn2_pass(AState& st, LAS unsigned char* buf, const bf16_t* qp, int koff, const bf16_t* Kg, long ldk, const bf16_t* Vg, long ldv,
                                           int kbeg, int kend, const float* tp, int wlo, int whi, int tid_in, int lane, int qw = 0, float cneg = 0.f, float cpos = 0.f) {
    constexpr int NS = DK / 16, PR = DKL / 8, NKP = DKL / 64, RSK = DKL * 2 + 16, KBYTES = 64 * RSK;
    int tid = tid_in; asm volatile("" : "+v"(tid));
    const int n = lane & 31, hi = lane >> 5, pr = pi32(n);
    bf16x8 qf[NS];
#pragma unroll
    for (int s = 0; s < NS; ++s) qf[s] = *(const bf16x8*)(qp + 16 * s);
    u32x4 kreg[NKP], vreg[2];
    int krow[NKP], kc[NKP];
#pragma unroll
    for (int i = 0; i < NKP; ++i) { const int p = tid + 512 * i; krow[i] = p / PR; kc[i] = p % PR; }
#define A2_GLOAD(k0_) do { _Pragma("unroll") for (int i = 0; i < NKP; ++i) kreg[i] = *(const u32x4*)(Kg + (long)((k0_) + krow[i]) * ldk + 8 * kc[i]); \
        _Pragma("unroll") for (int i = 0; i < 2; ++i) { const int p = tid + 512 * i; vreg[i] = *(const u32x4*)(Vg + (long)(p >> 3) * ldv + (k0_) + 8 * (p & 7)); } } while (0)
#define A2_LSTORE(b_) do { _Pragma("unroll") for (int i = 0; i < NKP; ++i) *(LAS u32x4*)(buf + (b_) * A2_BUFSZ + krow[i] * RSK + kc[i] * 16) = kreg[i]; \
        _Pragma("unroll") for (int i = 0; i < 2; ++i) { const int p = tid + 512 * i; *(LAS u32x4*)(buf + (b_) * A2_BUFSZ + KBYTES + (p >> 3) * A2_RSV + (p & 7) * 16) = vreg[i]; } } while (0)
    A2_GLOAD(kbeg); A2_LSTORE(0); __syncthreads();
    int b = 0;
    const int kfo = pr * RSK + koff + hi * 16, vfo = KBYTES + n * A2_RSV + hi * 16;
    if (st.m < -1.0e38f) {
        f32x16 sc;
#pragma unroll
        for (int r = 0; r < 16; ++r) sc[r] = 0.f;
#pragma unroll
        for (int s = 0; s < NS; ++s) { const bf16x8 kf0 = *(const LAS bf16x8*)(buf + kfo + 32 * s); sc = __builtin_amdgcn_mfma_f32_32x32x16_bf16(kf0, qf[s], sc, 0, 0, 0); }
        float mx = sc[0];
#pragma unroll
        for (int r = 1; r < 16; ++r) mx = fmaxf(mx, sc[r]);
        mx = fmaxf(mx, __shfl_xor(mx, 32));
        st.m = fmaxf(mx, -60.0f);
    }
    for (int k0 = kbeg; k0 < kend; k0 += 64) {
        const bool more = k0 + 64 < kend;
        if (more) A2_GLOAD(k0 + 64);
        LAS unsigned char* bb = buf + b * A2_BUFSZ;
        if (!(k0 + 64 <= wlo || k0 >= whi)) {
            float iv = -st.m; bool usetab = TAB;
            if (FARC) { if (k0 + 63 - qw <= -576) { iv += cneg; usetab = false; } else if (k0 - qw - 31 >= 576) { iv += cpos; usetab = false; } }
            if (TAB && usetab) a2_tile<NS, RSK, true>(st, bb, kfo, vfo, qf, tp + k0, iv);
            else a2_tile<NS, RSK, false>(st, bb, kfo, vfo, qf, tp, iv);
        }
        if (more) A2_LSTORE(b ^ 1);
        __syncthreads();
        b ^= 1;
    }
#undef A2_GLOAD
#undef A2_LSTORE
}

__device__ __forceinline__ void attn2_unit(const Args& a, const AttnBufs& B, int layer, int mixer, int head, int row0, int S, int q0, int tid, int lane, int wave, LAS unsigned char* buf) {
#ifdef ONLY_MIXER2
    mixer = ONLY_MIXER2;
#endif
    if (mixer == 0) {
        int ln_ = lane; asm volatile("" : "+v"(ln_)); const int n = ln_ & 31, hi = ln_ >> 5;
        const int half = wave >> 2, qw = q0 + 32 * (wave & 3); const long qrow = (long)row0 + qw + n;
        const float lam_init = layer == 0 ? 0.2f : 0.35550906759f;
        AState st; astate_init(st);
        attn2_pass<128, 64, true, true>(st, buf, B.PROJ + qrow * NP + PC_AQ + head * 128 + 64 * half + 8 * hi, 128 * half, B.PROJ + (long)row0 * NP + PC_AK + head * 128, NP,
                                  B.VT + (long)(head * 128) * TCM + row0, TCM, 0, S, B.tabA + head * TABA_N + TABA_OFF - (qw + n) + 8 * hi, 0, S, tid, ln_,
                                  qw, B.tabA[head * TABA_N + TABA_OFF - 700], B.tabA[head * TABA_N + TABA_OFF + 700]);
        astate_finish(st);
        LAS float* xb = (LAS float*)buf + (wave & 3) * 4096;
        if (half == 1) {
#pragma unroll
            for (int d = 0; d < 4; ++d)
#pragma unroll
                for (int r = 0; r < 16; ++r) xb[(d * 16 + r) * 64 + ln_] = st.o[d][r]; }
        __syncthreads();
        if (half == 0) {
            const float d1 = wave_sum(a.in[I_ALQ1][layer * 64 + ln_] * a.in[I_ALK1][layer * 64 + ln_]);
            const float d2 = wave_sum(a.in[I_ALQ2][layer * 64 + ln_] * a.in[I_ALK2][layer * 64 + ln_]);
            const float lam = expf(d1) - expf(d2) + lam_init;
            float ss = 0.f;
#pragma unroll
            for (int d = 0; d < 4; ++d)
#pragma unroll
                for (int r = 0; r < 16; ++r) { const float v = st.o[d][r] - lam * xb[(d * 16 + r) * 64 + ln_]; st.o[d][r] = v; ss += v * v; }
            ss += __shfl_xor(ss, 32);
            const float rs = (1.0f - lam_init) / sqrtf(ss * (1.0f / 128.0f) + EPS);
            const float* gn = a.in[I_AON] + layer * 128 + 4 * hi;
#pragma unroll
            for (int d = 0; d < 4; ++d)
#pragma unroll
                for (int g = 0; g < 4; ++g) { const f32x4 gg = *(const f32x4*)(gn + 32 * d + 8 * g);
#pragma unroll
                    for (int e = 0; e < 4; ++e) st.o[d][4 * g + e] *= rs * gg[e]; }
            store_o(st.o, B.BR + qrow * 2048 + 4 * hi + head * 128);
        }
    } else if (mixer == 1) {
        int ln_ = lane; asm volatile("" : "+v"(ln_)); const int n = ln_ & 31, hi = ln_ >> 5;
        const int qw = q0 + 32 * wave; const long qrow = (long)row0 + qw + n;
        AState st; astate_init(st);
        attn2_pass<192, 192, false>(st, buf, B.QB + qrow * 768 + head * 192 + 8 * hi, 0, B.KB + (long)row0 * 768 + head * 192, 768,
                                    B.VTB + (long)(head * 128) * TCM + row0, TCM, 0, S, nullptr, 0, S, tid, ln_);
        astate_finish(st); store_o(st.o, B.BR + qrow * 2048 + 4 * hi + 512 + head * 128);
    } else if (mixer == 2) {
        int ln_ = lane; asm volatile("" : "+v"(ln_)); const int n = ln_ & 31, hi = ln_ >> 5;
        const int qw = q0 + 32 * wave; const long qrow = (long)row0 + qw + n; const int kv = head >> 1;
        AState st; astate_init(st);
        attn2_pass<128, 128, false>(st, buf, B.PROJ + qrow * NP + PC_CQ + head * 128 + 8 * hi, 0, B.PROJ + (long)row0 * NP + PC_CK + kv * 128, NP,
                                    B.VT + (long)(512 + kv * 128) * TCM + row0, TCM, 0, S, nullptr, 0, S, tid, ln_);
        astate_finish(st); store_o(st.o, B.BR + qrow * 2048 + 4 * hi + 1024 + head * 128);
    } else {
        int ln_ = lane; asm volatile("" : "+v"(ln_)); const int n = ln_ & 31, hi = ln_ >> 5;
        const int qw = q0 + 32 * wave; const long qrow = (long)row0 + qw + n;
        AState st; astate_init(st);
#pragma unroll 1
        for (int g = 0; g < 3; ++g) { const int W = g == 0 ? 64 : (g == 1 ? 256 : 1024);
            const int kb = q0 - W > 0 ? q0 - W : 0, ke = q0 + 256 + W < S ? q0 + 256 + W : S;
            attn2_pass<128, 128, true>(st, buf, B.PROJ + qrow * NP + PC_DQ + (g * 4 + head) * 128 + 8 * hi, 0, B.PROJ + (long)row0 * NP + PC_DK + head * 128, NP,
                                       B.VT + (long)(768 + head * 128) * TCM + row0, TCM, kb, ke, B.tabD + (g * 4 + head) * TABD_N + TABD_OFF - (qw + n) + 8 * hi, qw - W, qw + 32 + W, tid, ln_); }
        astate_finish(st); store_o(st.o, B.BR + qrow * 2048 + 4 * hi + 1536 + head * 128);
    }
}
__device__ __forceinline__ void attn2_phase(const Args& a, const AttnBufs& B, int layer, int chunk, unsigned* ctr, int tid, int lane, int wave, LAS unsigned char* lds) {
    const int npr = chunk == 0 ? 1 : 0, nsm = chunk == 0 ? 4 : 12, TC = chunk == 0 ? 16384 : 24576;
    const int c0 = npr * 128, c1 = npr * 128, c2 = npr * 256, c3 = TC / 64, c4 = nsm * 32, c5 = nsm * 32, c6 = nsm * 64;
    const int total = c0 + c1 + c2 + c3 + c4 + c5 + c6;
    volatile LAS int* uw = (volatile LAS int*)(lds + 131072);
    for (;;) {
        __syncthreads();
        if (tid == 0) *uw = (int)atomicAdd(ctr, 1u);
        __syncthreads();
        int u = __builtin_amdgcn_readfirstlane(*uw);
        if (u >= total) break;
        int mixer, head, row0, S, q0;
        if (u < c0 + c1 + c2) { row0 = 0; S = TP;
            if (u < c0) { mixer = 1; q0 = (u % 32) * 256; head = u / 32; }
            else if (u < c0 + c1) { u -= c0; mixer = 2; q0 = (u % 32) * 256; head = u / 32; }
            else { u -= c0 + c1; mixer = 0; q0 = (u % 64) * 128; head = u / 64; }
        } else { u -= c0 + c1 + c2;
            if (u < c3) { mixer = 3; const int nb = TC / 256; const int q = (u % nb) * 256; head = u / nb;
                if (npr && q < TP) { row0 = 0; S = TP; } else { row0 = npr * TP + ((q - npr * TP) / SS) * SS; S = SS; }
                q0 = q - row0; }
            else { u -= c3; S = SS;
                if (u < c4) { mixer = 1; q0 = (u % 8) * 256; head = (u / 8) % 4; row0 = npr * TP + (u / 32) * SS; }
                else if (u < c4 + c5) { u -= c4; mixer = 2; q0 = (u % 8) * 256; head = (u / 8) % 4; row0 = npr * TP + (u / 32) * SS; }
                else { u -= c4 + c5; mixer = 0; q0 = (u % 16) * 128; head = (u / 16) % 4; row0 = npr * TP + (u / 64) * SS; } } }
        attn2_unit(a, B, layer, mixer, head, row0, S, q0, tid, lane, wave, lds);
    }
}


#define XB_TMO      128
#define XB_XCNT(j)  (256  + 64 * (j))
#define XB_XSUB(j)  (1280 + 64 * (j))
#define XB_XGEN(j)  (2304 + 64 * (j))
#define XB_TOP      3328
#define XB_TOPGEN   3392
#define XCD_BAR_WORDS 3456
#define XB_SPIN_CAP (1u << 22)
__device__ __forceinline__ unsigned xb_ld(unsigned* p)              { return __hip_atomic_load(p, __ATOMIC_RELAXED, __HIP_MEMORY_SCOPE_AGENT); }
__device__ __forceinline__ unsigned xb_add(unsigned* p, unsigned v) { return __hip_atomic_fetch_add(p, v, __ATOMIC_RELAXED, __HIP_MEMORY_SCOPE_AGENT); }
__device__ __forceinline__ unsigned xb_xcc_id() { return (unsigned)__builtin_amdgcn_s_getreg((3 << 11) | 20) & 0xFu; }
#define XB_SPIN(cond, bar) do { unsigned _sp = 0; while (cond) { __builtin_amdgcn_s_sleep(1); \
    if ((++_sp & 255u) == 0u) { if (xb_ld(&(bar)[XB_TMO])) break; if (_sp > XB_SPIN_CAP) { atomicAdd(&(bar)[XB_TMO], 1u); break; } } } } while (0)
struct XcdBarrier { unsigned* bar; unsigned x; volatile LAS unsigned* st; };
__device__ __forceinline__ XcdBarrier xcd_barrier_post(unsigned* bar, volatile LAS unsigned* st) {
    XcdBarrier b; b.bar = bar; b.x = xb_xcc_id(); b.st = st;
    if (threadIdx.x == 0) (void)xb_add(&bar[XB_XCNT(b.x)], 1u);
    return b;
}
__device__ __forceinline__ void xcd_barrier_complete(unsigned* bar, unsigned x, unsigned& nloc, unsigned& nx) {
    const unsigned G = gridDim.x * gridDim.y * gridDim.z;
    unsigned sum, cnt, mine, sp = 0u;
    for (;;) {
        sum = 0u; cnt = 0u; mine = 0u;
#pragma unroll
        for (unsigned j = 0; j < 16; ++j) { const unsigned c = xb_ld(&bar[XB_XCNT(j)]); sum += c; cnt += (c > 0u) ? 1u : 0u; mine = (j == x) ? c : mine; }
        if (sum == G) break;
        __builtin_amdgcn_s_sleep(1);
        if ((++sp & 255u) == 0u) { if (xb_ld(&bar[XB_TMO])) break; if (sp > XB_SPIN_CAP) { atomicAdd(&bar[XB_TMO], 1u); break; } }
    }
    nloc = mine > 0u ? mine : 1u; nx = cnt > 0u ? cnt : 1u;
}
__device__ __forceinline__ void xcd_barrier(const XcdBarrier& b) {
    asm volatile("s_waitcnt vmcnt(0)" ::: "memory");
    __syncthreads();
    if (threadIdx.x == 0) {
        unsigned* bar = b.bar;
        __builtin_amdgcn_s_waitcnt(0);
        unsigned nloc = b.st[0], nx = b.st[1];
        if (nloc == 0u) { xcd_barrier_complete(bar, b.x, nloc, nx); b.st[0] = nloc; b.st[1] = nx; }
        const unsigned old = xb_add(&bar[XB_XSUB(b.x)], 1u);
        const unsigned gen = old / nloc;
        if (old + 1u == (gen + 1u) * nloc) {
            __builtin_amdgcn_fence(__ATOMIC_RELEASE, "agent");
            asm volatile("s_waitcnt vmcnt(0)" ::: "memory");
            const unsigned og = xb_add(&bar[XB_TOP], 1u);
            const unsigned tg = og / nx;
            if (og + 1u == (tg + 1u) * nx) xb_add(&bar[XB_TOPGEN], 1u);
            else XB_SPIN(xb_ld(&bar[XB_TOPGEN]) == tg, bar);
            __builtin_amdgcn_fence(__ATOMIC_ACQUIRE, "agent");
            xb_add(&bar[XB_XGEN(b.x)], 1u);
            asm volatile("s_waitcnt vmcnt(0)" ::: "memory");
        } else {
            XB_SPIN(xb_ld(&bar[XB_XGEN(b.x)]) == gen, bar);
            __builtin_amdgcn_fence(__ATOMIC_ACQUIRE, "agent");
            asm volatile("s_waitcnt vmcnt(0)" ::: "memory");
        }
    }
    __syncthreads();
}

__global__ void __launch_bounds__(512, 2) mega(Args a) {
    extern __shared__ __attribute__((aligned(16))) unsigned char lds_raw[];
    LAS unsigned char* lds = (LAS unsigned char*)lds_raw;
    const int G = gridDim.x, bx = blockIdx.x;
    unsigned char* ws = a.ws;
    unsigned* ctl = (unsigned*)(ws + WS_CTL);
    float* tabA = (float*)(ws + WS_TABA); float* tabD = (float*)(ws + WS_TABD);
    unsigned char* W = ws + WS_W;
    bf16_t* H = (bf16_t*)(ws + WS_H);
    bf16_t* PROJ = (bf16_t*)(ws + WS_R1 + R1_PROJ); bf16_t* VT = (bf16_t*)(ws + WS_R1 + R1_VT); bf16_t* QB = (bf16_t*)(ws + WS_R1 + R1_QB);
    bf16_t* KB = (bf16_t*)(ws + WS_R1 + R1_KB); bf16_t* VTB = (bf16_t*)(ws + WS_R1 + R1_VTB);
    bf16_t* Y = (bf16_t*)(ws + WS_R1); bf16_t* FFH = (bf16_t*)(ws + WS_R1);
    bf16_t* BR = (bf16_t*)(ws + WS_R2); float* PART = (float*)(ws + WS_R2); bf16_t* U = (bf16_t*)(ws + WS_R2);
    bf16_t* MERGED = (bf16_t*)(ws + WS_R2); bf16_t* P16 = (bf16_t*)(ws + WS_R2 + 100 * MiB); bf16_t* XB = (bf16_t*)(ws + WS_XB);
    float* ssA = (float*)(ws + WS_SSP); float* ssB = ssA + (size_t)TCM * 32;
    cg::grid_group grid = cg::this_grid();
    volatile LAS unsigned* bst = (volatile LAS unsigned*)(lds + 131072 + 64);
    if (threadIdx.x < 2) bst[threadIdx.x] = 0u;
    __syncthreads();
    XcdBarrier xbar = xcd_barrier_post(ctl + 1024, bst);

    for (int pid = a.ph_lo; pid < a.ph_hi; ++pid) {
        int tid = threadIdx.x; asm volatile("" : "+v"(tid));
        const int lane = tid & 63, wave = __builtin_amdgcn_readfirstlane(tid >> 6);
        const int gw = bx * 8 + wave, ngw = G * 8;
        const int layer = pid / 25, q = pid % 25;
        if (q == 0) {
            if (layer == 0) build_tables(a.in[I_RELB], tabA, tabD, bx * 512 + tid, G * 512);
#ifndef NO_CONV
            convert_weights(a, layer, W, (LAS float*)(lds + wave * 16384), gw, ngw, lane);
#endif
        } else {
            const int chunk = (q - 1) / 12, kidx = (q - 1) % 12; const int k = kidx < 9 ? kidx + 1 : (kidx == 9 ? 11 : (kidx == 10 ? 12 : 15));
            const int m0 = chunk == 0 ? 0 : 16384, TC = chunk == 0 ? 16384 : 24576, nMt = TC / 256;
#ifdef NO_ROWS
            if (0) {
#else
            if (k == 1) {
#endif
                const float* g = a.in[I_NMIX] + layer * DM;
                for (int r = gw; r < TC; r += ngw) { const int m = m0 + r;
                    if (layer == 0) norm_row(xrow_ptr(a.in[I_XP], a.in[I_XS], m), g, H + (size_t)r * DM, lane, XB + (size_t)m * DM);
                    else norm_row_bf(XB + (size_t)m * DM, g, H + (size_t)r * DM, lane);
                    const float* pr = m < TP ? a.in[I_PP] + ((size_t)layer * TP + m) * 256 : a.in[I_PS] + ((size_t)layer * 32768 + (m - TP)) * 256;
                    const f32x4 v = *(const f32x4*)(pr + 4 * lane); u32x2 w; w.x = cvt_pk_bf16(v[0], v[1]); w.y = cvt_pk_bf16(v[2], v[3]); *(u32x2*)(P16 + (size_t)r * 256 + 4 * lane) = w;
                }
#ifdef NO_ROWS
            } else if (0) {
#else
            } else if (k == 3 || k == 5) {
#endif
                for (int r = gw; r < TC; r += ngw) { const int m = m0 + r; const int tseq = m < TP ? m : (m - TP) % SS;
                    if (k == 3) post1_row(a, layer, PROJ + (size_t)r * NP, tseq, lane);
                    else post2_row(a, layer, QB + (size_t)r * 768, KB + (size_t)r * 768, PROJ + (size_t)r * NP, tseq, lane); }
            } else if (k == 6) {
                AttnBufs B{PROJ, VT, QB, KB, VTB, BR, tabA, tabD};
#ifndef NO_ATTN
                #if ATTN_V2
                attn2_phase(a, B, layer, chunk, ctl + 64 * (layer * 2 + chunk), tid, lane, wave, lds);
#else
                attn_phase(a, B, layer, chunk, ctl + 64 * (layer * 2 + chunk), lane, (LAS float*)(lds + wave * 16384));
#endif
#endif
            } else {
                const int njobs = (k == 2 || k == 11) ? 2 : (k == 4 ? 3 : 1);
                int coff = 0;
                for (int j = 0; j < njobs; ++j) {
                    pg8::Gemm g; pg8::Epi E; int nM = nMt, nN = 8, rep = 1, adiv = 1 << 30; long astep = 0;
                    E.kind = pg8::EK_BF16; E.O = nullptr; E.ldc = 0; E.Y = nullptr; E.xin = nullptr; E.xob = nullptr; E.xof = nullptr; E.ssq = nullptr; E.rsq = nullptr;
                    bf16_t* XBc = XB + (size_t)m0 * DM;
                    g.A = H; g.Bt = (const bf16_t*)(W + WO_IN); g.lda = 2048; g.ldb = 2048; g.K = 2048;
                    if (k == 2 && j == 0) { nN = NP / 256; E.O = PROJ; E.ldc = NP; }
                    else if (k == 2) { g.A = (const bf16_t*)(W + WO_INV); g.Bt = H; nM = NVT / 256; nN = nMt; E.O = VT; E.ldc = TCM; }
                    else if (k == 4 && j == 0) { g.A = PROJ + PC_BCQ; g.lda = NP; g.Bt = (const bf16_t*)(W + WO_UQ); g.ldb = 512; g.K = 512; nN = 3; E.O = QB; E.ldc = 768; }
                    else if (k == 4 && j == 1) { g.A = PROJ + PC_BCKV; g.lda = NP; g.Bt = (const bf16_t*)(W + WO_UKN); g.ldb = 512; g.K = 512; nN = 2; E.kind = pg8::EK_SPLIT192; E.O = KB; E.ldc = 768; }
                    else if (k == 4) { g.A = (const bf16_t*)(W + WO_UKV); g.lda = 512; g.Bt = PROJ + PC_BCKV; g.ldb = NP; g.K = 512; nM = 2; nN = nMt; E.O = VTB; E.ldc = TCM; }
                    else if (k == 7) { g.A = BR; g.Bt = (const bf16_t*)(W + WO_B); g.ldb = 512; g.K = 512; nN = 32; adiv = 8; astep = 1024; E.O = Y; E.ldc = 8192; }
                    else if (k == 8) { g.Bt = (const bf16_t*)(W + WO_G); nN = 32; E.kind = pg8::EK_GATE; E.O = MERGED; E.Y = Y; }
                    else if (k == 9) { g.A = MERGED; g.Bt = (const bf16_t*)(W + WO_O); E.kind = pg8::EK_RES; E.xin = XBc; E.xob = XBc; E.ssq = ssA; }
                    else if (k == 11 && j == 0) { g.A = XBc; g.Bt = (const bf16_t*)(W + WO_1); nN = 32; E.kind = pg8::EK_RELU2; E.O = FFH; E.ldc = 8192; E.rsq = ssA; }
                    else if (k == 11) { g.A = P16; g.lda = 256; g.Bt = (const bf16_t*)(W + WO_PP); g.ldb = 256; g.K = 256; E.O = U; E.ldc = 2048; }
                    else if (k == 12) { g.A = FFH; g.lda = 8192; g.Bt = (const bf16_t*)(W + WO_2); g.ldb = 8192; g.K = 8192; E.kind = pg8::EK_RES; E.xin = XBc; E.xob = H; E.ssq = ssB; }
                    else { g.Bt = (const bf16_t*)(W + WO_PG); E.kind = pg8::EK_PLE; E.Y = U; E.xin = H; E.rsq = ssB; if (layer == 1) E.xof = a.out + (size_t)m0 * DM; else E.xob = XBc; }
                    pg8::Order S; S.init(nM, nN, G, (bx + G - coff) % G, rep, adiv, astep);
#ifndef NO_GEMM
                    pg8::gemm_phase<true>(lds, g, S, E, tid);
#endif
                    coff = (coff + (nM * nN) % G) % G;
                }
            }
        }
        if (pid + 1 < a.ph_hi) { if (pid == a.ph_lo) grid.sync(); else xcd_barrier(xbar); }
    }
}

extern "C" void kernel_launch(void* const* d_in, const int* in_sizes, int n_in, void* d_out, int out_size, void* d_ws, size_t ws_size, hipStream_t stream) {
    static int grid = 0;
    if (grid == 0) {
        if (n_in != 33 || out_size != TALL * DM || ws_size < WS_END) { fprintf(stderr, "kernel_launch: unexpected shapes (n_in %d out %d ws %zu need %zu)\n", n_in, out_size, ws_size, (size_t)WS_END); grid = -1; return; }
        int dev = 0, cus = 0, per_cu = 0;
        hipGetDevice(&dev); hipDeviceGetAttribute(&cus, hipDeviceAttributeMultiprocessorCount, dev);
        if (hipFuncSetAttribute((const void*)mega, hipFuncAttributeMaxDynamicSharedMemorySize, LDS_BYTES) != hipSuccess) { fprintf(stderr, "kernel_launch: hipFuncSetAttribute failed\n"); grid = -1; return; }
        if (hipOccupancyMaxActiveBlocksPerMultiprocessor(&per_cu, (const void*)mega, 512, LDS_BYTES) != hipSuccess || per_cu < 1) per_cu = 1;
        (void)hipGetLastError();
        grid = cus * per_cu;
        if (grid <= 0) grid = 256;
    }
    if (grid < 0) return;
    hipMemsetAsync((char*)d_ws + WS_CTL, 0, 32768, stream);
    Args a{};
    for (int i = 0; i < 33; ++i) a.in[i] = (const float*)d_in[i];
    a.out = (float*)d_out; a.ws = (unsigned char*)d_ws;
    constexpr int NPH = 50;
#if COOP
    a.ph_lo = 0; a.ph_hi = NPH;
    void* args[] = {&a};
    hipError_t e = hipLaunchCooperativeKernel((const void*)mega, dim3(grid), dim3(512), args, LDS_BYTES, stream);
    if (e != hipSuccess) fprintf(stderr, "cooperative launch failed: %s (grid %d)\n", hipGetErrorString(e), grid);
#else
    for (int p = 0; p < NPH; ++p) { a.ph_lo = p; a.ph_hi = p + 1; hipLaunchKernelGGL(mega, dim3(grid), dim3(512), LDS_BYTES, stream, a); }
#endif
}
```

```cpp
#include <hip/hip_runtime.h>
#include <hip/hip_cooperative_groups.h>
#include <cstdio>
#include <cstdint>
namespace cg = cooperative_groups;

#ifndef COOP
#define COOP 1
#endif
#ifndef ATTN_V2
#define ATTN_V2 1
#endif
#ifndef NCHUNK
#define NCHUNK 2
#endif

#define LAS __attribute__((address_space(3)))
typedef unsigned short bf16_t;
typedef short bf16x8 __attribute__((ext_vector_type(8)));
typedef float f32x4 __attribute__((ext_vector_type(4)));
typedef float f32x16 __attribute__((ext_vector_type(16)));
typedef unsigned u32x4 __attribute__((ext_vector_type(4)));
typedef unsigned u32x2 __attribute__((ext_vector_type(2)));
typedef float f32x4u __attribute__((ext_vector_type(4), aligned(4)));

constexpr int DM = 2048, TALL = 40960, TP = 8192, SS = 2048;
constexpr int NP = 5120;
constexpr int TCM = 24576;
constexpr int NVT = 1280;
constexpr int DFF = 8192;
constexpr int PC_AQ = 0, PC_AK = 512, PC_BCQ = 1024, PC_BCKV = 1536, PC_CQ = 2048, PC_CK = 2560, PC_DQ = 2816, PC_DK = 4352, PC_BKR = 4864;
constexpr float LOG2E = 1.4426950408889634f;
constexpr float EPS = 1e-6f;
constexpr int TABA_N = 16384, TABA_OFF = 8192, TABD_N = 2304, TABD_OFF = 1152;

constexpr size_t MiB = 1u << 20;
constexpr size_t WS_CTL = 0;
constexpr size_t WS_TABA = 64 * 1024;
constexpr size_t WS_TABD = 384 * 1024;
constexpr size_t WS_SS = 512 * 1024;
constexpr size_t WS_W = 1 * MiB;
constexpr size_t WO_IN = 0;
constexpr size_t WO_INV = WO_IN + (size_t)NP * 2048 * 2;
constexpr size_t WO_G = WO_INV + (size_t)NVT * 2048 * 2;
constexpr size_t WO_B = WO_G + (size_t)8192 * 2048 * 2;
constexpr size_t WO_O = WO_B + (size_t)8192 * 512 * 2;
constexpr size_t WO_1 = WO_O + (size_t)2048 * 2048 * 2;
constexpr size_t WO_2 = WO_1 + (size_t)8192 * 2048 * 2;
constexpr size_t WO_PG = WO_2 + (size_t)2048 * 8192 * 2;
constexpr size_t WO_PP = WO_PG + (size_t)2048 * 2048 * 2;
constexpr size_t WO_UQ = WO_PP + (size_t)2048 * 256 * 2;
constexpr size_t WO_UKN = WO_UQ + (size_t)768 * 512 * 2;
constexpr size_t WO_UKV = WO_UKN + (size_t)512 * 512 * 2;
constexpr size_t WO_END = WO_UKV + (size_t)512 * 512 * 2;
static_assert(WO_END <= 148 * MiB, "weights");
constexpr size_t WS_H = WS_W + 148 * MiB;
constexpr size_t WS_R1 = WS_H + (size_t)TCM * 2048 * 2;
constexpr size_t R1_PROJ = 0;
constexpr size_t R1_VT = R1_PROJ + (size_t)TCM * NP * 2;
constexpr size_t R1_QB = R1_VT + (size_t)NVT * TCM * 2;
constexpr size_t R1_KB = R1_QB + (size_t)TCM * 768 * 2;
constexpr size_t R1_VTB = R1_KB + (size_t)TCM * 768 * 2;
constexpr size_t R1_END = R1_VTB + (size_t)512 * TCM * 2;
static_assert(R1_END >= (size_t)TCM * 8192 * 2, "Y / FFH overlay");
constexpr size_t WS_R2 = WS_R1 + R1_END;
constexpr size_t WS_XB = WS_R2 + (size_t)TCM * 2048 * 4;
constexpr size_t WS_SSP = WS_XB + (size_t)TALL * 2048 * 2;
constexpr size_t WS_END = WS_SSP + 2 * (size_t)TCM * 32 * 4;

constexpr int LDS_BYTES = 147456;

typedef float f32x2_t __attribute__((ext_vector_type(2))); typedef __bf16 bf16x2_t __attribute__((ext_vector_type(2)));
__device__ __forceinline__ unsigned cvt_pk_bf16(float lo, float hi) { f32x2_t v = {lo, hi}; bf16x2_t b = __builtin_convertvector(v, bf16x2_t); return __builtin_bit_cast(unsigned, b); }
__device__ __forceinline__ float bf_lo(unsigned u) { return __uint_as_float(u << 16); }
__device__ __forceinline__ float bf_hi(unsigned u) { return __uint_as_float(u & 0xffff0000u); }
__device__ __forceinline__ float wave_sum(float v) {
#pragma unroll
    for (int o = 1; o < 64; o <<= 1) v += __shfl_xor(v, o);
    return v;
}
__device__ __forceinline__ float sigmoidf_fast(float x) { return __builtin_amdgcn_rcpf(1.0f + __builtin_amdgcn_exp2f(-x * LOG2E)); }
__device__ __forceinline__ const float* xrow_ptr(const float* s0, const float* s1, int m) { return m < TP ? s0 + (size_t)m * DM : s1 + (size_t)(m - TP) * DM; }

namespace pg8 {
constexpr int BM = 256, BK = 64, HALF = 128, HTB = HALF * BK * 2, STAGE_BYTES = 8 * HTB, NXCD = 8, WGM = 8;
__host__ __device__ __forceinline__ int lds_byte(int r, int c) { const int st = (r >> 4) * 2 + (c >> 5), rr = r & 15, cc = c & 31, ob = rr * 64 + cc * 2; return st * 1024 + (ob ^ (((ob >> 9) & 1) << 5)); }
__host__ __device__ __forceinline__ void stage_rc(int b, int& R, int& C) { const int st = b / 1024, sb = b % 1024, swz = sb ^ (((sb >> 9) & 1) << 5); R = (st >> 1) * 16 + swz / 64; C = (st & 1) * 32 + (swz % 64) / 2; }
__host__ __device__ __forceinline__ int perm32(int rho) { const int n = rho >> 4, i = rho & 15; return 8 * (i >> 2) + 4 * n + (i & 3); }

struct Unit { int pm, pn; long aoff; };
struct Gemm { const bf16_t* A; const bf16_t* Bt; int lda, ldb, K; };

struct Order {
    int nM, nN, nwg, G, c, rep, adiv, rev; long astep;
    __device__ void init(int nM_, int nN_, int G_, int c_, int rep_, int adiv_, long astep_, int rev_ = 0) { nM = nM_; nN = nN_; nwg = nM * nN; G = G_; c = c_; rep = rep_; adiv = adiv_; astep = astep_; rev = rev_; }
    __device__ bool next(int i, Unit& u) const {
        const int t = i / rep, sub = i - t * rep;
        const long L = (long)t * G + c; if (L >= nwg) return false;
        int wgid = (int)L; { const int q = nwg / NXCD, r = nwg % NXCD, xcd = wgid % NXCD, off = wgid / NXCD; wgid = (xcd < r ? xcd * (q + 1) : r * (q + 1) + (xcd - r) * q) + off; }
        const int nig = WGM * nN, gid = wgid / nig, fm = gid * WGM, gsz = (nM - fm) < WGM ? (nM - fm) : WGM;
        u.pm = fm + ((wgid % nig) % gsz); if (rev) u.pm = nM - 1 - u.pm; const int pn = (wgid % nig) / gsz; u.pn = pn + sub * nN; u.aoff = (long)(pn / adiv) * astep; return true;
    }
};

__device__ __forceinline__ float row_rs(const float* p, int fq) {
    const f32x4 v0 = *(const f32x4*)(p + 8 * fq), v1 = *(const f32x4*)(p + 8 * fq + 4);
    float t = ((v0[0] + v0[1]) + (v0[2] + v0[3])) + ((v1[0] + v1[1]) + (v1[2] + v1[3]));
    t += __shfl_xor(t, 16); t += __shfl_xor(t, 32);
    return 1.0f / sqrtf(t * (1.0f / 2048.0f) + EPS);
}
enum { EK_BF16 = 0, EK_SPLIT192 = 1, EK_RELU2 = 2, EK_GATE = 3, EK_RES = 4, EK_PLE = 5 };
struct Epi {
    static constexpr bool PERM = true;
    int kind; bf16_t* O; long ldc; const bf16_t* Y;
    const bf16_t* xin; bf16_t* xob; float* xof; float* ssq; const float* rsq;
    __device__ __forceinline__ void operator()(const f32x4 (&acc)[2][2][4][2], const Unit& u, int wr, int wc, int fr, int fq) const {
        const int row0 = u.pm * BM + wr * 64 + fr, col0 = u.pn * BM + wc * 32 + 8 * fq;
        if (kind <= EK_RELU2) {
            float rsv[2][4];
#pragma unroll
            for (int ai = 0; ai < 2; ++ai)
#pragma unroll
                for (int m = 0; m < 4; ++m) rsv[ai][m] = (kind == EK_RELU2) ? row_rs(rsq + (size_t)(row0 + ai * HALF + m * 16) * 32, fq) : 1.f;
#pragma unroll
            for (int ai = 0; ai < 2; ++ai)
#pragma unroll
                for (int m = 0; m < 4; ++m) { const int row = row0 + ai * HALF + m * 16; const float rs = rsv[ai][m];
#pragma unroll
                    for (int bj = 0; bj < 2; ++bj) { int col = col0 + bj * HALF; f32x4 v0 = acc[ai][bj][m][0], v1 = acc[ai][bj][m][1];
                        if (kind == EK_RELU2) {
#pragma unroll
                            for (int e = 0; e < 4; ++e) { float a = fmaxf(v0[e], 0.f) * rs, b = fmaxf(v1[e], 0.f) * rs; v0[e] = a * a; v1[e] = b * b; } }
                        if (kind == EK_SPLIT192) col = (col >> 7) * 192 + (col & 127);
                        u32x4 w; w.x = cvt_pk_bf16(v0[0], v0[1]); w.y = cvt_pk_bf16(v0[2], v0[3]); w.z = cvt_pk_bf16(v1[0], v1[1]); w.w = cvt_pk_bf16(v1[2], v1[3]);
                        *(u32x4*)(O + (size_t)row * ldc + col) = w; } }
        } else if (kind == EK_GATE) {
            const int oc = u.pn * 64 + wc * 16 + 4 * fq;
#pragma unroll
            for (int ai = 0; ai < 2; ++ai) {
                u32x2 yv[4][4];
#pragma unroll
                for (int m = 0; m < 4; ++m) { const bf16_t* yp = Y + (size_t)(row0 + ai * HALF + m * 16) * 8192 + oc;
#pragma unroll
                    for (int b = 0; b < 4; ++b) yv[m][b] = *(const u32x2*)(yp + b * 2048); }
#pragma unroll
                for (int m = 0; m < 4; ++m) { const int row = row0 + ai * HALF + m * 16;
                    f32x4 r = (f32x4){0.f, 0.f, 0.f, 0.f};
#pragma unroll
                    for (int b = 0; b < 4; ++b) { const u32x2 y = yv[m][b]; const f32x4 v = acc[ai][b >> 1][m][b & 1];
                        r[0] += sigmoidf_fast(v[0]) * bf_lo(y.x); r[1] += sigmoidf_fast(v[1]) * bf_hi(y.x); r[2] += sigmoidf_fast(v[2]) * bf_lo(y.y); r[3] += sigmoidf_fast(v[3]) * bf_hi(y.y); }
                    u32x2 w; w.x = cvt_pk_bf16(r[0], r[1]); w.y = cvt_pk_bf16(r[2], r[3]);
                    *(u32x2*)(O + (size_t)row * 2048 + oc) = w; }
            }
        } else if (kind == EK_RES) res_part<false, 4>(acc, u, wc, fq, row0, col0);
        else res_part<true, 2>(acc, u, wc, fq, row0, col0);
    }
    template <bool PLE, int MB>
    __device__ __forceinline__ void res_part(const f32x4 (&acc)[2][2][4][2], const Unit& u, int wc, int fq, int row0, int col0) const {
#pragma unroll
        for (int ai = 0; ai < 2; ++ai)
#pragma unroll
            for (int mb = 0; mb < 4; mb += MB) {
                u32x4 xv[MB][2], yv[MB][2]; float rsv[MB];
#pragma unroll
                for (int mm = 0; mm < MB; ++mm) { const int row = row0 + ai * HALF + (mb + mm) * 16;
                    rsv[mm] = PLE ? row_rs(rsq + (size_t)row * 32, fq) : 1.f;
#pragma unroll
                    for (int bj = 0; bj < 2; ++bj) { const int col = col0 + bj * HALF; xv[mm][bj] = *(const u32x4*)(xin + (size_t)row * DM + col);
                        if (PLE) yv[mm][bj] = *(const u32x4*)(Y + (size_t)row * 2048 + col); } }
#pragma unroll
                for (int mm = 0; mm < MB; ++mm) { const int m = mb + mm; const int row = row0 + ai * HALF + m * 16; const float rs = rsv[mm]; float sq = 0.f;
#pragma unroll
                    for (int bj = 0; bj < 2; ++bj) { const int col = col0 + bj * HALF; f32x4 v0 = acc[ai][bj][m][0], v1 = acc[ai][bj][m][1];
                        const u32x4 xb = xv[mm][bj];
                        if (PLE) { const u32x4 y = yv[mm][bj]; v0 = v0 * rs; v1 = v1 * rs;
                            v0[0] = sigmoidf_fast(v0[0]) * bf_lo(y.x); v0[1] = sigmoidf_fast(v0[1]) * bf_hi(y.x); v0[2] = sigmoidf_fast(v0[2]) * bf_lo(y.y); v0[3] = sigmoidf_fast(v0[3]) * bf_hi(y.y);
                            v1[0] = sigmoidf_fast(v1[0]) * bf_lo(y.z); v1[1] = sigmoidf_fast(v1[1]) * bf_hi(y.z); v1[2] = sigmoidf_fast(v1[2]) * bf_lo(y.w); v1[3] = sigmoidf_fast(v1[3]) * bf_hi(y.w); }
                        f32x4 n0, n1;
                        n0[0] = bf_lo(xb.x) + v0[0]; n0[1] = bf_hi(xb.x) + v0[1]; n0[2] = bf_lo(xb.y) + v0[2]; n0[3] = bf_hi(xb.y) + v0[3];
                        n1[0] = bf_lo(xb.z) + v1[0]; n1[1] = bf_hi(xb.z) + v1[1]; n1[2] = bf_lo(xb.w) + v1[2]; n1[3] = bf_hi(xb.w) + v1[3];
                        if (xof) { *(f32x4*)(xof + (size_t)row * DM + col) = n0; *(f32x4*)(xof + (size_t)row * DM + col + 4) = n1; }
                        else { u32x4 w; w.x = cvt_pk_bf16(n0[0], n0[1]); w.y = cvt_pk_bf16(n0[2], n0[3]); w.z = cvt_pk_bf16(n1[0], n1[1]); w.w = cvt_pk_bf16(n1[2], n1[3]);
                            *(u32x4*)(xob + (size_t)row * DM + col) = w; }
                        if (ssq) sq += (n0[0] * n0[0] + n0[1] * n0[1]) + (n0[2] * n0[2] + n0[3] * n0[3]) + (n1[0] * n1[0] + n1[1] * n1[1]) + (n1[2] * n1[2] + n1[3] * n1[3]); }
                    if (ssq) { sq += __shfl_xor(sq, 16); sq += __shfl_xor(sq, 32); if (fq == 0) ssq[(size_t)row * 32 + u.pn * 4 + wc] = sq; } }
            }
    }
};

template <bool ALIGN_EPI = true>
__device__ __forceinline__ void gemm_phase(LAS unsigned char* lds, const Gemm g, const Order& S, const Epi& E, const int tid) {
    const int wid = __builtin_amdgcn_readfirstlane(tid >> 6), lane = tid & 63, wr = wid >> 2, wc = wid & 3, fr = lane & 15, fq = lane >> 4;
    const int K = g.K, nt = K / BK;
    unsigned voffA[2], voffB[2];
#pragma unroll
    for (int i = 0; i < 2; ++i) { int R, C; stage_rc(tid * 16 + i * 8192, R, C); const int Rb = Epi::PERM ? ((R & ~31) + perm32(R & 31)) : R;
        voffA[i] = (unsigned)(R * g.lda + C) * 2u; voffB[i] = (unsigned)(Rb * g.ldb + C) * 2u; }
    const size_t kstep = (size_t)(BK * 2);
    const size_t hstA = (size_t)HALF * g.lda * 2, hstB = (size_t)HALF * g.ldb * 2;
    const size_t tstA = 2 * hstA, tstB = 2 * hstB;
    const unsigned ldsw = (unsigned)wid * 1024u;
    const int aoff = lds_byte(wr * 64 + fr, fq * 8), boff = lds_byte(wc * 32 + fr, fq * 8);
#define PG8_SA(b, h) (((b) * 2 + (h)) * HTB)
#define PG8_SB(b, h) ((4 + (b) * 2 + (h)) * HTB)
#define PG8_STAGE(bufoff, gbase, voff) do { _Pragma("unroll") for (int _i = 0; _i < 2; ++_i) \
        __builtin_amdgcn_global_load_lds((const unsigned*)((const char*)(gbase) + (voff)[_i]), (LAS unsigned*)(lds + (bufoff) + ldsw + _i * 8192), 16, 0, 0); } while (0)
#define PG8_LDA(dst, b, h) do { _Pragma("unroll") for (int m = 0; m < 4; ++m) _Pragma("unroll") for (int k = 0; k < 2; ++k) dst[m][k] = *(const LAS bf16x8*)(lds + PG8_SA(b, h) + aoff + m * 2048 + k * 1024); } while (0)
#define PG8_LDB(dst, b, h) do { _Pragma("unroll") for (int n = 0; n < 2; ++n) _Pragma("unroll") for (int k = 0; k < 2; ++k) dst[n][k] = *(const LAS bf16x8*)(lds + PG8_SB(b, h) + boff + n * 2048 + k * 1024); } while (0)
#define PG8_MMA(ai, bj, At, Bt) do { __builtin_amdgcn_s_setprio(1); _Pragma("unroll") for (int m = 0; m < 4; ++m) _Pragma("unroll") for (int n = 0; n < 2; ++n) _Pragma("unroll") for (int k = 0; k < 2; ++k) \
        acc[ai][bj][m][n] = __builtin_amdgcn_mfma_f32_16x16x32_bf16(Bt[n][k], At[m][k], acc[ai][bj][m][n], 0, 0, 0); __builtin_amdgcn_s_setprio(0); } while (0)
#define PG8_WAIT_V(n) asm volatile("s_waitcnt vmcnt(" #n ")" ::: "memory")
#define PG8_WAIT_L(n) asm volatile("s_waitcnt lgkmcnt(" #n ")" ::: "memory")
#define PG8_BAR __builtin_amdgcn_s_barrier()
#define PG8_SCHED __builtin_amdgcn_sched_barrier(0)
    Unit cur, nxt; int ui = 0;
    if (!S.next(0, cur)) return;
    f32x4 acc[2][2][4][2];
#pragma unroll
    for (int a = 0; a < 2; ++a)
#pragma unroll
        for (int b = 0; b < 2; ++b)
#pragma unroll
            for (int m = 0; m < 4; ++m)
#pragma unroll
                for (int n = 0; n < 2; ++n) acc[a][b][m][n] = (f32x4){0.f, 0.f, 0.f, 0.f};
    bf16x8 At[4][2], B0[2][2], B1[2][2];
    const char* cA = (const char*)g.A + (size_t)cur.pm * tstA + cur.aoff; const char* cB = (const char*)g.Bt + (size_t)cur.pn * tstB;
    PG8_STAGE(PG8_SB(0, 0), cB, voffB); PG8_STAGE(PG8_SB(0, 1), cB + hstB, voffB); PG8_STAGE(PG8_SA(0, 0), cA, voffA); PG8_STAGE(PG8_SA(0, 1), cA + hstA, voffA);
    if (wr == 1) PG8_BAR;
    PG8_WAIT_V(2); PG8_BAR;
    PG8_STAGE(PG8_SB(1, 0), cB + kstep, voffB); PG8_STAGE(PG8_SA(1, 0), cA + kstep, voffA); PG8_STAGE(PG8_SB(1, 1), cB + hstB + kstep, voffB);
    PG8_WAIT_V(6); PG8_BAR;
    for (;;) {
        const bool has_next = S.next(ui + 1, nxt);
        const char* nA = has_next ? (const char*)g.A + (size_t)nxt.pm * tstA + nxt.aoff : cA; const char* nB = has_next ? (const char*)g.Bt + (size_t)nxt.pn * tstB : cB;
        for (int t = 0; t < nt; t += 2) {
            const bool last = (t == nt - 2);
            const char* a1 = cA + (size_t)(t + 1) * kstep;
            const char* a2 = last ? nA : cA + (size_t)(t + 2) * kstep; const char* b2 = last ? nB : cB + (size_t)(t + 2) * kstep;
            const char* a3 = a2 + kstep; const char* b3 = b2 + kstep;
            PG8_LDB(B0, 0, 0); PG8_LDB(B1, 0, 1); PG8_SCHED; PG8_LDA(At, 0, 0); PG8_STAGE(PG8_SA(1, 1), a1 + hstA, voffA);
            PG8_WAIT_V(8); PG8_WAIT_L(0); PG8_BAR; PG8_MMA(0, 0, At, B0); PG8_MMA(0, 1, At, B1); PG8_BAR; PG8_SCHED;
            PG8_LDA(At, 0, 1); PG8_STAGE(PG8_SB(0, 0), b2, voffB); PG8_STAGE(PG8_SB(0, 1), b2 + hstB, voffB); PG8_STAGE(PG8_SA(0, 0), a2, voffA);
            PG8_WAIT_V(8); PG8_WAIT_L(0); PG8_BAR; PG8_MMA(1, 0, At, B0); PG8_MMA(1, 1, At, B1); PG8_BAR; PG8_SCHED;
            PG8_LDB(B0, 1, 0); PG8_LDB(B1, 1, 1); PG8_SCHED; PG8_LDA(At, 1, 0); PG8_STAGE(PG8_SA(0, 1), a2 + hstA, voffA);
            PG8_WAIT_V(8); PG8_WAIT_L(0); PG8_BAR; PG8_MMA(0, 0, At, B0); PG8_MMA(0, 1, At, B1); PG8_BAR; PG8_SCHED;
            PG8_LDA(At, 1, 1); PG8_STAGE(PG8_SB(1, 0), b3, voffB); PG8_STAGE(PG8_SB(1, 1), b3 + hstB, voffB); PG8_STAGE(PG8_SA(1, 0), a3, voffA);
            PG8_WAIT_V(8); PG8_WAIT_L(0); PG8_BAR; PG8_MMA(1, 0, At, B0); PG8_MMA(1, 1, At, B1); PG8_BAR; PG8_SCHED;
        }
        if constexpr (ALIGN_EPI) { if (wr == 0) PG8_BAR; }
        E(acc, cur, wr, wc, fr, fq);
        if (!has_next) break;
#pragma unroll
        for (int a = 0; a < 2; ++a)
#pragma unroll
            for (int b = 0; b < 2; ++b)
#pragma unroll
                for (int m = 0; m < 4; ++m)
#pragma unroll
                    for (int n = 0; n < 2; ++n) acc[a][b][m][n] = (f32x4){0.f, 0.f, 0.f, 0.f};
        cur = nxt; cA = nA; cB = nB; ++ui;
        if constexpr (ALIGN_EPI) { if (wr == 1) PG8_BAR; }
    }
    PG8_WAIT_V(0);
    if constexpr (!ALIGN_EPI) { if (wr == 0) PG8_BAR; }
    PG8_BAR;
#undef PG8_SA
#undef PG8_SB
#undef PG8_STAGE
#undef PG8_LDA
#undef PG8_LDB
#undef PG8_MMA
#undef PG8_WAIT_V
#undef PG8_WAIT_L
#undef PG8_BAR
#undef PG8_SCHED
}
}

struct Args { const float* in[33]; float* out; unsigned char* ws; int ph_lo, ph_hi; };
enum { I_XP = 0, I_XS, I_PP, I_PS, I_RELB, I_NMIX, I_WIN, I_AQN, I_AKN, I_ALQ1, I_ALK1, I_ALQ2, I_ALK2, I_AON, I_BCQN, I_BCKVN, I_BWUQ, I_BWUKV, I_BQN, I_BKN,
       I_CQN, I_CKN, I_DQN, I_DKN, I_WG, I_WB, I_WO, I_NFFN, I_W1, I_W2, I_NPLE, I_WPG, I_WPP };

__device__ __forceinline__ int rel_bucket(int rel) {
    const int n = rel < 0 ? -rel : rel;
    const float nf = (float)(n > 1 ? n : 1);
    int large = 8 + (int)(logf(nf / 8.0f) / 4.852030263919617f * 8.0f);
    large = large < 15 ? large : 15;
    return (rel > 0 ? 16 : 0) + (n < 8 ? n : large);
}
__device__ __forceinline__ void build_tables(const float* relb, float* tabA, float* tabD, int gtid, int gthreads) {
    for (int i = gtid; i < 4 * TABA_N; i += gthreads) { const int h = i / TABA_N, d = i % TABA_N - TABA_OFF; tabA[i] = relb[rel_bucket(d) * 16 + h] * LOG2E; }
    for (int i = gtid; i < 12 * TABD_N; i += gthreads) { const int gh = i / TABD_N, d = i % TABD_N - TABD_OFF; const int g = gh >> 2; const int dil = g == 0 ? 1 : (g == 1 ? 4 : 16);
        const int ad = d < 0 ? -d : d; const bool ok = (ad % dil == 0) && (ad <= 64 * dil);
        tabD[i] = ok ? relb[rel_bucket(d) * 16 + 4 + gh] * LOG2E : -1e30f; }
}
__device__ __forceinline__ void transpose_item(const float* W, int N, int k0, int n0, bf16_t* dst, int K, LAS float* scr, int lane, int gate_b = -1, const float* gsc = nullptr) {
#pragma unroll 8
    for (int i = 0; i < 32; ++i) { const int kk = 2 * i + (lane >> 5); float w = W[(size_t)(k0 + kk) * N + n0 + (lane & 31)]; if (gsc) w *= gsc[k0 + kk]; scr[kk * 33 + (lane & 31)] = w; }
    asm volatile("s_waitcnt lgkmcnt(0)" ::: "memory");
    const int c = lane & 7;
#pragma unroll
    for (int j = 0; j < 4; ++j) { const int n = (lane >> 3) + 8 * j; const LAS float* s = scr + (8 * c) * 33 + n;
        u32x4 o; o.x = cvt_pk_bf16(s[0 * 33], s[1 * 33]); o.y = cvt_pk_bf16(s[2 * 33], s[3 * 33]); o.z = cvt_pk_bf16(s[4 * 33], s[5 * 33]); o.w = cvt_pk_bf16(s[6 * 33], s[7 * 33]);
        size_t drow = (size_t)n;
        if (gate_b >= 0) { const int nn = n0 + n, j = nn & 63; drow = (size_t)((nn >> 6) * 256 + 128 * (gate_b >> 1) + 32 * (j >> 4) + 8 * ((j >> 2) & 3) + 4 * (gate_b & 1) + (j & 3)); }
        *(u32x4*)(dst + drow * K + k0 + 8 * c) = o; }
    asm volatile("s_waitcnt lgkmcnt(0)" ::: "memory");
}
__device__ __forceinline__ int win_row(int n0) {
    if (n0 < 512) return PC_AQ + n0;
    if (n0 < 1024) return PC_AK + (n0 - 512);
    if (n0 < 1536) return -(0 + (n0 - 1024) + 1);
    if (n0 < 2048) return PC_BCQ + (n0 - 1536);
    if (n0 < 2560) return PC_BCKV + (n0 - 2048);
    if (n0 < 2624) return PC_BKR + (n0 - 2560);
    if (n0 < 3136) return PC_CQ + (n0 - 2624);
    if (n0 < 3392) return PC_CK + (n0 - 3136);
    if (n0 < 3648) return -(512 + (n0 - 3392) + 1);
    if (n0 < 5184) return PC_DQ + (n0 - 3648);
    if (n0 < 5696) return PC_DK + (n0 - 5184);
    return -(768 + (n0 - 5696) + 1);
}
__device__ __forceinline__ void convert_weights(const Args& a, int layer, unsigned char* W, LAS float* scr, int gw, int ngw, int lane) {
    constexpr int I_IN = 32 * 194, I_G = 4 * 32 * 64, I_B = 4 * 8 * 64, I_O = 32 * 64, I_1 = 32 * 256, I_2 = 128 * 64, I_PG = 32 * 64, I_PPn = 4 * 64, I_UQ = 8 * 24, I_UKV = 8 * 32;
    constexpr int NIT = I_IN + I_G + I_B + I_O + I_1 + I_2 + I_PG + I_PPn + I_UQ + I_UKV;
    for (int it = gw; it < NIT; it += ngw) {
        int r = it;
        if (r < I_IN) { const int kb = r / 194, nb = r % 194; const int dr = win_row(nb * 32);
            bf16_t* dst = dr >= 0 ? (bf16_t*)(W + WO_IN) + (size_t)dr * 2048 : (bf16_t*)(W + WO_INV) + (size_t)(-dr - 1) * 2048;
            transpose_item(a.in[I_WIN] + (size_t)layer * 2048 * 6208, 6208, kb * 64, nb * 32, dst, 2048, scr, lane); continue; } r -= I_IN;
        if (r < I_G) { const int b = r / 2048, q = r % 2048, kb = q / 64, nb = q % 64;
            transpose_item(a.in[I_WG] + ((size_t)layer * 4 + b) * 2048 * 2048, 2048, kb * 64, nb * 32, (bf16_t*)(W + WO_G), 2048, scr, lane, b); continue; } r -= I_G;
        if (r < I_B) { const int b = r / 512, q = r % 512, kb = q / 64, nb = q % 64;
            transpose_item(a.in[I_WB] + ((size_t)layer * 4 + b) * 512 * 2048, 2048, kb * 64, nb * 32, (bf16_t*)(W + WO_B) + ((size_t)b * 2048 + nb * 32) * 512, 512, scr, lane); continue; } r -= I_B;
        if (r < I_O) { const int kb = r / 64, nb = r % 64;
            transpose_item(a.in[I_WO] + (size_t)layer * 2048 * 2048, 2048, kb * 64, nb * 32, (bf16_t*)(W + WO_O) + (size_t)(nb * 32) * 2048, 2048, scr, lane); continue; } r -= I_O;
        if (r < I_1) { const int kb = r / 256, nb = r % 256;
            transpose_item(a.in[I_W1] + (size_t)layer * 2048 * 8192, 8192, kb * 64, nb * 32, (bf16_t*)(W + WO_1) + (size_t)(nb * 32) * 2048, 2048, scr, lane, -1, a.in[I_NFFN] + layer * DM); continue; } r -= I_1;
        if (r < I_2) { const int kb = r / 64, nb = r % 64;
            transpose_item(a.in[I_W2] + (size_t)layer * 8192 * 2048, 2048, kb * 64, nb * 32, (bf16_t*)(W + WO_2) + (size_t)(nb * 32) * 8192, 8192, scr, lane); continue; } r -= I_2;
        if (r < I_PG) { const int kb = r / 64, nb = r % 64;
            transpose_item(a.in[I_WPG] + (size_t)layer * 2048 * 2048, 2048, kb * 64, nb * 32, (bf16_t*)(W + WO_PG) + (size_t)(nb * 32) * 2048, 2048, scr, lane, -1, a.in[I_NPLE] + layer * DM); continue; } r -= I_PG;
        if (r < I_PPn) { const int kb = r / 64, nb = r % 64;
            transpose_item(a.in[I_WPP] + (size_t)layer * 256 * 2048, 2048, kb * 64, nb * 32, (bf16_t*)(W + WO_PP) + (size_t)(nb * 32) * 256, 256, scr, lane); continue; } r -= I_PPn;
        if (r < I_UQ) { const int kb = r / 24, nb = r % 24;
            transpose_item(a.in[I_BWUQ] + (size_t)layer * 512 * 768, 768, kb * 64, nb * 32, (bf16_t*)(W + WO_UQ) + (size_t)(nb * 32) * 512, 512, scr, lane); continue; } r -= I_UQ;
        { const int kb = r / 32, nb = r % 32; const int n0 = nb * 32, h = n0 >> 8, j0 = n0 & 255;
            bf16_t* dst = j0 < 128 ? (bf16_t*)(W + WO_UKN) + (size_t)(h * 128 + j0) * 512 : (bf16_t*)(W + WO_UKV) + (size_t)(h * 128 + j0 - 128) * 512;
            transpose_item(a.in[I_BWUKV] + (size_t)layer * 512 * 1024, 1024, kb * 64, n0, dst, 512, scr, lane); }
    }
}

__device__ __forceinline__ void norm_row_bf(const bf16_t* x, const float* g, bf16_t* out, int lane) {
    f32x4 v[8]; float s = 0.f;
#pragma unroll
    for (int j = 0; j < 8; ++j) { const u32x2 u = *(const u32x2*)(x + 4 * lane + 256 * j); v[j][0] = bf_lo(u.x); v[j][1] = bf_hi(u.x); v[j][2] = bf_lo(u.y); v[j][3] = bf_hi(u.y);
        s += (v[j][0] * v[j][0] + v[j][1] * v[j][1]) + (v[j][2] * v[j][2] + v[j][3] * v[j][3]); }
    const float rs = 1.0f / sqrtf(wave_sum(s) * (1.0f / 2048.0f) + EPS);
#pragma unroll
    for (int j = 0; j < 8; ++j) { const f32x4 gg = *(const f32x4*)(g + 4 * lane + 256 * j);
        u32x2 w; w.x = cvt_pk_bf16(v[j][0] * rs * gg[0], v[j][1] * rs * gg[1]); w.y = cvt_pk_bf16(v[j][2] * rs * gg[2], v[j][3] * rs * gg[3]);
        *(u32x2*)(out + 4 * lane + 256 * j) = w; }
}
__device__ __forceinline__ void norm_row(const float* x, const float* g, bf16_t* out, int lane, bf16_t* xb) {
    f32x4 v[8]; float s = 0.f;
#pragma unroll
    for (int j = 0; j < 8; ++j) { v[j] = *(const f32x4*)(x + 4 * lane + 256 * j); s += (v[j][0] * v[j][0] + v[j][1] * v[j][1]) + (v[j][2] * v[j][2] + v[j][3] * v[j][3]);
        u32x2 w; w.x = cvt_pk_bf16(v[j][0], v[j][1]); w.y = cvt_pk_bf16(v[j][2], v[j][3]); *(u32x2*)(xb + 4 * lane + 256 * j) = w; }
    const float rs = 1.0f / sqrtf(wave_sum(s) * (1.0f / 2048.0f) + EPS);
#pragma unroll
    for (int j = 0; j < 8; ++j) { const f32x4 gg = *(const f32x4*)(g + 4 * lane + 256 * j);
        u32x2 w; w.x = cvt_pk_bf16(v[j][0] * rs * gg[0], v[j][1] * rs * gg[1]); w.y = cvt_pk_bf16(v[j][2] * rs * gg[2], v[j][3] * rs * gg[3]);
        *(u32x2*)(out + 4 * lane + 256 * j) = w; }
}
__device__ __forceinline__ void load8(const bf16_t* p, float (&f)[8]) { const u32x4 v = *(const u32x4*)p; f[0] = bf_lo(v.x); f[1] = bf_hi(v.x); f[2] = bf_lo(v.y); f[3] = bf_hi(v.y); f[4] = bf_lo(v.z); f[5] = bf_hi(v.z); f[6] = bf_lo(v.w); f[7] = bf_hi(v.w); }
__device__ __forceinline__ void store8(bf16_t* p, const float (&f)[8]) { u32x4 w; w.x = cvt_pk_bf16(f[0], f[1]); w.y = cvt_pk_bf16(f[2], f[3]); w.z = cvt_pk_bf16(f[4], f[5]); w.w = cvt_pk_bf16(f[6], f[7]); *(u32x4*)p = w; }
template <int GRP> __device__ __forceinline__ void norm8(float (&f)[8], const float* g, float scale, int lane) {
    float s = 0.f;
#pragma unroll
    for (int e = 0; e < 8; ++e) s += f[e] * f[e];
#pragma unroll
    for (int o = 1; o < GRP; o <<= 1) s += __shfl_xor(s, o);
    const float rs = scale / sqrtf(s * (1.0f / (GRP * 8)) + EPS);
    const int gi = (lane & (GRP - 1)) * 8;
#pragma unroll
    for (int e = 0; e < 8; ++e) f[e] = f[e] * rs * g[gi + e];
}
__device__ __forceinline__ float rope_inv(int i) { return __builtin_amdgcn_exp2f(-(float)i * (13.287712379549449f / 32.0f)) * 0.15915494309189535f; }
__device__ __forceinline__ void sincos_rev(float rev, float& sn, float& cs) { rev -= rintf(rev); sn = __builtin_amdgcn_sinf(rev); cs = __builtin_amdgcn_cosf(rev); }
__device__ __forceinline__ void axial_rope8(float (&f)[8], float rowpos, float colpos, int lane) {
    const int j = lane & 15, hf = j >> 3, jj = j & 7; const float pos = hf ? colpos : rowpos; const float sgn = jj < 4 ? -1.f : 1.f; const int i0 = 8 * (jj & 3);
#pragma unroll
    for (int e = 0; e < 8; ++e) { const float pv = __shfl_xor(f[e], 4); float sn, cs; sincos_rev(pos * rope_inv(i0 + e), sn, cs); f[e] = f[e] * cs + sgn * pv * sn; }
}
__device__ __forceinline__ void post1_row(const Args& a, int layer, bf16_t* P, int tseq, int lane) {
    float fq[8], fk[8], fcq[8], fckv[8], gq[8], gk[8], d0[8], d1[8], d2[8], dk[8];
    const int l2 = lane & 31;
    load8(P + PC_AQ + 8 * lane, fq); load8(P + PC_AK + 8 * lane, fk); load8(P + PC_BCQ + 8 * lane, fcq); load8(P + PC_BCKV + 8 * lane, fckv);
    load8(P + PC_CQ + 8 * lane, gq); load8(P + PC_CK + 8 * l2, gk);
    load8(P + PC_DQ + 8 * lane, d0); load8(P + PC_DQ + 512 + 8 * lane, d1); load8(P + PC_DQ + 1024 + 8 * lane, d2); load8(P + PC_DK + 8 * lane, dk);
    const float sA = 0.125f * LOG2E, sC = 0.08838834764831845f * LOG2E;
    const float rowpos = (float)(tseq >> 6), colpos = (float)(tseq & 63);
    norm8<8>(fq, a.in[I_AQN] + layer * 64, sA, lane); norm8<8>(fk, a.in[I_AKN] + layer * 64, 1.f, lane);
    norm8<64>(fcq, a.in[I_BCQN] + layer * 512, 1.f, lane); norm8<64>(fckv, a.in[I_BCKVN] + layer * 512, 1.f, lane);
    norm8<16>(gq, a.in[I_CQN] + layer * 128, sC, lane); axial_rope8(gq, rowpos, colpos, lane);
    norm8<16>(gk, a.in[I_CKN] + layer * 128, 1.f, lane); axial_rope8(gk, rowpos, colpos, lane);
    norm8<16>(d0, a.in[I_DQN] + layer * 128, sC, lane); norm8<16>(d1, a.in[I_DQN] + layer * 128, sC, lane); norm8<16>(d2, a.in[I_DQN] + layer * 128, sC, lane);
    norm8<16>(dk, a.in[I_DKN] + layer * 128, 1.f, lane);
    store8(P + PC_AQ + 8 * lane, fq); store8(P + PC_AK + 8 * lane, fk); store8(P + PC_BCQ + 8 * lane, fcq); store8(P + PC_BCKV + 8 * lane, fckv);
    store8(P + PC_CQ + 8 * lane, gq); if (lane < 32) store8(P + PC_CK + 8 * l2, gk);
    store8(P + PC_DQ + 8 * lane, d0); store8(P + PC_DQ + 512 + 8 * lane, d1); store8(P + PC_DQ + 1024 + 8 * lane, d2); store8(P + PC_DK + 8 * lane, dk);
}
__device__ __forceinline__ void mla_norm_rope(float (&f)[8], float (&r)[4], const float* g, float scale, float pos, int lane) {
    const int j = lane & 15;
    float s = 0.f;
#pragma unroll
    for (int e = 0; e < 8; ++e) s += f[e] * f[e];
#pragma unroll
    for (int e = 0; e < 4; ++e) s += r[e] * r[e];
#pragma unroll
    for (int o = 1; o < 16; o <<= 1) s += __shfl_xor(s, o);
    const float rs = scale / sqrtf(s * (1.0f / 192.0f) + EPS);
#pragma unroll
    for (int e = 0; e < 8; ++e) f[e] = f[e] * rs * g[8 * j + e];
#pragma unroll
    for (int e = 0; e < 4; ++e) r[e] = r[e] * rs * g[128 + 4 * j + e];
    const float sgn = j < 8 ? -1.f : 1.f; const int i0 = 4 * (j & 7);
#pragma unroll
    for (int e = 0; e < 4; ++e) { const float pv = __shfl_xor(r[e], 8); float sn, cs; sincos_rev(pos * rope_inv(i0 + e), sn, cs); r[e] = r[e] * cs + sgn * pv * sn; }
}
__device__ __forceinline__ void post2_row(const Args& a, int layer, bf16_t* Q, bf16_t* Kr, const bf16_t* P, int tseq, int lane) {
    const int h = lane >> 4, j = lane & 15; const float pos = (float)tseq;
    float f[8], r[4];
    float f2[8], r2[4];
    bf16_t* q = Q + h * 192; bf16_t* k = Kr + h * 192;
    load8(q + 8 * j, f); const u32x2 vq = *(const u32x2*)(q + 128 + 4 * j); load8(k + 8 * j, f2); const u32x2 vk = *(const u32x2*)(P + PC_BKR + 4 * j);
    r[0] = bf_lo(vq.x); r[1] = bf_hi(vq.x); r[2] = bf_lo(vq.y); r[3] = bf_hi(vq.y);
    r2[0] = bf_lo(vk.x); r2[1] = bf_hi(vk.x); r2[2] = bf_lo(vk.y); r2[3] = bf_hi(vk.y);
    mla_norm_rope(f, r, a.in[I_BQN] + layer * 192, 0.07216878364870323f * LOG2E, pos, lane);
    mla_norm_rope(f2, r2, a.in[I_BKN] + layer * 192, 1.f, pos, lane);
    store8(q + 8 * j, f); { u32x2 w; w.x = cvt_pk_bf16(r[0], r[1]); w.y = cvt_pk_bf16(r[2], r[3]); *(u32x2*)(q + 128 + 4 * j) = w; }
    store8(k + 8 * j, f2); { u32x2 w; w.x = cvt_pk_bf16(r2[0], r2[1]); w.y = cvt_pk_bf16(r2[2], r2[3]); *(u32x2*)(k + 128 + 4 * j) = w; }
}

struct AState { float m, l; f32x16 o[4]; };
__device__ __forceinline__ void astate_init(AState& st) { st.m = -3.0e38f; st.l = 0.f;
#pragma unroll
    for (int d = 0; d < 4; ++d)
#pragma unroll
        for (int r = 0; r < 16; ++r) st.o[d][r] = 0.f; }
template <int DK, bool TAB, bool QLDS = false>
__device__ __forceinline__ void attn_pass(AState& st, const bf16_t* qp, const bf16_t* kp, long ldk, const bf16_t* vp, long ldv, int kbeg, int kend, const float* tp, LAS bf16x8* qst = nullptr) {
    constexpr int NS = DK / 16;
    bf16x8 qf[QLDS ? 1 : NS], kf[NS];
    if (QLDS) {
#pragma unroll
        for (int s = 0; s < NS; ++s) qst[s * 64] = *(const bf16x8*)(qp + 16 * s);
    } else {
#pragma unroll
        for (int s = 0; s < NS; ++s) qf[s] = *(const bf16x8*)(qp + 16 * s);
    }
    { const bf16_t* k0p = kp + (long)kbeg * ldk;
#pragma unroll
      for (int s = 0; s < NS; ++s) kf[s] = *(const bf16x8*)(k0p + 16 * s); }
    for (int k0 = kbeg; k0 < kend; k0 += 32) {
        bf16x8 vf[4][2];
#pragma unroll
        for (int d = 0; d < 4; ++d)
#pragma unroll
            for (int s = 0; s < 2; ++s) vf[d][s] = *(const bf16x8*)(vp + (long)(32 * d) * ldv + k0 + 16 * s);
        f32x4 tb[4];
        if (TAB) {
#pragma unroll
            for (int s = 0; s < 2; ++s) { tb[2 * s] = *(const f32x4u*)(tp + k0 + 16 * s); tb[2 * s + 1] = *(const f32x4u*)(tp + k0 + 16 * s + 4); } }
        f32x16 sc;
#pragma unroll
        for (int r = 0; r < 16; ++r) sc[r] = 0.f;
#pragma unroll
        for (int s = 0; s < NS; ++s) sc = __builtin_amdgcn_mfma_f32_32x32x16_bf16(kf[s], QLDS ? qst[s * 64] : qf[QLDS ? 0 : s], sc, 0, 0, 0);
        if (k0 + 32 < kend) { const bf16_t* knp = kp + (long)(k0 + 32) * ldk;
#pragma unroll
            for (int s = 0; s < NS; ++s) kf[s] = *(const bf16x8*)(knp + 16 * s); }
        if (TAB) {
#pragma unroll
            for (int r = 0; r < 16; ++r) sc[r] += tb[r >> 2][r & 3]; }
        float mx = sc[0];
#pragma unroll
        for (int r = 1; r < 16; ++r) mx = fmaxf(mx, sc[r]);
        mx = fmaxf(mx, __shfl_xor(mx, 32));
        const float mn = fmaxf(st.m, mx);
        const float alpha = __builtin_amdgcn_exp2f(st.m - mn);
        st.m = mn;
        float ps = 0.f;
#pragma unroll
        for (int r = 0; r < 16; ++r) { sc[r] = __builtin_amdgcn_exp2f(sc[r] - mn); ps += sc[r]; }
        st.l = st.l * alpha + ps;
#pragma unroll
        for (int d = 0; d < 4; ++d)
#pragma unroll
            for (int r = 0; r < 16; ++r) st.o[d][r] *= alpha;
        u32x4 p0, p1;
        p0.x = cvt_pk_bf16(sc[0], sc[1]); p0.y = cvt_pk_bf16(sc[2], sc[3]); p0.z = cvt_pk_bf16(sc[4], sc[5]); p0.w = cvt_pk_bf16(sc[6], sc[7]);
        p1.x = cvt_pk_bf16(sc[8], sc[9]); p1.y = cvt_pk_bf16(sc[10], sc[11]); p1.z = cvt_pk_bf16(sc[12], sc[13]); p1.w = cvt_pk_bf16(sc[14], sc[15]);
        const bf16x8 pf0 = __builtin_bit_cast(bf16x8, p0), pf1 = __builtin_bit_cast(bf16x8, p1);
#pragma unroll
        for (int d = 0; d < 4; ++d) { st.o[d] = __builtin_amdgcn_mfma_f32_32x32x16_bf16(vf[d][0], pf0, st.o[d], 0, 0, 0); st.o[d] = __builtin_amdgcn_mfma_f32_32x32x16_bf16(vf[d][1], pf1, st.o[d], 0, 0, 0); }
    }
}
__device__ __forceinline__ void astate_finish(AState& st) {
    const float l = st.l + __shfl_xor(st.l, 32); const float inv = 1.0f / l;
#pragma unroll
    for (int d = 0; d < 4; ++d)
#pragma unroll
        for (int r = 0; r < 16; ++r) st.o[d][r] *= inv;
}
__device__ __forceinline__ void store_o(const f32x16 (&o)[4], bf16_t* op) {
#pragma unroll
    for (int d = 0; d < 4; ++d)
#pragma unroll
        for (int g = 0; g < 4; ++g) { u32x2 w; w.x = cvt_pk_bf16(o[d][4 * g], o[d][4 * g + 1]); w.y = cvt_pk_bf16(o[d][4 * g + 2], o[d][4 * g + 3]); *(u32x2*)(op + 32 * d + 8 * g) = w; }
}
__device__ __forceinline__ int pi32(int n) { return (n & ~12) | ((n & 4) << 1) | ((n & 8) >> 1); }

struct AttnBufs { const bf16_t* PROJ; const bf16_t* VT; const bf16_t* QB; const bf16_t* KB; const bf16_t* VTB; bf16_t* BR; const float* tabA; const float* tabD; };

__device__ __forceinline__ void attn_unit(const Args& a, const AttnBufs& B, int layer, int mixer, int head, int row0  , int S, int q0  , int lane, LAS float* stash) {
#define ATT_LANE_SETUP int ln_ = lane; asm volatile("" : "+v"(ln_)); const int n = ln_ & 31, hi = ln_ >> 5, pr = pi32(n); const long qrow = (long)row0 + q0 + n; bf16_t* op = B.BR + qrow * 2048 + 4 * hi;
#ifdef ONLY_MIXER
    mixer = ONLY_MIXER;
#endif
    if (mixer == 0) {
        ATT_LANE_SETUP
        const float lam_init = layer == 0 ? 0.2f : 0.35550906759f;
        const float d1 = wave_sum(a.in[I_ALQ1][layer * 64 + lane] * a.in[I_ALK1][layer * 64 + lane]);
        const float d2 = wave_sum(a.in[I_ALQ2][layer * 64 + lane] * a.in[I_ALK2][layer * 64 + lane]);
        const float lam = expf(d1) - expf(d2) + lam_init;
        const bf16_t* vp = B.VT + (long)(head * 128 + n) * TCM + row0 + 8 * hi;
        const float* tp = B.tabA + head * TABA_N + TABA_OFF - (q0 + n) + 8 * hi;
        { AState st; astate_init(st);
          attn_pass<64, true>(st, B.PROJ + qrow * NP + PC_AQ + head * 128 + 8 * hi, B.PROJ + (long)(row0 + pr) * NP + PC_AK + head * 128 + 8 * hi, NP, vp, TCM, 0, S, tp);
          astate_finish(st);
#pragma unroll
          for (int d = 0; d < 4; ++d)
#pragma unroll
              for (int r = 0; r < 16; ++r) stash[(d * 16 + r) * 64 + lane] = st.o[d][r]; }
        AState st; astate_init(st);
        attn_pass<64, true>(st, B.PROJ + qrow * NP + PC_AQ + head * 128 + 64 + 8 * hi, B.PROJ + (long)(row0 + pr) * NP + PC_AK + head * 128 + 64 + 8 * hi, NP, vp, TCM, 0, S, tp);
        astate_finish(st);
        float ss = 0.f;
#pragma unroll
        for (int d = 0; d < 4; ++d)
#pragma unroll
            for (int r = 0; r < 16; ++r) { const float v = stash[(d * 16 + r) * 64 + lane] - lam * st.o[d][r]; st.o[d][r] = v; ss += v * v; }
        ss += __shfl_xor(ss, 32);
        const float rs = (1.0f - lam_init) / sqrtf(ss * (1.0f / 128.0f) + EPS);
        const float* gn = a.in[I_AON] + layer * 128 + 4 * hi;
#pragma unroll
        for (int d = 0; d < 4; ++d)
#pragma unroll
            for (int g = 0; g < 4; ++g) { const f32x4 gg = *(const f32x4*)(gn + 32 * d + 8 * g);
#pragma unroll
                for (int e = 0; e < 4; ++e) st.o[d][4 * g + e] *= rs * gg[e]; }
        store_o(st.o, op + head * 128);
    } else if (mixer == 1) {
        ATT_LANE_SETUP
        AState st; astate_init(st);
        attn_pass<192, false, true>(st, B.QB + qrow * 768 + head * 192 + 8 * hi, B.KB + (long)(row0 + pr) * 768 + head * 192 + 8 * hi, 768,
                              B.VTB + (long)(head * 128 + n) * TCM + row0 + 8 * hi, TCM, 0, S, nullptr, (LAS bf16x8*)stash + lane);
        astate_finish(st); store_o(st.o, op + 512 + head * 128);
    } else if (mixer == 2) {
        ATT_LANE_SETUP
        const int kv = head >> 1;
        AState st; astate_init(st);
        attn_pass<128, false>(st, B.PROJ + qrow * NP + PC_CQ + head * 128 + 8 * hi, B.PROJ + (long)(row0 + pr) * NP + PC_CK + kv * 128 + 8 * hi, NP,
                              B.VT + (long)(512 + kv * 128 + n) * TCM + row0 + 8 * hi, TCM, 0, S, nullptr);
        astate_finish(st); store_o(st.o, op + 1024 + head * 128);
    } else {
        ATT_LANE_SETUP
        AState st; astate_init(st);
        const bf16_t* kp = B.PROJ + (long)(row0 + pr) * NP + PC_DK + head * 128 + 8 * hi;
        const bf16_t* vp = B.VT + (long)(768 + head * 128 + n) * TCM + row0 + 8 * hi;
#pragma unroll 1
        for (int g = 0; g < 3; ++g) { const int W = g == 0 ? 64 : (g == 1 ? 256 : 1024);
            const int kb = q0 - W > 0 ? q0 - W : 0, ke = q0 + 32 + W < S ? q0 + 32 + W : S;
            attn_pass<128, true>(st, B.PROJ + qrow * NP + PC_DQ + (g * 4 + head) * 128 + 8 * hi, kp, NP, vp, TCM, kb, ke, B.tabD + (g * 4 + head) * TABD_N + TABD_OFF - (q0 + n) + 8 * hi); }
        astate_finish(st); store_o(st.o, op + 1536 + head * 128);
    }
}
__device__ __forceinline__ void attn_phase(const Args& a, const AttnBufs& B, int layer, int chunk, unsigned* ctr, int lane, LAS float* stash) {
#if NCHUNK == 2
    const int npr = chunk == 0 ? 1 : 0, nsm = chunk == 0 ? 4 : 12, TC = chunk == 0 ? 16384 : 24576;
#else
    const int npr = chunk == 0 ? 1 : 0, nsm = chunk == 0 ? 0 : 4, TC = 8192;
#endif
    const int nP = npr * 1024, nS = nsm * 256, nD = TC / 8, total = 3 * nP + 3 * nS + nD;
    for (;;) {
        unsigned uu = 0; if (lane == 0) uu = atomicAdd(ctr, 1u);
        int u = __builtin_amdgcn_readfirstlane((int)uu);
        if (u >= total) break;
        int mixer, head, row0, S, q0;
        if (u < 3 * nP) { mixer = u / nP; const int r = u % nP; q0 = (r % 256) * 32; head = r / 256; row0 = 0; S = TP; }
        else { u -= 3 * nP;
            if (u < 3 * nS) { mixer = u / nS; const int r = u % nS; q0 = (r % 64) * 32; head = (r / 64) % 4; row0 = npr * TP + (r / 256) * SS; S = SS; }
            else { u -= 3 * nS; mixer = 3; const int qb = u % (TC / 32); head = u / (TC / 32); const int q = qb * 32;
                if (npr && q < TP) { row0 = 0; S = TP; } else { row0 = npr * TP + ((q - npr * TP) / SS) * SS; S = SS; }
                q0 = q - row0; } }
#ifdef ONLY_MIXER
        if (mixer != ONLY_MIXER) continue;
#endif
        attn_unit(a, B, layer, mixer, head, row0, S, q0, lane, stash);
    }
}


constexpr int A2_RSV = 144, A2_BUFSZ = 64 * 400 + 128 * A2_RSV;
static_assert(2 * A2_BUFSZ <= 131072 && 2 * A2_BUFSZ >= 65536, "attention LDS");

template <int NS, int RSK, bool USETAB>
__device__ __forceinline__ void a2_tile(AState& st, LAS unsigned char* bb, int kfo, int vfo, const bf16x8 (&qf)[NS], const float* tpk, float iv) {
#define A2_SB() __builtin_amdgcn_sched_barrier(0x0024)
#define A2_LDK0(s_) (*(const LAS bf16x8*)(bb + kfo + 32 * (s_)))
#define A2_LDK1(s_) (*(const LAS bf16x8*)(bb + kfo + 32 * RSK + 32 * (s_)))
#define A2_LDV0(i_) (*(const LAS bf16x8*)(bb + vfo + (32 * ((i_) & 3)) * A2_RSV + 32 * ((i_) >> 2)))
#define A2_LDV1(i_) (*(const LAS bf16x8*)(bb + vfo + (32 * ((i_) & 3)) * A2_RSV + 64 + 32 * ((i_) >> 2)))
    constexpr int PD = 3;
    f32x4 tb[8];
    if (USETAB) {
#pragma unroll
        for (int s = 0; s < 4; ++s) { tb[2 * s] = *(const f32x4u*)(tpk + 16 * s); tb[2 * s + 1] = *(const f32x4u*)(tpk + 16 * s + 4); } }
    f32x16 ini, sc0, sc1;
#pragma unroll
    for (int r = 0; r < 16; ++r) ini[r] = iv;
    u32x4 pw[4];
    float mx = -3.0e38f, ps = 0.f;
    bf16x8 ka[NS], kb[NS], va[8], vb[8];
#pragma unroll
    for (int s = 0; s < PD; ++s) ka[s] = A2_LDK0(s);
    A2_SB();
#pragma unroll
    for (int s = 0; s < NS; ++s) {
        if (s + PD < NS) ka[s + PD] = A2_LDK0(s + PD); else kb[s + PD - NS] = A2_LDK1(s + PD - NS);
        sc0 = __builtin_amdgcn_mfma_f32_32x32x16_bf16(ka[s], qf[s], s == 0 ? ini : sc0, 0, 0, 0);
        A2_SB(); }
#pragma unroll
    for (int s = 0; s < NS; ++s) {
        if (s + PD < NS) kb[s + PD] = A2_LDK1(s + PD); else va[s + PD - NS] = A2_LDV0(s + PD - NS);
        sc1 = __builtin_amdgcn_mfma_f32_32x32x16_bf16(kb[s], qf[s], s == 0 ? ini : sc1, 0, 0, 0);
        A2_SB();
#pragma unroll
        for (int pp = (8 * s) / NS; pp < (8 * (s + 1)) / NS; ++pp) {
            float x0 = sc0[2 * pp], x1 = sc0[2 * pp + 1];
            if (USETAB) { x0 += tb[(2 * pp) >> 2][(2 * pp) & 3]; x1 += tb[(2 * pp + 1) >> 2][(2 * pp + 1) & 3]; }
            mx = fmaxf(mx, fmaxf(x0, x1));
            const float e0 = __builtin_amdgcn_exp2f(x0), e1 = __builtin_amdgcn_exp2f(x1);
            ps += e0 + e1; pw[pp >> 2][pp & 3] = cvt_pk_bf16(e0, e1); }
        A2_SB();
    }
    {
        const bf16x8 pf0 = __builtin_bit_cast(bf16x8, pw[0]), pf1 = __builtin_bit_cast(bf16x8, pw[1]);
#pragma unroll
        for (int i = 0; i < 8; ++i) { const int h = i >> 2, d = i & 3;
            if (i + PD < 8) va[i + PD] = A2_LDV0(i + PD); else vb[i + PD - 8] = A2_LDV1(i + PD - 8);
            st.o[d] = __builtin_amdgcn_mfma_f32_32x32x16_bf16(va[i], h ? pf1 : pf0, st.o[d], 0, 0, 0);
            A2_SB();
            { const int pp = i; float x0 = sc1[2 * pp], x1 = sc1[2 * pp + 1];
              if (USETAB) { x0 += tb[4 + ((2 * pp) >> 2)][(2 * pp) & 3]; x1 += tb[4 + ((2 * pp + 1) >> 2)][(2 * pp + 1) & 3]; }
              mx = fmaxf(mx, fmaxf(x0, x1));
              const float e0 = __builtin_amdgcn_exp2f(x0), e1 = __builtin_amdgcn_exp2f(x1);
              ps += e0 + e1; pw[2 + (pp >> 2)][pp & 3] = cvt_pk_bf16(e0, e1); }
            A2_SB(); }
    }
    {
        const bf16x8 pf2 = __builtin_bit_cast(bf16x8, pw[2]), pf3 = __builtin_bit_cast(bf16x8, pw[3]);
#pragma unroll
        for (int i = 0; i < 8; ++i) { const int h = i >> 2, d = i & 3;
            if (i + PD < 8) vb[i + PD] = A2_LDV1(i + PD);
            st.o[d] = __builtin_amdgcn_mfma_f32_32x32x16_bf16(vb[i], h ? pf3 : pf2, st.o[d], 0, 0, 0);
            A2_SB(); }
    }
    st.l += ps;
    mx = fmaxf(mx, __shfl_xor(mx, 32));
    if (__any(mx > 8.0f)) {
        const float dm = fmaxf(mx, 0.f); const float alpha = __builtin_amdgcn_exp2f(-dm); st.m += dm; st.l *= alpha;
#pragma unroll
        for (int d = 0; d < 4; ++d)
#pragma unroll
            for (int r = 0; r < 16; ++r) st.o[d][r] *= alpha;
    }
#undef A2_SB
#undef A2_LDK0
#undef A2_LDK1
#undef A2_LDV0
#undef A2_LDV1
}
template <int DKL, int DK, bool TAB, bool FARC = false>
__device__ __forceinline__ void attn2_pass(AState& st, LAS unsigned char* buf, const bf16_t* qp, int koff, const bf16_t* Kg, long ldk, const bf16_t* Vg, long ldv,
                                           int kbeg, int kend, const float* tp, int wlo, int whi, int tid_in, int lane, int qw = 0, float cneg = 0.f, float cpos = 0.f) {
    constexpr int NS = DK / 16, PR = DKL / 8, NKP = DKL / 64, RSK = DKL * 2 + 16, KBYTES = 64 * RSK;
    int tid = tid_in; asm volatile("" : "+v"(tid));
    const int n = lane & 31, hi = lane >> 5, pr = pi32(n);
    bf16x8 qf[NS];
#pragma unroll
    for (int s = 0; s < NS; ++s) qf[s] = *(const bf16x8*)(qp + 16 * s);
    u32x4 kreg[NKP], vreg[2];
    int krow[NKP], kc[NKP];
#pragma unroll
    for (int i = 0; i < NKP; ++i) { const int p = tid + 512 * i; krow[i] = p / PR; kc[i] = p % PR; }
#define A2_GLOAD(k0_) do { _Pragma("unroll") for (int i = 0; i < NKP; ++i) kreg[i] = *(const u32x4*)(Kg + (long)((k0_) + krow[i]) * ldk + 8 * kc[i]); \
        _Pragma("unroll") for (int i = 0; i < 2; ++i) { const int p = tid + 512 * i; vreg[i] = *(const u32x4*)(Vg + (long)(p >> 3) * ldv + (k0_) + 8 * (p & 7)); } } while (0)
#define A2_LSTORE(b_) do { _Pragma("unroll") for (int i = 0; i < NKP; ++i) *(LAS u32x4*)(buf + (b_) * A2_BUFSZ + krow[i] * RSK + kc[i] * 16) = kreg[i]; \
        _Pragma("unroll") for (int i = 0; i < 2; ++i) { const int p = tid + 512 * i; *(LAS u32x4*)(buf + (b_) * A2_BUFSZ + KBYTES + (p >> 3) * A2_RSV + (p & 7) * 16) = vreg[i]; } } while (0)
    A2_GLOAD(kbeg); A2_LSTORE(0); __syncthreads();
    int b = 0;
    const int kfo = pr * RSK + koff + hi * 16, vfo = KBYTES + n * A2_RSV + hi * 16;
    if (st.m < -1.0e38f) {
        f32x16 sc;
#pragma unroll
        for (int r = 0; r < 16; ++r) sc[r] = 0.f;
#pragma unroll
        for (int s = 0; s < NS; ++s) { const bf16x8 kf0 = *(const LAS bf16x8*)(buf + kfo + 32 * s); sc = __builtin_amdgcn_mfma_f32_32x32x16_bf16(kf0, qf[s], sc, 0, 0, 0); }
        float mx = sc[0];
#pragma unroll
        for (int r = 1; r < 16; ++r) mx = fmaxf(mx, sc[r]);
        mx = fmaxf(mx, __shfl_xor(mx, 32));
        st.m = fmaxf(mx, -60.0f);
    }
    for (int k0 = kbeg; k0 < kend; k0 += 64) {
        const bool more = k0 + 64 < kend;
        if (more) A2_GLOAD(k0 + 64);
        LAS unsigned char* bb = buf + b * A2_BUFSZ;
        if (!(k0 + 64 <= wlo || k0 >= whi)) {
            float iv = -st.m; bool usetab = TAB;
            if (FARC) { if (k0 + 63 - qw <= -576) { iv += cneg; usetab = false; } else if (k0 - qw - 31 >= 576) { iv += cpos; usetab = false; } }
            if (TAB && usetab) a2_tile<NS, RSK, true>(st, bb, kfo, vfo, qf, tp + k0, iv);
            else a2_tile<NS, RSK, false>(st, bb, kfo, vfo, qf, tp, iv);
        }
        if (more) A2_LSTORE(b ^ 1);
        __syncthreads();
        b ^= 1;
    }
#undef A2_GLOAD
#undef A2_LSTORE
}

__device__ __forceinline__ void attn2_unit(const Args& a, const AttnBufs& B, int layer, int mixer, int head, int row0, int S, int q0, int tid, int lane, int wave, LAS unsigned char* buf) {
#ifdef ONLY_MIXER2
    mixer = ONLY_MIXER2;
#endif
    if (mixer == 0) {
        int ln_ = lane; asm volatile("" : "+v"(ln_)); const int n = ln_ & 31, hi = ln_ >> 5;
        const int half = wave >> 2, qw = q0 + 32 * (wave & 3); const long qrow = (long)row0 + qw + n;
        const float lam_init = layer == 0 ? 0.2f : 0.35550906759f;
        AState st; astate_init(st);
        attn2_pass<128, 64, true, true>(st, buf, B.PROJ + qrow * NP + PC_AQ + head * 128 + 64 * half + 8 * hi, 128 * half, B.PROJ + (long)row0 * NP + PC_AK + head * 128, NP,
                                  B.VT + (long)(head * 128) * TCM + row0, TCM, 0, S, B.tabA + head * TABA_N + TABA_OFF - (qw + n) + 8 * hi, 0, S, tid, ln_,
                                  qw, B.tabA[head * TABA_N + TABA_OFF - 700], B.tabA[head * TABA_N + TABA_OFF + 700]);
        astate_finish(st);
        LAS float* xb = (LAS float*)buf + (wave & 3) * 4096;
        if (half == 1) {
#pragma unroll
            for (int d = 0; d < 4; ++d)
#pragma unroll
                for (int r = 0; r < 16; ++r) xb[(d * 16 + r) * 64 + ln_] = st.o[d][r]; }
        __syncthreads();
        if (half == 0) {
            const float d1 = wave_sum(a.in[I_ALQ1][layer * 64 + ln_] * a.in[I_ALK1][layer * 64 + ln_]);
            const float d2 = wave_sum(a.in[I_ALQ2][layer * 64 + ln_] * a.in[I_ALK2][layer * 64 + ln_]);
            const float lam = expf(d1) - expf(d2) + lam_init;
            float ss = 0.f;
#pragma unroll
            for (int d = 0; d < 4; ++d)
#pragma unroll
                for (int r = 0; r < 16; ++r) { const float v = st.o[d][r] - lam * xb[(d * 16 + r) * 64 + ln_]; st.o[d][r] = v; ss += v * v; }
            ss += __shfl_xor(ss, 32);
            const float rs = (1.0f - lam_init) / sqrtf(ss * (1.0f / 128.0f) + EPS);
            const float* gn = a.in[I_AON] + layer * 128 + 4 * hi;
#pragma unroll
            for (int d = 0; d < 4; ++d)
#pragma unroll
                for (int g = 0; g < 4; ++g) { const f32x4 gg = *(const f32x4*)(gn + 32 * d + 8 * g);
#pragma unroll
                    for (int e = 0; e < 4; ++e) st.o[d][4 * g + e] *= rs * gg[e]; }
            store_o(st.o, B.BR + qrow * 2048 + 4 * hi + head * 128);
        }
    } else if (mixer == 1) {
        int ln_ = lane; asm volatile("" : "+v"(ln_)); const int n = ln_ & 31, hi = ln_ >> 5;
        const int qw = q0 + 32 * wave; const long qrow = (long)row0 + qw + n;
        AState st; astate_init(st);
        attn2_pass<192, 192, false>(st, buf, B.QB + qrow * 768 + head * 192 + 8 * hi, 0, B.KB + (long)row0 * 768 + head * 192, 768,
                                    B.VTB + (long)(head * 128) * TCM + row0, TCM, 0, S, nullptr, 0, S, tid, ln_);
        astate_finish(st); store_o(st.o, B.BR + qrow * 2048 + 4 * hi + 512 + head * 128);
    } else if (mixer == 2) {
        int ln_ = lane; asm volatile("" : "+v"(ln_)); const int n = ln_ & 31, hi = ln_ >> 5;
        const int qw = q0 + 32 * wave; const long qrow = (long)row0 + qw + n; const int kv = head >> 1;
        AState st; astate_init(st);
        attn2_pass<128, 128, false>(st, buf, B.PROJ + qrow * NP + PC_CQ + head * 128 + 8 * hi, 0, B.PROJ + (long)row0 * NP + PC_CK + kv * 128, NP,
                                    B.VT + (long)(512 + kv * 128) * TCM + row0, TCM, 0, S, nullptr, 0, S, tid, ln_);
        astate_finish(st); store_o(st.o, B.BR + qrow * 2048 + 4 * hi + 1024 + head * 128);
    } else {
        int ln_ = lane; asm volatile("" : "+v"(ln_)); const int n = ln_ & 31, hi = ln_ >> 5;
        const int qw = q0 + 32 * wave; const long qrow = (long)row0 + qw + n;
        AState st; astate_init(st);
#pragma unroll 1
        for (int g = 0; g < 3; ++g) { const int W = g == 0 ? 64 : (g == 1 ? 256 : 1024);
            const int kb = q0 - W > 0 ? q0 - W : 0, ke = q0 + 256 + W < S ? q0 + 256 + W : S;
            attn2_pass<128, 128, true>(st, buf, B.PROJ + qrow * NP + PC_DQ + (g * 4 + head) * 128 + 8 * hi, 0, B.PROJ + (long)row0 * NP + PC_DK + head * 128, NP,
                                       B.VT + (long)(768 + head * 128) * TCM + row0, TCM, kb, ke, B.tabD + (g * 4 + head) * TABD_N + TABD_OFF - (qw + n) + 8 * hi, qw - W, qw + 32 + W, tid, ln_); }
        astate_finish(st); store_o(st.o, B.BR + qrow * 2048 + 4 * hi + 1536 + head * 128);
    }
}
__device__ __forceinline__ void attn2_phase(const Args& a, const AttnBufs& B, int layer, int chunk, unsigned* ctr, int tid, int lane, int wave, LAS unsigned char* lds) {
#if NCHUNK == 2
    const int npr = chunk == 0 ? 1 : 0, nsm = chunk == 0 ? 4 : 12, TC = chunk == 0 ? 16384 : 24576;
#else
    const int npr = chunk == 0 ? 1 : 0, nsm = chunk == 0 ? 0 : 4, TC = 8192;
#endif
    const int c0 = npr * 128, c1 = npr * 128, c2 = npr * 256, c3 = TC / 64, c4 = nsm * 32, c5 = nsm * 32, c6 = nsm * 64;
    const int total = c0 + c1 + c2 + c3 + c4 + c5 + c6;
    volatile LAS int* uw = (volatile LAS int*)(lds + 131072);
    for (;;) {
        __syncthreads();
        if (tid == 0) *uw = (int)atomicAdd(ctr, 1u);
        __syncthreads();
        int u = __builtin_amdgcn_readfirstlane(*uw);
        if (u >= total) break;
        int mixer, head, row0, S, q0;
        if (u < c0 + c1 + c2) { row0 = 0; S = TP;
            if (u < c0) { mixer = 1; q0 = (u % 32) * 256; head = u / 32; }
            else if (u < c0 + c1) { u -= c0; mixer = 2; q0 = (u % 32) * 256; head = u / 32; }
            else { u -= c0 + c1; mixer = 0; q0 = (u % 64) * 128; head = u / 64; }
        } else { u -= c0 + c1 + c2;
            if (u < c3) { mixer = 3; const int nb = TC / 256; const int q = (u % nb) * 256; head = u / nb;
                if (npr && q < TP) { row0 = 0; S = TP; } else { row0 = npr * TP + ((q - npr * TP) / SS) * SS; S = SS; }
                q0 = q - row0; }
            else { u -= c3; S = SS;
                if (u < c4) { mixer = 1; q0 = (u % 8) * 256; head = (u / 8) % 4; row0 = npr * TP + (u / 32) * SS; }
                else if (u < c4 + c5) { u -= c4; mixer = 2; q0 = (u % 8) * 256; head = (u / 8) % 4; row0 = npr * TP + (u / 32) * SS; }
                else { u -= c4 + c5; mixer = 0; q0 = (u % 16) * 128; head = (u / 16) % 4; row0 = npr * TP + (u / 64) * SS; } } }
        attn2_unit(a, B, layer, mixer, head, row0, S, q0, tid, lane, wave, lds);
    }
}


#define XB_TMO      128
#define XB_XCNT(j)  (256  + 64 * (j))
#define XB_XSUB(j)  (1280 + 64 * (j))
#define XB_XGEN(j)  (2304 + 64 * (j))
#define XB_TOP      3328
#define XB_TOPGEN   3392
#define XCD_BAR_WORDS 3456
#define XB_SPIN_CAP (1u << 22)
__device__ __forceinline__ unsigned xb_ld(unsigned* p)              { return __hip_atomic_load(p, __ATOMIC_RELAXED, __HIP_MEMORY_SCOPE_AGENT); }
__device__ __forceinline__ unsigned xb_add(unsigned* p, unsigned v) { return __hip_atomic_fetch_add(p, v, __ATOMIC_RELAXED, __HIP_MEMORY_SCOPE_AGENT); }
__device__ __forceinline__ unsigned xb_xcc_id() { return (unsigned)__builtin_amdgcn_s_getreg((3 << 11) | 20) & 0xFu; }
#define XB_SPIN(cond, bar) do { unsigned _sp = 0; while (cond) { __builtin_amdgcn_s_sleep(1); \
    if ((++_sp & 255u) == 0u) { if (xb_ld(&(bar)[XB_TMO])) break; if (_sp > XB_SPIN_CAP) { atomicAdd(&(bar)[XB_TMO], 1u); break; } } } } while (0)
struct XcdBarrier { unsigned* bar; unsigned x; volatile LAS unsigned* st; };
__device__ __forceinline__ XcdBarrier xcd_barrier_post(unsigned* bar, volatile LAS unsigned* st) {
    XcdBarrier b; b.bar = bar; b.x = xb_xcc_id(); b.st = st;
    if (threadIdx.x == 0) (void)xb_add(&bar[XB_XCNT(b.x)], 1u);
    return b;
}
__device__ __forceinline__ void xcd_barrier_complete(unsigned* bar, unsigned x, unsigned& nloc, unsigned& nx) {
    const unsigned G = gridDim.x * gridDim.y * gridDim.z;
    unsigned sum, cnt, mine, sp = 0u;
    for (;;) {
        sum = 0u; cnt = 0u; mine = 0u;
#pragma unroll
        for (unsigned j = 0; j < 16; ++j) { const unsigned c = xb_ld(&bar[XB_XCNT(j)]); sum += c; cnt += (c > 0u) ? 1u : 0u; mine = (j == x) ? c : mine; }
        if (sum == G) break;
        __builtin_amdgcn_s_sleep(1);
        if ((++sp & 255u) == 0u) { if (xb_ld(&bar[XB_TMO])) break; if (sp > XB_SPIN_CAP) { atomicAdd(&bar[XB_TMO], 1u); break; } }
    }
    nloc = mine > 0u ? mine : 1u; nx = cnt > 0u ? cnt : 1u;
}
__device__ __forceinline__ void xcd_barrier(const XcdBarrier& b) {
    asm volatile("s_waitcnt vmcnt(0)" ::: "memory");
    __syncthreads();
    if (threadIdx.x == 0) {
        unsigned* bar = b.bar;
        __builtin_amdgcn_s_waitcnt(0);
        unsigned nloc = b.st[0], nx = b.st[1];
        if (nloc == 0u) { xcd_barrier_complete(bar, b.x, nloc, nx); b.st[0] = nloc; b.st[1] = nx; }
        const unsigned old = xb_add(&bar[XB_XSUB(b.x)], 1u);
        const unsigned gen = old / nloc;
        if (old + 1u == (gen + 1u) * nloc) {
            __builtin_amdgcn_fence(__ATOMIC_RELEASE, "agent");
            asm volatile("s_waitcnt vmcnt(0)" ::: "memory");
            const unsigned og = xb_add(&bar[XB_TOP], 1u);
            const unsigned tg = og / nx;
            if (og + 1u == (tg + 1u) * nx) xb_add(&bar[XB_TOPGEN], 1u);
            else XB_SPIN(xb_ld(&bar[XB_TOPGEN]) == tg, bar);
            __builtin_amdgcn_fence(__ATOMIC_ACQUIRE, "agent");
            xb_add(&bar[XB_XGEN(b.x)], 1u);
            asm volatile("s_waitcnt vmcnt(0)" ::: "memory");
        } else {
            XB_SPIN(xb_ld(&bar[XB_XGEN(b.x)]) == gen, bar);
            __builtin_amdgcn_fence(__ATOMIC_ACQUIRE, "agent");
            asm volatile("s_waitcnt vmcnt(0)" ::: "memory");
        }
    }
    __syncthreads();
}

__global__ void __launch_bounds__(512, 2) mega(Args a) {
    extern __shared__ __attribute__((aligned(16))) unsigned char lds_raw[];
    LAS unsigned char* lds = (LAS unsigned char*)lds_raw;
    const int G = gridDim.x, bx = blockIdx.x;
    unsigned char* ws = a.ws;
    unsigned* ctl = (unsigned*)(ws + WS_CTL);
    float* tabA = (float*)(ws + WS_TABA); float* tabD = (float*)(ws + WS_TABD);
    unsigned char* W = ws + WS_W;
    bf16_t* H = (bf16_t*)(ws + WS_H);
    bf16_t* PROJ = (bf16_t*)(ws + WS_R1 + R1_PROJ); bf16_t* VT = (bf16_t*)(ws + WS_R1 + R1_VT); bf16_t* QB = (bf16_t*)(ws + WS_R1 + R1_QB);
    bf16_t* KB = (bf16_t*)(ws + WS_R1 + R1_KB); bf16_t* VTB = (bf16_t*)(ws + WS_R1 + R1_VTB);
    bf16_t* Y = (bf16_t*)(ws + WS_R1); bf16_t* FFH = (bf16_t*)(ws + WS_R1);
    bf16_t* BR = (bf16_t*)(ws + WS_R2); float* PART = (float*)(ws + WS_R2); bf16_t* U = (bf16_t*)(ws + WS_R2);
    bf16_t* MERGED = (bf16_t*)(ws + WS_R2); bf16_t* P16 = (bf16_t*)(ws + WS_R2 + 100 * MiB); bf16_t* XB = (bf16_t*)(ws + WS_XB);
    float* ssA = (float*)(ws + WS_SSP); float* ssB = ssA + (size_t)TCM * 32;
    cg::grid_group grid = cg::this_grid();
    volatile LAS unsigned* bst = (volatile LAS unsigned*)(lds + 131072 + 64);
    if (threadIdx.x < 2) bst[threadIdx.x] = 0u;
    __syncthreads();
    XcdBarrier xbar = xcd_barrier_post(ctl + 1024, bst);

    for (int pid = a.ph_lo; pid < a.ph_hi; ++pid) {
        int tid = threadIdx.x; asm volatile("" : "+v"(tid));
        const int lane = tid & 63, wave = __builtin_amdgcn_readfirstlane(tid >> 6);
        const int gw = bx * 8 + wave, ngw = G * 8;
        const int layer = pid / (1 + 12 * NCHUNK), q = pid % (1 + 12 * NCHUNK);
        if (q == 0) {
            if (layer == 0) build_tables(a.in[I_RELB], tabA, tabD, bx * 512 + tid, G * 512);
#ifndef NO_CONV
            convert_weights(a, layer, W, (LAS float*)(lds + wave * 16384), gw, ngw, lane);
#endif
        } else {
            const int chunk = (q - 1) / 12, kidx = (q - 1) % 12; const int k = kidx < 9 ? kidx + 1 : (kidx == 9 ? 11 : (kidx == 10 ? 12 : 15));
#if NCHUNK == 2
            const int m0 = chunk == 0 ? 0 : 16384, TC = chunk == 0 ? 16384 : 24576, nMt = TC / 256;
#else
            const int m0 = chunk * 8192, TC = 8192, nMt = TC / 256;
#endif
#ifdef NO_ROWS
            if (0) {
#else
            if (k == 1) {
#endif
                const float* g = a.in[I_NMIX] + layer * DM;
                for (int r = gw; r < TC; r += ngw) { const int m = m0 + r;
                    if (layer == 0) norm_row(xrow_ptr(a.in[I_XP], a.in[I_XS], m), g, H + (size_t)r * DM, lane, XB + (size_t)m * DM);
                    else norm_row_bf(XB + (size_t)m * DM, g, H + (size_t)r * DM, lane);
                    const float* pr = m < TP ? a.in[I_PP] + ((size_t)layer * TP + m) * 256 : a.in[I_PS] + ((size_t)layer * 32768 + (m - TP)) * 256;
                    const f32x4 v = *(const f32x4*)(pr + 4 * lane); u32x2 w; w.x = cvt_pk_bf16(v[0], v[1]); w.y = cvt_pk_bf16(v[2], v[3]); *(u32x2*)(P16 + (size_t)r * 256 + 4 * lane) = w;
                }
#ifdef NO_ROWS
            } else if (0) {
#else
            } else if (k == 3 || k == 5) {
#endif
                for (int r = gw; r < TC; r += ngw) { const int m = m0 + r; const int tseq = m < TP ? m : (m - TP) % SS;
                    if (k == 3) post1_row(a, layer, PROJ + (size_t)r * NP, tseq, lane);
                    else post2_row(a, layer, QB + (size_t)r * 768, KB + (size_t)r * 768, PROJ + (size_t)r * NP, tseq, lane); }
            } else if (k == 6) {
                AttnBufs B{PROJ, VT, QB, KB, VTB, BR, tabA, tabD};
#ifndef NO_ATTN
                #if ATTN_V2
                attn2_phase(a, B, layer, chunk, ctl + 64 * (layer * NCHUNK + chunk), tid, lane, wave, lds);
#else
                attn_phase(a, B, layer, chunk, ctl + 64 * (layer * NCHUNK + chunk), lane, (LAS float*)(lds + wave * 16384));
#endif
#endif
            } else {
                const int njobs = (k == 2 || k == 11) ? 2 : (k == 4 ? 3 : 1);
                int coff = 0;
                for (int j = 0; j < njobs; ++j) {
                    pg8::Gemm g; pg8::Epi E; int nM = nMt, nN = 8, rep = 1, adiv = 1 << 30; long astep = 0;
                    E.kind = pg8::EK_BF16; E.O = nullptr; E.ldc = 0; E.Y = nullptr; E.xin = nullptr; E.xob = nullptr; E.xof = nullptr; E.ssq = nullptr; E.rsq = nullptr;
                    bf16_t* XBc = XB + (size_t)m0 * DM;
                    g.A = H; g.Bt = (const bf16_t*)(W + WO_IN); g.lda = 2048; g.ldb = 2048; g.K = 2048;
                    if (k == 2 && j == 0) { nN = NP / 256; E.O = PROJ; E.ldc = NP; }
                    else if (k == 2) { g.A = (const bf16_t*)(W + WO_INV); g.Bt = H; nM = NVT / 256; nN = nMt; E.O = VT; E.ldc = TCM; }
                    else if (k == 4 && j == 0) { g.A = PROJ + PC_BCQ; g.lda = NP; g.Bt = (const bf16_t*)(W + WO_UQ); g.ldb = 512; g.K = 512; nN = 3; E.O = QB; E.ldc = 768; }
                    else if (k == 4 && j == 1) { g.A = PROJ + PC_BCKV; g.lda = NP; g.Bt = (const bf16_t*)(W + WO_UKN); g.ldb = 512; g.K = 512; nN = 2; E.kind = pg8::EK_SPLIT192; E.O = KB; E.ldc = 768; }
                    else if (k == 4) { g.A = (const bf16_t*)(W + WO_UKV); g.lda = 512; g.Bt = PROJ + PC_BCKV; g.ldb = NP; g.K = 512; nM = 2; nN = nMt; E.O = VTB; E.ldc = TCM; }
                    else if (k == 7) { g.A = BR; g.Bt = (const bf16_t*)(W + WO_B); g.ldb = 512; g.K = 512; nN = 32; adiv = 8; astep = 1024; E.O = Y; E.ldc = 8192; }
                    else if (k == 8) { g.Bt = (const bf16_t*)(W + WO_G); nN = 32; E.kind = pg8::EK_GATE; E.O = MERGED; E.Y = Y; }
                    else if (k == 9) { g.A = MERGED; g.Bt = (const bf16_t*)(W + WO_O); E.kind = pg8::EK_RES; E.xin = XBc; E.xob = XBc; E.ssq = ssA; }
                    else if (k == 11 && j == 0) { g.A = XBc; g.Bt = (const bf16_t*)(W + WO_1); nN = 32; E.kind = pg8::EK_RELU2; E.O = FFH; E.ldc = 8192; E.rsq = ssA; }
                    else if (k == 11) { g.A = P16; g.lda = 256; g.Bt = (const bf16_t*)(W + WO_PP); g.ldb = 256; g.K = 256; E.O = U; E.ldc = 2048; }
                    else if (k == 12) { g.A = FFH; g.lda = 8192; g.Bt = (const bf16_t*)(W + WO_2); g.ldb = 8192; g.K = 8192; E.kind = pg8::EK_RES; E.xin = XBc; E.xob = H; E.ssq = ssB; }
                    else { g.Bt = (const bf16_t*)(W + WO_PG); E.kind = pg8::EK_PLE; E.Y = U; E.xin = H; E.rsq = ssB; if (layer == 1) E.xof = a.out + (size_t)m0 * DM; else E.xob = XBc; }
                    pg8::Order S; S.init(nM, nN, G, (bx + G - coff) % G, rep, adiv, astep, (k == 8 || k == 12) ? 1 : 0);
#ifndef NO_GEMM
                    pg8::gemm_phase<true>(lds, g, S, E, tid);
#endif
                    coff = (coff + (nM * nN) % G) % G;
                }
            }
        }
        if (pid + 1 < a.ph_hi) { if (pid == a.ph_lo) grid.sync(); else xcd_barrier(xbar); }
    }
}

extern "C" void kernel_launch(void* const* d_in, const int* in_sizes, int n_in, void* d_out, int out_size, void* d_ws, size_t ws_size, hipStream_t stream) {
    static int grid = 0;
    if (grid == 0) {
        if (n_in != 33 || out_size != TALL * DM || ws_size < WS_END) { fprintf(stderr, "kernel_launch: unexpected shapes (n_in %d out %d ws %zu need %zu)\n", n_in, out_size, ws_size, (size_t)WS_END); grid = -1; return; }
        int dev = 0, cus = 0, per_cu = 0;
        hipGetDevice(&dev); hipDeviceGetAttribute(&cus, hipDeviceAttributeMultiprocessorCount, dev);
        if (hipFuncSetAttribute((const void*)mega, hipFuncAttributeMaxDynamicSharedMemorySize, LDS_BYTES) != hipSuccess) { fprintf(stderr, "kernel_launch: hipFuncSetAttribute failed\n"); grid = -1; return; }
        if (hipOccupancyMaxActiveBlocksPerMultiprocessor(&per_cu, (const void*)mega, 512, LDS_BYTES) != hipSuccess || per_cu < 1) per_cu = 1;
        (void)hipGetLastError();
        grid = cus * per_cu;
        if (grid <= 0) grid = 256;
    }
    if (grid < 0) return;
    hipMemsetAsync((char*)d_ws + WS_CTL, 0, 32768, stream);
    Args a{};
    for (int i = 0; i < 33; ++i) a.in[i] = (const float*)d_in[i];
    a.out = (float*)d_out; a.ws = (unsigned char*)d_ws;
    constexpr int NPH = 2 * (1 + 12 * NCHUNK);
#if COOP
    a.ph_lo = 0; a.ph_hi = NPH;
    void* args[] = {&a};
    hipError_t e = hipLaunchCooperativeKernel((const void*)mega, dim3(grid), dim3(512), args, LDS_BYTES, stream);
    if (e != hipSuccess) fprintf(stderr, "cooperative launch failed: %s (grid %d)\n", hipGetErrorString(e), grid);
#else
    for (int p = 0; p < NPH; ++p) { a.ph_lo = p; a.ph_hi = p + 1; hipLaunchKernelGGL(mega, dim3(grid), dim3(512), LDS_BYTES, stream, a); }
#endif
}
```

```cpp
#include <hip/hip_runtime.h>
#include <hip/hip_cooperative_groups.h>
#include <cstdio>
#include <cstdint>
namespace cg = cooperative_groups;

#ifndef COOP
#define COOP 1
#endif
#ifndef ATTN_V2
#define ATTN_V2 1
#endif
#ifndef NCHUNK
#define NCHUNK 2
#endif

#define LAS __attribute__((address_space(3)))
typedef unsigned short bf16_t;
typedef short bf16x8 __attribute__((ext_vector_type(8)));
typedef float f32x4 __attribute__((ext_vector_type(4)));
typedef float f32x16 __attribute__((ext_vector_type(16)));
typedef unsigned u32x4 __attribute__((ext_vector_type(4)));
typedef unsigned u32x2 __attribute__((ext_vector_type(2)));
typedef float f32x4u __attribute__((ext_vector_type(4), aligned(4)));

constexpr int DM = 2048, TALL = 40960, TP = 8192, SS = 2048;
constexpr int NP = 5120;
constexpr int TCM = 24576;
constexpr int NVT = 1280;
constexpr int DFF = 8192;
constexpr int PC_AQ = 0, PC_AK = 512, PC_BCQ = 1024, PC_BCKV = 1536, PC_CQ = 2048, PC_CK = 2560, PC_DQ = 2816, PC_DK = 4352, PC_BKR = 4864;
constexpr float LOG2E = 1.4426950408889634f;
constexpr float EPS = 1e-6f;
constexpr int TABA_N = 16384, TABA_OFF = 8192, TABD_N = 2304, TABD_OFF = 1152;

constexpr size_t MiB = 1u << 20;
constexpr size_t WS_CTL = 0;
constexpr size_t WS_TABA = 64 * 1024;
constexpr size_t WS_TABD = 384 * 1024;
constexpr size_t WS_SS = 512 * 1024;
constexpr size_t WS_W = 1 * MiB;
constexpr size_t WO_IN = 0;
constexpr size_t WO_INV = WO_IN + (size_t)NP * 2048 * 2;
constexpr size_t WO_G = WO_INV + (size_t)NVT * 2048 * 2;
constexpr size_t WO_B = WO_G + (size_t)8192 * 2048 * 2;
constexpr size_t WO_O = WO_B + (size_t)8192 * 512 * 2;
constexpr size_t WO_1 = WO_O + (size_t)2048 * 2048 * 2;
constexpr size_t WO_2 = WO_1 + (size_t)8192 * 2048 * 2;
constexpr size_t WO_PG = WO_2 + (size_t)2048 * 8192 * 2;
constexpr size_t WO_PP = WO_PG + (size_t)2048 * 2048 * 2;
constexpr size_t WO_UQ = WO_PP + (size_t)2048 * 256 * 2;
constexpr size_t WO_UKN = WO_UQ + (size_t)768 * 512 * 2;
constexpr size_t WO_UKV = WO_UKN + (size_t)512 * 512 * 2;
constexpr size_t WO_END = WO_UKV + (size_t)512 * 512 * 2;
static_assert(WO_END <= 148 * MiB, "weights");
constexpr size_t WS_H = WS_W + 148 * MiB;
constexpr size_t WS_R1 = WS_H + (size_t)TCM * 2048 * 2;
constexpr size_t R1_PROJ = 0;
constexpr size_t R1_VT = R1_PROJ + (size_t)TCM * NP * 2;
constexpr size_t R1_QB = R1_VT + (size_t)NVT * TCM * 2;
constexpr size_t R1_KB = R1_QB + (size_t)TCM * 768 * 2;
constexpr size_t R1_VTB = R1_KB + (size_t)TCM * 768 * 2;
constexpr size_t R1_END = R1_VTB + (size_t)512 * TCM * 2;
static_assert(R1_END >= (size_t)TCM * 8192 * 2, "Y / FFH overlay");
constexpr size_t WS_R2 = WS_R1 + R1_END;
constexpr size_t WS_XB = WS_R2 + (size_t)TCM * 2048 * 4;
constexpr size_t WS_SSP = WS_XB + (size_t)TALL * 2048 * 2;
constexpr size_t WS_END = WS_SSP + 2 * (size_t)TCM * 32 * 4;

constexpr int LDS_BYTES = 147456;

typedef float f32x2_t __attribute__((ext_vector_type(2))); typedef __bf16 bf16x2_t __attribute__((ext_vector_type(2)));
__device__ __forceinline__ unsigned cvt_pk_bf16(float lo, float hi) { f32x2_t v = {lo, hi}; bf16x2_t b = __builtin_convertvector(v, bf16x2_t); return __builtin_bit_cast(unsigned, b); }
__device__ __forceinline__ float bf_lo(unsigned u) { return __uint_as_float(u << 16); }
__device__ __forceinline__ float bf_hi(unsigned u) { return __uint_as_float(u & 0xffff0000u); }
__device__ __forceinline__ float wave_sum(float v) {
#pragma unroll
    for (int o = 1; o < 64; o <<= 1) v += __shfl_xor(v, o);
    return v;
}
__device__ __forceinline__ float sigmoidf_fast(float x) { return __builtin_amdgcn_rcpf(1.0f + __builtin_amdgcn_exp2f(-x * LOG2E)); }
__device__ __forceinline__ const float* xrow_ptr(const float* s0, const float* s1, int m) { return m < TP ? s0 + (size_t)m * DM : s1 + (size_t)(m - TP) * DM; }

namespace pg8 {
constexpr int BM = 256, BK = 64, HALF = 128, HTB = HALF * BK * 2, STAGE_BYTES = 8 * HTB, NXCD = 8, WGM = 8;
__host__ __device__ __forceinline__ int lds_byte(int r, int c) { const int st = (r >> 4) * 2 + (c >> 5), rr = r & 15, cc = c & 31, ob = rr * 64 + cc * 2; return st * 1024 + (ob ^ (((ob >> 9) & 1) << 5)); }
__host__ __device__ __forceinline__ void stage_rc(int b, int& R, int& C) { const int st = b / 1024, sb = b % 1024, swz = sb ^ (((sb >> 9) & 1) << 5); R = (st >> 1) * 16 + swz / 64; C = (st & 1) * 32 + (swz % 64) / 2; }
__host__ __device__ __forceinline__ int perm32(int rho) { const int n = rho >> 4, i = rho & 15; return 8 * (i >> 2) + 4 * n + (i & 3); }

struct Unit { int pm, pn; long aoff; };
struct Gemm { const bf16_t* A; const bf16_t* Bt; int lda, ldb, K; };

struct Order {
    int nM, nN, nwg, G, c, rep, adiv, rev; long astep;
    __device__ void init(int nM_, int nN_, int G_, int c_, int rep_, int adiv_, long astep_, int rev_ = 0) { nM = nM_; nN = nN_; nwg = nM * nN; G = G_; c = c_; rep = rep_; adiv = adiv_; astep = astep_; rev = rev_; }
    __device__ bool next(int i, Unit& u) const {
        const int t = i / rep, sub = i - t * rep;
        const long L = (long)t * G + c; if (L >= nwg) return false;
        int wgid = (int)L; { const int q = nwg / NXCD, r = nwg % NXCD, xcd = wgid % NXCD, off = wgid / NXCD; wgid = (xcd < r ? xcd * (q + 1) : r * (q + 1) + (xcd - r) * q) + off; }
        const int nig = WGM * nN, gid = wgid / nig, fm = gid * WGM, gsz = (nM - fm) < WGM ? (nM - fm) : WGM;
        u.pm = fm + ((wgid % nig) % gsz); if (rev) u.pm = nM - 1 - u.pm; const int pn = (wgid % nig) / gsz; u.pn = pn + sub * nN; u.aoff = (long)(pn / adiv) * astep; return true;
    }
};

__device__ __forceinline__ float row_rs(const float* p, int fq) {
    const f32x4 v0 = *(const f32x4*)(p + 8 * fq), v1 = *(const f32x4*)(p + 8 * fq + 4);
    float t = ((v0[0] + v0[1]) + (v0[2] + v0[3])) + ((v1[0] + v1[1]) + (v1[2] + v1[3]));
    t += __shfl_xor(t, 16); t += __shfl_xor(t, 32);
    return 1.0f / sqrtf(t * (1.0f / 2048.0f) + EPS);
}
enum { EK_BF16 = 0, EK_SPLIT192 = 1, EK_RELU2 = 2, EK_GATE = 3, EK_RES = 4, EK_PLE = 5 };
struct Epi {
    static constexpr bool PERM = true;
    int kind; bf16_t* O; long ldc; const bf16_t* Y;
    const bf16_t* xin; bf16_t* xob; float* xof; float* ssq; const float* rsq;
    __device__ __forceinline__ void operator()(const f32x4 (&acc)[2][2][4][2], const Unit& u, int wr, int wc, int fr, int fq) const {
        const int row0 = u.pm * BM + wr * 64 + fr, col0 = u.pn * BM + wc * 32 + 8 * fq;
        if (kind <= EK_RELU2) {
            float rsv[2][4];
#pragma unroll
            for (int ai = 0; ai < 2; ++ai)
#pragma unroll
                for (int m = 0; m < 4; ++m) rsv[ai][m] = (kind == EK_RELU2) ? row_rs(rsq + (size_t)(row0 + ai * HALF + m * 16) * 32, fq) : 1.f;
#pragma unroll
            for (int ai = 0; ai < 2; ++ai)
#pragma unroll
                for (int m = 0; m < 4; ++m) { const int row = row0 + ai * HALF + m * 16; const float rs = rsv[ai][m];
#pragma unroll
                    for (int bj = 0; bj < 2; ++bj) { int col = col0 + bj * HALF; f32x4 v0 = acc[ai][bj][m][0], v1 = acc[ai][bj][m][1];
                        if (kind == EK_RELU2) {
#pragma unroll
                            for (int e = 0; e < 4; ++e) { float a = fmaxf(v0[e], 0.f) * rs, b = fmaxf(v1[e], 0.f) * rs; v0[e] = a * a; v1[e] = b * b; } }
                        if (kind == EK_SPLIT192) col = (col >> 7) * 192 + (col & 127);
                        u32x4 w; w.x = cvt_pk_bf16(v0[0], v0[1]); w.y = cvt_pk_bf16(v0[2], v0[3]); w.z = cvt_pk_bf16(v1[0], v1[1]); w.w = cvt_pk_bf16(v1[2], v1[3]);
                        *(u32x4*)(O + (size_t)row * ldc + col) = w; } }
        } else if (kind == EK_GATE) {
            const int oc = u.pn * 64 + wc * 16 + 4 * fq;
#pragma unroll
            for (int ai = 0; ai < 2; ++ai) {
                u32x2 yv[4][4];
#pragma unroll
                for (int m = 0; m < 4; ++m) { const bf16_t* yp = Y + (size_t)(row0 + ai * HALF + m * 16) * 8192 + oc;
#pragma unroll
                    for (int b = 0; b < 4; ++b) yv[m][b] = *(const u32x2*)(yp + b * 2048); }
#pragma unroll
                for (int m = 0; m < 4; ++m) { const int row = row0 + ai * HALF + m * 16;
                    f32x4 r = (f32x4){0.f, 0.f, 0.f, 0.f};
#pragma unroll
                    for (int b = 0; b < 4; ++b) { const u32x2 y = yv[m][b]; const f32x4 v = acc[ai][b >> 1][m][b & 1];
                        r[0] += sigmoidf_fast(v[0]) * bf_lo(y.x); r[1] += sigmoidf_fast(v[1]) * bf_hi(y.x); r[2] += sigmoidf_fast(v[2]) * bf_lo(y.y); r[3] += sigmoidf_fast(v[3]) * bf_hi(y.y); }
                    u32x2 w; w.x = cvt_pk_bf16(r[0], r[1]); w.y = cvt_pk_bf16(r[2], r[3]);
                    *(u32x2*)(O + (size_t)row * 2048 + oc) = w; }
            }
        } else if (kind == EK_RES) res_part<false, 4>(acc, u, wc, fq, row0, col0);
        else res_part<true, 2>(acc, u, wc, fq, row0, col0);
    }
    template <bool PLE, int MB>
    __device__ __forceinline__ void res_part(const f32x4 (&acc)[2][2][4][2], const Unit& u, int wc, int fq, int row0, int col0) const {
#pragma unroll
        for (int ai = 0; ai < 2; ++ai)
#pragma unroll
            for (int mb = 0; mb < 4; mb += MB) {
                u32x4 xv[MB][2], yv[MB][2]; float rsv[MB];
#pragma unroll
                for (int mm = 0; mm < MB; ++mm) { const int row = row0 + ai * HALF + (mb + mm) * 16;
                    rsv[mm] = PLE ? row_rs(rsq + (size_t)row * 32, fq) : 1.f;
#pragma unroll
                    for (int bj = 0; bj < 2; ++bj) { const int col = col0 + bj * HALF; xv[mm][bj] = *(const u32x4*)(xin + (size_t)row * DM + col);
                        if (PLE) yv[mm][bj] = *(const u32x4*)(Y + (size_t)row * 2048 + col); } }
#pragma unroll
                for (int mm = 0; mm < MB; ++mm) { const int m = mb + mm; const int row = row0 + ai * HALF + m * 16; const float rs = rsv[mm]; float sq = 0.f;
#pragma unroll
                    for (int bj = 0; bj < 2; ++bj) { const int col = col0 + bj * HALF; f32x4 v0 = acc[ai][bj][m][0], v1 = acc[ai][bj][m][1];
                        const u32x4 xb = xv[mm][bj];
                        if (PLE) { const u32x4 y = yv[mm][bj]; v0 = v0 * rs; v1 = v1 * rs;
                            v0[0] = sigmoidf_fast(v0[0]) * bf_lo(y.x); v0[1] = sigmoidf_fast(v0[1]) * bf_hi(y.x); v0[2] = sigmoidf_fast(v0[2]) * bf_lo(y.y); v0[3] = sigmoidf_fast(v0[3]) * bf_hi(y.y);
                            v1[0] = sigmoidf_fast(v1[0]) * bf_lo(y.z); v1[1] = sigmoidf_fast(v1[1]) * bf_hi(y.z); v1[2] = sigmoidf_fast(v1[2]) * bf_lo(y.w); v1[3] = sigmoidf_fast(v1[3]) * bf_hi(y.w); }
                        f32x4 n0, n1;
                        n0[0] = bf_lo(xb.x) + v0[0]; n0[1] = bf_hi(xb.x) + v0[1]; n0[2] = bf_lo(xb.y) + v0[2]; n0[3] = bf_hi(xb.y) + v0[3];
                        n1[0] = bf_lo(xb.z) + v1[0]; n1[1] = bf_hi(xb.z) + v1[1]; n1[2] = bf_lo(xb.w) + v1[2]; n1[3] = bf_hi(xb.w) + v1[3];
                        if (xof) { *(f32x4*)(xof + (size_t)row * DM + col) = n0; *(f32x4*)(xof + (size_t)row * DM + col + 4) = n1; }
                        else { u32x4 w; w.x = cvt_pk_bf16(n0[0], n0[1]); w.y = cvt_pk_bf16(n0[2], n0[3]); w.z = cvt_pk_bf16(n1[0], n1[1]); w.w = cvt_pk_bf16(n1[2], n1[3]);
                            *(u32x4*)(xob + (size_t)row * DM + col) = w; }
                        if (ssq) sq += (n0[0] * n0[0] + n0[1] * n0[1]) + (n0[2] * n0[2] + n0[3] * n0[3]) + (n1[0] * n1[0] + n1[1] * n1[1]) + (n1[2] * n1[2] + n1[3] * n1[3]); }
                    if (ssq) { sq += __shfl_xor(sq, 16); sq += __shfl_xor(sq, 32); if (fq == 0) ssq[(size_t)row * 32 + u.pn * 4 + wc] = sq; } }
            }
    }
};

template <bool ALIGN_EPI = true>
__device__ __forceinline__ void gemm_phase(LAS unsigned char* lds, const Gemm g, const Order& S, const Epi& E, const int tid) {
    const int wid = __builtin_amdgcn_readfirstlane(tid >> 6), lane = tid & 63, wr = wid >> 2, wc = wid & 3, fr = lane & 15, fq = lane >> 4;
    const int K = g.K, nt = K / BK;
    unsigned voffA[2], voffB[2];
#pragma unroll
    for (int i = 0; i < 2; ++i) { int R, C; stage_rc(tid * 16 + i * 8192, R, C); const int Rb = Epi::PERM ? ((R & ~31) + perm32(R & 31)) : R;
        voffA[i] = (unsigned)(R * g.lda + C) * 2u; voffB[i] = (unsigned)(Rb * g.ldb + C) * 2u; }
    const size_t kstep = (size_t)(BK * 2);
    const size_t hstA = (size_t)HALF * g.lda * 2, hstB = (size_t)HALF * g.ldb * 2;
    const size_t tstA = 2 * hstA, tstB = 2 * hstB;
    const unsigned ldsw = (unsigned)wid * 1024u;
    const int aoff = lds_byte(wr * 64 + fr, fq * 8), boff = lds_byte(wc * 32 + fr, fq * 8);
#define PG8_SA(b, h) (((b) * 2 + (h)) * HTB)
#define PG8_SB(b, h) ((4 + (b) * 2 + (h)) * HTB)
#define PG8_STAGE(bufoff, gbase, voff) do { _Pragma("unroll") for (int _i = 0; _i < 2; ++_i) \
        __builtin_amdgcn_global_load_lds((const unsigned*)((const char*)(gbase) + (voff)[_i]), (LAS unsigned*)(lds + (bufoff) + ldsw + _i * 8192), 16, 0, 0); } while (0)
#define PG8_LDA(dst, b, h) do { _Pragma("unroll") for (int m = 0; m < 4; ++m) _Pragma("unroll") for (int k = 0; k < 2; ++k) dst[m][k] = *(const LAS bf16x8*)(lds + PG8_SA(b, h) + aoff + m * 2048 + k * 1024); } while (0)
#define PG8_LDB(dst, b, h) do { _Pragma("unroll") for (int n = 0; n < 2; ++n) _Pragma("unroll") for (int k = 0; k < 2; ++k) dst[n][k] = *(const LAS bf16x8*)(lds + PG8_SB(b, h) + boff + n * 2048 + k * 1024); } while (0)
#define PG8_MMA(ai, bj, At, Bt) do { __builtin_amdgcn_s_setprio(1); _Pragma("unroll") for (int m = 0; m < 4; ++m) _Pragma("unroll") for (int n = 0; n < 2; ++n) _Pragma("unroll") for (int k = 0; k < 2; ++k) \
        acc[ai][bj][m][n] = __builtin_amdgcn_mfma_f32_16x16x32_bf16(Bt[n][k], At[m][k], acc[ai][bj][m][n], 0, 0, 0); __builtin_amdgcn_s_setprio(0); } while (0)
#define PG8_WAIT_V(n) asm volatile("s_waitcnt vmcnt(" #n ")" ::: "memory")
#define PG8_WAIT_L(n) asm volatile("s_waitcnt lgkmcnt(" #n ")" ::: "memory")
#define PG8_BAR __builtin_amdgcn_s_barrier()
#define PG8_SCHED __builtin_amdgcn_sched_barrier(0)
    Unit cur, nxt; int ui = 0;
    if (!S.next(0, cur)) return;
    f32x4 acc[2][2][4][2];
#pragma unroll
    for (int a = 0; a < 2; ++a)
#pragma unroll
        for (int b = 0; b < 2; ++b)
#pragma unroll
            for (int m = 0; m < 4; ++m)
#pragma unroll
                for (int n = 0; n < 2; ++n) acc[a][b][m][n] = (f32x4){0.f, 0.f, 0.f, 0.f};
    bf16x8 At[4][2], B0[2][2], B1[2][2];
    const char* cA = (const char*)g.A + (size_t)cur.pm * tstA + cur.aoff; const char* cB = (const char*)g.Bt + (size_t)cur.pn * tstB;
    PG8_STAGE(PG8_SB(0, 0), cB, voffB); PG8_STAGE(PG8_SB(0, 1), cB + hstB, voffB); PG8_STAGE(PG8_SA(0, 0), cA, voffA); PG8_STAGE(PG8_SA(0, 1), cA + hstA, voffA);
    if (wr == 1) PG8_BAR;
    PG8_WAIT_V(2); PG8_BAR;
    PG8_STAGE(PG8_SB(1, 0), cB + kstep, voffB); PG8_STAGE(PG8_SA(1, 0), cA + kstep, voffA); PG8_STAGE(PG8_SB(1, 1), cB + hstB + kstep, voffB);
    PG8_WAIT_V(6); PG8_BAR;
    for (;;) {
        const bool has_next = S.next(ui + 1, nxt);
        const char* nA = has_next ? (const char*)g.A + (size_t)nxt.pm * tstA + nxt.aoff : cA; const char* nB = has_next ? (const char*)g.Bt + (size_t)nxt.pn * tstB : cB;
        for (int t = 0; t < nt; t += 2) {
            const bool last = (t == nt - 2);
            const char* a1 = cA + (size_t)(t + 1) * kstep;
            const char* a2 = last ? nA : cA + (size_t)(t + 2) * kstep; const char* b2 = last ? nB : cB + (size_t)(t + 2) * kstep;
            const char* a3 = a2 + kstep; const char* b3 = b2 + kstep;
            PG8_LDB(B0, 0, 0); PG8_LDB(B1, 0, 1); PG8_SCHED; PG8_LDA(At, 0, 0); PG8_STAGE(PG8_SA(1, 1), a1 + hstA, voffA);
            PG8_WAIT_V(8); PG8_WAIT_L(0); PG8_BAR; PG8_MMA(0, 0, At, B0); PG8_MMA(0, 1, At, B1); PG8_BAR; PG8_SCHED;
            PG8_LDA(At, 0, 1); PG8_STAGE(PG8_SB(0, 0), b2, voffB); PG8_STAGE(PG8_SB(0, 1), b2 + hstB, voffB); PG8_STAGE(PG8_SA(0, 0), a2, voffA);
            PG8_WAIT_V(8); PG8_WAIT_L(0); PG8_BAR; PG8_MMA(1, 0, At, B0); PG8_MMA(1, 1, At, B1); PG8_BAR; PG8_SCHED;
            PG8_LDB(B0, 1, 0); PG8_LDB(B1, 1, 1); PG8_SCHED; PG8_LDA(At, 1, 0); PG8_STAGE(PG8_SA(0, 1), a2 + hstA, voffA);
            PG8_WAIT_V(8); PG8_WAIT_L(0); PG8_BAR; PG8_MMA(0, 0, At, B0); PG8_MMA(0, 1, At, B1); PG8_BAR; PG8_SCHED;
            PG8_LDA(At, 1, 1); PG8_STAGE(PG8_SB(1, 0), b3, voffB); PG8_STAGE(PG8_SB(1, 1), b3 + hstB, voffB); PG8_STAGE(PG8_SA(1, 0), a3, voffA);
            PG8_WAIT_V(8); PG8_WAIT_L(0); PG8_BAR; PG8_MMA(1, 0, At, B0); PG8_MMA(1, 1, At, B1); PG8_BAR; PG8_SCHED;
        }
        if constexpr (ALIGN_EPI) { if (wr == 0) PG8_BAR; }
        E(acc, cur, wr, wc, fr, fq);
        if (!has_next) break;
#pragma unroll
        for (int a = 0; a < 2; ++a)
#pragma unroll
            for (int b = 0; b < 2; ++b)
#pragma unroll
                for (int m = 0; m < 4; ++m)
#pragma unroll
                    for (int n = 0; n < 2; ++n) acc[a][b][m][n] = (f32x4){0.f, 0.f, 0.f, 0.f};
        cur = nxt; cA = nA; cB = nB; ++ui;
        if constexpr (ALIGN_EPI) { if (wr == 1) PG8_BAR; }
    }
    PG8_WAIT_V(0);
    if constexpr (!ALIGN_EPI) { if (wr == 0) PG8_BAR; }
    PG8_BAR;
#undef PG8_SA
#undef PG8_SB
#undef PG8_STAGE
#undef PG8_LDA
#undef PG8_LDB
#undef PG8_MMA
#undef PG8_WAIT_V
#undef PG8_WAIT_L
#undef PG8_BAR
#undef PG8_SCHED
}
}

struct Args { const float* in[33]; float* out; unsigned char* ws; int ph_lo, ph_hi; };
enum { I_XP = 0, I_XS, I_PP, I_PS, I_RELB, I_NMIX, I_WIN, I_AQN, I_AKN, I_ALQ1, I_ALK1, I_ALQ2, I_ALK2, I_AON, I_BCQN, I_BCKVN, I_BWUQ, I_BWUKV, I_BQN, I_BKN,
       I_CQN, I_CKN, I_DQN, I_DKN, I_WG, I_WB, I_WO, I_NFFN, I_W1, I_W2, I_NPLE, I_WPG, I_WPP };

__device__ __forceinline__ int rel_bucket(int rel) {
    const int n = rel < 0 ? -rel : rel;
    const float nf = (float)(n > 1 ? n : 1);
    int large = 8 + (int)(logf(nf / 8.0f) / 4.852030263919617f * 8.0f);
    large = large < 15 ? large : 15;
    return (rel > 0 ? 16 : 0) + (n < 8 ? n : large);
}
__device__ __forceinline__ void build_tables(const float* relb, float* tabA, float* tabD, int gtid, int gthreads) {
    for (int i = gtid; i < 4 * TABA_N; i += gthreads) { const int h = i / TABA_N, d = i % TABA_N - TABA_OFF; tabA[i] = relb[rel_bucket(d) * 16 + h] * LOG2E; }
    for (int i = gtid; i < 12 * TABD_N; i += gthreads) { const int gh = i / TABD_N, d = i % TABD_N - TABD_OFF; const int g = gh >> 2; const int dil = g == 0 ? 1 : (g == 1 ? 4 : 16);
        const int ad = d < 0 ? -d : d; const bool ok = (ad % dil == 0) && (ad <= 64 * dil);
        tabD[i] = ok ? relb[rel_bucket(d) * 16 + 4 + gh] * LOG2E : -1e30f; }
}
__device__ __forceinline__ void transpose_item(const float* W, int N, int k0, int n0, bf16_t* dst, int K, LAS float* scr, int lane, int gate_b = -1, const float* gsc = nullptr) {
    float wv[32];
#pragma unroll
    for (int i = 0; i < 32; ++i) { const int kk = 2 * i + (lane >> 5); wv[i] = W[(size_t)(k0 + kk) * N + n0 + (lane & 31)]; }
#pragma unroll
    for (int i = 0; i < 32; ++i) { const int kk = 2 * i + (lane >> 5); float w = wv[i]; if (gsc) w *= gsc[k0 + kk]; scr[kk * 33 + (lane & 31)] = w; }
    asm volatile("s_waitcnt lgkmcnt(0)" ::: "memory");
    const int c = lane & 7;
#pragma unroll
    for (int j = 0; j < 4; ++j) { const int n = (lane >> 3) + 8 * j; const LAS float* s = scr + (8 * c) * 33 + n;
        u32x4 o; o.x = cvt_pk_bf16(s[0 * 33], s[1 * 33]); o.y = cvt_pk_bf16(s[2 * 33], s[3 * 33]); o.z = cvt_pk_bf16(s[4 * 33], s[5 * 33]); o.w = cvt_pk_bf16(s[6 * 33], s[7 * 33]);
        size_t drow = (size_t)n;
        if (gate_b >= 0) { const int nn = n0 + n, j = nn & 63; drow = (size_t)((nn >> 6) * 256 + 128 * (gate_b >> 1) + 32 * (j >> 4) + 8 * ((j >> 2) & 3) + 4 * (gate_b & 1) + (j & 3)); }
        *(u32x4*)(dst + drow * K + k0 + 8 * c) = o; }
    asm volatile("s_waitcnt lgkmcnt(0)" ::: "memory");
}
__device__ __forceinline__ int win_row(int n0) {
    if (n0 < 512) return PC_AQ + n0;
    if (n0 < 1024) return PC_AK + (n0 - 512);
    if (n0 < 1536) return -(0 + (n0 - 1024) + 1);
    if (n0 < 2048) return PC_BCQ + (n0 - 1536);
    if (n0 < 2560) return PC_BCKV + (n0 - 2048);
    if (n0 < 2624) return PC_BKR + (n0 - 2560);
    if (n0 < 3136) return PC_CQ + (n0 - 2624);
    if (n0 < 3392) return PC_CK + (n0 - 3136);
    if (n0 < 3648) return -(512 + (n0 - 3392) + 1);
    if (n0 < 5184) return PC_DQ + (n0 - 3648);
    if (n0 < 5696) return PC_DK + (n0 - 5184);
    return -(768 + (n0 - 5696) + 1);
}
__device__ __forceinline__ void convert_weights(const Args& a, int layer, unsigned char* W, LAS float* scr, int gw, int ngw, int lane) {
    constexpr int I_IN = 32 * 194, I_G = 4 * 32 * 64, I_B = 4 * 8 * 64, I_O = 32 * 64, I_1 = 32 * 256, I_2 = 128 * 64, I_PG = 32 * 64, I_PPn = 4 * 64, I_UQ = 8 * 24, I_UKV = 8 * 32;
    constexpr int NIT = I_IN + I_G + I_B + I_O + I_1 + I_2 + I_PG + I_PPn + I_UQ + I_UKV;
    for (int it = gw; it < NIT; it += ngw) {
        int r = it;
        if (r < I_IN) { const int kb = r / 194, nb = r % 194; const int dr = win_row(nb * 32);
            bf16_t* dst = dr >= 0 ? (bf16_t*)(W + WO_IN) + (size_t)dr * 2048 : (bf16_t*)(W + WO_INV) + (size_t)(-dr - 1) * 2048;
            transpose_item(a.in[I_WIN] + (size_t)layer * 2048 * 6208, 6208, kb * 64, nb * 32, dst, 2048, scr, lane); continue; } r -= I_IN;
        if (r < I_G) { const int b = r / 2048, q = r % 2048, kb = q / 64, nb = q % 64;
            transpose_item(a.in[I_WG] + ((size_t)layer * 4 + b) * 2048 * 2048, 2048, kb * 64, nb * 32, (bf16_t*)(W + WO_G), 2048, scr, lane, b); continue; } r -= I_G;
        if (r < I_B) { const int b = r / 512, q = r % 512, kb = q / 64, nb = q % 64;
            transpose_item(a.in[I_WB] + ((size_t)layer * 4 + b) * 512 * 2048, 2048, kb * 64, nb * 32, (bf16_t*)(W + WO_B) + ((size_t)b * 2048 + nb * 32) * 512, 512, scr, lane); continue; } r -= I_B;
        if (r < I_O) { const int kb = r / 64, nb = r % 64;
            transpose_item(a.in[I_WO] + (size_t)layer * 2048 * 2048, 2048, kb * 64, nb * 32, (bf16_t*)(W + WO_O) + (size_t)(nb * 32) * 2048, 2048, scr, lane); continue; } r -= I_O;
        if (r < I_1) { const int kb = r / 256, nb = r % 256;
            transpose_item(a.in[I_W1] + (size_t)layer * 2048 * 8192, 8192, kb * 64, nb * 32, (bf16_t*)(W + WO_1) + (size_t)(nb * 32) * 2048, 2048, scr, lane, -1, a.in[I_NFFN] + layer * DM); continue; } r -= I_1;
        if (r < I_2) { const int kb = r / 64, nb = r % 64;
            transpose_item(a.in[I_W2] + (size_t)layer * 8192 * 2048, 2048, kb * 64, nb * 32, (bf16_t*)(W + WO_2) + (size_t)(nb * 32) * 8192, 8192, scr, lane); continue; } r -= I_2;
        if (r < I_PG) { const int kb = r / 64, nb = r % 64;
            transpose_item(a.in[I_WPG] + (size_t)layer * 2048 * 2048, 2048, kb * 64, nb * 32, (bf16_t*)(W + WO_PG) + (size_t)(nb * 32) * 2048, 2048, scr, lane, -1, a.in[I_NPLE] + layer * DM); continue; } r -= I_PG;
        if (r < I_PPn) { const int kb = r / 64, nb = r % 64;
            transpose_item(a.in[I_WPP] + (size_t)layer * 256 * 2048, 2048, kb * 64, nb * 32, (bf16_t*)(W + WO_PP) + (size_t)(nb * 32) * 256, 256, scr, lane); continue; } r -= I_PPn;
        if (r < I_UQ) { const int kb = r / 24, nb = r % 24;
            transpose_item(a.in[I_BWUQ] + (size_t)layer * 512 * 768, 768, kb * 64, nb * 32, (bf16_t*)(W + WO_UQ) + (size_t)(nb * 32) * 512, 512, scr, lane); continue; } r -= I_UQ;
        { const int kb = r / 32, nb = r % 32; const int n0 = nb * 32, h = n0 >> 8, j0 = n0 & 255;
            bf16_t* dst = j0 < 128 ? (bf16_t*)(W + WO_UKN) + (size_t)(h * 128 + j0) * 512 : (bf16_t*)(W + WO_UKV) + (size_t)(h * 128 + j0 - 128) * 512;
            transpose_item(a.in[I_BWUKV] + (size_t)layer * 512 * 1024, 1024, kb * 64, n0, dst, 512, scr, lane); }
    }
}

__device__ __forceinline__ void norm_row_bf(const bf16_t* x, const float* g, bf16_t* out, int lane) {
    f32x4 v[8]; float s = 0.f;
#pragma unroll
    for (int j = 0; j < 8; ++j) { const u32x2 u = *(const u32x2*)(x + 4 * lane + 256 * j); v[j][0] = bf_lo(u.x); v[j][1] = bf_hi(u.x); v[j][2] = bf_lo(u.y); v[j][3] = bf_hi(u.y);
        s += (v[j][0] * v[j][0] + v[j][1] * v[j][1]) + (v[j][2] * v[j][2] + v[j][3] * v[j][3]); }
    const float rs = 1.0f / sqrtf(wave_sum(s) * (1.0f / 2048.0f) + EPS);
#pragma unroll
    for (int j = 0; j < 8; ++j) { const f32x4 gg = *(const f32x4*)(g + 4 * lane + 256 * j);
        u32x2 w; w.x = cvt_pk_bf16(v[j][0] * rs * gg[0], v[j][1] * rs * gg[1]); w.y = cvt_pk_bf16(v[j][2] * rs * gg[2], v[j][3] * rs * gg[3]);
        *(u32x2*)(out + 4 * lane + 256 * j) = w; }
}
__device__ __forceinline__ void norm_row(const float* x, const float* g, bf16_t* out, int lane, bf16_t* xb) {
    f32x4 v[8]; float s = 0.f;
#pragma unroll
    for (int j = 0; j < 8; ++j) { v[j] = *(const f32x4*)(x + 4 * lane + 256 * j); s += (v[j][0] * v[j][0] + v[j][1] * v[j][1]) + (v[j][2] * v[j][2] + v[j][3] * v[j][3]);
        u32x2 w; w.x = cvt_pk_bf16(v[j][0], v[j][1]); w.y = cvt_pk_bf16(v[j][2], v[j][3]); *(u32x2*)(xb + 4 * lane + 256 * j) = w; }
    const float rs = 1.0f / sqrtf(wave_sum(s) * (1.0f / 2048.0f) + EPS);
#pragma unroll
    for (int j = 0; j < 8; ++j) { const f32x4 gg = *(const f32x4*)(g + 4 * lane + 256 * j);
        u32x2 w; w.x = cvt_pk_bf16(v[j][0] * rs * gg[0], v[j][1] * rs * gg[1]); w.y = cvt_pk_bf16(v[j][2] * rs * gg[2], v[j][3] * rs * gg[3]);
        *(u32x2*)(out + 4 * lane + 256 * j) = w; }
}
__device__ __forceinline__ void load8(const bf16_t* p, float (&f)[8]) { const u32x4 v = *(const u32x4*)p; f[0] = bf_lo(v.x); f[1] = bf_hi(v.x); f[2] = bf_lo(v.y); f[3] = bf_hi(v.y); f[4] = bf_lo(v.z); f[5] = bf_hi(v.z); f[6] = bf_lo(v.w); f[7] = bf_hi(v.w); }
__device__ __forceinline__ void store8(bf16_t* p, const float (&f)[8]) { u32x4 w; w.x = cvt_pk_bf16(f[0], f[1]); w.y = cvt_pk_bf16(f[2], f[3]); w.z = cvt_pk_bf16(f[4], f[5]); w.w = cvt_pk_bf16(f[6], f[7]); *(u32x4*)p = w; }
template <int GRP> __device__ __forceinline__ void norm8(float (&f)[8], const float* g, float scale, int lane) {
    float s = 0.f;
#pragma unroll
    for (int e = 0; e < 8; ++e) s += f[e] * f[e];
#pragma unroll
    for (int o = 1; o < GRP; o <<= 1) s += __shfl_xor(s, o);
    const float rs = scale / sqrtf(s * (1.0f / (GRP * 8)) + EPS);
    const int gi = (lane & (GRP - 1)) * 8;
#pragma unroll
    for (int e = 0; e < 8; ++e) f[e] = f[e] * rs * g[gi + e];
}
__device__ __forceinline__ float rope_inv(int i) { return __builtin_amdgcn_exp2f(-(float)i * (13.287712379549449f / 32.0f)) * 0.15915494309189535f; }
__device__ __forceinline__ void sincos_rev(float rev, float& sn, float& cs) { rev -= rintf(rev); sn = __builtin_amdgcn_sinf(rev); cs = __builtin_amdgcn_cosf(rev); }
__device__ __forceinline__ void axial_rope8(float (&f)[8], float rowpos, float colpos, int lane) {
    const int j = lane & 15, hf = j >> 3, jj = j & 7; const float pos = hf ? colpos : rowpos; const float sgn = jj < 4 ? -1.f : 1.f; const int i0 = 8 * (jj & 3);
#pragma unroll
    for (int e = 0; e < 8; ++e) { const float pv = __shfl_xor(f[e], 4); float sn, cs; sincos_rev(pos * rope_inv(i0 + e), sn, cs); f[e] = f[e] * cs + sgn * pv * sn; }
}
__device__ __forceinline__ void post1_row(const Args& a, int layer, bf16_t* P, int tseq, int lane) {
    float fq[8], fk[8], fcq[8], fckv[8], gq[8], gk[8], d0[8], d1[8], d2[8], dk[8];
    const int l2 = lane & 31;
    load8(P + PC_AQ + 8 * lane, fq); load8(P + PC_AK + 8 * lane, fk); load8(P + PC_BCQ + 8 * lane, fcq); load8(P + PC_BCKV + 8 * lane, fckv);
    load8(P + PC_CQ + 8 * lane, gq); load8(P + PC_CK + 8 * l2, gk);
    load8(P + PC_DQ + 8 * lane, d0); load8(P + PC_DQ + 512 + 8 * lane, d1); load8(P + PC_DQ + 1024 + 8 * lane, d2); load8(P + PC_DK + 8 * lane, dk);
    const float sA = 0.125f * LOG2E, sC = 0.08838834764831845f * LOG2E;
    const float rowpos = (float)(tseq >> 6), colpos = (float)(tseq & 63);
    norm8<8>(fq, a.in[I_AQN] + layer * 64, sA, lane); norm8<8>(fk, a.in[I_AKN] + layer * 64, 1.f, lane);
    norm8<64>(fcq, a.in[I_BCQN] + layer * 512, 1.f, lane); norm8<64>(fckv, a.in[I_BCKVN] + layer * 512, 1.f, lane);
    norm8<16>(gq, a.in[I_CQN] + layer * 128, sC, lane); axial_rope8(gq, rowpos, colpos, lane);
    norm8<16>(gk, a.in[I_CKN] + layer * 128, 1.f, lane); axial_rope8(gk, rowpos, colpos, lane);
    norm8<16>(d0, a.in[I_DQN] + layer * 128, sC, lane); norm8<16>(d1, a.in[I_DQN] + layer * 128, sC, lane); norm8<16>(d2, a.in[I_DQN] + layer * 128, sC, lane);
    norm8<16>(dk, a.in[I_DKN] + layer * 128, 1.f, lane);
    store8(P + PC_AQ + 8 * lane, fq); store8(P + PC_AK + 8 * lane, fk); store8(P + PC_BCQ + 8 * lane, fcq); store8(P + PC_BCKV + 8 * lane, fckv);
    store8(P + PC_CQ + 8 * lane, gq); if (lane < 32) store8(P + PC_CK + 8 * l2, gk);
    store8(P + PC_DQ + 8 * lane, d0); store8(P + PC_DQ + 512 + 8 * lane, d1); store8(P + PC_DQ + 1024 + 8 * lane, d2); store8(P + PC_DK + 8 * lane, dk);
}
__device__ __forceinline__ void mla_norm_rope(float (&f)[8], float (&r)[4], const float* g, float scale, float pos, int lane) {
    const int j = lane & 15;
    float s = 0.f;
#pragma unroll
    for (int e = 0; e < 8; ++e) s += f[e] * f[e];
#pragma unroll
    for (int e = 0; e < 4; ++e) s += r[e] * r[e];
#pragma unroll
    for (int o = 1; o < 16; o <<= 1) s += __shfl_xor(s, o);
    const float rs = scale / sqrtf(s * (1.0f / 192.0f) + EPS);
#pragma unroll
    for (int e = 0; e < 8; ++e) f[e] = f[e] * rs * g[8 * j + e];
#pragma unroll
    for (int e = 0; e < 4; ++e) r[e] = r[e] * rs * g[128 + 4 * j + e];
    const float sgn = j < 8 ? -1.f : 1.f; const int i0 = 4 * (j & 7);
#pragma unroll
    for (int e = 0; e < 4; ++e) { const float pv = __shfl_xor(r[e], 8); float sn, cs; sincos_rev(pos * rope_inv(i0 + e), sn, cs); r[e] = r[e] * cs + sgn * pv * sn; }
}
__device__ __forceinline__ void post2_row(const Args& a, int layer, bf16_t* Q, bf16_t* Kr, const bf16_t* P, int tseq, int lane) {
    const int h = lane >> 4, j = lane & 15; const float pos = (float)tseq;
    float f[8], r[4];
    float f2[8], r2[4];
    bf16_t* q = Q + h * 192; bf16_t* k = Kr + h * 192;
    load8(q + 8 * j, f); const u32x2 vq = *(const u32x2*)(q + 128 + 4 * j); load8(k + 8 * j, f2); const u32x2 vk = *(const u32x2*)(P + PC_BKR + 4 * j);
    r[0] = bf_lo(vq.x); r[1] = bf_hi(vq.x); r[2] = bf_lo(vq.y); r[3] = bf_hi(vq.y);
    r2[0] = bf_lo(vk.x); r2[1] = bf_hi(vk.x); r2[2] = bf_lo(vk.y); r2[3] = bf_hi(vk.y);
    mla_norm_rope(f, r, a.in[I_BQN] + layer * 192, 0.07216878364870323f * LOG2E, pos, lane);
    mla_norm_rope(f2, r2, a.in[I_BKN] + layer * 192, 1.f, pos, lane);
    store8(q + 8 * j, f); { u32x2 w; w.x = cvt_pk_bf16(r[0], r[1]); w.y = cvt_pk_bf16(r[2], r[3]); *(u32x2*)(q + 128 + 4 * j) = w; }
    store8(k + 8 * j, f2); { u32x2 w; w.x = cvt_pk_bf16(r2[0], r2[1]); w.y = cvt_pk_bf16(r2[2], r2[3]); *(u32x2*)(k + 128 + 4 * j) = w; }
}

struct AState { float m, l; f32x16 o[4]; };
__device__ __forceinline__ void astate_init(AState& st) { st.m = -3.0e38f; st.l = 0.f;
#pragma unroll
    for (int d = 0; d < 4; ++d)
#pragma unroll
        for (int r = 0; r < 16; ++r) st.o[d][r] = 0.f; }
template <int DK, bool TAB, bool QLDS = false>
__device__ __forceinline__ void attn_pass(AState& st, const bf16_t* qp, const bf16_t* kp, long ldk, const bf16_t* vp, long ldv, int kbeg, int kend, const float* tp, LAS bf16x8* qst = nullptr) {
    constexpr int NS = DK / 16;
    bf16x8 qf[QLDS ? 1 : NS], kf[NS];
    if (QLDS) {
#pragma unroll
        for (int s = 0; s < NS; ++s) qst[s * 64] = *(const bf16x8*)(qp + 16 * s);
    } else {
#pragma unroll
        for (int s = 0; s < NS; ++s) qf[s] = *(const bf16x8*)(qp + 16 * s);
    }
    { const bf16_t* k0p = kp + (long)kbeg * ldk;
#pragma unroll
      for (int s = 0; s < NS; ++s) kf[s] = *(const bf16x8*)(k0p + 16 * s); }
    for (int k0 = kbeg; k0 < kend; k0 += 32) {
        bf16x8 vf[4][2];
#pragma unroll
        for (int d = 0; d < 4; ++d)
#pragma unroll
            for (int s = 0; s < 2; ++s) vf[d][s] = *(const bf16x8*)(vp + (long)(32 * d) * ldv + k0 + 16 * s);
        f32x4 tb[4];
        if (TAB) {
#pragma unroll
            for (int s = 0; s < 2; ++s) { tb[2 * s] = *(const f32x4u*)(tp + k0 + 16 * s); tb[2 * s + 1] = *(const f32x4u*)(tp + k0 + 16 * s + 4); } }
        f32x16 sc;
#pragma unroll
        for (int r = 0; r < 16; ++r) sc[r] = 0.f;
#pragma unroll
        for (int s = 0; s < NS; ++s) sc = __builtin_amdgcn_mfma_f32_32x32x16_bf16(kf[s], QLDS ? qst[s * 64] : qf[QLDS ? 0 : s], sc, 0, 0, 0);
        if (k0 + 32 < kend) { const bf16_t* knp = kp + (long)(k0 + 32) * ldk;
#pragma unroll
            for (int s = 0; s < NS; ++s) kf[s] = *(const bf16x8*)(knp + 16 * s); }
        if (TAB) {
#pragma unroll
            for (int r = 0; r < 16; ++r) sc[r] += tb[r >> 2][r & 3]; }
        float mx = sc[0];
#pragma unroll
        for (int r = 1; r < 16; ++r) mx = fmaxf(mx, sc[r]);
        mx = fmaxf(mx, __shfl_xor(mx, 32));
        const float mn = fmaxf(st.m, mx);
        const float alpha = __builtin_amdgcn_exp2f(st.m - mn);
        st.m = mn;
        float ps = 0.f;
#pragma unroll
        for (int r = 0; r < 16; ++r) { sc[r] = __builtin_amdgcn_exp2f(sc[r] - mn); ps += sc[r]; }
        st.l = st.l * alpha + ps;
#pragma unroll
        for (int d = 0; d < 4; ++d)
#pragma unroll
            for (int r = 0; r < 16; ++r) st.o[d][r] *= alpha;
        u32x4 p0, p1;
        p0.x = cvt_pk_bf16(sc[0], sc[1]); p0.y = cvt_pk_bf16(sc[2], sc[3]); p0.z = cvt_pk_bf16(sc[4], sc[5]); p0.w = cvt_pk_bf16(sc[6], sc[7]);
        p1.x = cvt_pk_bf16(sc[8], sc[9]); p1.y = cvt_pk_bf16(sc[10], sc[11]); p1.z = cvt_pk_bf16(sc[12], sc[13]); p1.w = cvt_pk_bf16(sc[14], sc[15]);
        const bf16x8 pf0 = __builtin_bit_cast(bf16x8, p0), pf1 = __builtin_bit_cast(bf16x8, p1);
#pragma unroll
        for (int d = 0; d < 4; ++d) { st.o[d] = __builtin_amdgcn_mfma_f32_32x32x16_bf16(vf[d][0], pf0, st.o[d], 0, 0, 0); st.o[d] = __builtin_amdgcn_mfma_f32_32x32x16_bf16(vf[d][1], pf1, st.o[d], 0, 0, 0); }
    }
}
__device__ __forceinline__ void astate_finish(AState& st) {
    const float l = st.l + __shfl_xor(st.l, 32); const float inv = 1.0f / l;
#pragma unroll
    for (int d = 0; d < 4; ++d)
#pragma unroll
        for (int r = 0; r < 16; ++r) st.o[d][r] *= inv;
}
__device__ __forceinline__ void store_o(const f32x16 (&o)[4], bf16_t* op) {
#pragma unroll
    for (int d = 0; d < 4; ++d)
#pragma unroll
        for (int g = 0; g < 4; ++g) { u32x2 w; w.x = cvt_pk_bf16(o[d][4 * g], o[d][4 * g + 1]); w.y = cvt_pk_bf16(o[d][4 * g + 2], o[d][4 * g + 3]); *(u32x2*)(op + 32 * d + 8 * g) = w; }
}
__device__ __forceinline__ int pi32(int n) { return (n & ~12) | ((n & 4) << 1) | ((n & 8) >> 1); }

struct AttnBufs { const bf16_t* PROJ; const bf16_t* VT; const bf16_t* QB; const bf16_t* KB; const bf16_t* VTB; bf16_t* BR; const float* tabA; const float* tabD; };

__device__ __forceinline__ void attn_unit(const Args& a, const AttnBufs& B, int layer, int mixer, int head, int row0  , int S, int q0  , int lane, LAS float* stash) {
#define ATT_LANE_SETUP int ln_ = lane; asm volatile("" : "+v"(ln_)); const int n = ln_ & 31, hi = ln_ >> 5, pr = pi32(n); const long qrow = (long)row0 + q0 + n; bf16_t* op = B.BR + qrow * 2048 + 4 * hi;
#ifdef ONLY_MIXER
    mixer = ONLY_MIXER;
#endif
    if (mixer == 0) {
        ATT_LANE_SETUP
        const float lam_init = layer == 0 ? 0.2f : 0.35550906759f;
        const float d1 = wave_sum(a.in[I_ALQ1][layer * 64 + lane] * a.in[I_ALK1][layer * 64 + lane]);
        const float d2 = wave_sum(a.in[I_ALQ2][layer * 64 + lane] * a.in[I_ALK2][layer * 64 + lane]);
        const float lam = expf(d1) - expf(d2) + lam_init;
        const bf16_t* vp = B.VT + (long)(head * 128 + n) * TCM + row0 + 8 * hi;
        const float* tp = B.tabA + head * TABA_N + TABA_OFF - (q0 + n) + 8 * hi;
        { AState st; astate_init(st);
          attn_pass<64, true>(st, B.PROJ + qrow * NP + PC_AQ + head * 128 + 8 * hi, B.PROJ + (long)(row0 + pr) * NP + PC_AK + head * 128 + 8 * hi, NP, vp, TCM, 0, S, tp);
          astate_finish(st);
#pragma unroll
          for (int d = 0; d < 4; ++d)
#pragma unroll
              for (int r = 0; r < 16; ++r) stash[(d * 16 + r) * 64 + lane] = st.o[d][r]; }
        AState st; astate_init(st);
        attn_pass<64, true>(st, B.PROJ + qrow * NP + PC_AQ + head * 128 + 64 + 8 * hi, B.PROJ + (long)(row0 + pr) * NP + PC_AK + head * 128 + 64 + 8 * hi, NP, vp, TCM, 0, S, tp);
        astate_finish(st);
        float ss = 0.f;
#pragma unroll
        for (int d = 0; d < 4; ++d)
#pragma unroll
            for (int r = 0; r < 16; ++r) { const float v = stash[(d * 16 + r) * 64 + lane] - lam * st.o[d][r]; st.o[d][r] = v; ss += v * v; }
        ss += __shfl_xor(ss, 32);
        const float rs = (1.0f - lam_init) / sqrtf(ss * (1.0f / 128.0f) + EPS);
        const float* gn = a.in[I_AON] + layer * 128 + 4 * hi;
#pragma unroll
        for (int d = 0; d < 4; ++d)
#pragma unroll
            for (int g = 0; g < 4; ++g) { const f32x4 gg = *(const f32x4*)(gn + 32 * d + 8 * g);
#pragma unroll
                for (int e = 0; e < 4; ++e) st.o[d][4 * g + e] *= rs * gg[e]; }
        store_o(st.o, op + head * 128);
    } else if (mixer == 1) {
        ATT_LANE_SETUP
        AState st; astate_init(st);
        attn_pass<192, false, true>(st, B.QB + qrow * 768 + head * 192 + 8 * hi, B.KB + (long)(row0 + pr) * 768 + head * 192 + 8 * hi, 768,
                              B.VTB + (long)(head * 128 + n) * TCM + row0 + 8 * hi, TCM, 0, S, nullptr, (LAS bf16x8*)stash + lane);
        astate_finish(st); store_o(st.o, op + 512 + head * 128);
    } else if (mixer == 2) {
        ATT_LANE_SETUP
        const int kv = head >> 1;
        AState st; astate_init(st);
        attn_pass<128, false>(st, B.PROJ + qrow * NP + PC_CQ + head * 128 + 8 * hi, B.PROJ + (long)(row0 + pr) * NP + PC_CK + kv * 128 + 8 * hi, NP,
                              B.VT + (long)(512 + kv * 128 + n) * TCM + row0 + 8 * hi, TCM, 0, S, nullptr);
        astate_finish(st); store_o(st.o, op + 1024 + head * 128);
    } else {
        ATT_LANE_SETUP
        AState st; astate_init(st);
        const bf16_t* kp = B.PROJ + (long)(row0 + pr) * NP + PC_DK + head * 128 + 8 * hi;
        const bf16_t* vp = B.VT + (long)(768 + head * 128 + n) * TCM + row0 + 8 * hi;
#pragma unroll 1
        for (int g = 0; g < 3; ++g) { const int W = g == 0 ? 64 : (g == 1 ? 256 : 1024);
            const int kb = q0 - W > 0 ? q0 - W : 0, ke = q0 + 32 + W < S ? q0 + 32 + W : S;
            attn_pass<128, true>(st, B.PROJ + qrow * NP + PC_DQ + (g * 4 + head) * 128 + 8 * hi, kp, NP, vp, TCM, kb, ke, B.tabD + (g * 4 + head) * TABD_N + TABD_OFF - (q0 + n) + 8 * hi); }
        astate_finish(st); store_o(st.o, op + 1536 + head * 128);
    }
}
__device__ __forceinline__ void attn_phase(const Args& a, const AttnBufs& B, int layer, int chunk, unsigned* ctr, int lane, LAS float* stash) {
#if NCHUNK == 2
    const int npr = chunk == 0 ? 1 : 0, nsm = chunk == 0 ? 4 : 12, TC = chunk == 0 ? 16384 : 24576;
#else
    const int npr = chunk == 0 ? 1 : 0, nsm = chunk == 0 ? 0 : 4, TC = 8192;
#endif
    const int nP = npr * 1024, nS = nsm * 256, nD = TC / 8, total = 3 * nP + 3 * nS + nD;
    for (;;) {
        unsigned uu = 0; if (lane == 0) uu = atomicAdd(ctr, 1u);
        int u = __builtin_amdgcn_readfirstlane((int)uu);
        if (u >= total) break;
        int mixer, head, row0, S, q0;
        if (u < 3 * nP) { mixer = u / nP; const int r = u % nP; q0 = (r % 256) * 32; head = r / 256; row0 = 0; S = TP; }
        else { u -= 3 * nP;
            if (u < 3 * nS) { mixer = u / nS; const int r = u % nS; q0 = (r % 64) * 32; head = (r / 64) % 4; row0 = npr * TP + (r / 256) * SS; S = SS; }
            else { u -= 3 * nS; mixer = 3; const int qb = u % (TC / 32); head = u / (TC / 32); const int q = qb * 32;
                if (npr && q < TP) { row0 = 0; S = TP; } else { row0 = npr * TP + ((q - npr * TP) / SS) * SS; S = SS; }
                q0 = q - row0; } }
#ifdef ONLY_MIXER
        if (mixer != ONLY_MIXER) continue;
#endif
        attn_unit(a, B, layer, mixer, head, row0, S, q0, lane, stash);
    }
}


constexpr int A2_RSV = 144, A2_BUFSZ = 64 * 400 + 128 * A2_RSV;
static_assert(2 * A2_BUFSZ <= 131072 && 2 * A2_BUFSZ >= 65536, "attention LDS");

template <int NS, int RSK, bool USETAB>
__device__ __forceinline__ void a2_tile(AState& st, LAS unsigned char* bb, int kfo, int vfo, const bf16x8 (&qf)[NS], const float* tpk, float iv) {
#define A2_SB() __builtin_amdgcn_sched_barrier(0x0024)
#define A2_LDK0(s_) (*(const LAS bf16x8*)(bb + kfo + 32 * (s_)))
#define A2_LDK1(s_) (*(const LAS bf16x8*)(bb + kfo + 32 * RSK + 32 * (s_)))
#define A2_LDV0(i_) (*(const LAS bf16x8*)(bb + vfo + (32 * ((i_) & 3)) * A2_RSV + 32 * ((i_) >> 2)))
#define A2_LDV1(i_) (*(const LAS bf16x8*)(bb + vfo + (32 * ((i_) & 3)) * A2_RSV + 64 + 32 * ((i_) >> 2)))
    constexpr int PD = 3;
    f32x4 tb[8];
    if (USETAB) {
#pragma unroll
        for (int s = 0; s < 4; ++s) { tb[2 * s] = *(const f32x4u*)(tpk + 16 * s); tb[2 * s + 1] = *(const f32x4u*)(tpk + 16 * s + 4); } }
    f32x16 ini, sc0, sc1;
#pragma unroll
    for (int r = 0; r < 16; ++r) ini[r] = iv;
    u32x4 pw[4];
    float mx = -3.0e38f, ps = 0.f;
    bf16x8 ka[NS], kb[NS], va[8], vb[8];
#pragma unroll
    for (int s = 0; s < PD; ++s) ka[s] = A2_LDK0(s);
    A2_SB();
#pragma unroll
    for (int s = 0; s < NS; ++s) {
        if (s + PD < NS) ka[s + PD] = A2_LDK0(s + PD); else kb[s + PD - NS] = A2_LDK1(s + PD - NS);
        sc0 = __builtin_amdgcn_mfma_f32_32x32x16_bf16(ka[s], qf[s], s == 0 ? ini : sc0, 0, 0, 0);
        A2_SB(); }
#pragma unroll
    for (int s = 0; s < NS; ++s) {
        if (s + PD < NS) kb[s + PD] = A2_LDK1(s + PD); else va[s + PD - NS] = A2_LDV0(s + PD - NS);
        sc1 = __builtin_amdgcn_mfma_f32_32x32x16_bf16(kb[s], qf[s], s == 0 ? ini : sc1, 0, 0, 0);
        A2_SB();
#pragma unroll
        for (int pp = (8 * s) / NS; pp < (8 * (s + 1)) / NS; ++pp) {
            float x0 = sc0[2 * pp], x1 = sc0[2 * pp + 1];
            if (USETAB) { x0 += tb[(2 * pp) >> 2][(2 * pp) & 3]; x1 += tb[(2 * pp + 1) >> 2][(2 * pp + 1) & 3]; }
            mx = fmaxf(mx, fmaxf(x0, x1));
            const float e0 = __builtin_amdgcn_exp2f(x0), e1 = __builtin_amdgcn_exp2f(x1);
            ps += e0 + e1; pw[pp >> 2][pp & 3] = cvt_pk_bf16(e0, e1); }
        A2_SB();
    }
    {
        const bf16x8 pf0 = __builtin_bit_cast(bf16x8, pw[0]), pf1 = __builtin_bit_cast(bf16x8, pw[1]);
#pragma unroll
        for (int i = 0; i < 8; ++i) { const int h = i >> 2, d = i & 3;
            if (i + PD < 8) va[i + PD] = A2_LDV0(i + PD); else vb[i + PD - 8] = A2_LDV1(i + PD - 8);
            st.o[d] = __builtin_amdgcn_mfma_f32_32x32x16_bf16(va[i], h ? pf1 : pf0, st.o[d], 0, 0, 0);
            A2_SB();
            { const int pp = i; float x0 = sc1[2 * pp], x1 = sc1[2 * pp + 1];
              if (USETAB) { x0 += tb[4 + ((2 * pp) >> 2)][(2 * pp) & 3]; x1 += tb[4 + ((2 * pp + 1) >> 2)][(2 * pp + 1) & 3]; }
              mx = fmaxf(mx, fmaxf(x0, x1));
              const float e0 = __builtin_amdgcn_exp2f(x0), e1 = __builtin_amdgcn_exp2f(x1);
              ps += e0 + e1; pw[2 + (pp >> 2)][pp & 3] = cvt_pk_bf16(e0, e1); }
            A2_SB(); }
    }
    {
        const bf16x8 pf2 = __builtin_bit_cast(bf16x8, pw[2]), pf3 = __builtin_bit_cast(bf16x8, pw[3]);
#pragma unroll
        for (int i = 0; i < 8; ++i) { const int h = i >> 2, d = i & 3;
            if (i + PD < 8) vb[i + PD] = A2_LDV1(i + PD);
            st.o[d] = __builtin_amdgcn_mfma_f32_32x32x16_bf16(vb[i], h ? pf3 : pf2, st.o[d], 0, 0, 0);
            A2_SB(); }
    }
    st.l += ps;
    mx = fmaxf(mx, __shfl_xor(mx, 32));
    if (__any(mx > 8.0f)) {
        const float dm = fmaxf(mx, 0.f); const float alpha = __builtin_amdgcn_exp2f(-dm); st.m += dm; st.l *= alpha;
#pragma unroll
        for (int d = 0; d < 4; ++d)
#pragma unroll
            for (int r = 0; r < 16; ++r) st.o[d][r] *= alpha;
    }
#undef A2_SB
#undef A2_LDK0
#undef A2_LDK1
#undef A2_LDV0
#undef A2_LDV1
}
template <int DKL, int DK, bool TAB, bool FARC = false>
__device__ __forceinline__ void attn2_pass(AState& st, LAS unsigned char* buf, const bf16_t* qp, int koff, const bf16_t* Kg, long ldk, const bf16_t* Vg, long ldv,
                                           int kbeg, int kend, const float* tp, int wlo, int whi, int tid_in, int lane, int qw = 0, float cneg = 0.f, float cpos = 0.f) {
    constexpr int NS = DK / 16, PR = DKL / 8, NKP = DKL / 64, RSK = DKL * 2 + 16, KBYTES = 64 * RSK;
    int tid = tid_in; asm volatile("" : "+v"(tid));
    const int n = lane & 31, hi = lane >> 5, pr = pi32(n);
    bf16x8 qf[NS];
#pragma unroll
    for (int s = 0; s < NS; ++s) qf[s] = *(const bf16x8*)(qp + 16 * s);
    u32x4 kreg[NKP], vreg[2];
    int krow[NKP], kc[NKP];
#pragma unroll
    for (int i = 0; i < NKP; ++i) { const int p = tid + 512 * i; krow[i] = p / PR; kc[i] = p % PR; }
#define A2_GLOAD(k0_) do { _Pragma("unroll") for (int i = 0; i < NKP; ++i) kreg[i] = *(const u32x4*)(Kg + (long)((k0_) + krow[i]) * ldk + 8 * kc[i]); \
        _Pragma("unroll") for (int i = 0; i < 2; ++i) { const int p = tid + 512 * i; vreg[i] = *(const u32x4*)(Vg + (long)(p >> 3) * ldv + (k0_) + 8 * (p & 7)); } } while (0)
#define A2_LSTORE(b_) do { _Pragma("unroll") for (int i = 0; i < NKP; ++i) *(LAS u32x4*)(buf + (b_) * A2_BUFSZ + krow[i] * RSK + kc[i] * 16) = kreg[i]; \
        _Pragma("unroll") for (int i = 0; i < 2; ++i) { const int p = tid + 512 * i; *(LAS u32x4*)(buf + (b_) * A2_BUFSZ + KBYTES + (p >> 3) * A2_RSV + (p & 7) * 16) = vreg[i]; } } while (0)
    A2_GLOAD(kbeg); A2_LSTORE(0); __syncthreads();
    int b = 0;
    const int kfo = pr * RSK + koff + hi * 16, vfo = KBYTES + n * A2_RSV + hi * 16;
    if (st.m < -1.0e38f) {
        f32x16 sc;
#pragma unroll
        for (int r = 0; r < 16; ++r) sc[r] = 0.f;
#pragma unroll
        for (int s = 0; s < NS; ++s) { const bf16x8 kf0 = *(const LAS bf16x8*)(buf + kfo + 32 * s); sc = __builtin_amdgcn_mfma_f32_32x32x16_bf16(kf0, qf[s], sc, 0, 0, 0); }
        float mx = sc[0];
#pragma unroll
        for (int r = 1; r < 16; ++r) mx = fmaxf(mx, sc[r]);
        mx = fmaxf(mx, __shfl_xor(mx, 32));
        st.m = fmaxf(mx, -60.0f);
    }
    for (int k0 = kbeg; k0 < kend; k0 += 64) {
        const bool more = k0 + 64 < kend;
        if (more) A2_GLOAD(k0 + 64);
        LAS unsigned char* bb = buf + b * A2_BUFSZ;
        if (!(k0 + 64 <= wlo || k0 >= whi)) {
            float iv = -st.m; bool usetab = TAB;
            if (FARC) { if (k0 + 63 - qw <= -576) { iv += cneg; usetab = false; } else if (k0 - qw - 31 >= 576) { iv += cpos; usetab = false; } }
            if (TAB && usetab) a2_tile<NS, RSK, true>(st, bb, kfo, vfo, qf, tp + k0, iv);
            else a2_tile<NS, RSK, false>(st, bb, kfo, vfo, qf, tp, iv);
        }
        if (more) A2_LSTORE(b ^ 1);
        __syncthreads();
        b ^= 1;
    }
#undef A2_GLOAD
#undef A2_LSTORE
}

__device__ __forceinline__ void attn2_unit(const Args& a, const AttnBufs& B, int layer, int mixer, int head, int row0, int S, int q0, int tid, int lane, int wave, LAS unsigned char* buf) {
#ifdef ONLY_MIXER2
    mixer = ONLY_MIXER2;
#endif
    if (mixer == 0) {
        int ln_ = lane; asm volatile("" : "+v"(ln_)); const int n = ln_ & 31, hi = ln_ >> 5;
        const int half = wave >> 2, qw = q0 + 32 * (wave & 3); const long qrow = (long)row0 + qw + n;
        const float lam_init = layer == 0 ? 0.2f : 0.35550906759f;
        AState st; astate_init(st);
        attn2_pass<128, 64, true, true>(st, buf, B.PROJ + qrow * NP + PC_AQ + head * 128 + 64 * half + 8 * hi, 128 * half, B.PROJ + (long)row0 * NP + PC_AK + head * 128, NP,
                                  B.VT + (long)(head * 128) * TCM + row0, TCM, 0, S, B.tabA + head * TABA_N + TABA_OFF - (qw + n) + 8 * hi, 0, S, tid, ln_,
                                  qw, B.tabA[head * TABA_N + TABA_OFF - 700], B.tabA[head * TABA_N + TABA_OFF + 700]);
        astate_finish(st);
        LAS float* xb = (LAS float*)buf + (wave & 3) * 4096;
        if (half == 1) {
#pragma unroll
            for (int d = 0; d < 4; ++d)
#pragma unroll
                for (int r = 0; r < 16; ++r) xb[(d * 16 + r) * 64 + ln_] = st.o[d][r]; }
        __syncthreads();
        if (half == 0) {
            const float d1 = wave_sum(a.in[I_ALQ1][layer * 64 + ln_] * a.in[I_ALK1][layer * 64 + ln_]);
            const float d2 = wave_sum(a.in[I_ALQ2][layer * 64 + ln_] * a.in[I_ALK2][layer * 64 + ln_]);
            const float lam = expf(d1) - expf(d2) + lam_init;
            float ss = 0.f;
#pragma unroll
            for (int d = 0; d < 4; ++d)
#pragma unroll
                for (int r = 0; r < 16; ++r) { const float v = st.o[d][r] - lam * xb[(d * 16 + r) * 64 + ln_]; st.o[d][r] = v; ss += v * v; }
            ss += __shfl_xor(ss, 32);
            const float rs = (1.0f - lam_init) / sqrtf(ss * (1.0f / 128.0f) + EPS);
            const float* gn = a.in[I_AON] + layer * 128 + 4 * hi;
#pragma unroll
            for (int d = 0; d < 4; ++d)
#pragma unroll
                for (int g = 0; g < 4; ++g) { const f32x4 gg = *(const f32x4*)(gn + 32 * d + 8 * g);
#pragma unroll
                    for (int e = 0; e < 4; ++e) st.o[d][4 * g + e] *= rs * gg[e]; }
            store_o(st.o, B.BR + qrow * 2048 + 4 * hi + head * 128);
        }
    } else if (mixer == 1) {
        int ln_ = lane; asm volatile("" : "+v"(ln_)); const int n = ln_ & 31, hi = ln_ >> 5;
        const int qw = q0 + 32 * wave; const long qrow = (long)row0 + qw + n;
        AState st; astate_init(st);
        attn2_pass<192, 192, false>(st, buf, B.QB + qrow * 768 + head * 192 + 8 * hi, 0, B.KB + (long)row0 * 768 + head * 192, 768,
                                    B.VTB + (long)(head * 128) * TCM + row0, TCM, 0, S, nullptr, 0, S, tid, ln_);
        astate_finish(st); store_o(st.o, B.BR + qrow * 2048 + 4 * hi + 512 + head * 128);
    } else if (mixer == 2) {
        int ln_ = lane; asm volatile("" : "+v"(ln_)); const int n = ln_ & 31, hi = ln_ >> 5;
        const int qw = q0 + 32 * wave; const long qrow = (long)row0 + qw + n; const int kv = head >> 1;
        AState st; astate_init(st);
        attn2_pass<128, 128, false>(st, buf, B.PROJ + qrow * NP + PC_CQ + head * 128 + 8 * hi, 0, B.PROJ + (long)row0 * NP + PC_CK + kv * 128, NP,
                                    B.VT + (long)(512 + kv * 128) * TCM + row0, TCM, 0, S, nullptr, 0, S, tid, ln_);
        astate_finish(st); store_o(st.o, B.BR + qrow * 2048 + 4 * hi + 1024 + head * 128);
    } else {
        int ln_ = lane; asm volatile("" : "+v"(ln_)); const int n = ln_ & 31, hi = ln_ >> 5;
        const int qw = q0 + 32 * wave; const long qrow = (long)row0 + qw + n;
        AState st; astate_init(st);
#pragma unroll 1
        for (int g = 0; g < 3; ++g) { const int W = g == 0 ? 64 : (g == 1 ? 256 : 1024);
            const int kb = q0 - W > 0 ? q0 - W : 0, ke = q0 + 256 + W < S ? q0 + 256 + W : S;
            attn2_pass<128, 128, true>(st, buf, B.PROJ + qrow * NP + PC_DQ + (g * 4 + head) * 128 + 8 * hi, 0, B.PROJ + (long)row0 * NP + PC_DK + head * 128, NP,
                                       B.VT + (long)(768 + head * 128) * TCM + row0, TCM, kb, ke, B.tabD + (g * 4 + head) * TABD_N + TABD_OFF - (qw + n) + 8 * hi, qw - W, qw + 32 + W, tid, ln_); }
        astate_finish(st); store_o(st.o, B.BR + qrow * 2048 + 4 * hi + 1536 + head * 128);
    }
}
__device__ __forceinline__ void attn2_phase(const Args& a, const AttnBufs& B, int layer, int chunk, unsigned* ctr, int tid, int lane, int wave, LAS unsigned char* lds) {
#if NCHUNK == 2
    const int npr = chunk == 0 ? 1 : 0, nsm = chunk == 0 ? 4 : 12, TC = chunk == 0 ? 16384 : 24576;
#else
    const int npr = chunk == 0 ? 1 : 0, nsm = chunk == 0 ? 0 : 4, TC = 8192;
#endif
    const int c0 = npr * 128, c1 = npr * 128, c2 = npr * 256, c3 = TC / 64, c4 = nsm * 32, c5 = nsm * 32, c6 = nsm * 64;
    const int total = c0 + c1 + c2 + c3 + c4 + c5 + c6;
    volatile LAS int* uw = (volatile LAS int*)(lds + 131072);
    for (;;) {
        __syncthreads();
        if (tid == 0) *uw = (int)atomicAdd(ctr, 1u);
        __syncthreads();
        int u = __builtin_amdgcn_readfirstlane(*uw);
        if (u >= total) break;
        int mixer, head, row0, S, q0;
        if (u < c0 + c1 + c2) { row0 = 0; S = TP;
            if (u < c0) { mixer = 1; q0 = (u % 32) * 256; head = u / 32; }
            else if (u < c0 + c1) { u -= c0; mixer = 2; q0 = (u % 32) * 256; head = u / 32; }
            else { u -= c0 + c1; mixer = 0; q0 = (u % 64) * 128; head = u / 64; }
        } else { u -= c0 + c1 + c2;
            if (u < c3) { mixer = 3; const int nb = TC / 256; const int q = (u % nb) * 256; head = u / nb;
                if (npr && q < TP) { row0 = 0; S = TP; } else { row0 = npr * TP + ((q - npr * TP) / SS) * SS; S = SS; }
                q0 = q - row0; }
            else { u -= c3; S = SS;
                if (u < c4) { mixer = 1; q0 = (u % 8) * 256; head = (u / 8) % 4; row0 = npr * TP + (u / 32) * SS; }
                else if (u < c4 + c5) { u -= c4; mixer = 2; q0 = (u % 8) * 256; head = (u / 8) % 4; row0 = npr * TP + (u / 32) * SS; }
                else { u -= c4 + c5; mixer = 0; q0 = (u % 16) * 128; head = (u / 16) % 4; row0 = npr * TP + (u / 64) * SS; } } }
        attn2_unit(a, B, layer, mixer, head, row0, S, q0, tid, lane, wave, lds);
    }
}


#define XB_TMO      128
#define XB_XCNT(j)  (256  + 64 * (j))
#define XB_XSUB(j)  (1280 + 64 * (j))
#define XB_XGEN(j)  (2304 + 64 * (j))
#define XB_TOP      3328
#define XB_TOPGEN   3392
#define XCD_BAR_WORDS 3456
#define XB_SPIN_CAP (1u << 22)
__device__ __forceinline__ unsigned xb_ld(unsigned* p)              { return __hip_atomic_load(p, __ATOMIC_RELAXED, __HIP_MEMORY_SCOPE_AGENT); }
__device__ __forceinline__ unsigned xb_add(unsigned* p, unsigned v) { return __hip_atomic_fetch_add(p, v, __ATOMIC_RELAXED, __HIP_MEMORY_SCOPE_AGENT); }
__device__ __forceinline__ unsigned xb_xcc_id() { return (unsigned)__builtin_amdgcn_s_getreg((3 << 11) | 20) & 0xFu; }
#define XB_SPIN(cond, bar) do { unsigned _sp = 0; while (cond) { __builtin_amdgcn_s_sleep(1); \
    if ((++_sp & 255u) == 0u) { if (xb_ld(&(bar)[XB_TMO])) break; if (_sp > XB_SPIN_CAP) { atomicAdd(&(bar)[XB_TMO], 1u); break; } } } } while (0)
struct XcdBarrier { unsigned* bar; unsigned x; volatile LAS unsigned* st; };
__device__ __forceinline__ XcdBarrier xcd_barrier_post(unsigned* bar, volatile LAS unsigned* st) {
    XcdBarrier b; b.bar = bar; b.x = xb_xcc_id(); b.st = st;
    if (threadIdx.x == 0) (void)xb_add(&bar[XB_XCNT(b.x)], 1u);
    return b;
}
__device__ __forceinline__ void xcd_barrier_complete(unsigned* bar, unsigned x, unsigned& nloc, unsigned& nx) {
    const unsigned G = gridDim.x * gridDim.y * gridDim.z;
    unsigned sum, cnt, mine, sp = 0u;
    for (;;) {
        sum = 0u; cnt = 0u; mine = 0u;
#pragma unroll
        for (unsigned j = 0; j < 16; ++j) { const unsigned c = xb_ld(&bar[XB_XCNT(j)]); sum += c; cnt += (c > 0u) ? 1u : 0u; mine = (j == x) ? c : mine; }
        if (sum == G) break;
        __builtin_amdgcn_s_sleep(1);
        if ((++sp & 255u) == 0u) { if (xb_ld(&bar[XB_TMO])) break; if (sp > XB_SPIN_CAP) { atomicAdd(&bar[XB_TMO], 1u); break; } }
    }
    nloc = mine > 0u ? mine : 1u; nx = cnt > 0u ? cnt : 1u;
}
__device__ __forceinline__ void xcd_barrier(const XcdBarrier& b) {
    asm volatile("s_waitcnt vmcnt(0)" ::: "memory");
    __syncthreads();
    if (threadIdx.x == 0) {
        unsigned* bar = b.bar;
        __builtin_amdgcn_s_waitcnt(0);
        unsigned nloc = b.st[0], nx = b.st[1];
        if (nloc == 0u) { xcd_barrier_complete(bar, b.x, nloc, nx); b.st[0] = nloc; b.st[1] = nx; }
        const unsigned old = xb_add(&bar[XB_XSUB(b.x)], 1u);
        const unsigned gen = old / nloc;
        if (old + 1u == (gen + 1u) * nloc) {
            __builtin_amdgcn_fence(__ATOMIC_RELEASE, "agent");
            asm volatile("s_waitcnt vmcnt(0)" ::: "memory");
            const unsigned og = xb_add(&bar[XB_TOP], 1u);
            const unsigned tg = og / nx;
            if (og + 1u == (tg + 1u) * nx) xb_add(&bar[XB_TOPGEN], 1u);
            else XB_SPIN(xb_ld(&bar[XB_TOPGEN]) == tg, bar);
            __builtin_amdgcn_fence(__ATOMIC_ACQUIRE, "agent");
            xb_add(&bar[XB_XGEN(b.x)], 1u);
            asm volatile("s_waitcnt vmcnt(0)" ::: "memory");
        } else {
            XB_SPIN(xb_ld(&bar[XB_XGEN(b.x)]) == gen, bar);
            __builtin_amdgcn_fence(__ATOMIC_ACQUIRE, "agent");
            asm volatile("s_waitcnt vmcnt(0)" ::: "memory");
        }
    }
    __syncthreads();
}

__global__ void __launch_bounds__(512, 2) mega(Args a) {
    extern __shared__ __attribute__((aligned(16))) unsigned char lds_raw[];
    LAS unsigned char* lds = (LAS unsigned char*)lds_raw;
    const int G = gridDim.x, bx = blockIdx.x;
    unsigned char* ws = a.ws;
    unsigned* ctl = (unsigned*)(ws + WS_CTL);
    float* tabA = (float*)(ws + WS_TABA); float* tabD = (float*)(ws + WS_TABD);
    unsigned char* W = ws + WS_W;
    bf16_t* H = (bf16_t*)(ws + WS_H);
    bf16_t* PROJ = (bf16_t*)(ws + WS_R1 + R1_PROJ); bf16_t* VT = (bf16_t*)(ws + WS_R1 + R1_VT); bf16_t* QB = (bf16_t*)(ws + WS_R1 + R1_QB);
    bf16_t* KB = (bf16_t*)(ws + WS_R1 + R1_KB); bf16_t* VTB = (bf16_t*)(ws + WS_R1 + R1_VTB);
    bf16_t* Y = (bf16_t*)(ws + WS_R1); bf16_t* FFH = (bf16_t*)(ws + WS_R1);
    bf16_t* BR = (bf16_t*)(ws + WS_R2); float* PART = (float*)(ws + WS_R2); bf16_t* U = (bf16_t*)(ws + WS_R2);
    bf16_t* MERGED = (bf16_t*)(ws + WS_R2); bf16_t* P16 = (bf16_t*)(ws + WS_R2 + 100 * MiB); bf16_t* XB = (bf16_t*)(ws + WS_XB);
    float* ssA = (float*)(ws + WS_SSP); float* ssB = ssA + (size_t)TCM * 32;
    cg::grid_group grid = cg::this_grid();
    volatile LAS unsigned* bst = (volatile LAS unsigned*)(lds + 131072 + 64);
    if (threadIdx.x < 2) bst[threadIdx.x] = 0u;
    __syncthreads();
    XcdBarrier xbar = xcd_barrier_post(ctl + 1024, bst);

    for (int pid = a.ph_lo; pid < a.ph_hi; ++pid) {
        int tid = threadIdx.x; asm volatile("" : "+v"(tid));
        const int lane = tid & 63, wave = __builtin_amdgcn_readfirstlane(tid >> 6);
        const int gw = bx * 8 + wave, ngw = G * 8;
        const int layer = pid / (1 + 12 * NCHUNK), q = pid % (1 + 12 * NCHUNK);
        if (q == 0) {
            if (layer == 0) build_tables(a.in[I_RELB], tabA, tabD, bx * 512 + tid, G * 512);
#ifndef NO_CONV
            convert_weights(a, layer, W, (LAS float*)(lds + wave * 16384), gw, ngw, lane);
#endif
        } else {
            const int chunk = (q - 1) / 12, kidx = (q - 1) % 12; const int k = kidx < 9 ? kidx + 1 : (kidx == 9 ? 11 : (kidx == 10 ? 12 : 15));
#if NCHUNK == 2
            const int m0 = chunk == 0 ? 0 : 16384, TC = chunk == 0 ? 16384 : 24576, nMt = TC / 256;
#else
            const int m0 = chunk * 8192, TC = 8192, nMt = TC / 256;
#endif
#ifdef NO_ROWS
            if (0) {
#else
            if (k == 1) {
#endif
                const float* g = a.in[I_NMIX] + layer * DM;
                for (int r = gw; r < TC; r += ngw) { const int m = m0 + r;
                    if (layer == 0) norm_row(xrow_ptr(a.in[I_XP], a.in[I_XS], m), g, H + (size_t)r * DM, lane, XB + (size_t)m * DM);
                    else norm_row_bf(XB + (size_t)m * DM, g, H + (size_t)r * DM, lane);
                    const float* pr = m < TP ? a.in[I_PP] + ((size_t)layer * TP + m) * 256 : a.in[I_PS] + ((size_t)layer * 32768 + (m - TP)) * 256;
                    const f32x4 v = *(const f32x4*)(pr + 4 * lane); u32x2 w; w.x = cvt_pk_bf16(v[0], v[1]); w.y = cvt_pk_bf16(v[2], v[3]); *(u32x2*)(P16 + (size_t)r * 256 + 4 * lane) = w;
                }
#ifdef NO_ROWS
            } else if (0) {
#else
            } else if (k == 3 || k == 5) {
#endif
                for (int r = gw; r < TC; r += ngw) { const int m = m0 + r; const int tseq = m < TP ? m : (m - TP) % SS;
                    if (k == 3) post1_row(a, layer, PROJ + (size_t)r * NP, tseq, lane);
                    else post2_row(a, layer, QB + (size_t)r * 768, KB + (size_t)r * 768, PROJ + (size_t)r * NP, tseq, lane); }
            } else if (k == 6) {
                AttnBufs B{PROJ, VT, QB, KB, VTB, BR, tabA, tabD};
#ifndef NO_ATTN
                #if ATTN_V2
                attn2_phase(a, B, layer, chunk, ctl + 64 * (layer * NCHUNK + chunk), tid, lane, wave, lds);
#else
                attn_phase(a, B, layer, chunk, ctl + 64 * (layer * NCHUNK + chunk), lane, (LAS float*)(lds + wave * 16384));
#endif
#endif
            } else {
                const int njobs = (k == 2 || k == 11) ? 2 : (k == 4 ? 3 : 1);
                int coff = 0;
                for (int j = 0; j < njobs; ++j) {
                    pg8::Gemm g; pg8::Epi E; int nM = nMt, nN = 8, rep = 1, adiv = 1 << 30; long astep = 0;
                    E.kind = pg8::EK_BF16; E.O = nullptr; E.ldc = 0; E.Y = nullptr; E.xin = nullptr; E.xob = nullptr; E.xof = nullptr; E.ssq = nullptr; E.rsq = nullptr;
                    bf16_t* XBc = XB + (size_t)m0 * DM;
                    g.A = H; g.Bt = (const bf16_t*)(W + WO_IN); g.lda = 2048; g.ldb = 2048; g.K = 2048;
                    if (k == 2 && j == 0) { nN = NP / 256; E.O = PROJ; E.ldc = NP; }
                    else if (k == 2) { g.A = (const bf16_t*)(W + WO_INV); g.Bt = H; nM = NVT / 256; nN = nMt; E.O = VT; E.ldc = TCM; }
                    else if (k == 4 && j == 0) { g.A = PROJ + PC_BCQ; g.lda = NP; g.Bt = (const bf16_t*)(W + WO_UQ); g.ldb = 512; g.K = 512; nN = 3; E.O = QB; E.ldc = 768; }
                    else if (k == 4 && j == 1) { g.A = PROJ + PC_BCKV; g.lda = NP; g.Bt = (const bf16_t*)(W + WO_UKN); g.ldb = 512; g.K = 512; nN = 2; E.kind = pg8::EK_SPLIT192; E.O = KB; E.ldc = 768; }
                    else if (k == 4) { g.A = (const bf16_t*)(W + WO_UKV); g.lda = 512; g.Bt = PROJ + PC_BCKV; g.ldb = NP; g.K = 512; nM = 2; nN = nMt; E.O = VTB; E.ldc = TCM; }
                    else if (k == 7) { g.A = BR; g.Bt = (const bf16_t*)(W + WO_B); g.ldb = 512; g.K = 512; nN = 32; adiv = 8; astep = 1024; E.O = Y; E.ldc = 8192; }
                    else if (k == 8) { g.Bt = (const bf16_t*)(W + WO_G); nN = 32; E.kind = pg8::EK_GATE; E.O = MERGED; E.Y = Y; }
                    else if (k == 9) { g.A = MERGED; g.Bt = (const bf16_t*)(W + WO_O); E.kind = pg8::EK_RES; E.xin = XBc; E.xob = XBc; E.ssq = ssA; }
                    else if (k == 11 && j == 0) { g.A = XBc; g.Bt = (const bf16_t*)(W + WO_1); nN = 32; E.kind = pg8::EK_RELU2; E.O = FFH; E.ldc = 8192; E.rsq = ssA; }
                    else if (k == 11) { g.A = P16; g.lda = 256; g.Bt = (const bf16_t*)(W + WO_PP); g.ldb = 256; g.K = 256; E.O = U; E.ldc = 2048; }
                    else if (k == 12) { g.A = FFH; g.lda = 8192; g.Bt = (const bf16_t*)(W + WO_2); g.ldb = 8192; g.K = 8192; E.kind = pg8::EK_RES; E.xin = XBc; E.xob = H; E.ssq = ssB; }
                    else { g.Bt = (const bf16_t*)(W + WO_PG); E.kind = pg8::EK_PLE; E.Y = U; E.xin = H; E.rsq = ssB; if (layer == 1) E.xof = a.out + (size_t)m0 * DM; else E.xob = XBc; }
                    pg8::Order S; S.init(nM, nN, G, (bx + G - coff) % G, rep, adiv, astep, (k == 8 || k == 12) ? 1 : 0);
#ifndef NO_GEMM
                    pg8::gemm_phase<true>(lds, g, S, E, tid);
#endif
                    coff = (coff + (nM * nN) % G) % G;
                }
            }
        }
        if (pid + 1 < a.ph_hi) { if (pid == a.ph_lo) grid.sync(); else xcd_barrier(xbar); }
    }
}

extern "C" void kernel_launch(void* const* d_in, const int* in_sizes, int n_in, void* d_out, int out_size, void* d_ws, size_t ws_size, hipStream_t stream) {
    static int grid = 0;
    if (grid == 0) {
        if (n_in != 33 || out_size != TALL * DM || ws_size < WS_END) { fprintf(stderr, "kernel_launch: unexpected shapes (n_in %d out %d ws %zu need %zu)\n", n_in, out_size, ws_size, (size_t)WS_END); grid = -1; return; }
        int dev = 0, cus = 0, per_cu = 0;
        hipGetDevice(&dev); hipDeviceGetAttribute(&cus, hipDeviceAttributeMultiprocessorCount, dev);
        if (hipFuncSetAttribute((const void*)mega, hipFuncAttributeMaxDynamicSharedMemorySize, LDS_BYTES) != hipSuccess) { fprintf(stderr, "kernel_launch: hipFuncSetAttribute failed\n"); grid = -1; return; }
        if (hipOccupancyMaxActiveBlocksPerMultiprocessor(&per_cu, (const void*)mega, 512, LDS_BYTES) != hipSuccess || per_cu < 1) per_cu = 1;
        (void)hipGetLastError();
        grid = cus * per_cu;
        if (grid <= 0) grid = 256;
    }
    if (grid < 0) return;
    hipMemsetAsync((char*)d_ws + WS_CTL, 0, 32768, stream);
    Args a{};
    for (int i = 0; i < 33; ++i) a.in[i] = (const float*)d_in[i];
    a.out = (float*)d_out; a.ws = (unsigned char*)d_ws;
    constexpr int NPH = 2 * (1 + 12 * NCHUNK);
#if COOP
    a.ph_lo = 0; a.ph_hi = NPH;
    void* args[] = {&a};
    hipError_t e = hipLaunchCooperativeKernel((const void*)mega, dim3(grid), dim3(512), args, LDS_BYTES, stream);
    if (e != hipSuccess) fprintf(stderr, "cooperative launch failed: %s (grid %d)\n", hipGetErrorString(e), grid);
#else
    for (int p = 0; p < NPH; ++p) { a.ph_lo = p; a.ph_hi = p + 1; hipLaunchKernelGGL(mega, dim3(grid), dim3(512), LDS_BYTES, stream, a); }
#endif
}
```

```cpp
#include <hip/hip_runtime.h>
#include <hip/hip_cooperative_groups.h>
#include <cstdio>
#include <cstdint>
namespace cg = cooperative_groups;

#ifndef COOP
#define COOP 1
#endif
#ifndef ATTN_V2
#define ATTN_V2 1
#endif
#ifndef NCHUNK
#define NCHUNK 2
#endif

#define LAS __attribute__((address_space(3)))
typedef unsigned short bf16_t;
typedef short bf16x8 __attribute__((ext_vector_type(8)));
typedef float f32x4 __attribute__((ext_vector_type(4)));
typedef float f32x16 __attribute__((ext_vector_type(16)));
typedef unsigned u32x4 __attribute__((ext_vector_type(4)));
typedef unsigned u32x2 __attribute__((ext_vector_type(2)));
typedef float f32x4u __attribute__((ext_vector_type(4), aligned(4)));

constexpr int DM = 2048, TALL = 40960, TP = 8192, SS = 2048;
constexpr int NP = 5120;
constexpr int TCM = 24576;
constexpr int NVT = 1280;
constexpr int DFF = 8192;
constexpr int PC_AQ = 0, PC_AK = 512, PC_BCQ = 1024, PC_BCKV = 1536, PC_CQ = 2048, PC_CK = 2560, PC_DQ = 2816, PC_DK = 4352, PC_BKR = 4864;
constexpr float LOG2E = 1.4426950408889634f;
constexpr float EPS = 1e-6f;
constexpr int TABA_N = 16384, TABA_OFF = 8192, TABD_N = 2304, TABD_OFF = 1152;

constexpr size_t MiB = 1u << 20;
constexpr size_t WS_CTL = 0;
constexpr size_t WS_TABA = 64 * 1024;
constexpr size_t WS_TABD = 384 * 1024;
constexpr size_t WS_SS = 512 * 1024;
constexpr size_t WS_W = 1 * MiB;
constexpr size_t WO_IN = 0;
constexpr size_t WO_INV = WO_IN + (size_t)NP * 2048 * 2;
constexpr size_t WO_G = WO_INV + (size_t)NVT * 2048 * 2;
constexpr size_t WO_B = WO_G + (size_t)8192 * 2048 * 2;
constexpr size_t WO_O = WO_B + (size_t)8192 * 512 * 2;
constexpr size_t WO_1 = WO_O + (size_t)2048 * 2048 * 2;
constexpr size_t WO_2 = WO_1 + (size_t)8192 * 2048 * 2;
constexpr size_t WO_PG = WO_2 + (size_t)2048 * 8192 * 2;
constexpr size_t WO_PP = WO_PG + (size_t)2048 * 2048 * 2;
constexpr size_t WO_UQ = WO_PP + (size_t)2048 * 256 * 2;
constexpr size_t WO_UKN = WO_UQ + (size_t)768 * 512 * 2;
constexpr size_t WO_UKV = WO_UKN + (size_t)512 * 512 * 2;
constexpr size_t WO_END = WO_UKV + (size_t)512 * 512 * 2;
static_assert(WO_END <= 148 * MiB, "weights");
constexpr size_t WS_H = WS_W + 148 * MiB;
constexpr size_t WS_R1 = WS_H + (size_t)TCM * 2048 * 2;
constexpr size_t R1_PROJ = 0;
constexpr size_t R1_VT = R1_PROJ + (size_t)TCM * NP * 2;
constexpr size_t R1_QB = R1_VT + (size_t)NVT * TCM * 2;
constexpr size_t R1_KB = R1_QB + (size_t)TCM * 768 * 2;
constexpr size_t R1_VTB = R1_KB + (size_t)TCM * 768 * 2;
constexpr size_t R1_END = R1_VTB + (size_t)512 * TCM * 2;
static_assert(R1_END >= (size_t)TCM * 8192 * 2, "Y / FFH overlay");
constexpr size_t WS_R2 = WS_R1 + R1_END;
constexpr size_t WS_XB = WS_R2 + (size_t)TCM * 2048 * 4;
constexpr size_t WS_SSP = WS_XB + (size_t)TALL * 2048 * 2;
constexpr size_t WS_END = WS_SSP + 2 * (size_t)TCM * 32 * 4;

constexpr int LDS_BYTES = 147456;

typedef float f32x2_t __attribute__((ext_vector_type(2))); typedef __bf16 bf16x2_t __attribute__((ext_vector_type(2)));
__device__ __forceinline__ unsigned cvt_pk_bf16(float lo, float hi) { f32x2_t v = {lo, hi}; bf16x2_t b = __builtin_convertvector(v, bf16x2_t); return __builtin_bit_cast(unsigned, b); }
__device__ __forceinline__ float bf_lo(unsigned u) { return __uint_as_float(u << 16); }
__device__ __forceinline__ float bf_hi(unsigned u) { return __uint_as_float(u & 0xffff0000u); }
__device__ __forceinline__ float wave_sum(float v) {
#pragma unroll
    for (int o = 1; o < 64; o <<= 1) v += __shfl_xor(v, o);
    return v;
}
__device__ __forceinline__ float sigmoidf_fast(float x) { return __builtin_amdgcn_rcpf(1.0f + __builtin_amdgcn_exp2f(-x * LOG2E)); }
__device__ __forceinline__ const float* xrow_ptr(const float* s0, const float* s1, int m) { return m < TP ? s0 + (size_t)m * DM : s1 + (size_t)(m - TP) * DM; }

namespace pg8 {
constexpr int BM = 256, BK = 64, HALF = 128, HTB = HALF * BK * 2, STAGE_BYTES = 8 * HTB, NXCD = 8, WGM = 4;
__host__ __device__ __forceinline__ int lds_byte(int r, int c) { const int st = (r >> 4) * 2 + (c >> 5), rr = r & 15, cc = c & 31, ob = rr * 64 + cc * 2; return st * 1024 + (ob ^ (((ob >> 9) & 1) << 5)); }
__host__ __device__ __forceinline__ void stage_rc(int b, int& R, int& C) { const int st = b / 1024, sb = b % 1024, swz = sb ^ (((sb >> 9) & 1) << 5); R = (st >> 1) * 16 + swz / 64; C = (st & 1) * 32 + (swz % 64) / 2; }
__host__ __device__ __forceinline__ int perm32(int rho) { const int n = rho >> 4, i = rho & 15; return 8 * (i >> 2) + 4 * n + (i & 3); }

struct Unit { int pm, pn; long aoff; };
struct Gemm { const bf16_t* A; const bf16_t* Bt; int lda, ldb, K; };

struct Order {
    int nM, nN, nwg, G, c, rep, adiv, rev; long astep;
    __device__ void init(int nM_, int nN_, int G_, int c_, int rep_, int adiv_, long astep_, int rev_ = 0) { nM = nM_; nN = nN_; nwg = nM * nN; G = G_; c = c_; rep = rep_; adiv = adiv_; astep = astep_; rev = rev_; }
    __device__ bool next(int i, Unit& u) const {
        const int t = i / rep, sub = i - t * rep;
        const long L = (long)t * G + c; if (L >= nwg) return false;
        int wgid = (int)L; { const int q = nwg / NXCD, r = nwg % NXCD, xcd = wgid % NXCD, off = wgid / NXCD; wgid = (xcd < r ? xcd * (q + 1) : r * (q + 1) + (xcd - r) * q) + off; }
        const int nig = WGM * nN, gid = wgid / nig, fm = gid * WGM, gsz = (nM - fm) < WGM ? (nM - fm) : WGM;
        u.pm = fm + ((wgid % nig) % gsz); if (rev) u.pm = nM - 1 - u.pm; const int pn = (wgid % nig) / gsz; u.pn = pn + sub * nN; u.aoff = (long)(pn / adiv) * astep; return true;
    }
};

__device__ __forceinline__ float row_rs(const float* p, int fq) {
    const f32x4 v0 = *(const f32x4*)(p + 8 * fq), v1 = *(const f32x4*)(p + 8 * fq + 4);
    float t = ((v0[0] + v0[1]) + (v0[2] + v0[3])) + ((v1[0] + v1[1]) + (v1[2] + v1[3]));
    t += __shfl_xor(t, 16); t += __shfl_xor(t, 32);
    return 1.0f / sqrtf(t * (1.0f / 2048.0f) + EPS);
}
enum { EK_BF16 = 0, EK_SPLIT192 = 1, EK_RELU2 = 2, EK_GATE = 3, EK_RES = 4, EK_PLE = 5 };
struct Epi {
    static constexpr bool PERM = true;
    int kind; bf16_t* O; long ldc; const bf16_t* Y;
    const bf16_t* xin; bf16_t* xob; float* xof; float* ssq; const float* rsq;
    __device__ __forceinline__ void operator()(const f32x4 (&acc)[2][2][4][2], const Unit& u, int wr, int wc, int fr, int fq) const {
        const int row0 = u.pm * BM + wr * 64 + fr, col0 = u.pn * BM + wc * 32 + 8 * fq;
        if (kind <= EK_RELU2) {
            float rsv[2][4];
#pragma unroll
            for (int ai = 0; ai < 2; ++ai)
#pragma unroll
                for (int m = 0; m < 4; ++m) rsv[ai][m] = (kind == EK_RELU2) ? row_rs(rsq + (size_t)(row0 + ai * HALF + m * 16) * 32, fq) : 1.f;
#pragma unroll
            for (int ai = 0; ai < 2; ++ai)
#pragma unroll
                for (int m = 0; m < 4; ++m) { const int row = row0 + ai * HALF + m * 16; const float rs = rsv[ai][m];
#pragma unroll
                    for (int bj = 0; bj < 2; ++bj) { int col = col0 + bj * HALF; f32x4 v0 = acc[ai][bj][m][0], v1 = acc[ai][bj][m][1];
                        if (kind == EK_RELU2) {
#pragma unroll
                            for (int e = 0; e < 4; ++e) { float a = fmaxf(v0[e], 0.f) * rs, b = fmaxf(v1[e], 0.f) * rs; v0[e] = a * a; v1[e] = b * b; } }
                        if (kind == EK_SPLIT192) col = (col >> 7) * 192 + (col & 127);
                        u32x4 w; w.x = cvt_pk_bf16(v0[0], v0[1]); w.y = cvt_pk_bf16(v0[2], v0[3]); w.z = cvt_pk_bf16(v1[0], v1[1]); w.w = cvt_pk_bf16(v1[2], v1[3]);
                        *(u32x4*)(O + (size_t)row * ldc + col) = w; } }
        } else if (kind == EK_GATE) {
            const int oc = u.pn * 64 + wc * 16 + 4 * fq;
#pragma unroll
            for (int ai = 0; ai < 2; ++ai) {
                u32x2 yv[4][4];
#pragma unroll
                for (int m = 0; m < 4; ++m) { const bf16_t* yp = Y + (size_t)(row0 + ai * HALF + m * 16) * 8192 + oc;
#pragma unroll
                    for (int b = 0; b < 4; ++b) yv[m][b] = *(const u32x2*)(yp + b * 2048); }
#pragma unroll
                for (int m = 0; m < 4; ++m) { const int row = row0 + ai * HALF + m * 16;
                    f32x4 r = (f32x4){0.f, 0.f, 0.f, 0.f};
#pragma unroll
                    for (int b = 0; b < 4; ++b) { const u32x2 y = yv[m][b]; const f32x4 v = acc[ai][b >> 1][m][b & 1];
                        r[0] += sigmoidf_fast(v[0]) * bf_lo(y.x); r[1] += sigmoidf_fast(v[1]) * bf_hi(y.x); r[2] += sigmoidf_fast(v[2]) * bf_lo(y.y); r[3] += sigmoidf_fast(v[3]) * bf_hi(y.y); }
                    u32x2 w; w.x = cvt_pk_bf16(r[0], r[1]); w.y = cvt_pk_bf16(r[2], r[3]);
                    *(u32x2*)(O + (size_t)row * 2048 + oc) = w; }
            }
        } else if (kind == EK_RES) res_part<false, 4>(acc, u, wc, fq, row0, col0);
        else res_part<true, 2>(acc, u, wc, fq, row0, col0);
    }
    template <bool PLE, int MB>
    __device__ __forceinline__ void res_part(const f32x4 (&acc)[2][2][4][2], const Unit& u, int wc, int fq, int row0, int col0) const {
#pragma unroll
        for (int ai = 0; ai < 2; ++ai)
#pragma unroll
            for (int mb = 0; mb < 4; mb += MB) {
                u32x4 xv[MB][2], yv[MB][2]; float rsv[MB];
#pragma unroll
                for (int mm = 0; mm < MB; ++mm) { const int row = row0 + ai * HALF + (mb + mm) * 16;
                    rsv[mm] = PLE ? row_rs(rsq + (size_t)row * 32, fq) : 1.f;
#pragma unroll
                    for (int bj = 0; bj < 2; ++bj) { const int col = col0 + bj * HALF; xv[mm][bj] = *(const u32x4*)(xin + (size_t)row * DM + col);
                        if (PLE) yv[mm][bj] = *(const u32x4*)(Y + (size_t)row * 2048 + col); } }
#pragma unroll
                for (int mm = 0; mm < MB; ++mm) { const int m = mb + mm; const int row = row0 + ai * HALF + m * 16; const float rs = rsv[mm]; float sq = 0.f;
#pragma unroll
                    for (int bj = 0; bj < 2; ++bj) { const int col = col0 + bj * HALF; f32x4 v0 = acc[ai][bj][m][0], v1 = acc[ai][bj][m][1];
                        const u32x4 xb = xv[mm][bj];
                        if (PLE) { const u32x4 y = yv[mm][bj]; v0 = v0 * rs; v1 = v1 * rs;
                            v0[0] = sigmoidf_fast(v0[0]) * bf_lo(y.x); v0[1] = sigmoidf_fast(v0[1]) * bf_hi(y.x); v0[2] = sigmoidf_fast(v0[2]) * bf_lo(y.y); v0[3] = sigmoidf_fast(v0[3]) * bf_hi(y.y);
                            v1[0] = sigmoidf_fast(v1[0]) * bf_lo(y.z); v1[1] = sigmoidf_fast(v1[1]) * bf_hi(y.z); v1[2] = sigmoidf_fast(v1[2]) * bf_lo(y.w); v1[3] = sigmoidf_fast(v1[3]) * bf_hi(y.w); }
                        f32x4 n0, n1;
                        n0[0] = bf_lo(xb.x) + v0[0]; n0[1] = bf_hi(xb.x) + v0[1]; n0[2] = bf_lo(xb.y) + v0[2]; n0[3] = bf_hi(xb.y) + v0[3];
                        n1[0] = bf_lo(xb.z) + v1[0]; n1[1] = bf_hi(xb.z) + v1[1]; n1[2] = bf_lo(xb.w) + v1[2]; n1[3] = bf_hi(xb.w) + v1[3];
                        if (xof) { *(f32x4*)(xof + (size_t)row * DM + col) = n0; *(f32x4*)(xof + (size_t)row * DM + col + 4) = n1; }
                        else { u32x4 w; w.x = cvt_pk_bf16(n0[0], n0[1]); w.y = cvt_pk_bf16(n0[2], n0[3]); w.z = cvt_pk_bf16(n1[0], n1[1]); w.w = cvt_pk_bf16(n1[2], n1[3]);
                            *(u32x4*)(xob + (size_t)row * DM + col) = w; }
                        if (ssq) sq += (n0[0] * n0[0] + n0[1] * n0[1]) + (n0[2] * n0[2] + n0[3] * n0[3]) + (n1[0] * n1[0] + n1[1] * n1[1]) + (n1[2] * n1[2] + n1[3] * n1[3]); }
                    if (ssq) { sq += __shfl_xor(sq, 16); sq += __shfl_xor(sq, 32); if (fq == 0) ssq[(size_t)row * 32 + u.pn * 4 + wc] = sq; } }
            }
    }
};

template <bool ALIGN_EPI = true>
__device__ __forceinline__ void gemm_phase(LAS unsigned char* lds, const Gemm g, const Order& S, const Epi& E, const int tid) {
    const int wid = __builtin_amdgcn_readfirstlane(tid >> 6), lane = tid & 63, wr = wid >> 2, wc = wid & 3, fr = lane & 15, fq = lane >> 4;
    const int K = g.K, nt = K / BK;
    unsigned voffA[2], voffB[2];
#pragma unroll
    for (int i = 0; i < 2; ++i) { int R, C; stage_rc(tid * 16 + i * 8192, R, C); const int Rb = Epi::PERM ? ((R & ~31) + perm32(R & 31)) : R;
        voffA[i] = (unsigned)(R * g.lda + C) * 2u; voffB[i] = (unsigned)(Rb * g.ldb + C) * 2u; }
    const size_t kstep = (size_t)(BK * 2);
    const size_t hstA = (size_t)HALF * g.lda * 2, hstB = (size_t)HALF * g.ldb * 2;
    const size_t tstA = 2 * hstA, tstB = 2 * hstB;
    const unsigned ldsw = (unsigned)wid * 1024u;
    const int aoff = lds_byte(wr * 64 + fr, fq * 8), boff = lds_byte(wc * 32 + fr, fq * 8);
#define PG8_SA(b, h) (((b) * 2 + (h)) * HTB)
#define PG8_SB(b, h) ((4 + (b) * 2 + (h)) * HTB)
#define PG8_STAGE(bufoff, gbase, voff) do { _Pragma("unroll") for (int _i = 0; _i < 2; ++_i) \
        __builtin_amdgcn_global_load_lds((const unsigned*)((const char*)(gbase) + (voff)[_i]), (LAS unsigned*)(lds + (bufoff) + ldsw + _i * 8192), 16, 0, 0); } while (0)
#define PG8_LDA(dst, b, h) do { _Pragma("unroll") for (int m = 0; m < 4; ++m) _Pragma("unroll") for (int k = 0; k < 2; ++k) dst[m][k] = *(const LAS bf16x8*)(lds + PG8_SA(b, h) + aoff + m * 2048 + k * 1024); } while (0)
#define PG8_LDB(dst, b, h) do { _Pragma("unroll") for (int n = 0; n < 2; ++n) _Pragma("unroll") for (int k = 0; k < 2; ++k) dst[n][k] = *(const LAS bf16x8*)(lds + PG8_SB(b, h) + boff + n * 2048 + k * 1024); } while (0)
#define PG8_MMA(ai, bj, At, Bt) do { __builtin_amdgcn_s_setprio(1); _Pragma("unroll") for (int m = 0; m < 4; ++m) _Pragma("unroll") for (int n = 0; n < 2; ++n) _Pragma("unroll") for (int k = 0; k < 2; ++k) \
        acc[ai][bj][m][n] = __builtin_amdgcn_mfma_f32_16x16x32_bf16(Bt[n][k], At[m][k], acc[ai][bj][m][n], 0, 0, 0); __builtin_amdgcn_s_setprio(0); } while (0)
#define PG8_WAIT_V(n) asm volatile("s_waitcnt vmcnt(" #n ")" ::: "memory")
#define PG8_WAIT_L(n) asm volatile("s_waitcnt lgkmcnt(" #n ")" ::: "memory")
#define PG8_BAR __builtin_amdgcn_s_barrier()
#define PG8_SCHED __builtin_amdgcn_sched_barrier(0)
    Unit cur, nxt; int ui = 0;
    if (!S.next(0, cur)) return;
    f32x4 acc[2][2][4][2];
#pragma unroll
    for (int a = 0; a < 2; ++a)
#pragma unroll
        for (int b = 0; b < 2; ++b)
#pragma unroll
            for (int m = 0; m < 4; ++m)
#pragma unroll
                for (int n = 0; n < 2; ++n) acc[a][b][m][n] = (f32x4){0.f, 0.f, 0.f, 0.f};
    bf16x8 At[4][2], B0[2][2], B1[2][2];
    const char* cA = (const char*)g.A + (size_t)cur.pm * tstA + cur.aoff; const char* cB = (const char*)g.Bt + (size_t)cur.pn * tstB;
    PG8_STAGE(PG8_SB(0, 0), cB, voffB); PG8_STAGE(PG8_SB(0, 1), cB + hstB, voffB); PG8_STAGE(PG8_SA(0, 0), cA, voffA); PG8_STAGE(PG8_SA(0, 1), cA + hstA, voffA);
    if (wr == 1) PG8_BAR;
    PG8_WAIT_V(2); PG8_BAR;
    PG8_STAGE(PG8_SB(1, 0), cB + kstep, voffB); PG8_STAGE(PG8_SA(1, 0), cA + kstep, voffA); PG8_STAGE(PG8_SB(1, 1), cB + hstB + kstep, voffB);
    PG8_WAIT_V(6); PG8_BAR;
    for (;;) {
        const bool has_next = S.next(ui + 1, nxt);
        const char* nA = has_next ? (const char*)g.A + (size_t)nxt.pm * tstA + nxt.aoff : cA; const char* nB = has_next ? (const char*)g.Bt + (size_t)nxt.pn * tstB : cB;
        for (int t = 0; t < nt; t += 2) {
            const bool last = (t == nt - 2);
            const char* a1 = cA + (size_t)(t + 1) * kstep;
            const char* a2 = last ? nA : cA + (size_t)(t + 2) * kstep; const char* b2 = last ? nB : cB + (size_t)(t + 2) * kstep;
            const char* a3 = a2 + kstep; const char* b3 = b2 + kstep;
            PG8_LDB(B0, 0, 0); PG8_LDB(B1, 0, 1); PG8_SCHED; PG8_LDA(At, 0, 0); PG8_STAGE(PG8_SA(1, 1), a1 + hstA, voffA);
            PG8_WAIT_V(8); PG8_WAIT_L(0); PG8_BAR; PG8_MMA(0, 0, At, B0); PG8_MMA(0, 1, At, B1); PG8_BAR; PG8_SCHED;
            PG8_LDA(At, 0, 1); PG8_STAGE(PG8_SB(0, 0), b2, voffB); PG8_STAGE(PG8_SB(0, 1), b2 + hstB, voffB); PG8_STAGE(PG8_SA(0, 0), a2, voffA);
            PG8_WAIT_V(8); PG8_WAIT_L(0); PG8_BAR; PG8_MMA(1, 0, At, B0); PG8_MMA(1, 1, At, B1); PG8_BAR; PG8_SCHED;
            PG8_LDB(B0, 1, 0); PG8_LDB(B1, 1, 1); PG8_SCHED; PG8_LDA(At, 1, 0); PG8_STAGE(PG8_SA(0, 1), a2 + hstA, voffA);
            PG8_WAIT_V(8); PG8_WAIT_L(0); PG8_BAR; PG8_MMA(0, 0, At, B0); PG8_MMA(0, 1, At, B1); PG8_BAR; PG8_SCHED;
            PG8_LDA(At, 1, 1); PG8_STAGE(PG8_SB(1, 0), b3, voffB); PG8_STAGE(PG8_SB(1, 1), b3 + hstB, voffB); PG8_STAGE(PG8_SA(1, 0), a3, voffA);
            PG8_WAIT_V(8); PG8_WAIT_L(0); PG8_BAR; PG8_MMA(1, 0, At, B0); PG8_MMA(1, 1, At, B1); PG8_BAR; PG8_SCHED;
        }
        if constexpr (ALIGN_EPI) { if (wr == 0) PG8_BAR; }
        E(acc, cur, wr, wc, fr, fq);
        if (!has_next) break;
#pragma unroll
        for (int a = 0; a < 2; ++a)
#pragma unroll
            for (int b = 0; b < 2; ++b)
#pragma unroll
                for (int m = 0; m < 4; ++m)
#pragma unroll
                    for (int n = 0; n < 2; ++n) acc[a][b][m][n] = (f32x4){0.f, 0.f, 0.f, 0.f};
        cur = nxt; cA = nA; cB = nB; ++ui;
        if constexpr (ALIGN_EPI) { if (wr == 1) PG8_BAR; }
    }
    PG8_WAIT_V(0);
    if constexpr (!ALIGN_EPI) { if (wr == 0) PG8_BAR; }
    PG8_BAR;
#undef PG8_SA
#undef PG8_SB
#undef PG8_STAGE
#undef PG8_LDA
#undef PG8_LDB
#undef PG8_MMA
#undef PG8_WAIT_V
#undef PG8_WAIT_L
#undef PG8_BAR
#undef PG8_SCHED
}
}

struct Args { const float* in[33]; float* out; unsigned char* ws; int ph_lo, ph_hi; };
enum { I_XP = 0, I_XS, I_PP, I_PS, I_RELB, I_NMIX, I_WIN, I_AQN, I_AKN, I_ALQ1, I_ALK1, I_ALQ2, I_ALK2, I_AON, I_BCQN, I_BCKVN, I_BWUQ, I_BWUKV, I_BQN, I_BKN,
       I_CQN, I_CKN, I_DQN, I_DKN, I_WG, I_WB, I_WO, I_NFFN, I_W1, I_W2, I_NPLE, I_WPG, I_WPP };

__device__ __forceinline__ int rel_bucket(int rel) {
    const int n = rel < 0 ? -rel : rel;
    const float nf = (float)(n > 1 ? n : 1);
    int large = 8 + (int)(logf(nf / 8.0f) / 4.852030263919617f * 8.0f);
    large = large < 15 ? large : 15;
    return (rel > 0 ? 16 : 0) + (n < 8 ? n : large);
}
__device__ __forceinline__ void build_tables(const float* relb, float* tabA, float* tabD, int gtid, int gthreads) {
    for (int i = gtid; i < 4 * TABA_N; i += gthreads) { const int h = i / TABA_N, d = i % TABA_N - TABA_OFF; tabA[i] = relb[rel_bucket(d) * 16 + h] * LOG2E; }
    for (int i = gtid; i < 12 * TABD_N; i += gthreads) { const int gh = i / TABD_N, d = i % TABD_N - TABD_OFF; const int g = gh >> 2; const int dil = g == 0 ? 1 : (g == 1 ? 4 : 16);
        const int ad = d < 0 ? -d : d; const bool ok = (ad % dil == 0) && (ad <= 64 * dil);
        tabD[i] = ok ? relb[rel_bucket(d) * 16 + 4 + gh] * LOG2E : -1e30f; }
}
__device__ __forceinline__ void transpose_item(const float* W, int N, int k0, int n0, bf16_t* dst, int K, LAS float* scr, int lane, int gate_b = -1, const float* gsc = nullptr) {
    float wv[32];
#pragma unroll
    for (int i = 0; i < 32; ++i) { const int kk = 2 * i + (lane >> 5); wv[i] = W[(size_t)(k0 + kk) * N + n0 + (lane & 31)]; }
#pragma unroll
    for (int i = 0; i < 32; ++i) { const int kk = 2 * i + (lane >> 5); float w = wv[i]; if (gsc) w *= gsc[k0 + kk]; scr[kk * 33 + (lane & 31)] = w; }
    asm volatile("s_waitcnt lgkmcnt(0)" ::: "memory");
    const int c = lane & 7;
#pragma unroll
    for (int j = 0; j < 4; ++j) { const int n = (lane >> 3) + 8 * j; const LAS float* s = scr + (8 * c) * 33 + n;
        u32x4 o; o.x = cvt_pk_bf16(s[0 * 33], s[1 * 33]); o.y = cvt_pk_bf16(s[2 * 33], s[3 * 33]); o.z = cvt_pk_bf16(s[4 * 33], s[5 * 33]); o.w = cvt_pk_bf16(s[6 * 33], s[7 * 33]);
        size_t drow = (size_t)n;
        if (gate_b >= 0) { const int nn = n0 + n, j = nn & 63; drow = (size_t)((nn >> 6) * 256 + 128 * (gate_b >> 1) + 32 * (j >> 4) + 8 * ((j >> 2) & 3) + 4 * (gate_b & 1) + (j & 3)); }
        *(u32x4*)(dst + drow * K + k0 + 8 * c) = o; }
    asm volatile("s_waitcnt lgkmcnt(0)" ::: "memory");
}
__device__ __forceinline__ int win_row(int n0) {
    if (n0 < 512) return PC_AQ + n0;
    if (n0 < 1024) return PC_AK + (n0 - 512);
    if (n0 < 1536) return -(0 + (n0 - 1024) + 1);
    if (n0 < 2048) return PC_BCQ + (n0 - 1536);
    if (n0 < 2560) return PC_BCKV + (n0 - 2048);
    if (n0 < 2624) return PC_BKR + (n0 - 2560);
    if (n0 < 3136) return PC_CQ + (n0 - 2624);
    if (n0 < 3392) return PC_CK + (n0 - 3136);
    if (n0 < 3648) return -(512 + (n0 - 3392) + 1);
    if (n0 < 5184) return PC_DQ + (n0 - 3648);
    if (n0 < 5696) return PC_DK + (n0 - 5184);
    return -(768 + (n0 - 5696) + 1);
}
__device__ __forceinline__ void convert_weights(const Args& a, int layer, unsigned char* W, LAS float* scr, int gw, int ngw, int lane) {
    constexpr int I_IN = 32 * 194, I_G = 4 * 32 * 64, I_B = 4 * 8 * 64, I_O = 32 * 64, I_1 = 32 * 256, I_2 = 128 * 64, I_PG = 32 * 64, I_PPn = 4 * 64, I_UQ = 8 * 24, I_UKV = 8 * 32;
    constexpr int NIT = I_IN + I_G + I_B + I_O + I_1 + I_2 + I_PG + I_PPn + I_UQ + I_UKV;
    for (int it = gw; it < NIT; it += ngw) {
        int r = it;
        if (r < I_IN) { const int kb = r / 194, nb = r % 194; const int dr = win_row(nb * 32);
            bf16_t* dst = dr >= 0 ? (bf16_t*)(W + WO_IN) + (size_t)dr * 2048 : (bf16_t*)(W + WO_INV) + (size_t)(-dr - 1) * 2048;
            transpose_item(a.in[I_WIN] + (size_t)layer * 2048 * 6208, 6208, kb * 64, nb * 32, dst, 2048, scr, lane); continue; } r -= I_IN;
        if (r < I_G) { const int b = r / 2048, q = r % 2048, kb = q / 64, nb = q % 64;
            transpose_item(a.in[I_WG] + ((size_t)layer * 4 + b) * 2048 * 2048, 2048, kb * 64, nb * 32, (bf16_t*)(W + WO_G), 2048, scr, lane, b); continue; } r -= I_G;
        if (r < I_B) { const int b = r / 512, q = r % 512, kb = q / 64, nb = q % 64;
            transpose_item(a.in[I_WB] + ((size_t)layer * 4 + b) * 512 * 2048, 2048, kb * 64, nb * 32, (bf16_t*)(W + WO_B) + ((size_t)b * 2048 + nb * 32) * 512, 512, scr, lane); continue; } r -= I_B;
        if (r < I_O) { const int kb = r / 64, nb = r % 64;
            transpose_item(a.in[I_WO] + (size_t)layer * 2048 * 2048, 2048, kb * 64, nb * 32, (bf16_t*)(W + WO_O) + (size_t)(nb * 32) * 2048, 2048, scr, lane); continue; } r -= I_O;
        if (r < I_1) { const int kb = r / 256, nb = r % 256;
            transpose_item(a.in[I_W1] + (size_t)layer * 2048 * 8192, 8192, kb * 64, nb * 32, (bf16_t*)(W + WO_1) + (size_t)(nb * 32) * 2048, 2048, scr, lane, -1, a.in[I_NFFN] + layer * DM); continue; } r -= I_1;
        if (r < I_2) { const int kb = r / 64, nb = r % 64;
            transpose_item(a.in[I_W2] + (size_t)layer * 8192 * 2048, 2048, kb * 64, nb * 32, (bf16_t*)(W + WO_2) + (size_t)(nb * 32) * 8192, 8192, scr, lane); continue; } r -= I_2;
        if (r < I_PG) { const int kb = r / 64, nb = r % 64;
            transpose_item(a.in[I_WPG] + (size_t)layer * 2048 * 2048, 2048, kb * 64, nb * 32, (bf16_t*)(W + WO_PG) + (size_t)(nb * 32) * 2048, 2048, scr, lane, -1, a.in[I_NPLE] + layer * DM); continue; } r -= I_PG;
        if (r < I_PPn) { const int kb = r / 64, nb = r % 64;
            transpose_item(a.in[I_WPP] + (size_t)layer * 256 * 2048, 2048, kb * 64, nb * 32, (bf16_t*)(W + WO_PP) + (size_t)(nb * 32) * 256, 256, scr, lane); continue; } r -= I_PPn;
        if (r < I_UQ) { const int kb = r / 24, nb = r % 24;
            transpose_item(a.in[I_BWUQ] + (size_t)layer * 512 * 768, 768, kb * 64, nb * 32, (bf16_t*)(W + WO_UQ) + (size_t)(nb * 32) * 512, 512, scr, lane); continue; } r -= I_UQ;
        { const int kb = r / 32, nb = r % 32; const int n0 = nb * 32, h = n0 >> 8, j0 = n0 & 255;
            bf16_t* dst = j0 < 128 ? (bf16_t*)(W + WO_UKN) + (size_t)(h * 128 + j0) * 512 : (bf16_t*)(W + WO_UKV) + (size_t)(h * 128 + j0 - 128) * 512;
            transpose_item(a.in[I_BWUKV] + (size_t)layer * 512 * 1024, 1024, kb * 64, n0, dst, 512, scr, lane); }
    }
}

__device__ __forceinline__ void norm_row_bf(const bf16_t* x, const float* g, bf16_t* out, int lane) {
    f32x4 v[8]; float s = 0.f;
#pragma unroll
    for (int j = 0; j < 8; ++j) { const u32x2 u = *(const u32x2*)(x + 4 * lane + 256 * j); v[j][0] = bf_lo(u.x); v[j][1] = bf_hi(u.x); v[j][2] = bf_lo(u.y); v[j][3] = bf_hi(u.y);
        s += (v[j][0] * v[j][0] + v[j][1] * v[j][1]) + (v[j][2] * v[j][2] + v[j][3] * v[j][3]); }
    const float rs = 1.0f / sqrtf(wave_sum(s) * (1.0f / 2048.0f) + EPS);
#pragma unroll
    for (int j = 0; j < 8; ++j) { const f32x4 gg = *(const f32x4*)(g + 4 * lane + 256 * j);
        u32x2 w; w.x = cvt_pk_bf16(v[j][0] * rs * gg[0], v[j][1] * rs * gg[1]); w.y = cvt_pk_bf16(v[j][2] * rs * gg[2], v[j][3] * rs * gg[3]);
        *(u32x2*)(out + 4 * lane + 256 * j) = w; }
}
__device__ __forceinline__ void norm_row(const float* x, const float* g, bf16_t* out, int lane, bf16_t* xb) {
    f32x4 v[8]; float s = 0.f;
#pragma unroll
    for (int j = 0; j < 8; ++j) { v[j] = *(const f32x4*)(x + 4 * lane + 256 * j); s += (v[j][0] * v[j][0] + v[j][1] * v[j][1]) + (v[j][2] * v[j][2] + v[j][3] * v[j][3]);
        u32x2 w; w.x = cvt_pk_bf16(v[j][0], v[j][1]); w.y = cvt_pk_bf16(v[j][2], v[j][3]); *(u32x2*)(xb + 4 * lane + 256 * j) = w; }
    const float rs = 1.0f / sqrtf(wave_sum(s) * (1.0f / 2048.0f) + EPS);
#pragma unroll
    for (int j = 0; j < 8; ++j) { const f32x4 gg = *(const f32x4*)(g + 4 * lane + 256 * j);
        u32x2 w; w.x = cvt_pk_bf16(v[j][0] * rs * gg[0], v[j][1] * rs * gg[1]); w.y = cvt_pk_bf16(v[j][2] * rs * gg[2], v[j][3] * rs * gg[3]);
        *(u32x2*)(out + 4 * lane + 256 * j) = w; }
}
__device__ __forceinline__ void load8(const bf16_t* p, float (&f)[8]) { const u32x4 v = *(const u32x4*)p; f[0] = bf_lo(v.x); f[1] = bf_hi(v.x); f[2] = bf_lo(v.y); f[3] = bf_hi(v.y); f[4] = bf_lo(v.z); f[5] = bf_hi(v.z); f[6] = bf_lo(v.w); f[7] = bf_hi(v.w); }
__device__ __forceinline__ void store8(bf16_t* p, const float (&f)[8]) { u32x4 w; w.x = cvt_pk_bf16(f[0], f[1]); w.y = cvt_pk_bf16(f[2], f[3]); w.z = cvt_pk_bf16(f[4], f[5]); w.w = cvt_pk_bf16(f[6], f[7]); *(u32x4*)p = w; }
template <int GRP> __device__ __forceinline__ void norm8(float (&f)[8], const float* g, float scale, int lane) {
    float s = 0.f;
#pragma unroll
    for (int e = 0; e < 8; ++e) s += f[e] * f[e];
#pragma unroll
    for (int o = 1; o < GRP; o <<= 1) s += __shfl_xor(s, o);
    const float rs = scale / sqrtf(s * (1.0f / (GRP * 8)) + EPS);
    const int gi = (lane & (GRP - 1)) * 8;
#pragma unroll
    for (int e = 0; e < 8; ++e) f[e] = f[e] * rs * g[gi + e];
}
__device__ __forceinline__ float rope_inv(int i) { return __builtin_amdgcn_exp2f(-(float)i * (13.287712379549449f / 32.0f)) * 0.15915494309189535f; }
__device__ __forceinline__ void sincos_rev(float rev, float& sn, float& cs) { rev -= rintf(rev); sn = __builtin_amdgcn_sinf(rev); cs = __builtin_amdgcn_cosf(rev); }
__device__ __forceinline__ void axial_rope8(float (&f)[8], float rowpos, float colpos, int lane) {
    const int j = lane & 15, hf = j >> 3, jj = j & 7; const float pos = hf ? colpos : rowpos; const float sgn = jj < 4 ? -1.f : 1.f; const int i0 = 8 * (jj & 3);
#pragma unroll
    for (int e = 0; e < 8; ++e) { const float pv = __shfl_xor(f[e], 4); float sn, cs; sincos_rev(pos * rope_inv(i0 + e), sn, cs); f[e] = f[e] * cs + sgn * pv * sn; }
}
__device__ __forceinline__ void post1_row(const Args& a, int layer, bf16_t* P, int tseq, int lane) {
    float fq[8], fk[8], fcq[8], fckv[8], gq[8], gk[8], d0[8], d1[8], d2[8], dk[8];
    const int l2 = lane & 31;
    load8(P + PC_AQ + 8 * lane, fq); load8(P + PC_AK + 8 * lane, fk); load8(P + PC_BCQ + 8 * lane, fcq); load8(P + PC_BCKV + 8 * lane, fckv);
    load8(P + PC_CQ + 8 * lane, gq); load8(P + PC_CK + 8 * l2, gk);
    load8(P + PC_DQ + 8 * lane, d0); load8(P + PC_DQ + 512 + 8 * lane, d1); load8(P + PC_DQ + 1024 + 8 * lane, d2); load8(P + PC_DK + 8 * lane, dk);
    const float sA = 0.125f * LOG2E, sC = 0.08838834764831845f * LOG2E;
    const float rowpos = (float)(tseq >> 6), colpos = (float)(tseq & 63);
    norm8<8>(fq, a.in[I_AQN] + layer * 64, sA, lane); norm8<8>(fk, a.in[I_AKN] + layer * 64, 1.f, lane);
    norm8<64>(fcq, a.in[I_BCQN] + layer * 512, 1.f, lane); norm8<64>(fckv, a.in[I_BCKVN] + layer * 512, 1.f, lane);
    norm8<16>(gq, a.in[I_CQN] + layer * 128, sC, lane); axial_rope8(gq, rowpos, colpos, lane);
    norm8<16>(gk, a.in[I_CKN] + layer * 128, 1.f, lane); axial_rope8(gk, rowpos, colpos, lane);
    norm8<16>(d0, a.in[I_DQN] + layer * 128, sC, lane); norm8<16>(d1, a.in[I_DQN] + layer * 128, sC, lane); norm8<16>(d2, a.in[I_DQN] + layer * 128, sC, lane);
    norm8<16>(dk, a.in[I_DKN] + layer * 128, 1.f, lane);
    store8(P + PC_AQ + 8 * lane, fq); store8(P + PC_AK + 8 * lane, fk); store8(P + PC_BCQ + 8 * lane, fcq); store8(P + PC_BCKV + 8 * lane, fckv);
    store8(P + PC_CQ + 8 * lane, gq); if (lane < 32) store8(P + PC_CK + 8 * l2, gk);
    store8(P + PC_DQ + 8 * lane, d0); store8(P + PC_DQ + 512 + 8 * lane, d1); store8(P + PC_DQ + 1024 + 8 * lane, d2); store8(P + PC_DK + 8 * lane, dk);
}
__device__ __forceinline__ void mla_norm_rope(float (&f)[8], float (&r)[4], const float* g, float scale, float pos, int lane) {
    const int j = lane & 15;
    float s = 0.f;
#pragma unroll
    for (int e = 0; e < 8; ++e) s += f[e] * f[e];
#pragma unroll
    for (int e = 0; e < 4; ++e) s += r[e] * r[e];
#pragma unroll
    for (int o = 1; o < 16; o <<= 1) s += __shfl_xor(s, o);
    const float rs = scale / sqrtf(s * (1.0f / 192.0f) + EPS);
#pragma unroll
    for (int e = 0; e < 8; ++e) f[e] = f[e] * rs * g[8 * j + e];
#pragma unroll
    for (int e = 0; e < 4; ++e) r[e] = r[e] * rs * g[128 + 4 * j + e];
    const float sgn = j < 8 ? -1.f : 1.f; const int i0 = 4 * (j & 7);
#pragma unroll
    for (int e = 0; e < 4; ++e) { const float pv = __shfl_xor(r[e], 8); float sn, cs; sincos_rev(pos * rope_inv(i0 + e), sn, cs); r[e] = r[e] * cs + sgn * pv * sn; }
}
__device__ __forceinline__ void post2_row(const Args& a, int layer, bf16_t* Q, bf16_t* Kr, const bf16_t* P, int tseq, int lane) {
    const int h = lane >> 4, j = lane & 15; const float pos = (float)tseq;
    float f[8], r[4];
    float f2[8], r2[4];
    bf16_t* q = Q + h * 192; bf16_t* k = Kr + h * 192;
    load8(q + 8 * j, f); const u32x2 vq = *(const u32x2*)(q + 128 + 4 * j); load8(k + 8 * j, f2); const u32x2 vk = *(const u32x2*)(P + PC_BKR + 4 * j);
    r[0] = bf_lo(vq.x); r[1] = bf_hi(vq.x); r[2] = bf_lo(vq.y); r[3] = bf_hi(vq.y);
    r2[0] = bf_lo(vk.x); r2[1] = bf_hi(vk.x); r2[2] = bf_lo(vk.y); r2[3] = bf_hi(vk.y);
    mla_norm_rope(f, r, a.in[I_BQN] + layer * 192, 0.07216878364870323f * LOG2E, pos, lane);
    mla_norm_rope(f2, r2, a.in[I_BKN] + layer * 192, 1.f, pos, lane);
    store8(q + 8 * j, f); { u32x2 w; w.x = cvt_pk_bf16(r[0], r[1]); w.y = cvt_pk_bf16(r[2], r[3]); *(u32x2*)(q + 128 + 4 * j) = w; }
    store8(k + 8 * j, f2); { u32x2 w; w.x = cvt_pk_bf16(r2[0], r2[1]); w.y = cvt_pk_bf16(r2[2], r2[3]); *(u32x2*)(k + 128 + 4 * j) = w; }
}

struct AState { float m, l; f32x16 o[4]; };
__device__ __forceinline__ void astate_init(AState& st) { st.m = -3.0e38f; st.l = 0.f;
#pragma unroll
    for (int d = 0; d < 4; ++d)
#pragma unroll
        for (int r = 0; r < 16; ++r) st.o[d][r] = 0.f; }
template <int DK, bool TAB, bool QLDS = false>
__device__ __forceinline__ void attn_pass(AState& st, const bf16_t* qp, const bf16_t* kp, long ldk, const bf16_t* vp, long ldv, int kbeg, int kend, const float* tp, LAS bf16x8* qst = nullptr) {
    constexpr int NS = DK / 16;
    bf16x8 qf[QLDS ? 1 : NS], kf[NS];
    if (QLDS) {
#pragma unroll
        for (int s = 0; s < NS; ++s) qst[s * 64] = *(const bf16x8*)(qp + 16 * s);
    } else {
#pragma unroll
        for (int s = 0; s < NS; ++s) qf[s] = *(const bf16x8*)(qp + 16 * s);
    }
    { const bf16_t* k0p = kp + (long)kbeg * ldk;
#pragma unroll
      for (int s = 0; s < NS; ++s) kf[s] = *(const bf16x8*)(k0p + 16 * s); }
    for (int k0 = kbeg; k0 < kend; k0 += 32) {
        bf16x8 vf[4][2];
#pragma unroll
        for (int d = 0; d < 4; ++d)
#pragma unroll
            for (int s = 0; s < 2; ++s) vf[d][s] = *(const bf16x8*)(vp + (long)(32 * d) * ldv + k0 + 16 * s);
        f32x4 tb[4];
        if (TAB) {
#pragma unroll
            for (int s = 0; s < 2; ++s) { tb[2 * s] = *(const f32x4u*)(tp + k0 + 16 * s); tb[2 * s + 1] = *(const f32x4u*)(tp + k0 + 16 * s + 4); } }
        f32x16 sc;
#pragma unroll
        for (int r = 0; r < 16; ++r) sc[r] = 0.f;
#pragma unroll
        for (int s = 0; s < NS; ++s) sc = __builtin_amdgcn_mfma_f32_32x32x16_bf16(kf[s], QLDS ? qst[s * 64] : qf[QLDS ? 0 : s], sc, 0, 0, 0);
        if (k0 + 32 < kend) { const bf16_t* knp = kp + (long)(k0 + 32) * ldk;
#pragma unroll
            for (int s = 0; s < NS; ++s) kf[s] = *(const bf16x8*)(knp + 16 * s); }
        if (TAB) {
#pragma unroll
            for (int r = 0; r < 16; ++r) sc[r] += tb[r >> 2][r & 3]; }
        float mx = sc[0];
#pragma unroll
        for (int r = 1; r < 16; ++r) mx = fmaxf(mx, sc[r]);
        mx = fmaxf(mx, __shfl_xor(mx, 32));
        const float mn = fmaxf(st.m, mx);
        const float alpha = __builtin_amdgcn_exp2f(st.m - mn);
        st.m = mn;
        float ps = 0.f;
#pragma unroll
        for (int r = 0; r < 16; ++r) { sc[r] = __builtin_amdgcn_exp2f(sc[r] - mn); ps += sc[r]; }
        st.l = st.l * alpha + ps;
#pragma unroll
        for (int d = 0; d < 4; ++d)
#pragma unroll
            for (int r = 0; r < 16; ++r) st.o[d][r] *= alpha;
        u32x4 p0, p1;
        p0.x = cvt_pk_bf16(sc[0], sc[1]); p0.y = cvt_pk_bf16(sc[2], sc[3]); p0.z = cvt_pk_bf16(sc[4], sc[5]); p0.w = cvt_pk_bf16(sc[6], sc[7]);
        p1.x = cvt_pk_bf16(sc[8], sc[9]); p1.y = cvt_pk_bf16(sc[10], sc[11]); p1.z = cvt_pk_bf16(sc[12], sc[13]); p1.w = cvt_pk_bf16(sc[14], sc[15]);
        const bf16x8 pf0 = __builtin_bit_cast(bf16x8, p0), pf1 = __builtin_bit_cast(bf16x8, p1);
#pragma unroll
        for (int d = 0; d < 4; ++d) { st.o[d] = __builtin_amdgcn_mfma_f32_32x32x16_bf16(vf[d][0], pf0, st.o[d], 0, 0, 0); st.o[d] = __builtin_amdgcn_mfma_f32_32x32x16_bf16(vf[d][1], pf1, st.o[d], 0, 0, 0); }
    }
}
__device__ __forceinline__ void astate_finish(AState& st) {
    const float l = st.l + __shfl_xor(st.l, 32); const float inv = 1.0f / l;
#pragma unroll
    for (int d = 0; d < 4; ++d)
#pragma unroll
        for (int r = 0; r < 16; ++r) st.o[d][r] *= inv;
}
__device__ __forceinline__ void store_o(const f32x16 (&o)[4], bf16_t* op) {
#pragma unroll
    for (int d = 0; d < 4; ++d)
#pragma unroll
        for (int g = 0; g < 4; ++g) { u32x2 w; w.x = cvt_pk_bf16(o[d][4 * g], o[d][4 * g + 1]); w.y = cvt_pk_bf16(o[d][4 * g + 2], o[d][4 * g + 3]); *(u32x2*)(op + 32 * d + 8 * g) = w; }
}
__device__ __forceinline__ int pi32(int n) { return (n & ~12) | ((n & 4) << 1) | ((n & 8) >> 1); }

struct AttnBufs { const bf16_t* PROJ; const bf16_t* VT; const bf16_t* QB; const bf16_t* KB; const bf16_t* VTB; bf16_t* BR; const float* tabA; const float* tabD; };

__device__ __forceinline__ void attn_unit(const Args& a, const AttnBufs& B, int layer, int mixer, int head, int row0  , int S, int q0  , int lane, LAS float* stash) {
#define ATT_LANE_SETUP int ln_ = lane; asm volatile("" : "+v"(ln_)); const int n = ln_ & 31, hi = ln_ >> 5, pr = pi32(n); const long qrow = (long)row0 + q0 + n; bf16_t* op = B.BR + qrow * 2048 + 4 * hi;
#ifdef ONLY_MIXER
    mixer = ONLY_MIXER;
#endif
    if (mixer == 0) {
        ATT_LANE_SETUP
        const float lam_init = layer == 0 ? 0.2f : 0.35550906759f;
        const float d1 = wave_sum(a.in[I_ALQ1][layer * 64 + lane] * a.in[I_ALK1][layer * 64 + lane]);
        const float d2 = wave_sum(a.in[I_ALQ2][layer * 64 + lane] * a.in[I_ALK2][layer * 64 + lane]);
        const float lam = expf(d1) - expf(d2) + lam_init;
        const bf16_t* vp = B.VT + (long)(head * 128 + n) * TCM + row0 + 8 * hi;
        const float* tp = B.tabA + head * TABA_N + TABA_OFF - (q0 + n) + 8 * hi;
        { AState st; astate_init(st);
          attn_pass<64, true>(st, B.PROJ + qrow * NP + PC_AQ + head * 128 + 8 * hi, B.PROJ + (long)(row0 + pr) * NP + PC_AK + head * 128 + 8 * hi, NP, vp, TCM, 0, S, tp);
          astate_finish(st);
#pragma unroll
          for (int d = 0; d < 4; ++d)
#pragma unroll
              for (int r = 0; r < 16; ++r) stash[(d * 16 + r) * 64 + lane] = st.o[d][r]; }
        AState st; astate_init(st);
        attn_pass<64, true>(st, B.PROJ + qrow * NP + PC_AQ + head * 128 + 64 + 8 * hi, B.PROJ + (long)(row0 + pr) * NP + PC_AK + head * 128 + 64 + 8 * hi, NP, vp, TCM, 0, S, tp);
        astate_finish(st);
        float ss = 0.f;
#pragma unroll
        for (int d = 0; d < 4; ++d)
#pragma unroll
            for (int r = 0; r < 16; ++r) { const float v = stash[(d * 16 + r) * 64 + lane] - lam * st.o[d][r]; st.o[d][r] = v; ss += v * v; }
        ss += __shfl_xor(ss, 32);
        const float rs = (1.0f - lam_init) / sqrtf(ss * (1.0f / 128.0f) + EPS);
        const float* gn = a.in[I_AON] + layer * 128 + 4 * hi;
#pragma unroll
        for (int d = 0; d < 4; ++d)
#pragma unroll
            for (int g = 0; g < 4; ++g) { const f32x4 gg = *(const f32x4*)(gn + 32 * d + 8 * g);
#pragma unroll
                for (int e = 0; e < 4; ++e) st.o[d][4 * g + e] *= rs * gg[e]; }
        store_o(st.o, op + head * 128);
    } else if (mixer == 1) {
        ATT_LANE_SETUP
        AState st; astate_init(st);
        attn_pass<192, false, true>(st, B.QB + qrow * 768 + head * 192 + 8 * hi, B.KB + (long)(row0 + pr) * 768 + head * 192 + 8 * hi, 768,
                              B.VTB + (long)(head * 128 + n) * TCM + row0 + 8 * hi, TCM, 0, S, nullptr, (LAS bf16x8*)stash + lane);
        astate_finish(st); store_o(st.o, op + 512 + head * 128);
    } else if (mixer == 2) {
        ATT_LANE_SETUP
        const int kv = head >> 1;
        AState st; astate_init(st);
        attn_pass<128, false>(st, B.PROJ + qrow * NP + PC_CQ + head * 128 + 8 * hi, B.PROJ + (long)(row0 + pr) * NP + PC_CK + kv * 128 + 8 * hi, NP,
                              B.VT + (long)(512 + kv * 128 + n) * TCM + row0 + 8 * hi, TCM, 0, S, nullptr);
        astate_finish(st); store_o(st.o, op + 1024 + head * 128);
    } else {
        ATT_LANE_SETUP
        AState st; astate_init(st);
        const bf16_t* kp = B.PROJ + (long)(row0 + pr) * NP + PC_DK + head * 128 + 8 * hi;
        const bf16_t* vp = B.VT + (long)(768 + head * 128 + n) * TCM + row0 + 8 * hi;
#pragma unroll 1
        for (int g = 0; g < 3; ++g) { const int W = g == 0 ? 64 : (g == 1 ? 256 : 1024);
            const int kb = q0 - W > 0 ? q0 - W : 0, ke = q0 + 32 + W < S ? q0 + 32 + W : S;
            attn_pass<128, true>(st, B.PROJ + qrow * NP + PC_DQ + (g * 4 + head) * 128 + 8 * hi, kp, NP, vp, TCM, kb, ke, B.tabD + (g * 4 + head) * TABD_N + TABD_OFF - (q0 + n) + 8 * hi); }
        astate_finish(st); store_o(st.o, op + 1536 + head * 128);
    }
}
__device__ __forceinline__ void attn_phase(const Args& a, const AttnBufs& B, int layer, int chunk, unsigned* ctr, int lane, LAS float* stash) {
#if NCHUNK == 2
    const int npr = chunk == 0 ? 1 : 0, nsm = chunk == 0 ? 4 : 12, TC = chunk == 0 ? 16384 : 24576;
#else
    const int npr = chunk == 0 ? 1 : 0, nsm = chunk == 0 ? 0 : 4, TC = 8192;
#endif
    const int nP = npr * 1024, nS = nsm * 256, nD = TC / 8, total = 3 * nP + 3 * nS + nD;
    for (;;) {
        unsigned uu = 0; if (lane == 0) uu = atomicAdd(ctr, 1u);
        int u = __builtin_amdgcn_readfirstlane((int)uu);
        if (u >= total) break;
        int mixer, head, row0, S, q0;
        if (u < 3 * nP) { mixer = u / nP; const int r = u % nP; q0 = (r % 256) * 32; head = r / 256; row0 = 0; S = TP; }
        else { u -= 3 * nP;
            if (u < 3 * nS) { mixer = u / nS; const int r = u % nS; q0 = (r % 64) * 32; head = (r / 64) % 4; row0 = npr * TP + (r / 256) * SS; S = SS; }
            else { u -= 3 * nS; mixer = 3; const int qb = u % (TC / 32); head = u / (TC / 32); const int q = qb * 32;
                if (npr && q < TP) { row0 = 0; S = TP; } else { row0 = npr * TP + ((q - npr * TP) / SS) * SS; S = SS; }
                q0 = q - row0; } }
#ifdef ONLY_MIXER
        if (mixer != ONLY_MIXER) continue;
#endif
        attn_unit(a, B, layer, mixer, head, row0, S, q0, lane, stash);
    }
}


constexpr int A2_RSV = 144, A2_BUFSZ = 64 * 400 + 128 * A2_RSV;
static_assert(2 * A2_BUFSZ <= 131072 && 2 * A2_BUFSZ >= 65536, "attention LDS");

template <int NS, int RSK, bool USETAB>
__device__ __forceinline__ void a2_tile(AState& st, LAS unsigned char* bb, int kfo, int vfo, const bf16x8 (&qf)[NS], const float* tpk, float iv) {
#define A2_SB() __builtin_amdgcn_sched_barrier(0x0024)
#define A2_LDK0(s_) (*(const LAS bf16x8*)(bb + kfo + 32 * (s_)))
#define A2_LDK1(s_) (*(const LAS bf16x8*)(bb + kfo + 32 * RSK + 32 * (s_)))
#define A2_LDV0(i_) (*(const LAS bf16x8*)(bb + vfo + (32 * ((i_) & 3)) * A2_RSV + 32 * ((i_) >> 2)))
#define A2_LDV1(i_) (*(const LAS bf16x8*)(bb + vfo + (32 * ((i_) & 3)) * A2_RSV + 64 + 32 * ((i_) >> 2)))
    constexpr int PD = 3;
    f32x4 tb[8];
    if (USETAB) {
#pragma unroll
        for (int s = 0; s < 4; ++s) { tb[2 * s] = *(const f32x4u*)(tpk + 16 * s); tb[2 * s + 1] = *(const f32x4u*)(tpk + 16 * s + 4); } }
    f32x16 ini, sc0, sc1;
#pragma unroll
    for (int r = 0; r < 16; ++r) ini[r] = iv;
    u32x4 pw[4];
    float mx = -3.0e38f, ps = 0.f;
    bf16x8 ka[NS], kb[NS], va[8], vb[8];
#pragma unroll
    for (int s = 0; s < PD; ++s) ka[s] = A2_LDK0(s);
    A2_SB();
#pragma unroll
    for (int s = 0; s < NS; ++s) {
        if (s + PD < NS) ka[s + PD] = A2_LDK0(s + PD); else kb[s + PD - NS] = A2_LDK1(s + PD - NS);
        sc0 = __builtin_amdgcn_mfma_f32_32x32x16_bf16(ka[s], qf[s], s == 0 ? ini : sc0, 0, 0, 0);
        A2_SB(); }
#pragma unroll
    for (int s = 0; s < NS; ++s) {
        if (s + PD < NS) kb[s + PD] = A2_LDK1(s + PD); else va[s + PD - NS] = A2_LDV0(s + PD - NS);
        sc1 = __builtin_amdgcn_mfma_f32_32x32x16_bf16(kb[s], qf[s], s == 0 ? ini : sc1, 0, 0, 0);
        A2_SB();
#pragma unroll
        for (int pp = (8 * s) / NS; pp < (8 * (s + 1)) / NS; ++pp) {
            float x0 = sc0[2 * pp], x1 = sc0[2 * pp + 1];
            if (USETAB) { x0 += tb[(2 * pp) >> 2][(2 * pp) & 3]; x1 += tb[(2 * pp + 1) >> 2][(2 * pp + 1) & 3]; }
            mx = fmaxf(mx, fmaxf(x0, x1));
            const float e0 = __builtin_amdgcn_exp2f(x0), e1 = __builtin_amdgcn_exp2f(x1);
            ps += e0 + e1; pw[pp >> 2][pp & 3] = cvt_pk_bf16(e0, e1); }
        A2_SB();
    }
    {
        const bf16x8 pf0 = __builtin_bit_cast(bf16x8, pw[0]), pf1 = __builtin_bit_cast(bf16x8, pw[1]);
#pragma unroll
        for (int i = 0; i < 8; ++i) { const int h = i >> 2, d = i & 3;
            if (i + PD < 8) va[i + PD] = A2_LDV0(i + PD); else vb[i + PD - 8] = A2_LDV1(i + PD - 8);
            st.o[d] = __builtin_amdgcn_mfma_f32_32x32x16_bf16(va[i], h ? pf1 : pf0, st.o[d], 0, 0, 0);
            A2_SB();
            { const int pp = i; float x0 = sc1[2 * pp], x1 = sc1[2 * pp + 1];
              if (USETAB) { x0 += tb[4 + ((2 * pp) >> 2)][(2 * pp) & 3]; x1 += tb[4 + ((2 * pp + 1) >> 2)][(2 * pp + 1) & 3]; }
              mx = fmaxf(mx, fmaxf(x0, x1));
              const float e0 = __builtin_amdgcn_exp2f(x0), e1 = __builtin_amdgcn_exp2f(x1);
              ps += e0 + e1; pw[2 + (pp >> 2)][pp & 3] = cvt_pk_bf16(e0, e1); }
            A2_SB(); }
    }
    {
        const bf16x8 pf2 = __builtin_bit_cast(bf16x8, pw[2]), pf3 = __builtin_bit_cast(bf16x8, pw[3]);
#pragma unroll
        for (int i = 0; i < 8; ++i) { const int h = i >> 2, d = i & 3;
            if (i + PD < 8) vb[i + PD] = A2_LDV1(i + PD);
            st.o[d] = __builtin_amdgcn_mfma_f32_32x32x16_bf16(vb[i], h ? pf3 : pf2, st.o[d], 0, 0, 0);
            A2_SB(); }
    }
    st.l += ps;
    mx = fmaxf(mx, __shfl_xor(mx, 32));
    if (__any(mx > 8.0f)) {
        const float dm = fmaxf(mx, 0.f); const float alpha = __builtin_amdgcn_exp2f(-dm); st.m += dm; st.l *= alpha;
#pragma unroll
        for (int d = 0; d < 4; ++d)
#pragma unroll
            for (int r = 0; r < 16; ++r) st.o[d][r] *= alpha;
    }
#undef A2_SB
#undef A2_LDK0
#undef A2_LDK1
#undef A2_LDV0
#undef A2_LDV1
}
template <int DKL, int DK, bool TAB, bool FARC = false>
__device__ __forceinline__ void attn2_pass(AState& st, LAS unsigned char* buf, const bf16_t* qp, int koff, const bf16_t* Kg, long ldk, const bf16_t* Vg, long ldv,
                                           int kbeg, int kend, const float* tp, int wlo, int whi, int tid_in, int lane, int qw = 0, float cneg = 0.f, float cpos = 0.f) {
    constexpr int NS = DK / 16, PR = DKL / 8, NKP = DKL / 64, RSK = DKL * 2 + 16, KBYTES = 64 * RSK;
    int tid = tid_in; asm volatile("" : "+v"(tid));
    const int n = lane & 31, hi = lane >> 5, pr = pi32(n);
    bf16x8 qf[NS];
#pragma unroll
    for (int s = 0; s < NS; ++s) qf[s] = *(const bf16x8*)(qp + 16 * s);
    u32x4 kreg[NKP], vreg[2];
    int krow[NKP], kc[NKP];
#pragma unroll
    for (int i = 0; i < NKP; ++i) { const int p = tid + 512 * i; krow[i] = p / PR; kc[i] = p % PR; }
#define A2_GLOAD(k0_) do { _Pragma("unroll") for (int i = 0; i < NKP; ++i) kreg[i] = *(const u32x4*)(Kg + (long)((k0_) + krow[i]) * ldk + 8 * kc[i]); \
        _Pragma("unroll") for (int i = 0; i < 2; ++i) { const int p = tid + 512 * i; vreg[i] = *(const u32x4*)(Vg + (long)(p >> 3) * ldv + (k0_) + 8 * (p & 7)); } } while (0)
#define A2_LSTORE(b_) do { _Pragma("unroll") for (int i = 0; i < NKP; ++i) *(LAS u32x4*)(buf + (b_) * A2_BUFSZ + krow[i] * RSK + kc[i] * 16) = kreg[i]; \
        _Pragma("unroll") for (int i = 0; i < 2; ++i) { const int p = tid + 512 * i; *(LAS u32x4*)(buf + (b_) * A2_BUFSZ + KBYTES + (p >> 3) * A2_RSV + (p & 7) * 16) = vreg[i]; } } while (0)
    A2_GLOAD(kbeg); A2_LSTORE(0); __syncthreads();
    int b = 0;
    const int kfo = pr * RSK + koff + hi * 16, vfo = KBYTES + n * A2_RSV + hi * 16;
    if (st.m < -1.0e38f) {
        f32x16 sc;
#pragma unroll
        for (int r = 0; r < 16; ++r) sc[r] = 0.f;
#pragma unroll
        for (int s = 0; s < NS; ++s) { const bf16x8 kf0 = *(const LAS bf16x8*)(buf + kfo + 32 * s); sc = __builtin_amdgcn_mfma_f32_32x32x16_bf16(kf0, qf[s], sc, 0, 0, 0); }
        float mx = sc[0];
#pragma unroll
        for (int r = 1; r < 16; ++r) mx = fmaxf(mx, sc[r]);
        mx = fmaxf(mx, __shfl_xor(mx, 32));
        st.m = fmaxf(mx, -60.0f);
    }
    for (int k0 = kbeg; k0 < kend; k0 += 64) {
        const bool more = k0 + 64 < kend;
        if (more) A2_GLOAD(k0 + 64);
        LAS unsigned char* bb = buf + b * A2_BUFSZ;
        if (!(k0 + 64 <= wlo || k0 >= whi)) {
            float iv = -st.m; bool usetab = TAB;
            if (FARC) { if (k0 + 63 - qw <= -576) { iv += cneg; usetab = false; } else if (k0 - qw - 31 >= 576) { iv += cpos; usetab = false; } }
            if (TAB && usetab) a2_tile<NS, RSK, true>(st, bb, kfo, vfo, qf, tp + k0, iv);
            else a2_tile<NS, RSK, false>(st, bb, kfo, vfo, qf, tp, iv);
        }
        if (more) A2_LSTORE(b ^ 1);
        __syncthreads();
        b ^= 1;
    }
#undef A2_GLOAD
#undef A2_LSTORE
}

__device__ __forceinline__ void attn2_unit(const Args& a, const AttnBufs& B, int layer, int mixer, int head, int row0, int S, int q0, int tid, int lane, int wave, LAS unsigned char* buf) {
#ifdef ONLY_MIXER2
    mixer = ONLY_MIXER2;
#endif
    if (mixer == 0) {
        int ln_ = lane; asm volatile("" : "+v"(ln_)); const int n = ln_ & 31, hi = ln_ >> 5;
        const int half = wave >> 2, qw = q0 + 32 * (wave & 3); const long qrow = (long)row0 + qw + n;
        const float lam_init = layer == 0 ? 0.2f : 0.35550906759f;
        AState st; astate_init(st);
        attn2_pass<128, 64, true, true>(st, buf, B.PROJ + qrow * NP + PC_AQ + head * 128 + 64 * half + 8 * hi, 128 * half, B.PROJ + (long)row0 * NP + PC_AK + head * 128, NP,
                                  B.VT + (long)(head * 128) * TCM + row0, TCM, 0, S, B.tabA + head * TABA_N + TABA_OFF - (qw + n) + 8 * hi, 0, S, tid, ln_,
                                  qw, B.tabA[head * TABA_N + TABA_OFF - 700], B.tabA[head * TABA_N + TABA_OFF + 700]);
        astate_finish(st);
        LAS float* xb = (LAS float*)buf + (wave & 3) * 4096;
        if (half == 1) {
#pragma unroll
            for (int d = 0; d < 4; ++d)
#pragma unroll
                for (int r = 0; r < 16; ++r) xb[(d * 16 + r) * 64 + ln_] = st.o[d][r]; }
        __syncthreads();
        if (half == 0) {
            const float d1 = wave_sum(a.in[I_ALQ1][layer * 64 + ln_] * a.in[I_ALK1][layer * 64 + ln_]);
            const float d2 = wave_sum(a.in[I_ALQ2][layer * 64 + ln_] * a.in[I_ALK2][layer * 64 + ln_]);
            const float lam = expf(d1) - expf(d2) + lam_init;
            float ss = 0.f;
#pragma unroll
            for (int d = 0; d < 4; ++d)
#pragma unroll
                for (int r = 0; r < 16; ++r) { const float v = st.o[d][r] - lam * xb[(d * 16 + r) * 64 + ln_]; st.o[d][r] = v; ss += v * v; }
            ss += __shfl_xor(ss, 32);
            const float rs = (1.0f - lam_init) / sqrtf(ss * (1.0f / 128.0f) + EPS);
            const float* gn = a.in[I_AON] + layer * 128 + 4 * hi;
#pragma unroll
            for (int d = 0; d < 4; ++d)
#pragma unroll
                for (int g = 0; g < 4; ++g) { const f32x4 gg = *(const f32x4*)(gn + 32 * d + 8 * g);
#pragma unroll
                    for (int e = 0; e < 4; ++e) st.o[d][4 * g + e] *= rs * gg[e]; }
            store_o(st.o, B.BR + qrow * 2048 + 4 * hi + head * 128);
        }
    } else if (mixer == 1) {
        int ln_ = lane; asm volatile("" : "+v"(ln_)); const int n = ln_ & 31, hi = ln_ >> 5;
        const int qw = q0 + 32 * wave; const long qrow = (long)row0 + qw + n;
        AState st; astate_init(st);
        attn2_pass<192, 192, false>(st, buf, B.QB + qrow * 768 + head * 192 + 8 * hi, 0, B.KB + (long)row0 * 768 + head * 192, 768,
                                    B.VTB + (long)(head * 128) * TCM + row0, TCM, 0, S, nullptr, 0, S, tid, ln_);
        astate_finish(st); store_o(st.o, B.BR + qrow * 2048 + 4 * hi + 512 + head * 128);
    } else if (mixer == 2) {
        int ln_ = lane; asm volatile("" : "+v"(ln_)); const int n = ln_ & 31, hi = ln_ >> 5;
        const int qw = q0 + 32 * wave; const long qrow = (long)row0 + qw + n; const int kv = head >> 1;
        AState st; astate_init(st);
        attn2_pass<128, 128, false>(st, buf, B.PROJ + qrow * NP + PC_CQ + head * 128 + 8 * hi, 0, B.PROJ + (long)row0 * NP + PC_CK + kv * 128, NP,
                                    B.VT + (long)(512 + kv * 128) * TCM + row0, TCM, 0, S, nullptr, 0, S, tid, ln_);
        astate_finish(st); store_o(st.o, B.BR + qrow * 2048 + 4 * hi + 1024 + head * 128);
    } else {
        int ln_ = lane; asm volatile("" : "+v"(ln_)); const int n = ln_ & 31, hi = ln_ >> 5;
        const int qw = q0 + 32 * wave; const long qrow = (long)row0 + qw + n;
        AState st; astate_init(st);
#pragma unroll 1
        for (int g = 0; g < 3; ++g) { const int W = g == 0 ? 64 : (g == 1 ? 256 : 1024);
            const int kb = q0 - W > 0 ? q0 - W : 0, ke = q0 + 256 + W < S ? q0 + 256 + W : S;
            attn2_pass<128, 128, true>(st, buf, B.PROJ + qrow * NP + PC_DQ + (g * 4 + head) * 128 + 8 * hi, 0, B.PROJ + (long)row0 * NP + PC_DK + head * 128, NP,
                                       B.VT + (long)(768 + head * 128) * TCM + row0, TCM, kb, ke, B.tabD + (g * 4 + head) * TABD_N + TABD_OFF - (qw + n) + 8 * hi, qw - W, qw + 32 + W, tid, ln_); }
        astate_finish(st); store_o(st.o, B.BR + qrow * 2048 + 4 * hi + 1536 + head * 128);
    }
}
__device__ __forceinline__ void attn2_phase(const Args& a, const AttnBufs& B, int layer, int chunk, unsigned* ctr, int tid, int lane, int wave, LAS unsigned char* lds) {
#if NCHUNK == 2
    const int npr = chunk == 0 ? 1 : 0, nsm = chunk == 0 ? 4 : 12, TC = chunk == 0 ? 16384 : 24576;
#else
    const int npr = chunk == 0 ? 1 : 0, nsm = chunk == 0 ? 0 : 4, TC = 8192;
#endif
    const int c0 = npr * 128, c1 = npr * 128, c2 = npr * 256, c3 = TC / 64, c4 = nsm * 32, c5 = nsm * 32, c6 = nsm * 64;
    const int total = c0 + c1 + c2 + c3 + c4 + c5 + c6;
    volatile LAS int* uw = (volatile LAS int*)(lds + 131072);
    for (;;) {
        __syncthreads();
        if (tid == 0) *uw = (int)atomicAdd(ctr, 1u);
        __syncthreads();
        int u = __builtin_amdgcn_readfirstlane(*uw);
        if (u >= total) break;
        int mixer, head, row0, S, q0;
        if (u < c0 + c1 + c2) { row0 = 0; S = TP;
            if (u < c0) { mixer = 1; q0 = (u % 32) * 256; head = u / 32; }
            else if (u < c0 + c1) { u -= c0; mixer = 2; q0 = (u % 32) * 256; head = u / 32; }
            else { u -= c0 + c1; mixer = 0; q0 = (u % 64) * 128; head = u / 64; }
        } else { u -= c0 + c1 + c2;
            if (u < c3) { mixer = 3; const int nb = TC / 256; const int q = (u % nb) * 256; head = u / nb;
                if (npr && q < TP) { row0 = 0; S = TP; } else { row0 = npr * TP + ((q - npr * TP) / SS) * SS; S = SS; }
                q0 = q - row0; }
            else { u -= c3; S = SS;
                if (u < c4) { mixer = 1; q0 = (u % 8) * 256; head = (u / 8) % 4; row0 = npr * TP + (u / 32) * SS; }
                else if (u < c4 + c5) { u -= c4; mixer = 2; q0 = (u % 8) * 256; head = (u / 8) % 4; row0 = npr * TP + (u / 32) * SS; }
                else { u -= c4 + c5; mixer = 0; q0 = (u % 16) * 128; head = (u / 16) % 4; row0 = npr * TP + (u / 64) * SS; } } }
        attn2_unit(a, B, layer, mixer, head, row0, S, q0, tid, lane, wave, lds);
    }
}


#define XB_TMO      128
#define XB_XCNT(j)  (256  + 64 * (j))
#define XB_XSUB(j)  (1280 + 64 * (j))
#define XB_XGEN(j)  (2304 + 64 * (j))
#define XB_TOP      3328
#define XB_TOPGEN   3392
#define XCD_BAR_WORDS 3456
#define XB_SPIN_CAP (1u << 22)
__device__ __forceinline__ unsigned xb_ld(unsigned* p)              { return __hip_atomic_load(p, __ATOMIC_RELAXED, __HIP_MEMORY_SCOPE_AGENT); }
__device__ __forceinline__ unsigned xb_add(unsigned* p, unsigned v) { return __hip_atomic_fetch_add(p, v, __ATOMIC_RELAXED, __HIP_MEMORY_SCOPE_AGENT); }
__device__ __forceinline__ unsigned xb_xcc_id() { return (unsigned)__builtin_amdgcn_s_getreg((3 << 11) | 20) & 0xFu; }
#define XB_SPIN(cond, bar) do { unsigned _sp = 0; while (cond) { __builtin_amdgcn_s_sleep(1); \
    if ((++_sp & 255u) == 0u) { if (xb_ld(&(bar)[XB_TMO])) break; if (_sp > XB_SPIN_CAP) { atomicAdd(&(bar)[XB_TMO], 1u); break; } } } } while (0)
struct XcdBarrier { unsigned* bar; unsigned x; volatile LAS unsigned* st; };
__device__ __forceinline__ XcdBarrier xcd_barrier_post(unsigned* bar, volatile LAS unsigned* st) {
    XcdBarrier b; b.bar = bar; b.x = xb_xcc_id(); b.st = st;
    if (threadIdx.x == 0) st[2] = xb_add(&bar[XB_XCNT(b.x)], 1u);
    return b;
}
__device__ __forceinline__ void xcd_barrier_complete(unsigned* bar, unsigned x, unsigned& nloc, unsigned& nx) {
    const unsigned G = gridDim.x * gridDim.y * gridDim.z;
    unsigned sum, cnt, mine, sp = 0u;
    for (;;) {
        sum = 0u; cnt = 0u; mine = 0u;
#pragma unroll
        for (unsigned j = 0; j < 16; ++j) { const unsigned c = xb_ld(&bar[XB_XCNT(j)]); sum += c; cnt += (c > 0u) ? 1u : 0u; mine = (j == x) ? c : mine; }
        if (sum == G) break;
        __builtin_amdgcn_s_sleep(1);
        if ((++sp & 255u) == 0u) { if (xb_ld(&bar[XB_TMO])) break; if (sp > XB_SPIN_CAP) { atomicAdd(&bar[XB_TMO], 1u); break; } }
    }
    nloc = mine > 0u ? mine : 1u; nx = cnt > 0u ? cnt : 1u;
}
__device__ __forceinline__ void xcd_barrier(const XcdBarrier& b, bool local = false) {
    asm volatile("s_waitcnt vmcnt(0)" ::: "memory");
    __syncthreads();
    if (threadIdx.x == 0) {
        unsigned* bar = b.bar;
        __builtin_amdgcn_s_waitcnt(0);
        unsigned nloc = b.st[0], nx = b.st[1];
        if (nloc == 0u) { xcd_barrier_complete(bar, b.x, nloc, nx); b.st[0] = nloc; b.st[1] = nx; }
        const unsigned old = xb_add(&bar[XB_XSUB(b.x)], 1u);
        const unsigned gen = old / nloc;
        if (old + 1u == (gen + 1u) * nloc) {
            if (!local) {
            __builtin_amdgcn_fence(__ATOMIC_RELEASE, "agent");
            asm volatile("s_waitcnt vmcnt(0)" ::: "memory");
            const unsigned og = xb_add(&bar[XB_TOP], 1u);
            const unsigned tg = og / nx;
            if (og + 1u == (tg + 1u) * nx) xb_add(&bar[XB_TOPGEN], 1u);
            else XB_SPIN(xb_ld(&bar[XB_TOPGEN]) == tg, bar);
            }
            __builtin_amdgcn_fence(__ATOMIC_ACQUIRE, "agent");
            xb_add(&bar[XB_XGEN(b.x)], 1u);
            asm volatile("s_waitcnt vmcnt(0)" ::: "memory");
        } else {
            XB_SPIN(xb_ld(&bar[XB_XGEN(b.x)]) == gen, bar);
            __builtin_amdgcn_fence(__ATOMIC_ACQUIRE, "agent");
            asm volatile("s_waitcnt vmcnt(0)" ::: "memory");
        }
    }
    __syncthreads();
}

__global__ void __launch_bounds__(512, 2) mega(Args a) {
    extern __shared__ __attribute__((aligned(16))) unsigned char lds_raw[];
    LAS unsigned char* lds = (LAS unsigned char*)lds_raw;
    const int G = gridDim.x, bx = blockIdx.x;
    unsigned char* ws = a.ws;
    unsigned* ctl = (unsigned*)(ws + WS_CTL);
    float* tabA = (float*)(ws + WS_TABA); float* tabD = (float*)(ws + WS_TABD);
    unsigned char* W = ws + WS_W;
    bf16_t* H = (bf16_t*)(ws + WS_H);
    bf16_t* PROJ = (bf16_t*)(ws + WS_R1 + R1_PROJ); bf16_t* VT = (bf16_t*)(ws + WS_R1 + R1_VT); bf16_t* QB = (bf16_t*)(ws + WS_R1 + R1_QB);
    bf16_t* KB = (bf16_t*)(ws + WS_R1 + R1_KB); bf16_t* VTB = (bf16_t*)(ws + WS_R1 + R1_VTB);
    bf16_t* Y = (bf16_t*)(ws + WS_R1); bf16_t* FFH = (bf16_t*)(ws + WS_R1);
    bf16_t* BR = (bf16_t*)(ws + WS_R2); float* PART = (float*)(ws + WS_R2); bf16_t* U = (bf16_t*)(ws + WS_R2);
    bf16_t* MERGED = (bf16_t*)(ws + WS_R2); bf16_t* P16 = (bf16_t*)(ws + WS_R2 + 100 * MiB); bf16_t* XB = (bf16_t*)(ws + WS_XB);
    float* ssA = (float*)(ws + WS_SSP); float* ssB = ssA + (size_t)TCM * 32;
    cg::grid_group grid = cg::this_grid();
    volatile LAS unsigned* bst = (volatile LAS unsigned*)(lds + 131072 + 64);
    if (threadIdx.x < 6) bst[threadIdx.x] = threadIdx.x == 3 ? (unsigned)bx : 0u;
    __syncthreads();
    XcdBarrier xbar = xcd_barrier_post(ctl + 1024, bst);

    for (int pid = a.ph_lo; pid < a.ph_hi; ++pid) {
        int tid = threadIdx.x; asm volatile("" : "+v"(tid));
        const int lane = tid & 63, wave = __builtin_amdgcn_readfirstlane(tid >> 6);
        const int gw = bx * 8 + wave, ngw = G * 8;
        const int layer = pid / (1 + 12 * NCHUNK), q = pid % (1 + 12 * NCHUNK);
        bool locseam = false;
        if (q == 0) {
            if (layer == 0) build_tables(a.in[I_RELB], tabA, tabD, bx * 512 + tid, G * 512);
#ifndef NO_CONV
            convert_weights(a, layer, W, (LAS float*)(lds + wave * 16384), gw, ngw, lane);
#endif
        } else {
            const int chunk = (q - 1) / 12, kidx = (q - 1) % 12; const int k = kidx < 9 ? kidx + 1 : (kidx == 9 ? 11 : (kidx == 10 ? 12 : 15));
#if NCHUNK == 2
            const int m0 = chunk == 0 ? 0 : 16384, TC = chunk == 0 ? 16384 : 24576, nMt = TC / 256;
#else
            const int m0 = chunk * 8192, TC = 8192, nMt = TC / 256;
#endif
#ifdef NO_ROWS
            if (0) {
#else
            if (k == 1) {
#endif
                const float* g = a.in[I_NMIX] + layer * DM;
                for (int r = gw; r < TC; r += ngw) { const int m = m0 + r;
                    if (layer == 0) norm_row(xrow_ptr(a.in[I_XP], a.in[I_XS], m), g, H + (size_t)r * DM, lane, XB + (size_t)m * DM);
                    else norm_row_bf(XB + (size_t)m * DM, g, H + (size_t)r * DM, lane);
                    const float* pr = m < TP ? a.in[I_PP] + ((size_t)layer * TP + m) * 256 : a.in[I_PS] + ((size_t)layer * 32768 + (m - TP)) * 256;
                    const f32x4 v = *(const f32x4*)(pr + 4 * lane); u32x2 w; w.x = cvt_pk_bf16(v[0], v[1]); w.y = cvt_pk_bf16(v[2], v[3]); *(u32x2*)(P16 + (size_t)r * 256 + 4 * lane) = w;
                }
#ifdef NO_ROWS
            } else if (0) {
#else
            } else if (k == 3 || k == 5) {
#endif
                for (int r = gw; r < TC; r += ngw) { const int m = m0 + r; const int tseq = m < TP ? m : (m - TP) % SS;
                    if (k == 3) post1_row(a, layer, PROJ + (size_t)r * NP, tseq, lane);
                    else post2_row(a, layer, QB + (size_t)r * 768, KB + (size_t)r * 768, PROJ + (size_t)r * NP, tseq, lane); }
            } else if (k == 6) {
                AttnBufs B{PROJ, VT, QB, KB, VTB, BR, tabA, tabD};
#ifndef NO_ATTN
                #if ATTN_V2
                attn2_phase(a, B, layer, chunk, ctl + 64 * (layer * NCHUNK + chunk), tid, lane, wave, lds);
#else
                attn_phase(a, B, layer, chunk, ctl + 64 * (layer * NCHUNK + chunk), lane, (LAS float*)(lds + wave * 16384));
#endif
#endif
            } else {
                const int njobs = (k == 2 || k == 11) ? 2 : (k == 4 ? 3 : 1);
                locseam = (k >= 7 && k != 15);
                int coff = 0;
                for (int j = 0; j < njobs; ++j) {
                    pg8::Gemm g; pg8::Epi E; int nM = nMt, nN = 8, rep = 1, adiv = 1 << 30; long astep = 0;
                    E.kind = pg8::EK_BF16; E.O = nullptr; E.ldc = 0; E.Y = nullptr; E.xin = nullptr; E.xob = nullptr; E.xof = nullptr; E.ssq = nullptr; E.rsq = nullptr;
                    bf16_t* XBc = XB + (size_t)m0 * DM;
                    g.A = H; g.Bt = (const bf16_t*)(W + WO_IN); g.lda = 2048; g.ldb = 2048; g.K = 2048;
                    if (k == 2 && j == 0) { nN = NP / 256; E.O = PROJ; E.ldc = NP; }
                    else if (k == 2) { g.A = (const bf16_t*)(W + WO_INV); g.Bt = H; nM = NVT / 256; nN = nMt; E.O = VT; E.ldc = TCM; }
                    else if (k == 4 && j == 0) { g.A = PROJ + PC_BCQ; g.lda = NP; g.Bt = (const bf16_t*)(W + WO_UQ); g.ldb = 512; g.K = 512; nN = 3; E.O = QB; E.ldc = 768; }
                    else if (k == 4 && j == 1) { g.A = PROJ + PC_BCKV; g.lda = NP; g.Bt = (const bf16_t*)(W + WO_UKN); g.ldb = 512; g.K = 512; nN = 2; E.kind = pg8::EK_SPLIT192; E.O = KB; E.ldc = 768; }
                    else if (k == 4) { g.A = (const bf16_t*)(W + WO_UKV); g.lda = 512; g.Bt = PROJ + PC_BCKV; g.ldb = NP; g.K = 512; nM = 2; nN = nMt; E.O = VTB; E.ldc = TCM; }
                    else if (k == 7) { g.A = BR; g.Bt = (const bf16_t*)(W + WO_B); g.ldb = 512; g.K = 512; nN = 32; adiv = 8; astep = 1024; E.O = Y; E.ldc = 8192; }
                    else if (k == 8) { g.Bt = (const bf16_t*)(W + WO_G); nN = 32; E.kind = pg8::EK_GATE; E.O = MERGED; E.Y = Y; }
                    else if (k == 9) { g.A = MERGED; g.Bt = (const bf16_t*)(W + WO_O); E.kind = pg8::EK_RES; E.xin = XBc; E.xob = XBc; E.ssq = ssA; }
                    else if (k == 11 && j == 0) { g.A = XBc; g.Bt = (const bf16_t*)(W + WO_1); nN = 32; E.kind = pg8::EK_RELU2; E.O = FFH; E.ldc = 8192; E.rsq = ssA; }
                    else if (k == 11) { g.A = P16; g.lda = 256; g.Bt = (const bf16_t*)(W + WO_PP); g.ldb = 256; g.K = 256; E.O = U; E.ldc = 2048; }
                    else if (k == 12) { g.A = FFH; g.lda = 8192; g.Bt = (const bf16_t*)(W + WO_2); g.ldb = 8192; g.K = 8192; E.kind = pg8::EK_RES; E.xin = XBc; E.xob = H; E.ssq = ssB; }
                    else { g.Bt = (const bf16_t*)(W + WO_PG); E.kind = pg8::EK_PLE; E.Y = U; E.xin = H; E.rsq = ssB; if (layer == 1) E.xof = a.out + (size_t)m0 * DM; else E.xob = XBc; }
                    const int vbx = __builtin_amdgcn_readfirstlane((int)bst[3]);
                    pg8::Order S; S.init(nM, nN, G, (vbx + G - coff) % G, rep, adiv, astep, 0);
#ifndef NO_GEMM
                    pg8::gemm_phase<true>(lds, g, S, E, tid);
#endif
                    coff = (coff + (nM * nN) % G) % G;
                }
            }
        }
        if (pid + 1 < a.ph_hi) {
            if (pid == a.ph_lo) {
                grid.sync();
                if (threadIdx.x == 0) { bool ok = (G % 8 == 0);
                    for (unsigned j = 0; j < 16; ++j) { const unsigned cnt = xb_ld(&xbar.bar[XB_XCNT(j)]); if (cnt != (j < 8 ? (unsigned)G / 8u : 0u)) ok = false; }
                    bst[3] = ok ? (bst[2] * 8u + xbar.x) : (unsigned)bx; bst[4] = ok ? 1u : 0u; }
                __syncthreads();
            } else {
                xcd_barrier(xbar, locseam && bst[4] != 0u); } }
    }
}

extern "C" void kernel_launch(void* const* d_in, const int* in_sizes, int n_in, void* d_out, int out_size, void* d_ws, size_t ws_size, hipStream_t stream) {
    static int grid = 0;
    if (grid == 0) {
        if (n_in != 33 || out_size != TALL * DM || ws_size < WS_END) { fprintf(stderr, "kernel_launch: unexpected shapes (n_in %d out %d ws %zu need %zu)\n", n_in, out_size, ws_size, (size_t)WS_END); grid = -1; return; }
        int dev = 0, cus = 0, per_cu = 0;
        hipGetDevice(&dev); hipDeviceGetAttribute(&cus, hipDeviceAttributeMultiprocessorCount, dev);
        if (hipFuncSetAttribute((const void*)mega, hipFuncAttributeMaxDynamicSharedMemorySize, LDS_BYTES) != hipSuccess) { fprintf(stderr, "kernel_launch: hipFuncSetAttribute failed\n"); grid = -1; return; }
        if (hipOccupancyMaxActiveBlocksPerMultiprocessor(&per_cu, (const void*)mega, 512, LDS_BYTES) != hipSuccess || per_cu < 1) per_cu = 1;
        (void)hipGetLastError();
        grid = cus * per_cu;
        if (grid <= 0) grid = 256;
    }
    if (grid < 0) return;
    hipMemsetAsync((char*)d_ws + WS_CTL, 0, 32768, stream);
    Args a{};
    for (int i = 0; i < 33; ++i) a.in[i] = (const float*)d_in[i];
    a.out = (float*)d_out; a.ws = (unsigned char*)d_ws;
    constexpr int NPH = 2 * (1 + 12 * NCHUNK);
#if COOP
    a.ph_lo = 0; a.ph_hi = NPH;
    void* args[] = {&a};
    hipError_t e = hipLaunchCooperativeKernel((const void*)mega, dim3(grid), dim3(512), args, LDS_BYTES, stream);
    if (e != hipSuccess) fprintf(stderr, "cooperative launch failed: %s (grid %d)\n", hipGetErrorString(e), grid);
#else
    for (int p = 0; p < NPH; ++p) { a.ph_lo = p; a.ph_hi = p + 1; hipLaunchKernelGGL(mega, dim3(grid), dim3(512), LDS_BYTES, stream, a); }
#endif
}
```

```cpp
#include <hip/hip_runtime.h>
#include <hip/hip_cooperative_groups.h>
#include <cstdio>
#include <cstdint>
namespace cg = cooperative_groups;

#ifndef COOP
#define COOP 1
#endif
#ifndef ATTN_V2
#define ATTN_V2 1
#endif
#ifndef NCHUNK
#define NCHUNK 2
#endif

#define LAS __attribute__((address_space(3)))
typedef unsigned short bf16_t;
typedef short bf16x8 __attribute__((ext_vector_type(8)));
typedef float f32x4 __attribute__((ext_vector_type(4)));
typedef float f32x16 __attribute__((ext_vector_type(16)));
typedef unsigned u32x4 __attribute__((ext_vector_type(4)));
typedef unsigned u32x2 __attribute__((ext_vector_type(2)));
typedef float f32x4u __attribute__((ext_vector_type(4), aligned(4)));

constexpr int DM = 2048, TALL = 40960, TP = 8192, SS = 2048;
constexpr int NP = 5120;
constexpr int TCM = 24576;
constexpr int NVT = 1280;
constexpr int DFF = 8192;
constexpr int PC_AQ = 0, PC_AK = 512, PC_BCQ = 1024, PC_BCKV = 1536, PC_CQ = 2048, PC_CK = 2560, PC_DQ = 2816, PC_DK = 4352, PC_BKR = 4864;
constexpr float LOG2E = 1.4426950408889634f;
constexpr float EPS = 1e-6f;
constexpr int TABA_N = 16384, TABA_OFF = 8192, TABD_N = 2304, TABD_OFF = 1152;

constexpr size_t MiB = 1u << 20;
constexpr size_t WS_CTL = 0;
constexpr size_t WS_TABA = 64 * 1024;
constexpr size_t WS_TABD = 384 * 1024;
constexpr size_t WS_SS = 512 * 1024;
constexpr size_t WS_W = 1 * MiB;
constexpr size_t WO_IN = 0;
constexpr size_t WO_INV = WO_IN + (size_t)NP * 2048 * 2;
constexpr size_t WO_G = WO_INV + (size_t)NVT * 2048 * 2;
constexpr size_t WO_B = WO_G + (size_t)8192 * 2048 * 2;
constexpr size_t WO_O = WO_B + (size_t)8192 * 512 * 2;
constexpr size_t WO_1 = WO_O + (size_t)2048 * 2048 * 2;
constexpr size_t WO_2 = WO_1 + (size_t)8192 * 2048 * 2;
constexpr size_t WO_PG = WO_2 + (size_t)2048 * 8192 * 2;
constexpr size_t WO_PP = WO_PG + (size_t)2048 * 2048 * 2;
constexpr size_t WO_UQ = WO_PP + (size_t)2048 * 256 * 2;
constexpr size_t WO_UKN = WO_UQ + (size_t)768 * 512 * 2;
constexpr size_t WO_UKV = WO_UKN + (size_t)512 * 512 * 2;
constexpr size_t WO_END = WO_UKV + (size_t)512 * 512 * 2;
static_assert(WO_END <= 148 * MiB, "weights");
constexpr size_t WS_H = WS_W + 148 * MiB;
constexpr size_t WS_R1 = WS_H + (size_t)TCM * 2048 * 2;
constexpr size_t R1_PROJ = 0;
constexpr size_t R1_VT = R1_PROJ + (size_t)TCM * NP * 2;
constexpr size_t R1_QB = R1_VT + (size_t)NVT * TCM * 2;
constexpr size_t R1_KB = R1_QB + (size_t)TCM * 768 * 2;
constexpr size_t R1_VTB = R1_KB + (size_t)TCM * 768 * 2;
constexpr size_t R1_END = R1_VTB + (size_t)512 * TCM * 2;
static_assert(R1_END >= (size_t)TCM * 8192 * 2, "Y / FFH overlay");
constexpr size_t WS_R2 = WS_R1 + R1_END;
constexpr size_t WS_XB = WS_R2 + (size_t)TCM * 2048 * 4;
constexpr size_t WS_SSP = WS_XB + (size_t)TALL * 2048 * 2;
constexpr size_t WS_END = WS_SSP + 2 * (size_t)TCM * 32 * 4;

constexpr int LDS_BYTES = 147456;

typedef float f32x2_t __attribute__((ext_vector_type(2))); typedef __bf16 bf16x2_t __attribute__((ext_vector_type(2)));
__device__ __forceinline__ unsigned cvt_pk_bf16(float lo, float hi) { f32x2_t v = {lo, hi}; bf16x2_t b = __builtin_convertvector(v, bf16x2_t); return __builtin_bit_cast(unsigned, b); }
__device__ __forceinline__ float bf_lo(unsigned u) { return __uint_as_float(u << 16); }
__device__ __forceinline__ float bf_hi(unsigned u) { return __uint_as_float(u & 0xffff0000u); }
__device__ __forceinline__ float wave_sum(float v) {
#pragma unroll
    for (int o = 1; o < 64; o <<= 1) v += __shfl_xor(v, o);
    return v;
}
__device__ __forceinline__ float sigmoidf_fast(float x) { return __builtin_amdgcn_rcpf(1.0f + __builtin_amdgcn_exp2f(-x * LOG2E)); }
__device__ __forceinline__ const float* xrow_ptr(const float* s0, const float* s1, int m) { return m < TP ? s0 + (size_t)m * DM : s1 + (size_t)(m - TP) * DM; }

namespace pg8 {
constexpr int BM = 256, BK = 64, HALF = 128, HTB = HALF * BK * 2, STAGE_BYTES = 8 * HTB, NXCD = 8, WGM = 4;
__host__ __device__ __forceinline__ int lds_byte(int r, int c) { const int st = (r >> 4) * 2 + (c >> 5), rr = r & 15, cc = c & 31, ob = rr * 64 + cc * 2; return st * 1024 + (ob ^ (((ob >> 9) & 1) << 5)); }
__host__ __device__ __forceinline__ void stage_rc(int b, int& R, int& C) { const int st = b / 1024, sb = b % 1024, swz = sb ^ (((sb >> 9) & 1) << 5); R = (st >> 1) * 16 + swz / 64; C = (st & 1) * 32 + (swz % 64) / 2; }
__host__ __device__ __forceinline__ int perm32(int rho) { const int n = rho >> 4, i = rho & 15; return 8 * (i >> 2) + 4 * n + (i & 3); }

struct Unit { int pm, pn; long aoff; };
struct Gemm { const bf16_t* A; const bf16_t* Bt; int lda, ldb, K; };

struct Order {
    int nM, nN, nwg, G, c, rep, adiv, rev; long astep;
    __device__ void init(int nM_, int nN_, int G_, int c_, int rep_, int adiv_, long astep_, int rev_ = 0) { nM = nM_; nN = nN_; nwg = nM * nN; G = G_; c = c_; rep = rep_; adiv = adiv_; astep = astep_; rev = rev_; }
    __device__ bool next(int i, Unit& u) const {
        const int t = i / rep, sub = i - t * rep;
        const long L = (long)t * G + c; if (L >= nwg) return false;
        int wgid = (int)L; { const int q = nwg / NXCD, r = nwg % NXCD, xcd = wgid % NXCD, off = wgid / NXCD; wgid = (xcd < r ? xcd * (q + 1) : r * (q + 1) + (xcd - r) * q) + off; }
        const int nig = WGM * nN, gid = wgid / nig, fm = gid * WGM, gsz = (nM - fm) < WGM ? (nM - fm) : WGM;
        u.pm = fm + ((wgid % nig) % gsz); if (rev) u.pm = nM - 1 - u.pm; const int pn = (wgid % nig) / gsz; u.pn = pn + sub * nN; u.aoff = (long)(pn / adiv) * astep; return true;
    }
};

__device__ __forceinline__ float row_rs(const float* p, int fq) {
    const f32x4 v0 = *(const f32x4*)(p + 8 * fq), v1 = *(const f32x4*)(p + 8 * fq + 4);
    float t = ((v0[0] + v0[1]) + (v0[2] + v0[3])) + ((v1[0] + v1[1]) + (v1[2] + v1[3]));
    t += __shfl_xor(t, 16); t += __shfl_xor(t, 32);
    return 1.0f / sqrtf(t * (1.0f / 2048.0f) + EPS);
}
enum { EK_BF16 = 0, EK_SPLIT192 = 1, EK_RELU2 = 2, EK_GATE = 3, EK_RES = 4, EK_PLE = 5 };
struct Epi {
    static constexpr bool PERM = true;
    int kind; bf16_t* O; long ldc; const bf16_t* Y;
    const bf16_t* xin; bf16_t* xob; float* xof; float* ssq; const float* rsq;
    __device__ __forceinline__ void operator()(const f32x4 (&acc)[2][2][4][2], const Unit& u, int wr, int wc, int fr, int fq) const {
        const int row0 = u.pm * BM + wr * 64 + fr, col0 = u.pn * BM + wc * 32 + 8 * fq;
        if (kind <= EK_RELU2) {
            float rsv[2][4];
#pragma unroll
            for (int ai = 0; ai < 2; ++ai)
#pragma unroll
                for (int m = 0; m < 4; ++m) rsv[ai][m] = (kind == EK_RELU2) ? row_rs(rsq + (size_t)(row0 + ai * HALF + m * 16) * 32, fq) : 1.f;
#pragma unroll
            for (int ai = 0; ai < 2; ++ai)
#pragma unroll
                for (int m = 0; m < 4; ++m) { const int row = row0 + ai * HALF + m * 16; const float rs = rsv[ai][m];
#pragma unroll
                    for (int bj = 0; bj < 2; ++bj) { int col = col0 + bj * HALF; f32x4 v0 = acc[ai][bj][m][0], v1 = acc[ai][bj][m][1];
                        if (kind == EK_RELU2) {
#pragma unroll
                            for (int e = 0; e < 4; ++e) { float a = fmaxf(v0[e], 0.f) * rs, b = fmaxf(v1[e], 0.f) * rs; v0[e] = a * a; v1[e] = b * b; } }
                        if (kind == EK_SPLIT192) col = (col >> 7) * 192 + (col & 127);
                        u32x4 w; w.x = cvt_pk_bf16(v0[0], v0[1]); w.y = cvt_pk_bf16(v0[2], v0[3]); w.z = cvt_pk_bf16(v1[0], v1[1]); w.w = cvt_pk_bf16(v1[2], v1[3]);
                        *(u32x4*)(O + (size_t)row * ldc + col) = w; } }
        } else if (kind == EK_GATE) {
            const int oc = u.pn * 64 + wc * 16 + 4 * fq;
#pragma unroll
            for (int ai = 0; ai < 2; ++ai) {
                u32x2 yv[4][4];
#pragma unroll
                for (int m = 0; m < 4; ++m) { const bf16_t* yp = Y + (size_t)(row0 + ai * HALF + m * 16) * 8192 + oc;
#pragma unroll
                    for (int b = 0; b < 4; ++b) yv[m][b] = *(const u32x2*)(yp + b * 2048); }
#pragma unroll
                for (int m = 0; m < 4; ++m) { const int row = row0 + ai * HALF + m * 16;
                    f32x4 r = (f32x4){0.f, 0.f, 0.f, 0.f};
#pragma unroll
                    for (int b = 0; b < 4; ++b) { const u32x2 y = yv[m][b]; const f32x4 v = acc[ai][b >> 1][m][b & 1];
                        r[0] += sigmoidf_fast(v[0]) * bf_lo(y.x); r[1] += sigmoidf_fast(v[1]) * bf_hi(y.x); r[2] += sigmoidf_fast(v[2]) * bf_lo(y.y); r[3] += sigmoidf_fast(v[3]) * bf_hi(y.y); }
                    u32x2 w; w.x = cvt_pk_bf16(r[0], r[1]); w.y = cvt_pk_bf16(r[2], r[3]);
                    *(u32x2*)(O + (size_t)row * 2048 + oc) = w; }
            }
        } else if (kind == EK_RES) res_part<false, 4>(acc, u, wc, fq, row0, col0);
        else res_part<true, 2>(acc, u, wc, fq, row0, col0);
    }
    template <bool PLE, int MB>
    __device__ __forceinline__ void res_part(const f32x4 (&acc)[2][2][4][2], const Unit& u, int wc, int fq, int row0, int col0) const {
#pragma unroll
        for (int ai = 0; ai < 2; ++ai)
#pragma unroll
            for (int mb = 0; mb < 4; mb += MB) {
                u32x4 xv[MB][2], yv[MB][2]; float rsv[MB];
#pragma unroll
                for (int mm = 0; mm < MB; ++mm) { const int row = row0 + ai * HALF + (mb + mm) * 16;
                    rsv[mm] = PLE ? row_rs(rsq + (size_t)row * 32, fq) : 1.f;
#pragma unroll
                    for (int bj = 0; bj < 2; ++bj) { const int col = col0 + bj * HALF; xv[mm][bj] = *(const u32x4*)(xin + (size_t)row * DM + col);
                        if (PLE) yv[mm][bj] = *(const u32x4*)(Y + (size_t)row * 2048 + col); } }
#pragma unroll
                for (int mm = 0; mm < MB; ++mm) { const int m = mb + mm; const int row = row0 + ai * HALF + m * 16; const float rs = rsv[mm]; float sq = 0.f;
#pragma unroll
                    for (int bj = 0; bj < 2; ++bj) { const int col = col0 + bj * HALF; f32x4 v0 = acc[ai][bj][m][0], v1 = acc[ai][bj][m][1];
                        const u32x4 xb = xv[mm][bj];
                        if (PLE) { const u32x4 y = yv[mm][bj]; v0 = v0 * rs; v1 = v1 * rs;
                            v0[0] = sigmoidf_fast(v0[0]) * bf_lo(y.x); v0[1] = sigmoidf_fast(v0[1]) * bf_hi(y.x); v0[2] = sigmoidf_fast(v0[2]) * bf_lo(y.y); v0[3] = sigmoidf_fast(v0[3]) * bf_hi(y.y);
                            v1[0] = sigmoidf_fast(v1[0]) * bf_lo(y.z); v1[1] = sigmoidf_fast(v1[1]) * bf_hi(y.z); v1[2] = sigmoidf_fast(v1[2]) * bf_lo(y.w); v1[3] = sigmoidf_fast(v1[3]) * bf_hi(y.w); }
                        f32x4 n0, n1;
                        n0[0] = bf_lo(xb.x) + v0[0]; n0[1] = bf_hi(xb.x) + v0[1]; n0[2] = bf_lo(xb.y) + v0[2]; n0[3] = bf_hi(xb.y) + v0[3];
                        n1[0] = bf_lo(xb.z) + v1[0]; n1[1] = bf_hi(xb.z) + v1[1]; n1[2] = bf_lo(xb.w) + v1[2]; n1[3] = bf_hi(xb.w) + v1[3];
                        if (xof) { *(f32x4*)(xof + (size_t)row * DM + col) = n0; *(f32x4*)(xof + (size_t)row * DM + col + 4) = n1; }
                        else { u32x4 w; w.x = cvt_pk_bf16(n0[0], n0[1]); w.y = cvt_pk_bf16(n0[2], n0[3]); w.z = cvt_pk_bf16(n1[0], n1[1]); w.w = cvt_pk_bf16(n1[2], n1[3]);
                            *(u32x4*)(xob + (size_t)row * DM + col) = w; }
                        if (ssq) sq += (n0[0] * n0[0] + n0[1] * n0[1]) + (n0[2] * n0[2] + n0[3] * n0[3]) + (n1[0] * n1[0] + n1[1] * n1[1]) + (n1[2] * n1[2] + n1[3] * n1[3]); }
                    if (ssq) { sq += __shfl_xor(sq, 16); sq += __shfl_xor(sq, 32); if (fq == 0) ssq[(size_t)row * 32 + u.pn * 4 + wc] = sq; } }
            }
    }
};

template <bool ALIGN_EPI = true>
__device__ __forceinline__ void gemm_phase(LAS unsigned char* lds, const Gemm g, const Order& S, const Epi& E, const int tid) {
    const int wid = __builtin_amdgcn_readfirstlane(tid >> 6), lane = tid & 63, wr = wid >> 2, wc = wid & 3, fr = lane & 15, fq = lane >> 4;
    const int K = g.K, nt = K / BK;
    unsigned voffA[2], voffB[2];
#pragma unroll
    for (int i = 0; i < 2; ++i) { int R, C; stage_rc(tid * 16 + i * 8192, R, C); const int Rb = Epi::PERM ? ((R & ~31) + perm32(R & 31)) : R;
        voffA[i] = (unsigned)(R * g.lda + C) * 2u; voffB[i] = (unsigned)(Rb * g.ldb + C) * 2u; }
    const size_t kstep = (size_t)(BK * 2);
    const size_t hstA = (size_t)HALF * g.lda * 2, hstB = (size_t)HALF * g.ldb * 2;
    const size_t tstA = 2 * hstA, tstB = 2 * hstB;
    const unsigned ldsw = (unsigned)wid * 1024u;
    const int aoff = lds_byte(wr * 64 + fr, fq * 8), boff = lds_byte(wc * 32 + fr, fq * 8);
#define PG8_SA(b, h) (((b) * 2 + (h)) * HTB)
#define PG8_SB(b, h) ((4 + (b) * 2 + (h)) * HTB)
#define PG8_STAGE(bufoff, gbase, voff) do { _Pragma("unroll") for (int _i = 0; _i < 2; ++_i) \
        __builtin_amdgcn_global_load_lds((const unsigned*)((const char*)(gbase) + (voff)[_i]), (LAS unsigned*)(lds + (bufoff) + ldsw + _i * 8192), 16, 0, 0); } while (0)
#define PG8_LDA(dst, b, h) do { _Pragma("unroll") for (int m = 0; m < 4; ++m) _Pragma("unroll") for (int k = 0; k < 2; ++k) dst[m][k] = *(const LAS bf16x8*)(lds + PG8_SA(b, h) + aoff + m * 2048 + k * 1024); } while (0)
#define PG8_LDB(dst, b, h) do { _Pragma("unroll") for (int n = 0; n < 2; ++n) _Pragma("unroll") for (int k = 0; k < 2; ++k) dst[n][k] = *(const LAS bf16x8*)(lds + PG8_SB(b, h) + boff + n * 2048 + k * 1024); } while (0)
#define PG8_MMA(ai, bj, At, Bt) do { __builtin_amdgcn_s_setprio(1); _Pragma("unroll") for (int m = 0; m < 4; ++m) _Pragma("unroll") for (int n = 0; n < 2; ++n) _Pragma("unroll") for (int k = 0; k < 2; ++k) \
        acc[ai][bj][m][n] = __builtin_amdgcn_mfma_f32_16x16x32_bf16(Bt[n][k], At[m][k], acc[ai][bj][m][n], 0, 0, 0); __builtin_amdgcn_s_setprio(0); } while (0)
#define PG8_WAIT_V(n) asm volatile("s_waitcnt vmcnt(" #n ")" ::: "memory")
#define PG8_WAIT_L(n) asm volatile("s_waitcnt lgkmcnt(" #n ")" ::: "memory")
#define PG8_BAR __builtin_amdgcn_s_barrier()
#define PG8_SCHED __builtin_amdgcn_sched_barrier(0)
    Unit cur, nxt; int ui = 0;
    if (!S.next(0, cur)) return;
    f32x4 acc[2][2][4][2];
#pragma unroll
    for (int a = 0; a < 2; ++a)
#pragma unroll
        for (int b = 0; b < 2; ++b)
#pragma unroll
            for (int m = 0; m < 4; ++m)
#pragma unroll
                for (int n = 0; n < 2; ++n) acc[a][b][m][n] = (f32x4){0.f, 0.f, 0.f, 0.f};
    bf16x8 At[4][2], B0[2][2], B1[2][2];
    const char* cA = (const char*)g.A + (size_t)cur.pm * tstA + cur.aoff; const char* cB = (const char*)g.Bt + (size_t)cur.pn * tstB;
    PG8_STAGE(PG8_SB(0, 0), cB, voffB); PG8_STAGE(PG8_SB(0, 1), cB + hstB, voffB); PG8_STAGE(PG8_SA(0, 0), cA, voffA); PG8_STAGE(PG8_SA(0, 1), cA + hstA, voffA);
    if (wr == 1) PG8_BAR;
    PG8_WAIT_V(2); PG8_BAR;
    PG8_STAGE(PG8_SB(1, 0), cB + kstep, voffB); PG8_STAGE(PG8_SA(1, 0), cA + kstep, voffA); PG8_STAGE(PG8_SB(1, 1), cB + hstB + kstep, voffB);
    PG8_WAIT_V(6); PG8_BAR;
    for (;;) {
        const bool has_next = S.next(ui + 1, nxt);
        const char* nA = has_next ? (const char*)g.A + (size_t)nxt.pm * tstA + nxt.aoff : cA; const char* nB = has_next ? (const char*)g.Bt + (size_t)nxt.pn * tstB : cB;
        for (int t = 0; t < nt; t += 2) {
            const bool last = (t == nt - 2);
            const char* a1 = cA + (size_t)(t + 1) * kstep;
            const char* a2 = last ? nA : cA + (size_t)(t + 2) * kstep; const char* b2 = last ? nB : cB + (size_t)(t + 2) * kstep;
            const char* a3 = a2 + kstep; const char* b3 = b2 + kstep;
            PG8_LDB(B0, 0, 0); PG8_LDB(B1, 0, 1); PG8_SCHED; PG8_LDA(At, 0, 0); PG8_STAGE(PG8_SA(1, 1), a1 + hstA, voffA);
            PG8_WAIT_V(8); PG8_WAIT_L(0); PG8_BAR; PG8_MMA(0, 0, At, B0); PG8_MMA(0, 1, At, B1); PG8_BAR; PG8_SCHED;
            PG8_LDA(At, 0, 1); PG8_STAGE(PG8_SB(0, 0), b2, voffB); PG8_STAGE(PG8_SB(0, 1), b2 + hstB, voffB); PG8_STAGE(PG8_SA(0, 0), a2, voffA);
            PG8_WAIT_V(8); PG8_WAIT_L(0); PG8_BAR; PG8_MMA(1, 0, At, B0); PG8_MMA(1, 1, At, B1); PG8_BAR; PG8_SCHED;
            PG8_LDB(B0, 1, 0); PG8_LDB(B1, 1, 1); PG8_SCHED; PG8_LDA(At, 1, 0); PG8_STAGE(PG8_SA(0, 1), a2 + hstA, voffA);
            PG8_WAIT_V(8); PG8_WAIT_L(0); PG8_BAR; PG8_MMA(0, 0, At, B0); PG8_MMA(0, 1, At, B1); PG8_BAR; PG8_SCHED;
            PG8_LDA(At, 1, 1); PG8_STAGE(PG8_SB(1, 0), b3, voffB); PG8_STAGE(PG8_SB(1, 1), b3 + hstB, voffB); PG8_STAGE(PG8_SA(1, 0), a3, voffA);
            PG8_WAIT_V(8); PG8_WAIT_L(0); PG8_BAR; PG8_MMA(1, 0, At, B0); PG8_MMA(1, 1, At, B1); PG8_BAR; PG8_SCHED;
        }
        if constexpr (ALIGN_EPI) { if (wr == 0) PG8_BAR; }
        E(acc, cur, wr, wc, fr, fq);
        if (!has_next) break;
#pragma unroll
        for (int a = 0; a < 2; ++a)
#pragma unroll
            for (int b = 0; b < 2; ++b)
#pragma unroll
                for (int m = 0; m < 4; ++m)
#pragma unroll
                    for (int n = 0; n < 2; ++n) acc[a][b][m][n] = (f32x4){0.f, 0.f, 0.f, 0.f};
        cur = nxt; cA = nA; cB = nB; ++ui;
        if constexpr (ALIGN_EPI) { if (wr == 1) PG8_BAR; }
    }
    PG8_WAIT_V(0);
    if constexpr (!ALIGN_EPI) { if (wr == 0) PG8_BAR; }
    PG8_BAR;
#undef PG8_SA
#undef PG8_SB
#undef PG8_STAGE
#undef PG8_LDA
#undef PG8_LDB
#undef PG8_MMA
#undef PG8_WAIT_V
#undef PG8_WAIT_L
#undef PG8_BAR
#undef PG8_SCHED
}
}

struct Args { const float* in[33]; float* out; unsigned char* ws; int ph_lo, ph_hi; };
enum { I_XP = 0, I_XS, I_PP, I_PS, I_RELB, I_NMIX, I_WIN, I_AQN, I_AKN, I_ALQ1, I_ALK1, I_ALQ2, I_ALK2, I_AON, I_BCQN, I_BCKVN, I_BWUQ, I_BWUKV, I_BQN, I_BKN,
       I_CQN, I_CKN, I_DQN, I_DKN, I_WG, I_WB, I_WO, I_NFFN, I_W1, I_W2, I_NPLE, I_WPG, I_WPP };

__device__ __forceinline__ int rel_bucket(int rel) {
    const int n = rel < 0 ? -rel : rel;
    const float nf = (float)(n > 1 ? n : 1);
    int large = 8 + (int)(logf(nf / 8.0f) / 4.852030263919617f * 8.0f);
    large = large < 15 ? large : 15;
    return (rel > 0 ? 16 : 0) + (n < 8 ? n : large);
}
__device__ __forceinline__ void build_tables(const float* relb, float* tabA, float* tabD, int gtid, int gthreads) {
    for (int i = gtid; i < 4 * TABA_N; i += gthreads) { const int h = i / TABA_N, d = i % TABA_N - TABA_OFF; tabA[i] = relb[rel_bucket(d) * 16 + h] * LOG2E; }
    for (int i = gtid; i < 12 * TABD_N; i += gthreads) { const int gh = i / TABD_N, d = i % TABD_N - TABD_OFF; const int g = gh >> 2; const int dil = g == 0 ? 1 : (g == 1 ? 4 : 16);
        const int ad = d < 0 ? -d : d; const bool ok = (ad % dil == 0) && (ad <= 64 * dil);
        tabD[i] = ok ? relb[rel_bucket(d) * 16 + 4 + gh] * LOG2E : -1e30f; }
}
__device__ __forceinline__ void transpose_item(const float* W, int N, int k0, int n0, bf16_t* dst, int K, LAS float* scr, int lane, int gate_b = -1, const float* gsc = nullptr) {
    float wv[32];
#pragma unroll
    for (int i = 0; i < 32; ++i) { const int kk = 2 * i + (lane >> 5); wv[i] = W[(size_t)(k0 + kk) * N + n0 + (lane & 31)]; }
#pragma unroll
    for (int i = 0; i < 32; ++i) { const int kk = 2 * i + (lane >> 5); float w = wv[i]; if (gsc) w *= gsc[k0 + kk]; scr[kk * 33 + (lane & 31)] = w; }
    asm volatile("s_waitcnt lgkmcnt(0)" ::: "memory");
    const int c = lane & 7;
#pragma unroll
    for (int j = 0; j < 4; ++j) { const int n = (lane >> 3) + 8 * j; const LAS float* s = scr + (8 * c) * 33 + n;
        u32x4 o; o.x = cvt_pk_bf16(s[0 * 33], s[1 * 33]); o.y = cvt_pk_bf16(s[2 * 33], s[3 * 33]); o.z = cvt_pk_bf16(s[4 * 33], s[5 * 33]); o.w = cvt_pk_bf16(s[6 * 33], s[7 * 33]);
        size_t drow = (size_t)n;
        if (gate_b >= 0) { const int nn = n0 + n, j = nn & 63; drow = (size_t)((nn >> 6) * 256 + 128 * (gate_b >> 1) + 32 * (j >> 4) + 8 * ((j >> 2) & 3) + 4 * (gate_b & 1) + (j & 3)); }
        *(u32x4*)(dst + drow * K + k0 + 8 * c) = o; }
    asm volatile("s_waitcnt lgkmcnt(0)" ::: "memory");
}
__device__ __forceinline__ int win_row(int n0) {
    if (n0 < 512) return PC_AQ + n0;
    if (n0 < 1024) return PC_AK + (n0 - 512);
    if (n0 < 1536) return -(0 + (n0 - 1024) + 1);
    if (n0 < 2048) return PC_BCQ + (n0 - 1536);
    if (n0 < 2560) return PC_BCKV + (n0 - 2048);
    if (n0 < 2624) return PC_BKR + (n0 - 2560);
    if (n0 < 3136) return PC_CQ + (n0 - 2624);
    if (n0 < 3392) return PC_CK + (n0 - 3136);
    if (n0 < 3648) return -(512 + (n0 - 3392) + 1);
    if (n0 < 5184) return PC_DQ + (n0 - 3648);
    if (n0 < 5696) return PC_DK + (n0 - 5184);
    return -(768 + (n0 - 5696) + 1);
}
__device__ __forceinline__ void convert_weights(const Args& a, int layer, unsigned char* W, LAS float* scr, int gw, int ngw, int lane) {
    constexpr int I_IN = 32 * 194, I_G = 4 * 32 * 64, I_B = 4 * 8 * 64, I_O = 32 * 64, I_1 = 32 * 256, I_2 = 128 * 64, I_PG = 32 * 64, I_PPn = 4 * 64, I_UQ = 8 * 24, I_UKV = 8 * 32;
    constexpr int NIT = I_IN + I_G + I_B + I_O + I_1 + I_2 + I_PG + I_PPn + I_UQ + I_UKV;
    for (int it = gw; it < NIT; it += ngw) {
        int r = it;
        if (r < I_IN) { const int kb = r / 194, nb = r % 194; const int dr = win_row(nb * 32);
            bf16_t* dst = dr >= 0 ? (bf16_t*)(W + WO_IN) + (size_t)dr * 2048 : (bf16_t*)(W + WO_INV) + (size_t)(-dr - 1) * 2048;
            transpose_item(a.in[I_WIN] + (size_t)layer * 2048 * 6208, 6208, kb * 64, nb * 32, dst, 2048, scr, lane); continue; } r -= I_IN;
        if (r < I_G) { const int b = r / 2048, q = r % 2048, kb = q / 64, nb = q % 64;
            transpose_item(a.in[I_WG] + ((size_t)layer * 4 + b) * 2048 * 2048, 2048, kb * 64, nb * 32, (bf16_t*)(W + WO_G), 2048, scr, lane, b); continue; } r -= I_G;
        if (r < I_B) { const int b = r / 512, q = r % 512, kb = q / 64, nb = q % 64;
            transpose_item(a.in[I_WB] + ((size_t)layer * 4 + b) * 512 * 2048, 2048, kb * 64, nb * 32, (bf16_t*)(W + WO_B) + ((size_t)b * 2048 + nb * 32) * 512, 512, scr, lane); continue; } r -= I_B;
        if (r < I_O) { const int kb = r / 64, nb = r % 64;
            transpose_item(a.in[I_WO] + (size_t)layer * 2048 * 2048, 2048, kb * 64, nb * 32, (bf16_t*)(W + WO_O) + (size_t)(nb * 32) * 2048, 2048, scr, lane); continue; } r -= I_O;
        if (r < I_1) { const int kb = r / 256, nb = r % 256;
            transpose_item(a.in[I_W1] + (size_t)layer * 2048 * 8192, 8192, kb * 64, nb * 32, (bf16_t*)(W + WO_1) + (size_t)(nb * 32) * 2048, 2048, scr, lane, -1, a.in[I_NFFN] + layer * DM); continue; } r -= I_1;
        if (r < I_2) { const int kb = r / 64, nb = r % 64;
            transpose_item(a.in[I_W2] + (size_t)layer * 8192 * 2048, 2048, kb * 64, nb * 32, (bf16_t*)(W + WO_2) + (size_t)(nb * 32) * 8192, 8192, scr, lane); continue; } r -= I_2;
        if (r < I_PG) { const int kb = r / 64, nb = r % 64;
            transpose_item(a.in[I_WPG] + (size_t)layer * 2048 * 2048, 2048, kb * 64, nb * 32, (bf16_t*)(W + WO_PG) + (size_t)(nb * 32) * 2048, 2048, scr, lane, -1, a.in[I_NPLE] + layer * DM); continue; } r -= I_PG;
        if (r < I_PPn) { const int kb = r / 64, nb = r % 64;
            transpose_item(a.in[I_WPP] + (size_t)layer * 256 * 2048, 2048, kb * 64, nb * 32, (bf16_t*)(W + WO_PP) + (size_t)(nb * 32) * 256, 256, scr, lane); continue; } r -= I_PPn;
        if (r < I_UQ) { const int kb = r / 24, nb = r % 24;
            transpose_item(a.in[I_BWUQ] + (size_t)layer * 512 * 768, 768, kb * 64, nb * 32, (bf16_t*)(W + WO_UQ) + (size_t)(nb * 32) * 512, 512, scr, lane); continue; } r -= I_UQ;
        { const int kb = r / 32, nb = r % 32; const int n0 = nb * 32, h = n0 >> 8, j0 = n0 & 255;
            bf16_t* dst = j0 < 128 ? (bf16_t*)(W + WO_UKN) + (size_t)(h * 128 + j0) * 512 : (bf16_t*)(W + WO_UKV) + (size_t)(h * 128 + j0 - 128) * 512;
            transpose_item(a.in[I_BWUKV] + (size_t)layer * 512 * 1024, 1024, kb * 64, n0, dst, 512, scr, lane); }
    }
}

__device__ __forceinline__ void norm_row_bf(const bf16_t* x, const float* g, bf16_t* out, int lane) {
    f32x4 v[8]; float s = 0.f;
#pragma unroll
    for (int j = 0; j < 8; ++j) { const u32x2 u = *(const u32x2*)(x + 4 * lane + 256 * j); v[j][0] = bf_lo(u.x); v[j][1] = bf_hi(u.x); v[j][2] = bf_lo(u.y); v[j][3] = bf_hi(u.y);
        s += (v[j][0] * v[j][0] + v[j][1] * v[j][1]) + (v[j][2] * v[j][2] + v[j][3] * v[j][3]); }
    const float rs = 1.0f / sqrtf(wave_sum(s) * (1.0f / 2048.0f) + EPS);
#pragma unroll
    for (int j = 0; j < 8; ++j) { const f32x4 gg = *(const f32x4*)(g + 4 * lane + 256 * j);
        u32x2 w; w.x = cvt_pk_bf16(v[j][0] * rs * gg[0], v[j][1] * rs * gg[1]); w.y = cvt_pk_bf16(v[j][2] * rs * gg[2], v[j][3] * rs * gg[3]);
        *(u32x2*)(out + 4 * lane + 256 * j) = w; }
}
__device__ __forceinline__ void norm_row(const float* x, const float* g, bf16_t* out, int lane, bf16_t* xb) {
    f32x4 v[8]; float s = 0.f;
#pragma unroll
    for (int j = 0; j < 8; ++j) { v[j] = *(const f32x4*)(x + 4 * lane + 256 * j); s += (v[j][0] * v[j][0] + v[j][1] * v[j][1]) + (v[j][2] * v[j][2] + v[j][3] * v[j][3]);
        u32x2 w; w.x = cvt_pk_bf16(v[j][0], v[j][1]); w.y = cvt_pk_bf16(v[j][2], v[j][3]); *(u32x2*)(xb + 4 * lane + 256 * j) = w; }
    const float rs = 1.0f / sqrtf(wave_sum(s) * (1.0f / 2048.0f) + EPS);
#pragma unroll
    for (int j = 0; j < 8; ++j) { const f32x4 gg = *(const f32x4*)(g + 4 * lane + 256 * j);
        u32x2 w; w.x = cvt_pk_bf16(v[j][0] * rs * gg[0], v[j][1] * rs * gg[1]); w.y = cvt_pk_bf16(v[j][2] * rs * gg[2], v[j][3] * rs * gg[3]);
        *(u32x2*)(out + 4 * lane + 256 * j) = w; }
}
__device__ __forceinline__ void load8(const bf16_t* p, float (&f)[8]) { const u32x4 v = *(const u32x4*)p; f[0] = bf_lo(v.x); f[1] = bf_hi(v.x); f[2] = bf_lo(v.y); f[3] = bf_hi(v.y); f[4] = bf_lo(v.z); f[5] = bf_hi(v.z); f[6] = bf_lo(v.w); f[7] = bf_hi(v.w); }
__device__ __forceinline__ void store8(bf16_t* p, const float (&f)[8]) { u32x4 w; w.x = cvt_pk_bf16(f[0], f[1]); w.y = cvt_pk_bf16(f[2], f[3]); w.z = cvt_pk_bf16(f[4], f[5]); w.w = cvt_pk_bf16(f[6], f[7]); *(u32x4*)p = w; }
template <int GRP> __device__ __forceinline__ void norm8(float (&f)[8], const float* g, float scale, int lane) {
    float s = 0.f;
#pragma unroll
    for (int e = 0; e < 8; ++e) s += f[e] * f[e];
#pragma unroll
    for (int o = 1; o < GRP; o <<= 1) s += __shfl_xor(s, o);
    const float rs = scale / sqrtf(s * (1.0f / (GRP * 8)) + EPS);
    const int gi = (lane & (GRP - 1)) * 8;
#pragma unroll
    for (int e = 0; e < 8; ++e) f[e] = f[e] * rs * g[gi + e];
}
__device__ __forceinline__ float rope_inv(int i) { return __builtin_amdgcn_exp2f(-(float)i * (13.287712379549449f / 32.0f)) * 0.15915494309189535f; }
__device__ __forceinline__ void sincos_rev(float rev, float& sn, float& cs) { rev -= rintf(rev); sn = __builtin_amdgcn_sinf(rev); cs = __builtin_amdgcn_cosf(rev); }
__device__ __forceinline__ void axial_rope8(float (&f)[8], float rowpos, float colpos, int lane) {
    const int j = lane & 15, hf = j >> 3, jj = j & 7; const float pos = hf ? colpos : rowpos; const float sgn = jj < 4 ? -1.f : 1.f; const int i0 = 8 * (jj & 3);
#pragma unroll
    for (int e = 0; e < 8; ++e) { const float pv = __shfl_xor(f[e], 4); float sn, cs; sincos_rev(pos * rope_inv(i0 + e), sn, cs); f[e] = f[e] * cs + sgn * pv * sn; }
}
__device__ __forceinline__ void post1_row(const Args& a, int layer, bf16_t* P, int tseq, int lane) {
    float fq[8], fk[8], fcq[8], fckv[8], gq[8], gk[8], d0[8], d1[8], d2[8], dk[8];
    const int l2 = lane & 31;
    load8(P + PC_AQ + 8 * lane, fq); load8(P + PC_AK + 8 * lane, fk); load8(P + PC_BCQ + 8 * lane, fcq); load8(P + PC_BCKV + 8 * lane, fckv);
    load8(P + PC_CQ + 8 * lane, gq); load8(P + PC_CK + 8 * l2, gk);
    load8(P + PC_DQ + 8 * lane, d0); load8(P + PC_DQ + 512 + 8 * lane, d1); load8(P + PC_DQ + 1024 + 8 * lane, d2); load8(P + PC_DK + 8 * lane, dk);
    const float sA = 0.125f * LOG2E, sC = 0.08838834764831845f * LOG2E;
    const float rowpos = (float)(tseq >> 6), colpos = (float)(tseq & 63);
    norm8<8>(fq, a.in[I_AQN] + layer * 64, sA, lane); norm8<8>(fk, a.in[I_AKN] + layer * 64, 1.f, lane);
    norm8<64>(fcq, a.in[I_BCQN] + layer * 512, 1.f, lane); norm8<64>(fckv, a.in[I_BCKVN] + layer * 512, 1.f, lane);
    norm8<16>(gq, a.in[I_CQN] + layer * 128, sC, lane); axial_rope8(gq, rowpos, colpos, lane);
    norm8<16>(gk, a.in[I_CKN] + layer * 128, 1.f, lane); axial_rope8(gk, rowpos, colpos, lane);
    norm8<16>(d0, a.in[I_DQN] + layer * 128, sC, lane); norm8<16>(d1, a.in[I_DQN] + layer * 128, sC, lane); norm8<16>(d2, a.in[I_DQN] + layer * 128, sC, lane);
    norm8<16>(dk, a.in[I_DKN] + layer * 128, 1.f, lane);
    store8(P + PC_AQ + 8 * lane, fq); store8(P + PC_AK + 8 * lane, fk); store8(P + PC_BCQ + 8 * lane, fcq); store8(P + PC_BCKV + 8 * lane, fckv);
    store8(P + PC_CQ + 8 * lane, gq); if (lane < 32) store8(P + PC_CK + 8 * l2, gk);
    store8(P + PC_DQ + 8 * lane, d0); store8(P + PC_DQ + 512 + 8 * lane, d1); store8(P + PC_DQ + 1024 + 8 * lane, d2); store8(P + PC_DK + 8 * lane, dk);
}
__device__ __forceinline__ void mla_norm_rope(float (&f)[8], float (&r)[4], const float* g, float scale, float pos, int lane) {
    const int j = lane & 15;
    float s = 0.f;
#pragma unroll
    for (int e = 0; e < 8; ++e) s += f[e] * f[e];
#pragma unroll
    for (int e = 0; e < 4; ++e) s += r[e] * r[e];
#pragma unroll
    for (int o = 1; o < 16; o <<= 1) s += __shfl_xor(s, o);
    const float rs = scale / sqrtf(s * (1.0f / 192.0f) + EPS);
#pragma unroll
    for (int e = 0; e < 8; ++e) f[e] = f[e] * rs * g[8 * j + e];
#pragma unroll
    for (int e = 0; e < 4; ++e) r[e] = r[e] * rs * g[128 + 4 * j + e];
    const float sgn = j < 8 ? -1.f : 1.f; const int i0 = 4 * (j & 7);
#pragma unroll
    for (int e = 0; e < 4; ++e) { const float pv = __shfl_xor(r[e], 8); float sn, cs; sincos_rev(pos * rope_inv(i0 + e), sn, cs); r[e] = r[e] * cs + sgn * pv * sn; }
}
__device__ __forceinline__ void post2_row(const Args& a, int layer, bf16_t* Q, bf16_t* Kr, const bf16_t* P, int tseq, int lane) {
    const int h = lane >> 4, j = lane & 15; const float pos = (float)tseq;
    float f[8], r[4];
    float f2[8], r2[4];
    bf16_t* q = Q + h * 192; bf16_t* k = Kr + h * 192;
    load8(q + 8 * j, f); const u32x2 vq = *(const u32x2*)(q + 128 + 4 * j); load8(k + 8 * j, f2); const u32x2 vk = *(const u32x2*)(P + PC_BKR + 4 * j);
    r[0] = bf_lo(vq.x); r[1] = bf_hi(vq.x); r[2] = bf_lo(vq.y); r[3] = bf_hi(vq.y);
    r2[0] = bf_lo(vk.x); r2[1] = bf_hi(vk.x); r2[2] = bf_lo(vk.y); r2[3] = bf_hi(vk.y);
    mla_norm_rope(f, r, a.in[I_BQN] + layer * 192, 0.07216878364870323f * LOG2E, pos, lane);
    mla_norm_rope(f2, r2, a.in[I_BKN] + layer * 192, 1.f, pos, lane);
    store8(q + 8 * j, f); { u32x2 w; w.x = cvt_pk_bf16(r[0], r[1]); w.y = cvt_pk_bf16(r[2], r[3]); *(u32x2*)(q + 128 + 4 * j) = w; }
    store8(k + 8 * j, f2); { u32x2 w; w.x = cvt_pk_bf16(r2[0], r2[1]); w.y = cvt_pk_bf16(r2[2], r2[3]); *(u32x2*)(k + 128 + 4 * j) = w; }
}

struct AState { float m, l; f32x16 o[4]; };
__device__ __forceinline__ void astate_init(AState& st) { st.m = -3.0e38f; st.l = 0.f;
#pragma unroll
    for (int d = 0; d < 4; ++d)
#pragma unroll
        for (int r = 0; r < 16; ++r) st.o[d][r] = 0.f; }
template <int DK, bool TAB, bool QLDS = false>
__device__ __forceinline__ void attn_pass(AState& st, const bf16_t* qp, const bf16_t* kp, long ldk, const bf16_t* vp, long ldv, int kbeg, int kend, const float* tp, LAS bf16x8* qst = nullptr) {
    constexpr int NS = DK / 16;
    bf16x8 qf[QLDS ? 1 : NS], kf[NS];
    if (QLDS) {
#pragma unroll
        for (int s = 0; s < NS; ++s) qst[s * 64] = *(const bf16x8*)(qp + 16 * s);
    } else {
#pragma unroll
        for (int s = 0; s < NS; ++s) qf[s] = *(const bf16x8*)(qp + 16 * s);
    }
    { const bf16_t* k0p = kp + (long)kbeg * ldk;
#pragma unroll
      for (int s = 0; s < NS; ++s) kf[s] = *(const bf16x8*)(k0p + 16 * s); }
    for (int k0 = kbeg; k0 < kend; k0 += 32) {
        bf16x8 vf[4][2];
#pragma unroll
        for (int d = 0; d < 4; ++d)
#pragma unroll
            for (int s = 0; s < 2; ++s) vf[d][s] = *(const bf16x8*)(vp + (long)(32 * d) * ldv + k0 + 16 * s);
        f32x4 tb[4];
        if (TAB) {
#pragma unroll
            for (int s = 0; s < 2; ++s) { tb[2 * s] = *(const f32x4u*)(tp + k0 + 16 * s); tb[2 * s + 1] = *(const f32x4u*)(tp + k0 + 16 * s + 4); } }
        f32x16 sc;
#pragma unroll
        for (int r = 0; r < 16; ++r) sc[r] = 0.f;
#pragma unroll
        for (int s = 0; s < NS; ++s) sc = __builtin_amdgcn_mfma_f32_32x32x16_bf16(kf[s], QLDS ? qst[s * 64] : qf[QLDS ? 0 : s], sc, 0, 0, 0);
        if (k0 + 32 < kend) { const bf16_t* knp = kp + (long)(k0 + 32) * ldk;
#pragma unroll
            for (int s = 0; s < NS; ++s) kf[s] = *(const bf16x8*)(knp + 16 * s); }
        if (TAB) {
#pragma unroll
            for (int r = 0; r < 16; ++r) sc[r] += tb[r >> 2][r & 3]; }
        float mx = sc[0];
#pragma unroll
        for (int r = 1; r < 16; ++r) mx = fmaxf(mx, sc[r]);
        mx = fmaxf(mx, __shfl_xor(mx, 32));
        const float mn = fmaxf(st.m, mx);
        const float alpha = __builtin_amdgcn_exp2f(st.m - mn);
        st.m = mn;
        float ps = 0.f;
#pragma unroll
        for (int r = 0; r < 16; ++r) { sc[r] = __builtin_amdgcn_exp2f(sc[r] - mn); ps += sc[r]; }
        st.l = st.l * alpha + ps;
#pragma unroll
        for (int d = 0; d < 4; ++d)
#pragma unroll
            for (int r = 0; r < 16; ++r) st.o[d][r] *= alpha;
        u32x4 p0, p1;
        p0.x = cvt_pk_bf16(sc[0], sc[1]); p0.y = cvt_pk_bf16(sc[2], sc[3]); p0.z = cvt_pk_bf16(sc[4], sc[5]); p0.w = cvt_pk_bf16(sc[6], sc[7]);
        p1.x = cvt_pk_bf16(sc[8], sc[9]); p1.y = cvt_pk_bf16(sc[10], sc[11]); p1.z = cvt_pk_bf16(sc[12], sc[13]); p1.w = cvt_pk_bf16(sc[14], sc[15]);
        const bf16x8 pf0 = __builtin_bit_cast(bf16x8, p0), pf1 = __builtin_bit_cast(bf16x8, p1);
#pragma unroll
        for (int d = 0; d < 4; ++d) { st.o[d] = __builtin_amdgcn_mfma_f32_32x32x16_bf16(vf[d][0], pf0, st.o[d], 0, 0, 0); st.o[d] = __builtin_amdgcn_mfma_f32_32x32x16_bf16(vf[d][1], pf1, st.o[d], 0, 0, 0); }
    }
}
__device__ __forceinline__ void astate_finish(AState& st) {
    const float l = st.l + __shfl_xor(st.l, 32); const float inv = 1.0f / l;
#pragma unroll
    for (int d = 0; d < 4; ++d)
#pragma unroll
        for (int r = 0; r < 16; ++r) st.o[d][r] *= inv;
}
__device__ __forceinline__ void store_o(const f32x16 (&o)[4], bf16_t* op) {
#pragma unroll
    for (int d = 0; d < 4; ++d)
#pragma unroll
        for (int g = 0; g < 4; ++g) { u32x2 w; w.x = cvt_pk_bf16(o[d][4 * g], o[d][4 * g + 1]); w.y = cvt_pk_bf16(o[d][4 * g + 2], o[d][4 * g + 3]); *(u32x2*)(op + 32 * d + 8 * g) = w; }
}
__device__ __forceinline__ int pi32(int n) { return (n & ~12) | ((n & 4) << 1) | ((n & 8) >> 1); }

struct AttnBufs { const bf16_t* PROJ; const bf16_t* VT; const bf16_t* QB; const bf16_t* KB; const bf16_t* VTB; bf16_t* BR; const float* tabA; const float* tabD; };

__device__ __forceinline__ void attn_unit(const Args& a, const AttnBufs& B, int layer, int mixer, int head, int row0  , int S, int q0  , int lane, LAS float* stash) {
#define ATT_LANE_SETUP int ln_ = lane; asm volatile("" : "+v"(ln_)); const int n = ln_ & 31, hi = ln_ >> 5, pr = pi32(n); const long qrow = (long)row0 + q0 + n; bf16_t* op = B.BR + qrow * 2048 + 4 * hi;
#ifdef ONLY_MIXER
    mixer = ONLY_MIXER;
#endif
    if (mixer == 0) {
        ATT_LANE_SETUP
        const float lam_init = layer == 0 ? 0.2f : 0.35550906759f;
        const float d1 = wave_sum(a.in[I_ALQ1][layer * 64 + lane] * a.in[I_ALK1][layer * 64 + lane]);
        const float d2 = wave_sum(a.in[I_ALQ2][layer * 64 + lane] * a.in[I_ALK2][layer * 64 + lane]);
        const float lam = expf(d1) - expf(d2) + lam_init;
        const bf16_t* vp = B.VT + (long)(head * 128 + n) * TCM + row0 + 8 * hi;
        const float* tp = B.tabA + head * TABA_N + TABA_OFF - (q0 + n) + 8 * hi;
        { AState st; astate_init(st);
          attn_pass<64, true>(st, B.PROJ + qrow * NP + PC_AQ + head * 128 + 8 * hi, B.PROJ + (long)(row0 + pr) * NP + PC_AK + head * 128 + 8 * hi, NP, vp, TCM, 0, S, tp);
          astate_finish(st);
#pragma unroll
          for (int d = 0; d < 4; ++d)
#pragma unroll
              for (int r = 0; r < 16; ++r) stash[(d * 16 + r) * 64 + lane] = st.o[d][r]; }
        AState st; astate_init(st);
        attn_pass<64, true>(st, B.PROJ + qrow * NP + PC_AQ + head * 128 + 64 + 8 * hi, B.PROJ + (long)(row0 + pr) * NP + PC_AK + head * 128 + 64 + 8 * hi, NP, vp, TCM, 0, S, tp);
        astate_finish(st);
        float ss = 0.f;
#pragma unroll
        for (int d = 0; d < 4; ++d)
#pragma unroll
            for (int r = 0; r < 16; ++r) { const float v = stash[(d * 16 + r) * 64 + lane] - lam * st.o[d][r]; st.o[d][r] = v; ss += v * v; }
        ss += __shfl_xor(ss, 32);
        const float rs = (1.0f - lam_init) / sqrtf(ss * (1.0f / 128.0f) + EPS);
        const float* gn = a.in[I_AON] + layer * 128 + 4 * hi;
#pragma unroll
        for (int d = 0; d < 4; ++d)
#pragma unroll
            for (int g = 0; g < 4; ++g) { const f32x4 gg = *(const f32x4*)(gn + 32 * d + 8 * g);
#pragma unroll
                for (int e = 0; e < 4; ++e) st.o[d][4 * g + e] *= rs * gg[e]; }
        store_o(st.o, op + head * 128);
    } else if (mixer == 1) {
        ATT_LANE_SETUP
        AState st; astate_init(st);
        attn_pass<192, false, true>(st, B.QB + qrow * 768 + head * 192 + 8 * hi, B.KB + (long)(row0 + pr) * 768 + head * 192 + 8 * hi, 768,
                              B.VTB + (long)(head * 128 + n) * TCM + row0 + 8 * hi, TCM, 0, S, nullptr, (LAS bf16x8*)stash + lane);
        astate_finish(st); store_o(st.o, op + 512 + head * 128);
    } else if (mixer == 2) {
        ATT_LANE_SETUP
        const int kv = head >> 1;
        AState st; astate_init(st);
        attn_pass<128, false>(st, B.PROJ + qrow * NP + PC_CQ + head * 128 + 8 * hi, B.PROJ + (long)(row0 + pr) * NP + PC_CK + kv * 128 + 8 * hi, NP,
                              B.VT + (long)(512 + kv * 128 + n) * TCM + row0 + 8 * hi, TCM, 0, S, nullptr);
        astate_finish(st); store_o(st.o, op + 1024 + head * 128);
    } else {
        ATT_LANE_SETUP
        AState st; astate_init(st);
        const bf16_t* kp = B.PROJ + (long)(row0 + pr) * NP + PC_DK + head * 128 + 8 * hi;
        const bf16_t* vp = B.VT + (long)(768 + head * 128 + n) * TCM + row0 + 8 * hi;
#pragma unroll 1
        for (int g = 0; g < 3; ++g) { const int W = g == 0 ? 64 : (g == 1 ? 256 : 1024);
            const int kb = q0 - W > 0 ? q0 - W : 0, ke = q0 + 32 + W < S ? q0 + 32 + W : S;
            attn_pass<128, true>(st, B.PROJ + qrow * NP + PC_DQ + (g * 4 + head) * 128 + 8 * hi, kp, NP, vp, TCM, kb, ke, B.tabD + (g * 4 + head) * TABD_N + TABD_OFF - (q0 + n) + 8 * hi); }
        astate_finish(st); store_o(st.o, op + 1536 + head * 128);
    }
}
__device__ __forceinline__ void attn_phase(const Args& a, const AttnBufs& B, int layer, int chunk, unsigned* ctr, int lane, LAS float* stash) {
#if NCHUNK == 2
    const int npr = chunk == 0 ? 1 : 0, nsm = chunk == 0 ? 4 : 12, TC = chunk == 0 ? 16384 : 24576;
#else
    const int npr = chunk == 0 ? 1 : 0, nsm = chunk == 0 ? 0 : 4, TC = 8192;
#endif
    const int nP = npr * 1024, nS = nsm * 256, nD = TC / 8, total = 3 * nP + 3 * nS + nD;
    for (;;) {
        unsigned uu = 0; if (lane == 0) uu = atomicAdd(ctr, 1u);
        int u = __builtin_amdgcn_readfirstlane((int)uu);
        if (u >= total) break;
        int mixer, head, row0, S, q0;
        if (u < 3 * nP) { mixer = u / nP; const int r = u % nP; q0 = (r % 256) * 32; head = r / 256; row0 = 0; S = TP; }
        else { u -= 3 * nP;
            if (u < 3 * nS) { mixer = u / nS; const int r = u % nS; q0 = (r % 64) * 32; head = (r / 64) % 4; row0 = npr * TP + (r / 256) * SS; S = SS; }
            else { u -= 3 * nS; mixer = 3; const int qb = u % (TC / 32); head = u / (TC / 32); const int q = qb * 32;
                if (npr && q < TP) { row0 = 0; S = TP; } else { row0 = npr * TP + ((q - npr * TP) / SS) * SS; S = SS; }
                q0 = q - row0; } }
#ifdef ONLY_MIXER
        if (mixer != ONLY_MIXER) continue;
#endif
        attn_unit(a, B, layer, mixer, head, row0, S, q0, lane, stash);
    }
}


constexpr int A2_RSV = 144, A2_BUFSZ = 64 * 400 + 128 * A2_RSV;
static_assert(2 * A2_BUFSZ <= 131072 && 2 * A2_BUFSZ >= 65536, "attention LDS");

template <int NS, int RSK, bool USETAB>
__device__ __forceinline__ void a2_tile(AState& st, LAS unsigned char* bb, int kfo, int vfo, const bf16x8 (&qf)[NS], const float* tpk, float iv) {
#define A2_SB() __builtin_amdgcn_sched_barrier(0x0024)
#define A2_LDK0(s_) (*(const LAS bf16x8*)(bb + kfo + 32 * (s_)))
#define A2_LDK1(s_) (*(const LAS bf16x8*)(bb + kfo + 32 * RSK + 32 * (s_)))
#define A2_LDV0(i_) (*(const LAS bf16x8*)(bb + vfo + (32 * ((i_) & 3)) * A2_RSV + 32 * ((i_) >> 2)))
#define A2_LDV1(i_) (*(const LAS bf16x8*)(bb + vfo + (32 * ((i_) & 3)) * A2_RSV + 64 + 32 * ((i_) >> 2)))
    constexpr int PD = 3;
    f32x4 tb[8];
    if (USETAB) {
#pragma unroll
        for (int s = 0; s < 4; ++s) { tb[2 * s] = *(const f32x4u*)(tpk + 16 * s); tb[2 * s + 1] = *(const f32x4u*)(tpk + 16 * s + 4); } }
    f32x16 ini, sc0, sc1;
#pragma unroll
    for (int r = 0; r < 16; ++r) ini[r] = iv;
    u32x4 pw[4];
    float mx = -3.0e38f, ps = 0.f;
    bf16x8 ka[NS], kb[NS], va[8], vb[8];
#pragma unroll
    for (int s = 0; s < PD; ++s) ka[s] = A2_LDK0(s);
    A2_SB();
#pragma unroll
    for (int s = 0; s < NS; ++s) {
        if (s + PD < NS) ka[s + PD] = A2_LDK0(s + PD); else kb[s + PD - NS] = A2_LDK1(s + PD - NS);
        sc0 = __builtin_amdgcn_mfma_f32_32x32x16_bf16(ka[s], qf[s], s == 0 ? ini : sc0, 0, 0, 0);
        A2_SB(); }
#pragma unroll
    for (int s = 0; s < NS; ++s) {
        if (s + PD < NS) kb[s + PD] = A2_LDK1(s + PD); else va[s + PD - NS] = A2_LDV0(s + PD - NS);
        sc1 = __builtin_amdgcn_mfma_f32_32x32x16_bf16(kb[s], qf[s], s == 0 ? ini : sc1, 0, 0, 0);
        A2_SB();
#pragma unroll
        for (int pp = (8 * s) / NS; pp < (8 * (s + 1)) / NS; ++pp) {
            float x0 = sc0[2 * pp], x1 = sc0[2 * pp + 1];
            if (USETAB) { x0 += tb[(2 * pp) >> 2][(2 * pp) & 3]; x1 += tb[(2 * pp + 1) >> 2][(2 * pp + 1) & 3]; }
            mx = fmaxf(mx, fmaxf(x0, x1));
            const float e0 = __builtin_amdgcn_exp2f(x0), e1 = __builtin_amdgcn_exp2f(x1);
            ps += e0 + e1; pw[pp >> 2][pp & 3] = cvt_pk_bf16(e0, e1); }
        A2_SB();
    }
    {
        const bf16x8 pf0 = __builtin_bit_cast(bf16x8, pw[0]), pf1 = __builtin_bit_cast(bf16x8, pw[1]);
#pragma unroll
        for (int i = 0; i < 8; ++i) { const int h = i >> 2, d = i & 3;
            if (i + PD < 8) va[i + PD] = A2_LDV0(i + PD); else vb[i + PD - 8] = A2_LDV1(i + PD - 8);
            st.o[d] = __builtin_amdgcn_mfma_f32_32x32x16_bf16(va[i], h ? pf1 : pf0, st.o[d], 0, 0, 0);
            A2_SB();
            { const int pp = i; float x0 = sc1[2 * pp], x1 = sc1[2 * pp + 1];
              if (USETAB) { x0 += tb[4 + ((2 * pp) >> 2)][(2 * pp) & 3]; x1 += tb[4 + ((2 * pp + 1) >> 2)][(2 * pp + 1) & 3]; }
              mx = fmaxf(mx, fmaxf(x0, x1));
              const float e0 = __builtin_amdgcn_exp2f(x0), e1 = __builtin_amdgcn_exp2f(x1);
              ps += e0 + e1; pw[2 + (pp >> 2)][pp & 3] = cvt_pk_bf16(e0, e1); }
            A2_SB(); }
    }
    {
        const bf16x8 pf2 = __builtin_bit_cast(bf16x8, pw[2]), pf3 = __builtin_bit_cast(bf16x8, pw[3]);
#pragma unroll
        for (int i = 0; i < 8; ++i) { const int h = i >> 2, d = i & 3;
            if (i + PD < 8) vb[i + PD] = A2_LDV1(i + PD);
            st.o[d] = __builtin_amdgcn_mfma_f32_32x32x16_bf16(vb[i], h ? pf3 : pf2, st.o[d], 0, 0, 0);
            A2_SB(); }
    }
    st.l += ps;
    mx = fmaxf(mx, __shfl_xor(mx, 32));
    if (__any(mx > 8.0f)) {
        const float dm = fmaxf(mx, 0.f); const float alpha = __builtin_amdgcn_exp2f(-dm); st.m += dm; st.l *= alpha;
#pragma unroll
        for (int d = 0; d < 4; ++d)
#pragma unroll
            for (int r = 0; r < 16; ++r) st.o[d][r] *= alpha;
    }
#undef A2_SB
#undef A2_LDK0
#undef A2_LDK1
#undef A2_LDV0
#undef A2_LDV1
}
template <int DKL, int DK, bool TAB, bool FARC = false>
__device__ __forceinline__ void attn2_pass(AState& st, LAS unsigned char* buf, const bf16_t* qp, int koff, const bf16_t* Kg, long ldk, const bf16_t* Vg, long ldv,
                                           int kbeg, int kend, const float* tp, int wlo, int whi, int tid_in, int lane, int qw = 0, float cneg = 0.f, float cpos = 0.f) {
    constexpr int NS = DK / 16, PR = DKL / 8, NKP = DKL / 64, RSK = DKL * 2 + 16, KBYTES = 64 * RSK;
    int tid = tid_in; asm volatile("" : "+v"(tid));
    const int n = lane & 31, hi = lane >> 5, pr = pi32(n);
    bf16x8 qf[NS];
#pragma unroll
    for (int s = 0; s < NS; ++s) qf[s] = *(const bf16x8*)(qp + 16 * s);
    u32x4 kreg[NKP], vreg[2];
    int krow[NKP], kc[NKP];
#pragma unroll
    for (int i = 0; i < NKP; ++i) { const int p = tid + 512 * i; krow[i] = p / PR; kc[i] = p % PR; }
#define A2_GLOAD(k0_) do { _Pragma("unroll") for (int i = 0; i < NKP; ++i) kreg[i] = *(const u32x4*)(Kg + (long)((k0_) + krow[i]) * ldk + 8 * kc[i]); \
        _Pragma("unroll") for (int i = 0; i < 2; ++i) { const int p = tid + 512 * i; vreg[i] = *(const u32x4*)(Vg + (long)(p >> 3) * ldv + (k0_) + 8 * (p & 7)); } } while (0)
#define A2_LSTORE(b_) do { _Pragma("unroll") for (int i = 0; i < NKP; ++i) *(LAS u32x4*)(buf + (b_) * A2_BUFSZ + krow[i] * RSK + kc[i] * 16) = kreg[i]; \
        _Pragma("unroll") for (int i = 0; i < 2; ++i) { const int p = tid + 512 * i; *(LAS u32x4*)(buf + (b_) * A2_BUFSZ + KBYTES + (p >> 3) * A2_RSV + (p & 7) * 16) = vreg[i]; } } while (0)
    A2_GLOAD(kbeg); A2_LSTORE(0); __syncthreads();
    int b = 0;
    const int kfo = pr * RSK + koff + hi * 16, vfo = KBYTES + n * A2_RSV + hi * 16;
    if (st.m < -1.0e38f) {
        f32x16 sc;
#pragma unroll
        for (int r = 0; r < 16; ++r) sc[r] = 0.f;
#pragma unroll
        for (int s = 0; s < NS; ++s) { const bf16x8 kf0 = *(const LAS bf16x8*)(buf + kfo + 32 * s); sc = __builtin_amdgcn_mfma_f32_32x32x16_bf16(kf0, qf[s], sc, 0, 0, 0); }
        float mx = sc[0];
#pragma unroll
        for (int r = 1; r < 16; ++r) mx = fmaxf(mx, sc[r]);
        mx = fmaxf(mx, __shfl_xor(mx, 32));
        st.m = fmaxf(mx, -60.0f);
    }
    for (int k0 = kbeg; k0 < kend; k0 += 64) {
        const bool more = k0 + 64 < kend;
        if (more) A2_GLOAD(k0 + 64);
        LAS unsigned char* bb = buf + b * A2_BUFSZ;
        if (!(k0 + 64 <= wlo || k0 >= whi)) {
            float iv = -st.m; bool usetab = TAB;
            if (FARC) { if (k0 + 63 - qw <= -576) { iv += cneg; usetab = false; } else if (k0 - qw - 31 >= 576) { iv += cpos; usetab = false; } }
            if (TAB && usetab) a2_tile<NS, RSK, true>(st, bb, kfo, vfo, qf, tp + k0, iv);
            else a2_tile<NS, RSK, false>(st, bb, kfo, vfo, qf, tp, iv);
        }
        if (more) A2_LSTORE(b ^ 1);
        __syncthreads();
        b ^= 1;
    }
#undef A2_GLOAD
#undef A2_LSTORE
}

__device__ __forceinline__ void attn2_unit(const Args& a, const AttnBufs& B, int layer, int mixer, int head, int row0, int S, int q0, int tid, int lane, int wave, LAS unsigned char* buf) {
#ifdef ONLY_MIXER2
    mixer = ONLY_MIXER2;
#endif
    if (mixer == 0) {
        int ln_ = lane; asm volatile("" : "+v"(ln_)); const int n = ln_ & 31, hi = ln_ >> 5;
        const int half = wave >> 2, qw = q0 + 32 * (wave & 3); const long qrow = (long)row0 + qw + n;
        const float lam_init = layer == 0 ? 0.2f : 0.35550906759f;
        AState st; astate_init(st);
        attn2_pass<128, 64, true, true>(st, buf, B.PROJ + qrow * NP + PC_AQ + head * 128 + 64 * half + 8 * hi, 128 * half, B.PROJ + (long)row0 * NP + PC_AK + head * 128, NP,
                                  B.VT + (long)(head * 128) * TCM + row0, TCM, 0, S, B.tabA + head * TABA_N + TABA_OFF - (qw + n) + 8 * hi, 0, S, tid, ln_,
                                  qw, B.tabA[head * TABA_N + TABA_OFF - 700], B.tabA[head * TABA_N + TABA_OFF + 700]);
        astate_finish(st);
        LAS float* xb = (LAS float*)buf + (wave & 3) * 4096;
        if (half == 1) {
#pragma unroll
            for (int d = 0; d < 4; ++d)
#pragma unroll
                for (int r = 0; r < 16; ++r) xb[(d * 16 + r) * 64 + ln_] = st.o[d][r]; }
        __syncthreads();
        if (half == 0) {
            const float d1 = wave_sum(a.in[I_ALQ1][layer * 64 + ln_] * a.in[I_ALK1][layer * 64 + ln_]);
            const float d2 = wave_sum(a.in[I_ALQ2][layer * 64 + ln_] * a.in[I_ALK2][layer * 64 + ln_]);
            const float lam = expf(d1) - expf(d2) + lam_init;
            float ss = 0.f;
#pragma unroll
            for (int d = 0; d < 4; ++d)
#pragma unroll
                for (int r = 0; r < 16; ++r) { const float v = st.o[d][r] - lam * xb[(d * 16 + r) * 64 + ln_]; st.o[d][r] = v; ss += v * v; }
            ss += __shfl_xor(ss, 32);
            const float rs = (1.0f - lam_init) / sqrtf(ss * (1.0f / 128.0f) + EPS);
            const float* gn = a.in[I_AON] + layer * 128 + 4 * hi;
#pragma unroll
            for (int d = 0; d < 4; ++d)
#pragma unroll
                for (int g = 0; g < 4; ++g) { const f32x4 gg = *(const f32x4*)(gn + 32 * d + 8 * g);
#pragma unroll
                    for (int e = 0; e < 4; ++e) st.o[d][4 * g + e] *= rs * gg[e]; }
            store_o(st.o, B.BR + qrow * 2048 + 4 * hi + head * 128);
        }
    } else if (mixer == 1) {
        int ln_ = lane; asm volatile("" : "+v"(ln_)); const int n = ln_ & 31, hi = ln_ >> 5;
        const int qw = q0 + 32 * wave; const long qrow = (long)row0 + qw + n;
        AState st; astate_init(st);
        attn2_pass<192, 192, false>(st, buf, B.QB + qrow * 768 + head * 192 + 8 * hi, 0, B.KB + (long)row0 * 768 + head * 192, 768,
                                    B.VTB + (long)(head * 128) * TCM + row0, TCM, 0, S, nullptr, 0, S, tid, ln_);
        astate_finish(st); store_o(st.o, B.BR + qrow * 2048 + 4 * hi + 512 + head * 128);
    } else if (mixer == 2) {
        int ln_ = lane; asm volatile("" : "+v"(ln_)); const int n = ln_ & 31, hi = ln_ >> 5;
        const int qw = q0 + 32 * wave; const long qrow = (long)row0 + qw + n; const int kv = head >> 1;
        AState st; astate_init(st);
        attn2_pass<128, 128, false>(st, buf, B.PROJ + qrow * NP + PC_CQ + head * 128 + 8 * hi, 0, B.PROJ + (long)row0 * NP + PC_CK + kv * 128, NP,
                                    B.VT + (long)(512 + kv * 128) * TCM + row0, TCM, 0, S, nullptr, 0, S, tid, ln_);
        astate_finish(st); store_o(st.o, B.BR + qrow * 2048 + 4 * hi + 1024 + head * 128);
    } else {
        int ln_ = lane; asm volatile("" : "+v"(ln_)); const int n = ln_ & 31, hi = ln_ >> 5;
        const int qw = q0 + 32 * wave; const long qrow = (long)row0 + qw + n;
        AState st; astate_init(st);
#pragma unroll 1
        for (int g = 0; g < 3; ++g) { const int W = g == 0 ? 64 : (g == 1 ? 256 : 1024);
            const int kb = q0 - W > 0 ? q0 - W : 0, ke = q0 + 256 + W < S ? q0 + 256 + W : S;
            attn2_pass<128, 128, true>(st, buf, B.PROJ + qrow * NP + PC_DQ + (g * 4 + head) * 128 + 8 * hi, 0, B.PROJ + (long)row0 * NP + PC_DK + head * 128, NP,
                                       B.VT + (long)(768 + head * 128) * TCM + row0, TCM, kb, ke, B.tabD + (g * 4 + head) * TABD_N + TABD_OFF - (qw + n) + 8 * hi, qw - W, qw + 32 + W, tid, ln_); }
        astate_finish(st); store_o(st.o, B.BR + qrow * 2048 + 4 * hi + 1536 + head * 128);
    }
}
__device__ __forceinline__ void attn2_phase(const Args& a, const AttnBufs& B, int layer, int chunk, unsigned* ctr, int tid, int lane, int wave, LAS unsigned char* lds) {
#if NCHUNK == 2
    const int npr = chunk == 0 ? 1 : 0, nsm = chunk == 0 ? 4 : 12, TC = chunk == 0 ? 16384 : 24576;
#else
    const int npr = chunk == 0 ? 1 : 0, nsm = chunk == 0 ? 0 : 4, TC = 8192;
#endif
    const int c0 = npr * 128, c1 = npr * 128, c2 = npr * 256, c3 = TC / 64, c4 = nsm * 32, c5 = nsm * 32, c6 = nsm * 64;
    const int total = c0 + c1 + c2 + c3 + c4 + c5 + c6;
    volatile LAS int* uw = (volatile LAS int*)(lds + 131072);
    for (;;) {
        __syncthreads();
        if (tid == 0) *uw = (int)atomicAdd(ctr, 1u);
        __syncthreads();
        int u = __builtin_amdgcn_readfirstlane(*uw);
        if (u >= total) break;
        int mixer, head, row0, S, q0;
        if (u < c0 + c1 + c2) { row0 = 0; S = TP;
            if (u < c0) { mixer = 1; q0 = (u % 32) * 256; head = u / 32; }
            else if (u < c0 + c1) { u -= c0; mixer = 2; q0 = (u % 32) * 256; head = u / 32; }
            else { u -= c0 + c1; mixer = 0; q0 = (u % 64) * 128; head = u / 64; }
        } else { u -= c0 + c1 + c2;
            if (u < c3) { mixer = 3; const int nb = TC / 256; const int q = (u % nb) * 256; head = u / nb;
                if (npr && q < TP) { row0 = 0; S = TP; } else { row0 = npr * TP + ((q - npr * TP) / SS) * SS; S = SS; }
                q0 = q - row0; }
            else { u -= c3; S = SS;
                if (u < c4) { mixer = 1; q0 = (u % 8) * 256; head = (u / 8) % 4; row0 = npr * TP + (u / 32) * SS; }
                else if (u < c4 + c5) { u -= c4; mixer = 2; q0 = (u % 8) * 256; head = (u / 8) % 4; row0 = npr * TP + (u / 32) * SS; }
                else { u -= c4 + c5; mixer = 0; q0 = (u % 16) * 128; head = (u / 16) % 4; row0 = npr * TP + (u / 64) * SS; } } }
        attn2_unit(a, B, layer, mixer, head, row0, S, q0, tid, lane, wave, lds);
    }
}


#define XB_TMO      128
#define XB_XCNT(j)  (256  + 64 * (j))
#define XB_XSUB(j)  (1280 + 64 * (j))
#define XB_XGEN(j)  (2304 + 64 * (j))
#define XB_TOP      3328
#define XB_TOPGEN   3392
#define XCD_BAR_WORDS 3456
#define XB_SPIN_CAP (1u << 22)
__device__ __forceinline__ unsigned xb_ld(unsigned* p)              { return __hip_atomic_load(p, __ATOMIC_RELAXED, __HIP_MEMORY_SCOPE_AGENT); }
__device__ __forceinline__ unsigned xb_add(unsigned* p, unsigned v) { return __hip_atomic_fetch_add(p, v, __ATOMIC_RELAXED, __HIP_MEMORY_SCOPE_AGENT); }
__device__ __forceinline__ unsigned xb_xcc_id() { return (unsigned)__builtin_amdgcn_s_getreg((3 << 11) | 20) & 0xFu; }
#define XB_SPIN(cond, bar) do { unsigned _sp = 0; while (cond) { __builtin_amdgcn_s_sleep(1); \
    if ((++_sp & 255u) == 0u) { if (xb_ld(&(bar)[XB_TMO])) break; if (_sp > XB_SPIN_CAP) { atomicAdd(&(bar)[XB_TMO], 1u); break; } } } } while (0)
struct XcdBarrier { unsigned* bar; unsigned x; volatile LAS unsigned* st; };
__device__ __forceinline__ XcdBarrier xcd_barrier_post(unsigned* bar, volatile LAS unsigned* st) {
    XcdBarrier b; b.bar = bar; b.x = xb_xcc_id(); b.st = st;
    if (threadIdx.x == 0) st[2] = xb_add(&bar[XB_XCNT(b.x)], 1u);
    return b;
}
__device__ __forceinline__ void xcd_barrier_complete(unsigned* bar, unsigned x, unsigned& nloc, unsigned& nx) {
    const unsigned G = gridDim.x * gridDim.y * gridDim.z;
    unsigned sum, cnt, mine, sp = 0u;
    for (;;) {
        sum = 0u; cnt = 0u; mine = 0u;
#pragma unroll
        for (unsigned j = 0; j < 16; ++j) { const unsigned c = xb_ld(&bar[XB_XCNT(j)]); sum += c; cnt += (c > 0u) ? 1u : 0u; mine = (j == x) ? c : mine; }
        if (sum == G) break;
        __builtin_amdgcn_s_sleep(1);
        if ((++sp & 255u) == 0u) { if (xb_ld(&bar[XB_TMO])) break; if (sp > XB_SPIN_CAP) { atomicAdd(&bar[XB_TMO], 1u); break; } }
    }
    nloc = mine > 0u ? mine : 1u; nx = cnt > 0u ? cnt : 1u;
}
__device__ __forceinline__ void xcd_barrier(const XcdBarrier& b, bool local = false) {
    asm volatile("s_waitcnt vmcnt(0)" ::: "memory");
    __syncthreads();
    if (threadIdx.x == 0) {
        unsigned* bar = b.bar;
        __builtin_amdgcn_s_waitcnt(0);
        unsigned nloc = b.st[0], nx = b.st[1];
        if (nloc == 0u) { xcd_barrier_complete(bar, b.x, nloc, nx); b.st[0] = nloc; b.st[1] = nx; }
        const unsigned old = xb_add(&bar[XB_XSUB(b.x)], 1u);
        const unsigned gen = old / nloc;
        if (old + 1u == (gen + 1u) * nloc) {
            if (!local) {
            __builtin_amdgcn_fence(__ATOMIC_RELEASE, "agent");
            asm volatile("s_waitcnt vmcnt(0)" ::: "memory");
            const unsigned og = xb_add(&bar[XB_TOP], 1u);
            const unsigned tg = og / nx;
            if (og + 1u == (tg + 1u) * nx) xb_add(&bar[XB_TOPGEN], 1u);
            else XB_SPIN(xb_ld(&bar[XB_TOPGEN]) == tg, bar);
            }
            __builtin_amdgcn_fence(__ATOMIC_ACQUIRE, "agent");
            xb_add(&bar[XB_XGEN(b.x)], 1u);
            asm volatile("s_waitcnt vmcnt(0)" ::: "memory");
        } else {
            XB_SPIN(xb_ld(&bar[XB_XGEN(b.x)]) == gen, bar);
            __builtin_amdgcn_fence(__ATOMIC_ACQUIRE, "agent");
            asm volatile("s_waitcnt vmcnt(0)" ::: "memory");
        }
    }
    __syncthreads();
}

__global__ void __launch_bounds__(512, 2) mega(Args a) {
    extern __shared__ __attribute__((aligned(16))) unsigned char lds_raw[];
    LAS unsigned char* lds = (LAS unsigned char*)lds_raw;
    const int G = gridDim.x, bx = blockIdx.x;
    unsigned char* ws = a.ws;
    unsigned* ctl = (unsigned*)(ws + WS_CTL);
    float* tabA = (float*)(ws + WS_TABA); float* tabD = (float*)(ws + WS_TABD);
    unsigned char* W = ws + WS_W;
    bf16_t* H = (bf16_t*)(ws + WS_H);
    bf16_t* PROJ = (bf16_t*)(ws + WS_R1 + R1_PROJ); bf16_t* VT = (bf16_t*)(ws + WS_R1 + R1_VT); bf16_t* QB = (bf16_t*)(ws + WS_R1 + R1_QB);
    bf16_t* KB = (bf16_t*)(ws + WS_R1 + R1_KB); bf16_t* VTB = (bf16_t*)(ws + WS_R1 + R1_VTB);
    bf16_t* Y = (bf16_t*)(ws + WS_R1); bf16_t* FFH = (bf16_t*)(ws + WS_R1);
    bf16_t* BR = (bf16_t*)(ws + WS_R2); float* PART = (float*)(ws + WS_R2); bf16_t* U = (bf16_t*)(ws + WS_R2);
    bf16_t* MERGED = (bf16_t*)(ws + WS_R2); bf16_t* P16 = (bf16_t*)(ws + WS_R2 + 100 * MiB); bf16_t* XB = (bf16_t*)(ws + WS_XB);
    float* ssA = (float*)(ws + WS_SSP); float* ssB = ssA + (size_t)TCM * 32;
    cg::grid_group grid = cg::this_grid();
    volatile LAS unsigned* bst = (volatile LAS unsigned*)(lds + 131072 + 64);
    if (threadIdx.x < 6) bst[threadIdx.x] = threadIdx.x == 3 ? (unsigned)bx : 0u;
    __syncthreads();
    XcdBarrier xbar = xcd_barrier_post(ctl + 1024, bst);

    for (int pid = a.ph_lo; pid < a.ph_hi; ++pid) {
        int tid = threadIdx.x; asm volatile("" : "+v"(tid));
        const int lane = tid & 63, wave = __builtin_amdgcn_readfirstlane(tid >> 6);
        const int gw = bx * 8 + wave, ngw = G * 8;
        const int layer = pid / (1 + 12 * NCHUNK), q = pid % (1 + 12 * NCHUNK);
        bool locseam = false;
        if (q == 0) {
            if (layer == 0) build_tables(a.in[I_RELB], tabA, tabD, bx * 512 + tid, G * 512);
#ifndef NO_CONV
            convert_weights(a, layer, W, (LAS float*)(lds + wave * 16384), gw, ngw, lane);
#endif
        } else {
            const int chunk = (q - 1) / 12, kidx = (q - 1) % 12; const int k = kidx < 9 ? kidx + 1 : (kidx == 9 ? 11 : (kidx == 10 ? 12 : 15));
#if NCHUNK == 2
            const int m0 = chunk == 0 ? 0 : 16384, TC = chunk == 0 ? 16384 : 24576, nMt = TC / 256;
#else
            const int m0 = chunk * 8192, TC = 8192, nMt = TC / 256;
#endif
#ifdef NO_ROWS
            if (0) {
#else
            if (k == 1) {
#endif
                const float* g = a.in[I_NMIX] + layer * DM;
                for (int r = gw; r < TC; r += ngw) { const int m = m0 + r;
                    if (layer == 0) norm_row(xrow_ptr(a.in[I_XP], a.in[I_XS], m), g, H + (size_t)r * DM, lane, XB + (size_t)m * DM);
                    else norm_row_bf(XB + (size_t)m * DM, g, H + (size_t)r * DM, lane);
                    const float* pr = m < TP ? a.in[I_PP] + ((size_t)layer * TP + m) * 256 : a.in[I_PS] + ((size_t)layer * 32768 + (m - TP)) * 256;
                    const f32x4 v = *(const f32x4*)(pr + 4 * lane); u32x2 w; w.x = cvt_pk_bf16(v[0], v[1]); w.y = cvt_pk_bf16(v[2], v[3]); *(u32x2*)(P16 + (size_t)r * 256 + 4 * lane) = w;
                }
#ifdef NO_ROWS
            } else if (0) {
#else
            } else if (k == 3 || k == 5) {
#endif
                for (int r = gw; r < TC; r += ngw) { const int m = m0 + r; const int tseq = m < TP ? m : (m - TP) % SS;
                    if (k == 3) post1_row(a, layer, PROJ + (size_t)r * NP, tseq, lane);
                    else post2_row(a, layer, QB + (size_t)r * 768, KB + (size_t)r * 768, PROJ + (size_t)r * NP, tseq, lane); }
            } else if (k == 6) {
                AttnBufs B{PROJ, VT, QB, KB, VTB, BR, tabA, tabD};
#ifndef NO_ATTN
                #if ATTN_V2
                attn2_phase(a, B, layer, chunk, ctl + 64 * (layer * NCHUNK + chunk), tid, lane, wave, lds);
#else
                attn_phase(a, B, layer, chunk, ctl + 64 * (layer * NCHUNK + chunk), lane, (LAS float*)(lds + wave * 16384));
#endif
#endif
            } else {
                const int njobs = (k == 2 || k == 11) ? 2 : (k == 4 ? 3 : 1);
                locseam = (k >= 7 && k != 15);
                int coff = 0;
                for (int j = 0; j < njobs; ++j) {
                    pg8::Gemm g; pg8::Epi E; int nM = nMt, nN = 8, rep = 1, adiv = 1 << 30; long astep = 0;
                    E.kind = pg8::EK_BF16; E.O = nullptr; E.ldc = 0; E.Y = nullptr; E.xin = nullptr; E.xob = nullptr; E.xof = nullptr; E.ssq = nullptr; E.rsq = nullptr;
                    bf16_t* XBc = XB + (size_t)m0 * DM;
                    g.A = H; g.Bt = (const bf16_t*)(W + WO_IN); g.lda = 2048; g.ldb = 2048; g.K = 2048;
                    if (k == 2 && j == 0) { nN = NP / 256; E.O = PROJ; E.ldc = NP; }
                    else if (k == 2) { g.A = (const bf16_t*)(W + WO_INV); g.Bt = H; nM = NVT / 256; nN = nMt; E.O = VT; E.ldc = TCM; }
                    else if (k == 4 && j == 0) { g.A = PROJ + PC_BCQ; g.lda = NP; g.Bt = (const bf16_t*)(W + WO_UQ); g.ldb = 512; g.K = 512; nN = 3; E.O = QB; E.ldc = 768; }
                    else if (k == 4 && j == 1) { g.A = PROJ + PC_BCKV; g.lda = NP; g.Bt = (const bf16_t*)(W + WO_UKN); g.ldb = 512; g.K = 512; nN = 2; E.kind = pg8::EK_SPLIT192; E.O = KB; E.ldc = 768; }
                    else if (k == 4) { g.A = (const bf16_t*)(W + WO_UKV); g.lda = 512; g.Bt = PROJ + PC_BCKV; g.ldb = NP; g.K = 512; nM = 2; nN = nMt; E.O = VTB; E.ldc = TCM; }
                    else if (k == 7) { g.A = BR; g.Bt = (const bf16_t*)(W + WO_B); g.ldb = 512; g.K = 512; nN = 32; adiv = 8; astep = 1024; E.O = Y; E.ldc = 8192; }
                    else if (k == 8) { g.Bt = (const bf16_t*)(W + WO_G); nN = 32; E.kind = pg8::EK_GATE; E.O = MERGED; E.Y = Y; }
                    else if (k == 9) { g.A = MERGED; g.Bt = (const bf16_t*)(W + WO_O); E.kind = pg8::EK_RES; E.xin = XBc; E.xob = XBc; E.ssq = ssA; }
                    else if (k == 11 && j == 0) { g.A = XBc; g.Bt = (const bf16_t*)(W + WO_1); nN = 32; E.kind = pg8::EK_RELU2; E.O = FFH; E.ldc = 8192; E.rsq = ssA; }
                    else if (k == 11) { g.A = P16; g.lda = 256; g.Bt = (const bf16_t*)(W + WO_PP); g.ldb = 256; g.K = 256; E.O = U; E.ldc = 2048; }
                    else if (k == 12) { g.A = FFH; g.lda = 8192; g.Bt = (const bf16_t*)(W + WO_2); g.ldb = 8192; g.K = 8192; E.kind = pg8::EK_RES; E.xin = XBc; E.xob = H; E.ssq = ssB; }
                    else { g.Bt = (const bf16_t*)(W + WO_PG); E.kind = pg8::EK_PLE; E.Y = U; E.xin = H; E.rsq = ssB; if (layer == 1) E.xof = a.out + (size_t)m0 * DM; else E.xob = XBc; }
                    const int vbx = __builtin_amdgcn_readfirstlane((int)bst[3]);
                    pg8::Order S; S.init(nM, nN, G, (vbx + G - coff) % G, rep, adiv, astep, 0);
#ifndef NO_GEMM
                    pg8::gemm_phase<true>(lds, g, S, E, tid);
#endif
                    coff = (coff + (nM * nN) % G) % G;
                }
            }
        }
        if (pid + 1 < a.ph_hi) {
            if (pid == a.ph_lo) {
                if (a.ph_lo < 0) grid.sync();
                xcd_barrier(xbar);
                if (threadIdx.x == 0) { bool ok = (G % 8 == 0);
                    for (unsigned j = 0; j < 16; ++j) { const unsigned cnt = xb_ld(&xbar.bar[XB_XCNT(j)]); if (cnt != (j < 8 ? (unsigned)G / 8u : 0u)) ok = false; }
                    bst[3] = ok ? (bst[2] * 8u + xbar.x) : (unsigned)bx; bst[4] = ok ? 1u : 0u; }
                __syncthreads();
            } else {
                xcd_barrier(xbar, locseam && bst[4] != 0u); } }
    }
}

extern "C" void kernel_launch(void* const* d_in, const int* in_sizes, int n_in, void* d_out, int out_size, void* d_ws, size_t ws_size, hipStream_t stream) {
    static int grid = 0;
    if (grid == 0) {
        if (n_in != 33 || out_size != TALL * DM || ws_size < WS_END) { fprintf(stderr, "kernel_launch: unexpected shapes (n_in %d out %d ws %zu need %zu)\n", n_in, out_size, ws_size, (size_t)WS_END); grid = -1; return; }
        int dev = 0, cus = 0, per_cu = 0;
        hipGetDevice(&dev); hipDeviceGetAttribute(&cus, hipDeviceAttributeMultiprocessorCount, dev);
        if (hipFuncSetAttribute((const void*)mega, hipFuncAttributeMaxDynamicSharedMemorySize, LDS_BYTES) != hipSuccess) { fprintf(stderr, "kernel_launch: hipFuncSetAttribute failed\n"); grid = -1; return; }
        if (hipOccupancyMaxActiveBlocksPerMultiprocessor(&per_cu, (const void*)mega, 512, LDS_BYTES) != hipSuccess || per_cu < 1) per_cu = 1;
        (void)hipGetLastError();
        grid = cus * per_cu;
        if (grid <= 0) grid = 256;
    }
    if (grid < 0) return;
    hipMemsetAsync((char*)d_ws + WS_CTL, 0, 32768, stream);
    Args a{};
    for (int i = 0; i < 33; ++i) a.in[i] = (const float*)d_in[i];
    a.out = (float*)d_out; a.ws = (unsigned char*)d_ws;
    constexpr int NPH = 2 * (1 + 12 * NCHUNK);
#if COOP
    a.ph_lo = 0; a.ph_hi = NPH;
    void* args[] = {&a};
    hipError_t e = hipLaunchCooperativeKernel((const void*)mega, dim3(grid), dim3(512), args, LDS_BYTES, stream);
    if (e != hipSuccess) fprintf(stderr, "cooperative launch failed: %s (grid %d)\n", hipGetErrorString(e), grid);
#else
    for (int p = 0; p < NPH; ++p) { a.ph_lo = p; a.ph_hi = p + 1; hipLaunchKernelGGL(mega, dim3(grid), dim3(512), LDS_BYTES, stream, a); }
#endif
}
```

```cpp
#include <hip/hip_runtime.h>
#include <hip/hip_cooperative_groups.h>
#include <cstdio>
#include <cstdint>
namespace cg = cooperative_groups;

#ifndef COOP
#define COOP 1
#endif
#ifndef ATTN_V2
#define ATTN_V2 1
#endif
#ifndef NCHUNK
#define NCHUNK 2
#endif

#define LAS __attribute__((address_space(3)))
typedef unsigned short bf16_t;
typedef short bf16x8 __attribute__((ext_vector_type(8)));
typedef float f32x4 __attribute__((ext_vector_type(4)));
typedef float f32x16 __attribute__((ext_vector_type(16)));
typedef unsigned u32x4 __attribute__((ext_vector_type(4)));
typedef unsigned u32x2 __attribute__((ext_vector_type(2)));
typedef float f32x4u __attribute__((ext_vector_type(4), aligned(4)));

constexpr int DM = 2048, TALL = 40960, TP = 8192, SS = 2048;
constexpr int NP = 5120;
constexpr int TCM = 24576;
constexpr int NVT = 1280;
constexpr int DFF = 8192;
constexpr int PC_AQ = 0, PC_AK = 512, PC_BCQ = 1024, PC_BCKV = 1536, PC_CQ = 2048, PC_CK = 2560, PC_DQ = 2816, PC_DK = 4352, PC_BKR = 4864;
constexpr float LOG2E = 1.4426950408889634f;
constexpr float EPS = 1e-6f;
constexpr int TABA_N = 16384, TABA_OFF = 8192, TABD_N = 2304, TABD_OFF = 1152;

constexpr size_t MiB = 1u << 20;
constexpr size_t WS_CTL = 0;
constexpr size_t WS_TABA = 64 * 1024;
constexpr size_t WS_TABD = 384 * 1024;
constexpr size_t WS_SS = 512 * 1024;
constexpr size_t WS_W = 1 * MiB;
constexpr size_t WO_IN = 0;
constexpr size_t WO_INV = WO_IN + (size_t)NP * 2048 * 2;
constexpr size_t WO_G = WO_INV + (size_t)NVT * 2048 * 2;
constexpr size_t WO_B = WO_G + (size_t)8192 * 2048 * 2;
constexpr size_t WO_O = WO_B + (size_t)8192 * 512 * 2;
constexpr size_t WO_1 = WO_O + (size_t)2048 * 2048 * 2;
constexpr size_t WO_2 = WO_1 + (size_t)8192 * 2048 * 2;
constexpr size_t WO_PG = WO_2 + (size_t)2048 * 8192 * 2;
constexpr size_t WO_PP = WO_PG + (size_t)2048 * 2048 * 2;
constexpr size_t WO_UQ = WO_PP + (size_t)2048 * 256 * 2;
constexpr size_t WO_UKN = WO_UQ + (size_t)768 * 512 * 2;
constexpr size_t WO_UKV = WO_UKN + (size_t)512 * 512 * 2;
constexpr size_t WO_END = WO_UKV + (size_t)512 * 512 * 2;
static_assert(WO_END <= 148 * MiB, "weights");
constexpr size_t WS_H = WS_W + 148 * MiB;
constexpr size_t WS_R1 = WS_H + (size_t)TCM * 2048 * 2;
constexpr size_t R1_PROJ = 0;
constexpr size_t R1_VT = R1_PROJ + (size_t)TCM * NP * 2;
constexpr size_t R1_QB = R1_VT + (size_t)NVT * TCM * 2;
constexpr size_t R1_KB = R1_QB + (size_t)TCM * 768 * 2;
constexpr size_t R1_VTB = R1_KB + (size_t)TCM * 768 * 2;
constexpr size_t R1_END = R1_VTB + (size_t)512 * TCM * 2;
static_assert(R1_END >= (size_t)TCM * 8192 * 2, "Y / FFH overlay");
constexpr size_t WS_R2 = WS_R1 + R1_END;
constexpr size_t WS_XB = WS_R2 + (size_t)TCM * 2048 * 4;
constexpr size_t WS_SSP = WS_XB + (size_t)TALL * 2048 * 2;
constexpr size_t WS_END = WS_SSP + 2 * (size_t)TCM * 32 * 4;

constexpr int LDS_BYTES = 147456;

typedef float f32x2_t __attribute__((ext_vector_type(2))); typedef __bf16 bf16x2_t __attribute__((ext_vector_type(2)));
__device__ __forceinline__ unsigned cvt_pk_bf16(float lo, float hi) { f32x2_t v = {lo, hi}; bf16x2_t b = __builtin_convertvector(v, bf16x2_t); return __builtin_bit_cast(unsigned, b); }
__device__ __forceinline__ float bf_lo(unsigned u) { return __uint_as_float(u << 16); }
__device__ __forceinline__ float bf_hi(unsigned u) { return __uint_as_float(u & 0xffff0000u); }
__device__ __forceinline__ float wave_sum(float v) {
#pragma unroll
    for (int o = 1; o < 64; o <<= 1) v += __shfl_xor(v, o);
    return v;
}
__device__ __forceinline__ float sigmoidf_fast(float x) { return __builtin_amdgcn_rcpf(1.0f + __builtin_amdgcn_exp2f(-x * LOG2E)); }
__device__ __forceinline__ const float* xrow_ptr(const float* s0, const float* s1, int m) { return m < TP ? s0 + (size_t)m * DM : s1 + (size_t)(m - TP) * DM; }

namespace pg8 {
constexpr int BM = 256, BK = 64, HALF = 128, HTB = HALF * BK * 2, STAGE_BYTES = 8 * HTB, NXCD = 8, WGM = 4;
__host__ __device__ __forceinline__ int lds_byte(int r, int c) { const int st = (r >> 4) * 2 + (c >> 5), rr = r & 15, cc = c & 31, ob = rr * 64 + cc * 2; return st * 1024 + (ob ^ (((ob >> 9) & 1) << 5)); }
__host__ __device__ __forceinline__ void stage_rc(int b, int& R, int& C) { const int st = b / 1024, sb = b % 1024, swz = sb ^ (((sb >> 9) & 1) << 5); R = (st >> 1) * 16 + swz / 64; C = (st & 1) * 32 + (swz % 64) / 2; }
__host__ __device__ __forceinline__ int perm32(int rho) { const int n = rho >> 4, i = rho & 15; return 8 * (i >> 2) + 4 * n + (i & 3); }

struct Unit { int pm, pn; long aoff; };
struct Gemm { const bf16_t* A; const bf16_t* Bt; int lda, ldb, K; };

struct Order {
    int nM, nN, nwg, G, c, rep, adiv, swp; long astep;
    __device__ void init(int nM_, int nN_, int G_, int c_, int rep_, int adiv_, long astep_, int swp_ = 0) { nM = nM_; nN = nN_; nwg = nM * nN; G = G_; c = c_; rep = rep_; adiv = adiv_; astep = astep_; swp = swp_; }
    __device__ bool next(int i, Unit& u) const {
        const int t = i / rep, sub = i - t * rep;
        const long L = (long)t * G + c; if (L >= nwg) return false;
        int wgid = (int)L; { const int q = nwg / NXCD, r = nwg % NXCD, xcd = wgid % NXCD, off = wgid / NXCD; wgid = (xcd < r ? xcd * (q + 1) : r * (q + 1) + (xcd - r) * q) + off; }
        const int nig = WGM * nN, gid = wgid / nig, fm = gid * WGM, gsz = (nM - fm) < WGM ? (nM - fm) : WGM;
        u.pm = fm + ((wgid % nig) % gsz); const int pn = (wgid % nig) / gsz; u.pn = pn + sub * nN; u.aoff = (long)(pn / adiv) * astep;
        if (swp) { const int t2 = u.pm; u.pm = u.pn; u.pn = t2; }
        return true;
    }
};

__device__ __forceinline__ float row_rs(const float* p, int fq) {
    const f32x4 v0 = *(const f32x4*)(p + 8 * fq), v1 = *(const f32x4*)(p + 8 * fq + 4);
    float t = ((v0[0] + v0[1]) + (v0[2] + v0[3])) + ((v1[0] + v1[1]) + (v1[2] + v1[3]));
    t += __shfl_xor(t, 16); t += __shfl_xor(t, 32);
    return 1.0f / sqrtf(t * (1.0f / 2048.0f) + EPS);
}
enum { EK_BF16 = 0, EK_SPLIT192 = 1, EK_RELU2 = 2, EK_GATE = 3, EK_RES = 4, EK_PLE = 5 };
struct Epi {
    static constexpr bool PERM = true;
    int kind; bf16_t* O; long ldc; const bf16_t* Y;
    const bf16_t* xin; bf16_t* xob; float* xof; float* ssq; const float* rsq;
    __device__ __forceinline__ void operator()(const f32x4 (&acc)[2][2][4][2], const Unit& u, int wr, int wc, int fr, int fq) const {
        const int row0 = u.pm * BM + wr * 64 + fr, col0 = u.pn * BM + wc * 32 + 8 * fq;
        if (kind <= EK_RELU2) {
            float rsv[2][4];
#pragma unroll
            for (int ai = 0; ai < 2; ++ai)
#pragma unroll
                for (int m = 0; m < 4; ++m) rsv[ai][m] = (kind == EK_RELU2) ? row_rs(rsq + (size_t)(row0 + ai * HALF + m * 16) * 32, fq) : 1.f;
#pragma unroll
            for (int ai = 0; ai < 2; ++ai)
#pragma unroll
                for (int m = 0; m < 4; ++m) { const int row = row0 + ai * HALF + m * 16; const float rs = rsv[ai][m];
#pragma unroll
                    for (int bj = 0; bj < 2; ++bj) { int col = col0 + bj * HALF; f32x4 v0 = acc[ai][bj][m][0], v1 = acc[ai][bj][m][1];
                        if (kind == EK_RELU2) {
#pragma unroll
                            for (int e = 0; e < 4; ++e) { float a = fmaxf(v0[e], 0.f) * rs, b = fmaxf(v1[e], 0.f) * rs; v0[e] = a * a; v1[e] = b * b; } }
                        if (kind == EK_SPLIT192) col = (col >> 7) * 192 + (col & 127);
                        u32x4 w; w.x = cvt_pk_bf16(v0[0], v0[1]); w.y = cvt_pk_bf16(v0[2], v0[3]); w.z = cvt_pk_bf16(v1[0], v1[1]); w.w = cvt_pk_bf16(v1[2], v1[3]);
                        *(u32x4*)(O + (size_t)row * ldc + col) = w; } }
        } else if (kind == EK_GATE) {
            const int oc = u.pn * 64 + wc * 16 + 4 * fq;
#pragma unroll
            for (int ai = 0; ai < 2; ++ai) {
                u32x2 yv[4][4];
#pragma unroll
                for (int m = 0; m < 4; ++m) { const bf16_t* yp = Y + (size_t)(row0 + ai * HALF + m * 16) * 8192 + oc;
#pragma unroll
                    for (int b = 0; b < 4; ++b) yv[m][b] = *(const u32x2*)(yp + b * 2048); }
#pragma unroll
                for (int m = 0; m < 4; ++m) { const int row = row0 + ai * HALF + m * 16;
                    f32x4 r = (f32x4){0.f, 0.f, 0.f, 0.f};
#pragma unroll
                    for (int b = 0; b < 4; ++b) { const u32x2 y = yv[m][b]; const f32x4 v = acc[ai][b >> 1][m][b & 1];
                        r[0] += sigmoidf_fast(v[0]) * bf_lo(y.x); r[1] += sigmoidf_fast(v[1]) * bf_hi(y.x); r[2] += sigmoidf_fast(v[2]) * bf_lo(y.y); r[3] += sigmoidf_fast(v[3]) * bf_hi(y.y); }
                    u32x2 w; w.x = cvt_pk_bf16(r[0], r[1]); w.y = cvt_pk_bf16(r[2], r[3]);
                    *(u32x2*)(O + (size_t)row * 2048 + oc) = w; }
            }
        } else if (kind == EK_RES) res_part<false, 4>(acc, u, wc, fq, row0, col0);
        else res_part<true, 2>(acc, u, wc, fq, row0, col0);
    }
    template <bool PLE, int MB>
    __device__ __forceinline__ void res_part(const f32x4 (&acc)[2][2][4][2], const Unit& u, int wc, int fq, int row0, int col0) const {
#pragma unroll
        for (int ai = 0; ai < 2; ++ai)
#pragma unroll
            for (int mb = 0; mb < 4; mb += MB) {
                u32x4 xv[MB][2], yv[MB][2]; float rsv[MB];
#pragma unroll
                for (int mm = 0; mm < MB; ++mm) { const int row = row0 + ai * HALF + (mb + mm) * 16;
                    rsv[mm] = PLE ? row_rs(rsq + (size_t)row * 32, fq) : 1.f;
#pragma unroll
                    for (int bj = 0; bj < 2; ++bj) { const int col = col0 + bj * HALF; xv[mm][bj] = *(const u32x4*)(xin + (size_t)row * DM + col);
                        if (PLE) yv[mm][bj] = *(const u32x4*)(Y + (size_t)row * 2048 + col); } }
#pragma unroll
                for (int mm = 0; mm < MB; ++mm) { const int m = mb + mm; const int row = row0 + ai * HALF + m * 16; const float rs = rsv[mm]; float sq = 0.f;
#pragma unroll
                    for (int bj = 0; bj < 2; ++bj) { const int col = col0 + bj * HALF; f32x4 v0 = acc[ai][bj][m][0], v1 = acc[ai][bj][m][1];
                        const u32x4 xb = xv[mm][bj];
                        if (PLE) { const u32x4 y = yv[mm][bj]; v0 = v0 * rs; v1 = v1 * rs;
                            v0[0] = sigmoidf_fast(v0[0]) * bf_lo(y.x); v0[1] = sigmoidf_fast(v0[1]) * bf_hi(y.x); v0[2] = sigmoidf_fast(v0[2]) * bf_lo(y.y); v0[3] = sigmoidf_fast(v0[3]) * bf_hi(y.y);
                            v1[0] = sigmoidf_fast(v1[0]) * bf_lo(y.z); v1[1] = sigmoidf_fast(v1[1]) * bf_hi(y.z); v1[2] = sigmoidf_fast(v1[2]) * bf_lo(y.w); v1[3] = sigmoidf_fast(v1[3]) * bf_hi(y.w); }
                        f32x4 n0, n1;
                        n0[0] = bf_lo(xb.x) + v0[0]; n0[1] = bf_hi(xb.x) + v0[1]; n0[2] = bf_lo(xb.y) + v0[2]; n0[3] = bf_hi(xb.y) + v0[3];
                        n1[0] = bf_lo(xb.z) + v1[0]; n1[1] = bf_hi(xb.z) + v1[1]; n1[2] = bf_lo(xb.w) + v1[2]; n1[3] = bf_hi(xb.w) + v1[3];
                        if (xof) { *(f32x4*)(xof + (size_t)row * DM + col) = n0; *(f32x4*)(xof + (size_t)row * DM + col + 4) = n1; }
                        else { u32x4 w; w.x = cvt_pk_bf16(n0[0], n0[1]); w.y = cvt_pk_bf16(n0[2], n0[3]); w.z = cvt_pk_bf16(n1[0], n1[1]); w.w = cvt_pk_bf16(n1[2], n1[3]);
                            *(u32x4*)(xob + (size_t)row * DM + col) = w; }
                        if (ssq) sq += (n0[0] * n0[0] + n0[1] * n0[1]) + (n0[2] * n0[2] + n0[3] * n0[3]) + (n1[0] * n1[0] + n1[1] * n1[1]) + (n1[2] * n1[2] + n1[3] * n1[3]); }
                    if (ssq) { sq += __shfl_xor(sq, 16); sq += __shfl_xor(sq, 32); if (fq == 0) ssq[(size_t)row * 32 + u.pn * 4 + wc] = sq; } }
            }
    }
};

template <bool ALIGN_EPI = true>
__device__ __forceinline__ void gemm_phase(LAS unsigned char* lds, const Gemm g, const Order& S, const Epi& E, const int tid) {
    const int wid = __builtin_amdgcn_readfirstlane(tid >> 6), lane = tid & 63, wr = wid >> 2, wc = wid & 3, fr = lane & 15, fq = lane >> 4;
    const int K = g.K, nt = K / BK;
    unsigned voffA[2], voffB[2];
#pragma unroll
    for (int i = 0; i < 2; ++i) { int R, C; stage_rc(tid * 16 + i * 8192, R, C); const int Rb = Epi::PERM ? ((R & ~31) + perm32(R & 31)) : R;
        voffA[i] = (unsigned)(R * g.lda + C) * 2u; voffB[i] = (unsigned)(Rb * g.ldb + C) * 2u; }
    const size_t kstep = (size_t)(BK * 2);
    const size_t hstA = (size_t)HALF * g.lda * 2, hstB = (size_t)HALF * g.ldb * 2;
    const size_t tstA = 2 * hstA, tstB = 2 * hstB;
    const unsigned ldsw = (unsigned)wid * 1024u;
    const int aoff = lds_byte(wr * 64 + fr, fq * 8), boff = lds_byte(wc * 32 + fr, fq * 8);
#define PG8_SA(b, h) (((b) * 2 + (h)) * HTB)
#define PG8_SB(b, h) ((4 + (b) * 2 + (h)) * HTB)
#define PG8_STAGE(bufoff, gbase, voff) do { _Pragma("unroll") for (int _i = 0; _i < 2; ++_i) \
        __builtin_amdgcn_global_load_lds((const unsigned*)((const char*)(gbase) + (voff)[_i]), (LAS unsigned*)(lds + (bufoff) + ldsw + _i * 8192), 16, 0, 0); } while (0)
#define PG8_LDA(dst, b, h) do { _Pragma("unroll") for (int m = 0; m < 4; ++m) _Pragma("unroll") for (int k = 0; k < 2; ++k) dst[m][k] = *(const LAS bf16x8*)(lds + PG8_SA(b, h) + aoff + m * 2048 + k * 1024); } while (0)
#define PG8_LDB(dst, b, h) do { _Pragma("unroll") for (int n = 0; n < 2; ++n) _Pragma("unroll") for (int k = 0; k < 2; ++k) dst[n][k] = *(const LAS bf16x8*)(lds + PG8_SB(b, h) + boff + n * 2048 + k * 1024); } while (0)
#define PG8_MMA(ai, bj, At, Bt) do { __builtin_amdgcn_s_setprio(1); _Pragma("unroll") for (int m = 0; m < 4; ++m) _Pragma("unroll") for (int n = 0; n < 2; ++n) _Pragma("unroll") for (int k = 0; k < 2; ++k) \
        acc[ai][bj][m][n] = __builtin_amdgcn_mfma_f32_16x16x32_bf16(Bt[n][k], At[m][k], acc[ai][bj][m][n], 0, 0, 0); __builtin_amdgcn_s_setprio(0); } while (0)
#define PG8_WAIT_V(n) asm volatile("s_waitcnt vmcnt(" #n ")" ::: "memory")
#define PG8_WAIT_L(n) asm volatile("s_waitcnt lgkmcnt(" #n ")" ::: "memory")
#define PG8_BAR __builtin_amdgcn_s_barrier()
#define PG8_SCHED __builtin_amdgcn_sched_barrier(0)
    Unit cur, nxt; int ui = 0;
    if (!S.next(0, cur)) return;
    f32x4 acc[2][2][4][2];
#pragma unroll
    for (int a = 0; a < 2; ++a)
#pragma unroll
        for (int b = 0; b < 2; ++b)
#pragma unroll
            for (int m = 0; m < 4; ++m)
#pragma unroll
                for (int n = 0; n < 2; ++n) acc[a][b][m][n] = (f32x4){0.f, 0.f, 0.f, 0.f};
    bf16x8 At[4][2], B0[2][2], B1[2][2];
    const char* cA = (const char*)g.A + (size_t)cur.pm * tstA + cur.aoff; const char* cB = (const char*)g.Bt + (size_t)cur.pn * tstB;
    PG8_STAGE(PG8_SB(0, 0), cB, voffB); PG8_STAGE(PG8_SB(0, 1), cB + hstB, voffB); PG8_STAGE(PG8_SA(0, 0), cA, voffA); PG8_STAGE(PG8_SA(0, 1), cA + hstA, voffA);
    if (wr == 1) PG8_BAR;
    PG8_WAIT_V(2); PG8_BAR;
    PG8_STAGE(PG8_SB(1, 0), cB + kstep, voffB); PG8_STAGE(PG8_SA(1, 0), cA + kstep, voffA); PG8_STAGE(PG8_SB(1, 1), cB + hstB + kstep, voffB);
    PG8_WAIT_V(6); PG8_BAR;
    for (;;) {
        const bool has_next = S.next(ui + 1, nxt);
        const char* nA = has_next ? (const char*)g.A + (size_t)nxt.pm * tstA + nxt.aoff : cA; const char* nB = has_next ? (const char*)g.Bt + (size_t)nxt.pn * tstB : cB;
        for (int t = 0; t < nt; t += 2) {
            const bool last = (t == nt - 2);
            const char* a1 = cA + (size_t)(t + 1) * kstep;
            const char* a2 = last ? nA : cA + (size_t)(t + 2) * kstep; const char* b2 = last ? nB : cB + (size_t)(t + 2) * kstep;
            const char* a3 = a2 + kstep; const char* b3 = b2 + kstep;
            PG8_LDB(B0, 0, 0); PG8_LDB(B1, 0, 1); PG8_SCHED; PG8_LDA(At, 0, 0); PG8_STAGE(PG8_SA(1, 1), a1 + hstA, voffA);
            PG8_WAIT_V(8); PG8_WAIT_L(0); PG8_BAR; PG8_MMA(0, 0, At, B0); PG8_MMA(0, 1, At, B1); PG8_BAR; PG8_SCHED;
            PG8_LDA(At, 0, 1); PG8_STAGE(PG8_SB(0, 0), b2, voffB); PG8_STAGE(PG8_SB(0, 1), b2 + hstB, voffB); PG8_STAGE(PG8_SA(0, 0), a2, voffA);
            PG8_WAIT_V(8); PG8_WAIT_L(0); PG8_BAR; PG8_MMA(1, 0, At, B0); PG8_MMA(1, 1, At, B1); PG8_BAR; PG8_SCHED;
            PG8_LDB(B0, 1, 0); PG8_LDB(B1, 1, 1); PG8_SCHED; PG8_LDA(At, 1, 0); PG8_STAGE(PG8_SA(0, 1), a2 + hstA, voffA);
            PG8_WAIT_V(8); PG8_WAIT_L(0); PG8_BAR; PG8_MMA(0, 0, At, B0); PG8_MMA(0, 1, At, B1); PG8_BAR; PG8_SCHED;
            PG8_LDA(At, 1, 1); PG8_STAGE(PG8_SB(1, 0), b3, voffB); PG8_STAGE(PG8_SB(1, 1), b3 + hstB, voffB); PG8_STAGE(PG8_SA(1, 0), a3, voffA);
            PG8_WAIT_V(8); PG8_WAIT_L(0); PG8_BAR; PG8_MMA(1, 0, At, B0); PG8_MMA(1, 1, At, B1); PG8_BAR; PG8_SCHED;
        }
        if constexpr (ALIGN_EPI) { if (wr == 0) PG8_BAR; }
        E(acc, cur, wr, wc, fr, fq);
        if (!has_next) break;
#pragma unroll
        for (int a = 0; a < 2; ++a)
#pragma unroll
            for (int b = 0; b < 2; ++b)
#pragma unroll
                for (int m = 0; m < 4; ++m)
#pragma unroll
                    for (int n = 0; n < 2; ++n) acc[a][b][m][n] = (f32x4){0.f, 0.f, 0.f, 0.f};
        cur = nxt; cA = nA; cB = nB; ++ui;
        if constexpr (ALIGN_EPI) { if (wr == 1) PG8_BAR; }
    }
    PG8_WAIT_V(0);
    if constexpr (!ALIGN_EPI) { if (wr == 0) PG8_BAR; }
    PG8_BAR;
#undef PG8_SA
#undef PG8_SB
#undef PG8_STAGE
#undef PG8_LDA
#undef PG8_LDB
#undef PG8_MMA
#undef PG8_WAIT_V
#undef PG8_WAIT_L
#undef PG8_BAR
#undef PG8_SCHED
}
}

struct Args { const float* in[33]; float* out; unsigned char* ws; int ph_lo, ph_hi; };
enum { I_XP = 0, I_XS, I_PP, I_PS, I_RELB, I_NMIX, I_WIN, I_AQN, I_AKN, I_ALQ1, I_ALK1, I_ALQ2, I_ALK2, I_AON, I_BCQN, I_BCKVN, I_BWUQ, I_BWUKV, I_BQN, I_BKN,
       I_CQN, I_CKN, I_DQN, I_DKN, I_WG, I_WB, I_WO, I_NFFN, I_W1, I_W2, I_NPLE, I_WPG, I_WPP };

__device__ __forceinline__ int rel_bucket(int rel) {
    const int n = rel < 0 ? -rel : rel;
    const float nf = (float)(n > 1 ? n : 1);
    int large = 8 + (int)(logf(nf / 8.0f) / 4.852030263919617f * 8.0f);
    large = large < 15 ? large : 15;
    return (rel > 0 ? 16 : 0) + (n < 8 ? n : large);
}
__device__ __forceinline__ void build_tables(const float* relb, float* tabA, float* tabD, int gtid, int gthreads) {
    for (int i = gtid; i < 4 * TABA_N; i += gthreads) { const int h = i / TABA_N, d = i % TABA_N - TABA_OFF; tabA[i] = relb[rel_bucket(d) * 16 + h] * LOG2E; }
    for (int i = gtid; i < 12 * TABD_N; i += gthreads) { const int gh = i / TABD_N, d = i % TABD_N - TABD_OFF; const int g = gh >> 2; const int dil = g == 0 ? 1 : (g == 1 ? 4 : 16);
        const int ad = d < 0 ? -d : d; const bool ok = (ad % dil == 0) && (ad <= 64 * dil);
        tabD[i] = ok ? relb[rel_bucket(d) * 16 + 4 + gh] * LOG2E : -1e30f; }
}
__device__ __forceinline__ void transpose_item(const float* W, int N, int k0, int n0, bf16_t* dst, int K, LAS float* scr, int lane, int gate_b = -1, const float* gsc = nullptr) {
    float wv[32];
#pragma unroll
    for (int i = 0; i < 32; ++i) { const int kk = 2 * i + (lane >> 5); wv[i] = W[(size_t)(k0 + kk) * N + n0 + (lane & 31)]; }
#pragma unroll
    for (int i = 0; i < 32; ++i) { const int kk = 2 * i + (lane >> 5); float w = wv[i]; if (gsc) w *= gsc[k0 + kk]; scr[kk * 33 + (lane & 31)] = w; }
    asm volatile("s_waitcnt lgkmcnt(0)" ::: "memory");
    const int c = lane & 7;
#pragma unroll
    for (int j = 0; j < 4; ++j) { const int n = (lane >> 3) + 8 * j; const LAS float* s = scr + (8 * c) * 33 + n;
        u32x4 o; o.x = cvt_pk_bf16(s[0 * 33], s[1 * 33]); o.y = cvt_pk_bf16(s[2 * 33], s[3 * 33]); o.z = cvt_pk_bf16(s[4 * 33], s[5 * 33]); o.w = cvt_pk_bf16(s[6 * 33], s[7 * 33]);
        size_t drow = (size_t)n;
        if (gate_b >= 0) { const int nn = n0 + n, j = nn & 63; drow = (size_t)((nn >> 6) * 256 + 128 * (gate_b >> 1) + 32 * (j >> 4) + 8 * ((j >> 2) & 3) + 4 * (gate_b & 1) + (j & 3)); }
        *(u32x4*)(dst + drow * K + k0 + 8 * c) = o; }
    asm volatile("s_waitcnt lgkmcnt(0)" ::: "memory");
}
__device__ __forceinline__ int win_row(int n0) {
    if (n0 < 512) return PC_AQ + n0;
    if (n0 < 1024) return PC_AK + (n0 - 512);
    if (n0 < 1536) return -(0 + (n0 - 1024) + 1);
    if (n0 < 2048) return PC_BCQ + (n0 - 1536);
    if (n0 < 2560) return PC_BCKV + (n0 - 2048);
    if (n0 < 2624) return PC_BKR + (n0 - 2560);
    if (n0 < 3136) return PC_CQ + (n0 - 2624);
    if (n0 < 3392) return PC_CK + (n0 - 3136);
    if (n0 < 3648) return -(512 + (n0 - 3392) + 1);
    if (n0 < 5184) return PC_DQ + (n0 - 3648);
    if (n0 < 5696) return PC_DK + (n0 - 5184);
    return -(768 + (n0 - 5696) + 1);
}
__device__ __forceinline__ void convert_weights(const Args& a, int layer, unsigned char* W, LAS float* scr, int gw, int ngw, int lane) {
    constexpr int I_IN = 32 * 194, I_G = 4 * 32 * 64, I_B = 4 * 8 * 64, I_O = 32 * 64, I_1 = 32 * 256, I_2 = 128 * 64, I_PG = 32 * 64, I_PPn = 4 * 64, I_UQ = 8 * 24, I_UKV = 8 * 32;
    constexpr int NIT = I_IN + I_G + I_B + I_O + I_1 + I_2 + I_PG + I_PPn + I_UQ + I_UKV;
    for (int it = gw; it < NIT; it += ngw) {
        int r = it;
        if (r < I_IN) { const int kb = r / 194, nb = r % 194; const int dr = win_row(nb * 32);
            bf16_t* dst = dr >= 0 ? (bf16_t*)(W + WO_IN) + (size_t)dr * 2048 : (bf16_t*)(W + WO_INV) + (size_t)(-dr - 1) * 2048;
            transpose_item(a.in[I_WIN] + (size_t)layer * 2048 * 6208, 6208, kb * 64, nb * 32, dst, 2048, scr, lane); continue; } r -= I_IN;
        if (r < I_G) { const int b = r / 2048, q = r % 2048, kb = q / 64, nb = q % 64;
            transpose_item(a.in[I_WG] + ((size_t)layer * 4 + b) * 2048 * 2048, 2048, kb * 64, nb * 32, (bf16_t*)(W + WO_G), 2048, scr, lane, b); continue; } r -= I_G;
        if (r < I_B) { const int b = r / 512, q = r % 512, kb = q / 64, nb = q % 64;
            transpose_item(a.in[I_WB] + ((size_t)layer * 4 + b) * 512 * 2048, 2048, kb * 64, nb * 32, (bf16_t*)(W + WO_B) + ((size_t)b * 2048 + nb * 32) * 512, 512, scr, lane); continue; } r -= I_B;
        if (r < I_O) { const int kb = r / 64, nb = r % 64;
            transpose_item(a.in[I_WO] + (size_t)layer * 2048 * 2048, 2048, kb * 64, nb * 32, (bf16_t*)(W + WO_O) + (size_t)(nb * 32) * 2048, 2048, scr, lane); continue; } r -= I_O;
        if (r < I_1) { const int kb = r / 256, nb = r % 256;
            transpose_item(a.in[I_W1] + (size_t)layer * 2048 * 8192, 8192, kb * 64, nb * 32, (bf16_t*)(W + WO_1) + (size_t)(nb * 32) * 2048, 2048, scr, lane, -1, a.in[I_NFFN] + layer * DM); continue; } r -= I_1;
        if (r < I_2) { const int kb = r / 64, nb = r % 64;
            transpose_item(a.in[I_W2] + (size_t)layer * 8192 * 2048, 2048, kb * 64, nb * 32, (bf16_t*)(W + WO_2) + (size_t)(nb * 32) * 8192, 8192, scr, lane); continue; } r -= I_2;
        if (r < I_PG) { const int kb = r / 64, nb = r % 64;
            transpose_item(a.in[I_WPG] + (size_t)layer * 2048 * 2048, 2048, kb * 64, nb * 32, (bf16_t*)(W + WO_PG) + (size_t)(nb * 32) * 2048, 2048, scr, lane, -1, a.in[I_NPLE] + layer * DM); continue; } r -= I_PG;
        if (r < I_PPn) { const int kb = r / 64, nb = r % 64;
            transpose_item(a.in[I_WPP] + (size_t)layer * 256 * 2048, 2048, kb * 64, nb * 32, (bf16_t*)(W + WO_PP) + (size_t)(nb * 32) * 256, 256, scr, lane); continue; } r -= I_PPn;
        if (r < I_UQ) { const int kb = r / 24, nb = r % 24;
            transpose_item(a.in[I_BWUQ] + (size_t)layer * 512 * 768, 768, kb * 64, nb * 32, (bf16_t*)(W + WO_UQ) + (size_t)(nb * 32) * 512, 512, scr, lane); continue; } r -= I_UQ;
        { const int kb = r / 32, nb = r % 32; const int n0 = nb * 32, h = n0 >> 8, j0 = n0 & 255;
            bf16_t* dst = j0 < 128 ? (bf16_t*)(W + WO_UKN) + (size_t)(h * 128 + j0) * 512 : (bf16_t*)(W + WO_UKV) + (size_t)(h * 128 + j0 - 128) * 512;
            transpose_item(a.in[I_BWUKV] + (size_t)layer * 512 * 1024, 1024, kb * 64, n0, dst, 512, scr, lane); }
    }
}

__device__ __forceinline__ void norm_row_bf(const bf16_t* x, const float* g, bf16_t* out, int lane) {
    f32x4 v[8]; float s = 0.f;
#pragma unroll
    for (int j = 0; j < 8; ++j) { const u32x2 u = *(const u32x2*)(x + 4 * lane + 256 * j); v[j][0] = bf_lo(u.x); v[j][1] = bf_hi(u.x); v[j][2] = bf_lo(u.y); v[j][3] = bf_hi(u.y);
        s += (v[j][0] * v[j][0] + v[j][1] * v[j][1]) + (v[j][2] * v[j][2] + v[j][3] * v[j][3]); }
    const float rs = 1.0f / sqrtf(wave_sum(s) * (1.0f / 2048.0f) + EPS);
#pragma unroll
    for (int j = 0; j < 8; ++j) { const f32x4 gg = *(const f32x4*)(g + 4 * lane + 256 * j);
        u32x2 w; w.x = cvt_pk_bf16(v[j][0] * rs * gg[0], v[j][1] * rs * gg[1]); w.y = cvt_pk_bf16(v[j][2] * rs * gg[2], v[j][3] * rs * gg[3]);
        *(u32x2*)(out + 4 * lane + 256 * j) = w; }
}
__device__ __forceinline__ void norm_row(const float* x, const float* g, bf16_t* out, int lane, bf16_t* xb) {
    f32x4 v[8]; float s = 0.f;
#pragma unroll
    for (int j = 0; j < 8; ++j) { v[j] = *(const f32x4*)(x + 4 * lane + 256 * j); s += (v[j][0] * v[j][0] + v[j][1] * v[j][1]) + (v[j][2] * v[j][2] + v[j][3] * v[j][3]);
        u32x2 w; w.x = cvt_pk_bf16(v[j][0], v[j][1]); w.y = cvt_pk_bf16(v[j][2], v[j][3]); *(u32x2*)(xb + 4 * lane + 256 * j) = w; }
    const float rs = 1.0f / sqrtf(wave_sum(s) * (1.0f / 2048.0f) + EPS);
#pragma unroll
    for (int j = 0; j < 8; ++j) { const f32x4 gg = *(const f32x4*)(g + 4 * lane + 256 * j);
        u32x2 w; w.x = cvt_pk_bf16(v[j][0] * rs * gg[0], v[j][1] * rs * gg[1]); w.y = cvt_pk_bf16(v[j][2] * rs * gg[2], v[j][3] * rs * gg[3]);
        *(u32x2*)(out + 4 * lane + 256 * j) = w; }
}
__device__ __forceinline__ void load8(const bf16_t* p, float (&f)[8]) { const u32x4 v = *(const u32x4*)p; f[0] = bf_lo(v.x); f[1] = bf_hi(v.x); f[2] = bf_lo(v.y); f[3] = bf_hi(v.y); f[4] = bf_lo(v.z); f[5] = bf_hi(v.z); f[6] = bf_lo(v.w); f[7] = bf_hi(v.w); }
__device__ __forceinline__ void store8(bf16_t* p, const float (&f)[8]) { u32x4 w; w.x = cvt_pk_bf16(f[0], f[1]); w.y = cvt_pk_bf16(f[2], f[3]); w.z = cvt_pk_bf16(f[4], f[5]); w.w = cvt_pk_bf16(f[6], f[7]); *(u32x4*)p = w; }
template <int GRP> __device__ __forceinline__ void norm8(float (&f)[8], const float* g, float scale, int lane) {
    float s = 0.f;
#pragma unroll
    for (int e = 0; e < 8; ++e) s += f[e] * f[e];
#pragma unroll
    for (int o = 1; o < GRP; o <<= 1) s += __shfl_xor(s, o);
    const float rs = scale / sqrtf(s * (1.0f / (GRP * 8)) + EPS);
    const int gi = (lane & (GRP - 1)) * 8;
#pragma unroll
    for (int e = 0; e < 8; ++e) f[e] = f[e] * rs * g[gi + e];
}
__device__ __forceinline__ float rope_inv(int i) { return __builtin_amdgcn_exp2f(-(float)i * (13.287712379549449f / 32.0f)) * 0.15915494309189535f; }
__device__ __forceinline__ void sincos_rev(float rev, float& sn, float& cs) { rev -= rintf(rev); sn = __builtin_amdgcn_sinf(rev); cs = __builtin_amdgcn_cosf(rev); }
__device__ __forceinline__ void axial_rope8(float (&f)[8], float rowpos, float colpos, int lane) {
    const int j = lane & 15, hf = j >> 3, jj = j & 7; const float pos = hf ? colpos : rowpos; const float sgn = jj < 4 ? -1.f : 1.f; const int i0 = 8 * (jj & 3);
#pragma unroll
    for (int e = 0; e < 8; ++e) { const float pv = __shfl_xor(f[e], 4); float sn, cs; sincos_rev(pos * rope_inv(i0 + e), sn, cs); f[e] = f[e] * cs + sgn * pv * sn; }
}
__device__ __forceinline__ void post1_row(const Args& a, int layer, bf16_t* P, int tseq, int lane) {
    float fq[8], fk[8], fcq[8], fckv[8], gq[8], gk[8], d0[8], d1[8], d2[8], dk[8];
    const int l2 = lane & 31;
    load8(P + PC_AQ + 8 * lane, fq); load8(P + PC_AK + 8 * lane, fk); load8(P + PC_BCQ + 8 * lane, fcq); load8(P + PC_BCKV + 8 * lane, fckv);
    load8(P + PC_CQ + 8 * lane, gq); load8(P + PC_CK + 8 * l2, gk);
    load8(P + PC_DQ + 8 * lane, d0); load8(P + PC_DQ + 512 + 8 * lane, d1); load8(P + PC_DQ + 1024 + 8 * lane, d2); load8(P + PC_DK + 8 * lane, dk);
    const float sA = 0.125f * LOG2E, sC = 0.08838834764831845f * LOG2E;
    const float rowpos = (float)(tseq >> 6), colpos = (float)(tseq & 63);
    norm8<8>(fq, a.in[I_AQN] + layer * 64, sA, lane); norm8<8>(fk, a.in[I_AKN] + layer * 64, 1.f, lane);
    norm8<64>(fcq, a.in[I_BCQN] + layer * 512, 1.f, lane); norm8<64>(fckv, a.in[I_BCKVN] + layer * 512, 1.f, lane);
    norm8<16>(gq, a.in[I_CQN] + layer * 128, sC, lane); axial_rope8(gq, rowpos, colpos, lane);
    norm8<16>(gk, a.in[I_CKN] + layer * 128, 1.f, lane); axial_rope8(gk, rowpos, colpos, lane);
    norm8<16>(d0, a.in[I_DQN] + layer * 128, sC, lane); norm8<16>(d1, a.in[I_DQN] + layer * 128, sC, lane); norm8<16>(d2, a.in[I_DQN] + layer * 128, sC, lane);
    norm8<16>(dk, a.in[I_DKN] + layer * 128, 1.f, lane);
    store8(P + PC_AQ + 8 * lane, fq); store8(P + PC_AK + 8 * lane, fk); store8(P + PC_BCQ + 8 * lane, fcq); store8(P + PC_BCKV + 8 * lane, fckv);
    store8(P + PC_CQ + 8 * lane, gq); if (lane < 32) store8(P + PC_CK + 8 * l2, gk);
    store8(P + PC_DQ + 8 * lane, d0); store8(P + PC_DQ + 512 + 8 * lane, d1); store8(P + PC_DQ + 1024 + 8 * lane, d2); store8(P + PC_DK + 8 * lane, dk);
}
__device__ __forceinline__ void mla_norm_rope(float (&f)[8], float (&r)[4], const float* g, float scale, float pos, int lane) {
    const int j = lane & 15;
    float s = 0.f;
#pragma unroll
    for (int e = 0; e < 8; ++e) s += f[e] * f[e];
#pragma unroll
    for (int e = 0; e < 4; ++e) s += r[e] * r[e];
#pragma unroll
    for (int o = 1; o < 16; o <<= 1) s += __shfl_xor(s, o);
    const float rs = scale / sqrtf(s * (1.0f / 192.0f) + EPS);
#pragma unroll
    for (int e = 0; e < 8; ++e) f[e] = f[e] * rs * g[8 * j + e];
#pragma unroll
    for (int e = 0; e < 4; ++e) r[e] = r[e] * rs * g[128 + 4 * j + e];
    const float sgn = j < 8 ? -1.f : 1.f; const int i0 = 4 * (j & 7);
#pragma unroll
    for (int e = 0; e < 4; ++e) { const float pv = __shfl_xor(r[e], 8); float sn, cs; sincos_rev(pos * rope_inv(i0 + e), sn, cs); r[e] = r[e] * cs + sgn * pv * sn; }
}
__device__ __forceinline__ void post2_row(const Args& a, int layer, bf16_t* Q, bf16_t* Kr, const bf16_t* P, int tseq, int lane) {
    const int h = lane >> 4, j = lane & 15; const float pos = (float)tseq;
    float f[8], r[4];
    float f2[8], r2[4];
    bf16_t* q = Q + h * 192; bf16_t* k = Kr + h * 192;
    load8(q + 8 * j, f); const u32x2 vq = *(const u32x2*)(q + 128 + 4 * j); load8(k + 8 * j, f2); const u32x2 vk = *(const u32x2*)(P + PC_BKR + 4 * j);
    r[0] = bf_lo(vq.x); r[1] = bf_hi(vq.x); r[2] = bf_lo(vq.y); r[3] = bf_hi(vq.y);
    r2[0] = bf_lo(vk.x); r2[1] = bf_hi(vk.x); r2[2] = bf_lo(vk.y); r2[3] = bf_hi(vk.y);
    mla_norm_rope(f, r, a.in[I_BQN] + layer * 192, 0.07216878364870323f * LOG2E, pos, lane);
    mla_norm_rope(f2, r2, a.in[I_BKN] + layer * 192, 1.f, pos, lane);
    store8(q + 8 * j, f); { u32x2 w; w.x = cvt_pk_bf16(r[0], r[1]); w.y = cvt_pk_bf16(r[2], r[3]); *(u32x2*)(q + 128 + 4 * j) = w; }
    store8(k + 8 * j, f2); { u32x2 w; w.x = cvt_pk_bf16(r2[0], r2[1]); w.y = cvt_pk_bf16(r2[2], r2[3]); *(u32x2*)(k + 128 + 4 * j) = w; }
}

struct AState { float m, l; f32x16 o[4]; };
__device__ __forceinline__ void astate_init(AState& st) { st.m = -3.0e38f; st.l = 0.f;
#pragma unroll
    for (int d = 0; d < 4; ++d)
#pragma unroll
        for (int r = 0; r < 16; ++r) st.o[d][r] = 0.f; }
template <int DK, bool TAB, bool QLDS = false>
__device__ __forceinline__ void attn_pass(AState& st, const bf16_t* qp, const bf16_t* kp, long ldk, const bf16_t* vp, long ldv, int kbeg, int kend, const float* tp, LAS bf16x8* qst = nullptr) {
    constexpr int NS = DK / 16;
    bf16x8 qf[QLDS ? 1 : NS], kf[NS];
    if (QLDS) {
#pragma unroll
        for (int s = 0; s < NS; ++s) qst[s * 64] = *(const bf16x8*)(qp + 16 * s);
    } else {
#pragma unroll
        for (int s = 0; s < NS; ++s) qf[s] = *(const bf16x8*)(qp + 16 * s);
    }
    { const bf16_t* k0p = kp + (long)kbeg * ldk;
#pragma unroll
      for (int s = 0; s < NS; ++s) kf[s] = *(const bf16x8*)(k0p + 16 * s); }
    for (int k0 = kbeg; k0 < kend; k0 += 32) {
        bf16x8 vf[4][2];
#pragma unroll
        for (int d = 0; d < 4; ++d)
#pragma unroll
            for (int s = 0; s < 2; ++s) vf[d][s] = *(const bf16x8*)(vp + (long)(32 * d) * ldv + k0 + 16 * s);
        f32x4 tb[4];
        if (TAB) {
#pragma unroll
            for (int s = 0; s < 2; ++s) { tb[2 * s] = *(const f32x4u*)(tp + k0 + 16 * s); tb[2 * s + 1] = *(const f32x4u*)(tp + k0 + 16 * s + 4); } }
        f32x16 sc;
#pragma unroll
        for (int r = 0; r < 16; ++r) sc[r] = 0.f;
#pragma unroll
        for (int s = 0; s < NS; ++s) sc = __builtin_amdgcn_mfma_f32_32x32x16_bf16(kf[s], QLDS ? qst[s * 64] : qf[QLDS ? 0 : s], sc, 0, 0, 0);
        if (k0 + 32 < kend) { const bf16_t* knp = kp + (long)(k0 + 32) * ldk;
#pragma unroll
            for (int s = 0; s < NS; ++s) kf[s] = *(const bf16x8*)(knp + 16 * s); }
        if (TAB) {
#pragma unroll
            for (int r = 0; r < 16; ++r) sc[r] += tb[r >> 2][r & 3]; }
        float mx = sc[0];
#pragma unroll
        for (int r = 1; r < 16; ++r) mx = fmaxf(mx, sc[r]);
        mx = fmaxf(mx, __shfl_xor(mx, 32));
        const float mn = fmaxf(st.m, mx);
        const float alpha = __builtin_amdgcn_exp2f(st.m - mn);
        st.m = mn;
        float ps = 0.f;
#pragma unroll
        for (int r = 0; r < 16; ++r) { sc[r] = __builtin_amdgcn_exp2f(sc[r] - mn); ps += sc[r]; }
        st.l = st.l * alpha + ps;
#pragma unroll
        for (int d = 0; d < 4; ++d)
#pragma unroll
            for (int r = 0; r < 16; ++r) st.o[d][r] *= alpha;
        u32x4 p0, p1;
        p0.x = cvt_pk_bf16(sc[0], sc[1]); p0.y = cvt_pk_bf16(sc[2], sc[3]); p0.z = cvt_pk_bf16(sc[4], sc[5]); p0.w = cvt_pk_bf16(sc[6], sc[7]);
        p1.x = cvt_pk_bf16(sc[8], sc[9]); p1.y = cvt_pk_bf16(sc[10], sc[11]); p1.z = cvt_pk_bf16(sc[12], sc[13]); p1.w = cvt_pk_bf16(sc[14], sc[15]);
        const bf16x8 pf0 = __builtin_bit_cast(bf16x8, p0), pf1 = __builtin_bit_cast(bf16x8, p1);
#pragma unroll
        for (int d = 0; d < 4; ++d) { st.o[d] = __builtin_amdgcn_mfma_f32_32x32x16_bf16(vf[d][0], pf0, st.o[d], 0, 0, 0); st.o[d] = __builtin_amdgcn_mfma_f32_32x32x16_bf16(vf[d][1], pf1, st.o[d], 0, 0, 0); }
    }
}
__device__ __forceinline__ void astate_finish(AState& st) {
    const float l = st.l + __shfl_xor(st.l, 32); const float inv = 1.0f / l;
#pragma unroll
    for (int d = 0; d < 4; ++d)
#pragma unroll
        for (int r = 0; r < 16; ++r) st.o[d][r] *= inv;
}
__device__ __forceinline__ void store_o(const f32x16 (&o)[4], bf16_t* op) {
#pragma unroll
    for (int d = 0; d < 4; ++d)
#pragma unroll
        for (int g = 0; g < 4; ++g) { u32x2 w; w.x = cvt_pk_bf16(o[d][4 * g], o[d][4 * g + 1]); w.y = cvt_pk_bf16(o[d][4 * g + 2], o[d][4 * g + 3]); *(u32x2*)(op + 32 * d + 8 * g) = w; }
}
__device__ __forceinline__ int pi32(int n) { return (n & ~12) | ((n & 4) << 1) | ((n & 8) >> 1); }

struct AttnBufs { const bf16_t* PROJ; const bf16_t* VT; const bf16_t* QB; const bf16_t* KB; const bf16_t* VTB; bf16_t* BR; const float* tabA; const float* tabD; };

__device__ __forceinline__ void attn_unit(const Args& a, const AttnBufs& B, int layer, int mixer, int head, int row0  , int S, int q0  , int lane, LAS float* stash) {
#define ATT_LANE_SETUP int ln_ = lane; asm volatile("" : "+v"(ln_)); const int n = ln_ & 31, hi = ln_ >> 5, pr = pi32(n); const long qrow = (long)row0 + q0 + n; bf16_t* op = B.BR + qrow * 2048 + 4 * hi;
#ifdef ONLY_MIXER
    mixer = ONLY_MIXER;
#endif
    if (mixer == 0) {
        ATT_LANE_SETUP
        const float lam_init = layer == 0 ? 0.2f : 0.35550906759f;
        const float d1 = wave_sum(a.in[I_ALQ1][layer * 64 + lane] * a.in[I_ALK1][layer * 64 + lane]);
        const float d2 = wave_sum(a.in[I_ALQ2][layer * 64 + lane] * a.in[I_ALK2][layer * 64 + lane]);
        const float lam = expf(d1) - expf(d2) + lam_init;
        const bf16_t* vp = B.VT + (long)(head * 128 + n) * TCM + row0 + 8 * hi;
        const float* tp = B.tabA + head * TABA_N + TABA_OFF - (q0 + n) + 8 * hi;
        { AState st; astate_init(st);
          attn_pass<64, true>(st, B.PROJ + qrow * NP + PC_AQ + head * 128 + 8 * hi, B.PROJ + (long)(row0 + pr) * NP + PC_AK + head * 128 + 8 * hi, NP, vp, TCM, 0, S, tp);
          astate_finish(st);
#pragma unroll
          for (int d = 0; d < 4; ++d)
#pragma unroll
              for (int r = 0; r < 16; ++r) stash[(d * 16 + r) * 64 + lane] = st.o[d][r]; }
        AState st; astate_init(st);
        attn_pass<64, true>(st, B.PROJ + qrow * NP + PC_AQ + head * 128 + 64 + 8 * hi, B.PROJ + (long)(row0 + pr) * NP + PC_AK + head * 128 + 64 + 8 * hi, NP, vp, TCM, 0, S, tp);
        astate_finish(st);
        float ss = 0.f;
#pragma unroll
        for (int d = 0; d < 4; ++d)
#pragma unroll
            for (int r = 0; r < 16; ++r) { const float v = stash[(d * 16 + r) * 64 + lane] - lam * st.o[d][r]; st.o[d][r] = v; ss += v * v; }
        ss += __shfl_xor(ss, 32);
        const float rs = (1.0f - lam_init) / sqrtf(ss * (1.0f / 128.0f) + EPS);
        const float* gn = a.in[I_AON] + layer * 128 + 4 * hi;
#pragma unroll
        for (int d = 0; d < 4; ++d)
#pragma unroll
            for (int g = 0; g < 4; ++g) { const f32x4 gg = *(const f32x4*)(gn + 32 * d + 8 * g);
#pragma unroll
                for (int e = 0; e < 4; ++e) st.o[d][4 * g + e] *= rs * gg[e]; }
        store_o(st.o, op + head * 128);
    } else if (mixer == 1) {
        ATT_LANE_SETUP
        AState st; astate_init(st);
        attn_pass<192, false, true>(st, B.QB + qrow * 768 + head * 192 + 8 * hi, B.KB + (long)(row0 + pr) * 768 + head * 192 + 8 * hi, 768,
                              B.VTB + (long)(head * 128 + n) * TCM + row0 + 8 * hi, TCM, 0, S, nullptr, (LAS bf16x8*)stash + lane);
        astate_finish(st); store_o(st.o, op + 512 + head * 128);
    } else if (mixer == 2) {
        ATT_LANE_SETUP
        const int kv = head >> 1;
        AState st; astate_init(st);
        attn_pass<128, false>(st, B.PROJ + qrow * NP + PC_CQ + head * 128 + 8 * hi, B.PROJ + (long)(row0 + pr) * NP + PC_CK + kv * 128 + 8 * hi, NP,
                              B.VT + (long)(512 + kv * 128 + n) * TCM + row0 + 8 * hi, TCM, 0, S, nullptr);
        astate_finish(st); store_o(st.o, op + 1024 + head * 128);
    } else {
        ATT_LANE_SETUP
        AState st; astate_init(st);
        const bf16_t* kp = B.PROJ + (long)(row0 + pr) * NP + PC_DK + head * 128 + 8 * hi;
        const bf16_t* vp = B.VT + (long)(768 + head * 128 + n) * TCM + row0 + 8 * hi;
#pragma unroll 1
        for (int g = 0; g < 3; ++g) { const int W = g == 0 ? 64 : (g == 1 ? 256 : 1024);
            const int kb = q0 - W > 0 ? q0 - W : 0, ke = q0 + 32 + W < S ? q0 + 32 + W : S;
            attn_pass<128, true>(st, B.PROJ + qrow * NP + PC_DQ + (g * 4 + head) * 128 + 8 * hi, kp, NP, vp, TCM, kb, ke, B.tabD + (g * 4 + head) * TABD_N + TABD_OFF - (q0 + n) + 8 * hi); }
        astate_finish(st); store_o(st.o, op + 1536 + head * 128);
    }
}
__device__ __forceinline__ void attn_phase(const Args& a, const AttnBufs& B, int layer, int chunk, unsigned* ctr, int lane, LAS float* stash) {
#if NCHUNK == 2
    const int npr = chunk == 0 ? 1 : 0, nsm = chunk == 0 ? 4 : 12, TC = chunk == 0 ? 16384 : 24576;
#else
    const int npr = chunk == 0 ? 1 : 0, nsm = chunk == 0 ? 0 : 4, TC = 8192;
#endif
    const int nP = npr * 1024, nS = nsm * 256, nD = TC / 8, total = 3 * nP + 3 * nS + nD;
    for (;;) {
        unsigned uu = 0; if (lane == 0) uu = atomicAdd(ctr, 1u);
        int u = __builtin_amdgcn_readfirstlane((int)uu);
        if (u >= total) break;
        int mixer, head, row0, S, q0;
        if (u < 3 * nP) { mixer = u / nP; const int r = u % nP; q0 = (r % 256) * 32; head = r / 256; row0 = 0; S = TP; }
        else { u -= 3 * nP;
            if (u < 3 * nS) { mixer = u / nS; const int r = u % nS; q0 = (r % 64) * 32; head = (r / 64) % 4; row0 = npr * TP + (r / 256) * SS; S = SS; }
            else { u -= 3 * nS; mixer = 3; const int qb = u % (TC / 32); head = u / (TC / 32); const int q = qb * 32;
                if (npr && q < TP) { row0 = 0; S = TP; } else { row0 = npr * TP + ((q - npr * TP) / SS) * SS; S = SS; }
                q0 = q - row0; } }
#ifdef ONLY_MIXER
        if (mixer != ONLY_MIXER) continue;
#endif
        attn_unit(a, B, layer, mixer, head, row0, S, q0, lane, stash);
    }
}


constexpr int A2_RSV = 144, A2_BUFSZ = 64 * 400 + 128 * A2_RSV;
static_assert(2 * A2_BUFSZ <= 131072 && 2 * A2_BUFSZ >= 65536, "attention LDS");

template <int NS, int RSK, bool USETAB>
__device__ __forceinline__ void a2_tile(AState& st, LAS unsigned char* bb, int kfo, int vfo, const bf16x8 (&qf)[NS], const float* tpk, float iv) {
#define A2_SB() __builtin_amdgcn_sched_barrier(0x0024)
#define A2_LDK0(s_) (*(const LAS bf16x8*)(bb + kfo + 32 * (s_)))
#define A2_LDK1(s_) (*(const LAS bf16x8*)(bb + kfo + 32 * RSK + 32 * (s_)))
#define A2_LDV0(i_) (*(const LAS bf16x8*)(bb + vfo + (32 * ((i_) & 3)) * A2_RSV + 32 * ((i_) >> 2)))
#define A2_LDV1(i_) (*(const LAS bf16x8*)(bb + vfo + (32 * ((i_) & 3)) * A2_RSV + 64 + 32 * ((i_) >> 2)))
    constexpr int PD = 3;
    f32x4 tb[8];
    if (USETAB) {
#pragma unroll
        for (int s = 0; s < 4; ++s) { tb[2 * s] = *(const f32x4u*)(tpk + 16 * s); tb[2 * s + 1] = *(const f32x4u*)(tpk + 16 * s + 4); } }
    f32x16 ini, sc0, sc1;
#pragma unroll
    for (int r = 0; r < 16; ++r) ini[r] = iv;
    u32x4 pw[4];
    float mx = -3.0e38f, ps = 0.f;
    bf16x8 ka[NS], kb[NS], va[8], vb[8];
#pragma unroll
    for (int s = 0; s < PD; ++s) ka[s] = A2_LDK0(s);
    A2_SB();
#pragma unroll
    for (int s = 0; s < NS; ++s) {
        if (s + PD < NS) ka[s + PD] = A2_LDK0(s + PD); else kb[s + PD - NS] = A2_LDK1(s + PD - NS);
        sc0 = __builtin_amdgcn_mfma_f32_32x32x16_bf16(ka[s], qf[s], s == 0 ? ini : sc0, 0, 0, 0);
        A2_SB(); }
#pragma unroll
    for (int s = 0; s < NS; ++s) {
        if (s + PD < NS) kb[s + PD] = A2_LDK1(s + PD); else va[s + PD - NS] = A2_LDV0(s + PD - NS);
        sc1 = __builtin_amdgcn_mfma_f32_32x32x16_bf16(kb[s], qf[s], s == 0 ? ini : sc1, 0, 0, 0);
        A2_SB();
#pragma unroll
        for (int pp = (8 * s) / NS; pp < (8 * (s + 1)) / NS; ++pp) {
            float x0 = sc0[2 * pp], x1 = sc0[2 * pp + 1];
            if (USETAB) { x0 += tb[(2 * pp) >> 2][(2 * pp) & 3]; x1 += tb[(2 * pp + 1) >> 2][(2 * pp + 1) & 3]; }
            mx = fmaxf(mx, fmaxf(x0, x1));
            const float e0 = __builtin_amdgcn_exp2f(x0), e1 = __builtin_amdgcn_exp2f(x1);
            ps += e0 + e1; pw[pp >> 2][pp & 3] = cvt_pk_bf16(e0, e1); }
        A2_SB();
    }
    {
        const bf16x8 pf0 = __builtin_bit_cast(bf16x8, pw[0]), pf1 = __builtin_bit_cast(bf16x8, pw[1]);
#pragma unroll
        for (int i = 0; i < 8; ++i) { const int h = i >> 2, d = i & 3;
            if (i + PD < 8) va[i + PD] = A2_LDV0(i + PD); else vb[i + PD - 8] = A2_LDV1(i + PD - 8);
            st.o[d] = __builtin_amdgcn_mfma_f32_32x32x16_bf16(va[i], h ? pf1 : pf0, st.o[d], 0, 0, 0);
            A2_SB();
            { const int pp = i; float x0 = sc1[2 * pp], x1 = sc1[2 * pp + 1];
              if (USETAB) { x0 += tb[4 + ((2 * pp) >> 2)][(2 * pp) & 3]; x1 += tb[4 + ((2 * pp + 1) >> 2)][(2 * pp + 1) & 3]; }
              mx = fmaxf(mx, fmaxf(x0, x1));
              const float e0 = __builtin_amdgcn_exp2f(x0), e1 = __builtin_amdgcn_exp2f(x1);
              ps += e0 + e1; pw[2 + (pp >> 2)][pp & 3] = cvt_pk_bf16(e0, e1); }
            A2_SB(); }
    }
    {
        const bf16x8 pf2 = __builtin_bit_cast(bf16x8, pw[2]), pf3 = __builtin_bit_cast(bf16x8, pw[3]);
#pragma unroll
        for (int i = 0; i < 8; ++i) { const int h = i >> 2, d = i & 3;
            if (i + PD < 8) vb[i + PD] = A2_LDV1(i + PD);
            st.o[d] = __builtin_amdgcn_mfma_f32_32x32x16_bf16(vb[i], h ? pf3 : pf2, st.o[d], 0, 0, 0);
            A2_SB(); }
    }
    st.l += ps;
    mx = fmaxf(mx, __shfl_xor(mx, 32));
    if (__any(mx > 8.0f)) {
        const float dm = fmaxf(mx, 0.f); const float alpha = __builtin_amdgcn_exp2f(-dm); st.m += dm; st.l *= alpha;
#pragma unroll
        for (int d = 0; d < 4; ++d)
#pragma unroll
            for (int r = 0; r < 16; ++r) st.o[d][r] *= alpha;
    }
#undef A2_SB
#undef A2_LDK0
#undef A2_LDK1
#undef A2_LDV0
#undef A2_LDV1
}
template <int DKL, int DK, bool TAB, bool FARC = false>
__device__ __forceinline__ void attn2_pass(AState& st, LAS unsigned char* buf, const bf16_t* qp, int koff, const bf16_t* Kg, long ldk, const bf16_t* Vg, long ldv,
                                           int kbeg, int kend, const float* tp, int wlo, int whi, int tid_in, int lane, int qw = 0, float cneg = 0.f, float cpos = 0.f) {
    constexpr int NS = DK / 16, PR = DKL / 8, NKP = DKL / 64, RSK = DKL * 2 + 16, KBYTES = 64 * RSK;
    int tid = tid_in; asm volatile("" : "+v"(tid));
    const int n = lane & 31, hi = lane >> 5, pr = pi32(n);
    bf16x8 qf[NS];
#pragma unroll
    for (int s = 0; s < NS; ++s) qf[s] = *(const bf16x8*)(qp + 16 * s);
    u32x4 kreg[NKP], vreg[2];
    int krow[NKP], kc[NKP];
#pragma unroll
    for (int i = 0; i < NKP; ++i) { const int p = tid + 512 * i; krow[i] = p / PR; kc[i] = p % PR; }
#define A2_GLOAD(k0_) do { _Pragma("unroll") for (int i = 0; i < NKP; ++i) kreg[i] = *(const u32x4*)(Kg + (long)((k0_) + krow[i]) * ldk + 8 * kc[i]); \
        _Pragma("unroll") for (int i = 0; i < 2; ++i) { const int p = tid + 512 * i; vreg[i] = *(const u32x4*)(Vg + (long)(p >> 3) * ldv + (k0_) + 8 * (p & 7)); } } while (0)
#define A2_LSTORE(b_) do { _Pragma("unroll") for (int i = 0; i < NKP; ++i) *(LAS u32x4*)(buf + (b_) * A2_BUFSZ + krow[i] * RSK + kc[i] * 16) = kreg[i]; \
        _Pragma("unroll") for (int i = 0; i < 2; ++i) { const int p = tid + 512 * i; *(LAS u32x4*)(buf + (b_) * A2_BUFSZ + KBYTES + (p >> 3) * A2_RSV + (p & 7) * 16) = vreg[i]; } } while (0)
    A2_GLOAD(kbeg); A2_LSTORE(0); __syncthreads();
    int b = 0;
    const int kfo = pr * RSK + koff + hi * 16, vfo = KBYTES + n * A2_RSV + hi * 16;
    if (st.m < -1.0e38f) {
        f32x16 sc;
#pragma unroll
        for (int r = 0; r < 16; ++r) sc[r] = 0.f;
#pragma unroll
        for (int s = 0; s < NS; ++s) { const bf16x8 kf0 = *(const LAS bf16x8*)(buf + kfo + 32 * s); sc = __builtin_amdgcn_mfma_f32_32x32x16_bf16(kf0, qf[s], sc, 0, 0, 0); }
        float mx = sc[0];
#pragma unroll
        for (int r = 1; r < 16; ++r) mx = fmaxf(mx, sc[r]);
        mx = fmaxf(mx, __shfl_xor(mx, 32));
        st.m = fmaxf(mx, -60.0f);
    }
    for (int k0 = kbeg; k0 < kend; k0 += 64) {
        const bool more = k0 + 64 < kend;
        if (more) A2_GLOAD(k0 + 64);
        LAS unsigned char* bb = buf + b * A2_BUFSZ;
        if (!(k0 + 64 <= wlo || k0 >= whi)) {
            float iv = -st.m; bool usetab = TAB;
            if (FARC) { if (k0 + 63 - qw <= -576) { iv += cneg; usetab = false; } else if (k0 - qw - 31 >= 576) { iv += cpos; usetab = false; } }
            if (TAB && usetab) a2_tile<NS, RSK, true>(st, bb, kfo, vfo, qf, tp + k0, iv);
            else a2_tile<NS, RSK, false>(st, bb, kfo, vfo, qf, tp, iv);
        }
        if (more) A2_LSTORE(b ^ 1);
        __syncthreads();
        b ^= 1;
    }
#undef A2_GLOAD
#undef A2_LSTORE
}

__device__ __forceinline__ void attn2_unit(const Args& a, const AttnBufs& B, int layer, int mixer, int head, int row0, int S, int q0, int tid, int lane, int wave, LAS unsigned char* buf) {
#ifdef ONLY_MIXER2
    mixer = ONLY_MIXER2;
#endif
    if (mixer == 0) {
        int ln_ = lane; asm volatile("" : "+v"(ln_)); const int n = ln_ & 31, hi = ln_ >> 5;
        const int half = wave >> 2, qw = q0 + 32 * (wave & 3); const long qrow = (long)row0 + qw + n;
        const float lam_init = layer == 0 ? 0.2f : 0.35550906759f;
        AState st; astate_init(st);
        attn2_pass<128, 64, true, true>(st, buf, B.PROJ + qrow * NP + PC_AQ + head * 128 + 64 * half + 8 * hi, 128 * half, B.PROJ + (long)row0 * NP + PC_AK + head * 128, NP,
                                  B.VT + (long)(head * 128) * TCM + row0, TCM, 0, S, B.tabA + head * TABA_N + TABA_OFF - (qw + n) + 8 * hi, 0, S, tid, ln_,
                                  qw, B.tabA[head * TABA_N + TABA_OFF - 700], B.tabA[head * TABA_N + TABA_OFF + 700]);
        astate_finish(st);
        LAS float* xb = (LAS float*)buf + (wave & 3) * 4096;
        if (half == 1) {
#pragma unroll
            for (int d = 0; d < 4; ++d)
#pragma unroll
                for (int r = 0; r < 16; ++r) xb[(d * 16 + r) * 64 + ln_] = st.o[d][r]; }
        __syncthreads();
        if (half == 0) {
            const float d1 = wave_sum(a.in[I_ALQ1][layer * 64 + ln_] * a.in[I_ALK1][layer * 64 + ln_]);
            const float d2 = wave_sum(a.in[I_ALQ2][layer * 64 + ln_] * a.in[I_ALK2][layer * 64 + ln_]);
            const float lam = expf(d1) - expf(d2) + lam_init;
            float ss = 0.f;
#pragma unroll
            for (int d = 0; d < 4; ++d)
#pragma unroll
                for (int r = 0; r < 16; ++r) { const float v = st.o[d][r] - lam * xb[(d * 16 + r) * 64 + ln_]; st.o[d][r] = v; ss += v * v; }
            ss += __shfl_xor(ss, 32);
            const float rs = (1.0f - lam_init) / sqrtf(ss * (1.0f / 128.0f) + EPS);
            const float* gn = a.in[I_AON] + layer * 128 + 4 * hi;
#pragma unroll
            for (int d = 0; d < 4; ++d)
#pragma unroll
                for (int g = 0; g < 4; ++g) { const f32x4 gg = *(const f32x4*)(gn + 32 * d + 8 * g);
#pragma unroll
                    for (int e = 0; e < 4; ++e) st.o[d][4 * g + e] *= rs * gg[e]; }
            store_o(st.o, B.BR + qrow * 2048 + 4 * hi + head * 128);
        }
    } else if (mixer == 1) {
        int ln_ = lane; asm volatile("" : "+v"(ln_)); const int n = ln_ & 31, hi = ln_ >> 5;
        const int qw = q0 + 32 * wave; const long qrow = (long)row0 + qw + n;
        AState st; astate_init(st);
        attn2_pass<192, 192, false>(st, buf, B.QB + qrow * 768 + head * 192 + 8 * hi, 0, B.KB + (long)row0 * 768 + head * 192, 768,
                                    B.VTB + (long)(head * 128) * TCM + row0, TCM, 0, S, nullptr, 0, S, tid, ln_);
        astate_finish(st); store_o(st.o, B.BR + qrow * 2048 + 4 * hi + 512 + head * 128);
    } else if (mixer == 2) {
        int ln_ = lane; asm volatile("" : "+v"(ln_)); const int n = ln_ & 31, hi = ln_ >> 5;
        const int qw = q0 + 32 * wave; const long qrow = (long)row0 + qw + n; const int kv = head >> 1;
        AState st; astate_init(st);
        attn2_pass<128, 128, false>(st, buf, B.PROJ + qrow * NP + PC_CQ + head * 128 + 8 * hi, 0, B.PROJ + (long)row0 * NP + PC_CK + kv * 128, NP,
                                    B.VT + (long)(512 + kv * 128) * TCM + row0, TCM, 0, S, nullptr, 0, S, tid, ln_);
        astate_finish(st); store_o(st.o, B.BR + qrow * 2048 + 4 * hi + 1024 + head * 128);
    } else {
        int ln_ = lane; asm volatile("" : "+v"(ln_)); const int n = ln_ & 31, hi = ln_ >> 5;
        const int qw = q0 + 32 * wave; const long qrow = (long)row0 + qw + n;
        AState st; astate_init(st);
#pragma unroll 1
        for (int g = 0; g < 3; ++g) { const int W = g == 0 ? 64 : (g == 1 ? 256 : 1024);
            const int kb = q0 - W > 0 ? q0 - W : 0, ke = q0 + 256 + W < S ? q0 + 256 + W : S;
            attn2_pass<128, 128, true>(st, buf, B.PROJ + qrow * NP + PC_DQ + (g * 4 + head) * 128 + 8 * hi, 0, B.PROJ + (long)row0 * NP + PC_DK + head * 128, NP,
                                       B.VT + (long)(768 + head * 128) * TCM + row0, TCM, kb, ke, B.tabD + (g * 4 + head) * TABD_N + TABD_OFF - (qw + n) + 8 * hi, qw - W, qw + 32 + W, tid, ln_); }
        astate_finish(st); store_o(st.o, B.BR + qrow * 2048 + 4 * hi + 1536 + head * 128);
    }
}
__device__ __forceinline__ void attn2_phase(const Args& a, const AttnBufs& B, int layer, int chunk, unsigned* ctr, int tid, int lane, int wave, LAS unsigned char* lds) {
#if NCHUNK == 2
    const int npr = chunk == 0 ? 1 : 0, nsm = chunk == 0 ? 4 : 12, TC = chunk == 0 ? 16384 : 24576;
#else
    const int npr = chunk == 0 ? 1 : 0, nsm = chunk == 0 ? 0 : 4, TC = 8192;
#endif
    const int c0 = npr * 128, c1 = npr * 128, c2 = npr * 256, c3 = TC / 64, c4 = nsm * 32, c5 = nsm * 32, c6 = nsm * 64;
    const int total = c0 + c1 + c2 + c3 + c4 + c5 + c6;
    volatile LAS int* uw = (volatile LAS int*)(lds + 131072);
    for (;;) {
        __syncthreads();
        if (tid == 0) *uw = (int)atomicAdd(ctr, 1u);
        __syncthreads();
        int u = __builtin_amdgcn_readfirstlane(*uw);
        if (u >= total) break;
        int mixer, head, row0, S, q0;
        if (u < c0 + c1 + c2) { row0 = 0; S = TP;
            if (u < c0) { mixer = 1; q0 = (u % 32) * 256; head = u / 32; }
            else if (u < c0 + c1) { u -= c0; mixer = 2; q0 = (u % 32) * 256; head = u / 32; }
            else { u -= c0 + c1; mixer = 0; q0 = (u % 64) * 128; head = u / 64; }
        } else { u -= c0 + c1 + c2;
            if (u < c3) { mixer = 3; const int nb = TC / 256; const int q = (u % nb) * 256; head = u / nb;
                if (npr && q < TP) { row0 = 0; S = TP; } else { row0 = npr * TP + ((q - npr * TP) / SS) * SS; S = SS; }
                q0 = q - row0; }
            else { u -= c3; S = SS;
                if (u < c4) { mixer = 1; q0 = (u % 8) * 256; head = (u / 8) % 4; row0 = npr * TP + (u / 32) * SS; }
                else if (u < c4 + c5) { u -= c4; mixer = 2; q0 = (u % 8) * 256; head = (u / 8) % 4; row0 = npr * TP + (u / 32) * SS; }
                else { u -= c4 + c5; mixer = 0; q0 = (u % 16) * 128; head = (u / 16) % 4; row0 = npr * TP + (u / 64) * SS; } } }
        attn2_unit(a, B, layer, mixer, head, row0, S, q0, tid, lane, wave, lds);
    }
}


#define XB_TMO      128
#define XB_XCNT(j)  (256  + 64 * (j))
#define XB_XSUB(j)  (1280 + 64 * (j))
#define XB_XGEN(j)  (2304 + 64 * (j))
#define XB_TOP      3328
#define XB_TOPGEN   3392
#define XCD_BAR_WORDS 3456
#define XB_SPIN_CAP (1u << 22)
__device__ __forceinline__ unsigned xb_ld(unsigned* p)              { return __hip_atomic_load(p, __ATOMIC_RELAXED, __HIP_MEMORY_SCOPE_AGENT); }
__device__ __forceinline__ unsigned xb_add(unsigned* p, unsigned v) { return __hip_atomic_fetch_add(p, v, __ATOMIC_RELAXED, __HIP_MEMORY_SCOPE_AGENT); }
__device__ __forceinline__ unsigned xb_xcc_id() { return (unsigned)__builtin_amdgcn_s_getreg((3 << 11) | 20) & 0xFu; }
#define XB_SPIN(cond, bar) do { unsigned _sp = 0; while (cond) { __builtin_amdgcn_s_sleep(1); \
    if ((++_sp & 255u) == 0u) { if (xb_ld(&(bar)[XB_TMO])) break; if (_sp > XB_SPIN_CAP) { atomicAdd(&(bar)[XB_TMO], 1u); break; } } } } while (0)
struct XcdBarrier { unsigned* bar; unsigned x; volatile LAS unsigned* st; };
__device__ __forceinline__ XcdBarrier xcd_barrier_post(unsigned* bar, volatile LAS unsigned* st) {
    XcdBarrier b; b.bar = bar; b.x = xb_xcc_id(); b.st = st;
    if (threadIdx.x == 0) st[2] = xb_add(&bar[XB_XCNT(b.x)], 1u);
    return b;
}
__device__ __forceinline__ void xcd_barrier_complete(unsigned* bar, unsigned x, unsigned& nloc, unsigned& nx) {
    const unsigned G = gridDim.x * gridDim.y * gridDim.z;
    unsigned sum, cnt, mine, sp = 0u;
    for (;;) {
        sum = 0u; cnt = 0u; mine = 0u;
#pragma unroll
        for (unsigned j = 0; j < 16; ++j) { const unsigned c = xb_ld(&bar[XB_XCNT(j)]); sum += c; cnt += (c > 0u) ? 1u : 0u; mine = (j == x) ? c : mine; }
        if (sum == G) break;
        __builtin_amdgcn_s_sleep(1);
        if ((++sp & 255u) == 0u) { if (xb_ld(&bar[XB_TMO])) break; if (sp > XB_SPIN_CAP) { atomicAdd(&bar[XB_TMO], 1u); break; } }
    }
    nloc = mine > 0u ? mine : 1u; nx = cnt > 0u ? cnt : 1u;
}
__device__ __forceinline__ void xcd_barrier(const XcdBarrier& b, bool local = false) {
    asm volatile("s_waitcnt vmcnt(0)" ::: "memory");
    __syncthreads();
    if (threadIdx.x == 0) {
        unsigned* bar = b.bar;
        __builtin_amdgcn_s_waitcnt(0);
        unsigned nloc = b.st[0], nx = b.st[1];
        if (nloc == 0u) { xcd_barrier_complete(bar, b.x, nloc, nx); b.st[0] = nloc; b.st[1] = nx; }
        const unsigned old = xb_add(&bar[XB_XSUB(b.x)], 1u);
        const unsigned gen = old / nloc;
        if (old + 1u == (gen + 1u) * nloc) {
            if (!local) {
            __builtin_amdgcn_fence(__ATOMIC_RELEASE, "agent");
            asm volatile("s_waitcnt vmcnt(0)" ::: "memory");
            const unsigned og = xb_add(&bar[XB_TOP], 1u);
            const unsigned tg = og / nx;
            if (og + 1u == (tg + 1u) * nx) xb_add(&bar[XB_TOPGEN], 1u);
            else XB_SPIN(xb_ld(&bar[XB_TOPGEN]) == tg, bar);
            }
            __builtin_amdgcn_fence(__ATOMIC_ACQUIRE, "agent");
            xb_add(&bar[XB_XGEN(b.x)], 1u);
            asm volatile("s_waitcnt vmcnt(0)" ::: "memory");
        } else {
            XB_SPIN(xb_ld(&bar[XB_XGEN(b.x)]) == gen, bar);
            __builtin_amdgcn_fence(__ATOMIC_ACQUIRE, "agent");
            asm volatile("s_waitcnt vmcnt(0)" ::: "memory");
        }
    }
    __syncthreads();
}

__global__ void __launch_bounds__(512, 2) mega(Args a) {
    extern __shared__ __attribute__((aligned(16))) unsigned char lds_raw[];
    LAS unsigned char* lds = (LAS unsigned char*)lds_raw;
    const int G = gridDim.x, bx = blockIdx.x;
    unsigned char* ws = a.ws;
    unsigned* ctl = (unsigned*)(ws + WS_CTL);
    float* tabA = (float*)(ws + WS_TABA); float* tabD = (float*)(ws + WS_TABD);
    unsigned char* W = ws + WS_W;
    bf16_t* H = (bf16_t*)(ws + WS_H);
    bf16_t* PROJ = (bf16_t*)(ws + WS_R1 + R1_PROJ); bf16_t* VT = (bf16_t*)(ws + WS_R1 + R1_VT); bf16_t* QB = (bf16_t*)(ws + WS_R1 + R1_QB);
    bf16_t* KB = (bf16_t*)(ws + WS_R1 + R1_KB); bf16_t* VTB = (bf16_t*)(ws + WS_R1 + R1_VTB);
    bf16_t* Y = (bf16_t*)(ws + WS_R1); bf16_t* FFH = (bf16_t*)(ws + WS_R1);
    bf16_t* BR = (bf16_t*)(ws + WS_R2); float* PART = (float*)(ws + WS_R2); bf16_t* U = (bf16_t*)(ws + WS_R2);
    bf16_t* MERGED = (bf16_t*)(ws + WS_R2); bf16_t* P16 = (bf16_t*)(ws + WS_R2 + 100 * MiB); bf16_t* XB = (bf16_t*)(ws + WS_XB);
    float* ssA = (float*)(ws + WS_SSP); float* ssB = ssA + (size_t)TCM * 32;
    cg::grid_group grid = cg::this_grid();
    volatile LAS unsigned* bst = (volatile LAS unsigned*)(lds + 131072 + 64);
    if (threadIdx.x < 6) bst[threadIdx.x] = threadIdx.x == 3 ? (unsigned)bx : 0u;
    __syncthreads();
    XcdBarrier xbar = xcd_barrier_post(ctl + 1024, bst);

    for (int pid = a.ph_lo; pid < a.ph_hi; ++pid) {
        int tid = threadIdx.x; asm volatile("" : "+v"(tid));
        const int lane = tid & 63, wave = __builtin_amdgcn_readfirstlane(tid >> 6);
        const int gw = bx * 8 + wave, ngw = G * 8;
        const int layer = pid / (1 + 12 * NCHUNK), q = pid % (1 + 12 * NCHUNK);
        bool locseam = false;
        if (q == 0) {
            if (layer == 0) build_tables(a.in[I_RELB], tabA, tabD, bx * 512 + tid, G * 512);
#ifndef NO_CONV
            convert_weights(a, layer, W, (LAS float*)(lds + wave * 16384), gw, ngw, lane);
#endif
        } else {
            const int chunk = (q - 1) / 12, kidx = (q - 1) % 12; const int k = kidx < 9 ? kidx + 1 : (kidx == 9 ? 11 : (kidx == 10 ? 12 : 15));
#if NCHUNK == 2
            const int m0 = chunk == 0 ? 0 : 16384, TC = chunk == 0 ? 16384 : 24576, nMt = TC / 256;
            const bool locr = bst[4] != 0u;
            const int rbeg = locr ? (int)xbar.x * (TC / 8) + (int)bst[2] * 8 + wave : gw, rend = locr ? ((int)xbar.x + 1) * (TC / 8) : TC, rstep = locr ? G : ngw;
#else
            const int m0 = chunk * 8192, TC = 8192, nMt = TC / 256;
#endif
#ifdef NO_ROWS
            if (0) {
#else
            if (k == 1) {
#endif
                const float* g = a.in[I_NMIX] + layer * DM;
                locseam = true;
                for (int r = rbeg; r < rend; r += rstep) { const int m = m0 + r;
                    if (layer == 0) norm_row(xrow_ptr(a.in[I_XP], a.in[I_XS], m), g, H + (size_t)r * DM, lane, XB + (size_t)m * DM);
                    else norm_row_bf(XB + (size_t)m * DM, g, H + (size_t)r * DM, lane);
                    const float* pr = m < TP ? a.in[I_PP] + ((size_t)layer * TP + m) * 256 : a.in[I_PS] + ((size_t)layer * 32768 + (m - TP)) * 256;
                    const f32x4 v = *(const f32x4*)(pr + 4 * lane); u32x2 w; w.x = cvt_pk_bf16(v[0], v[1]); w.y = cvt_pk_bf16(v[2], v[3]); *(u32x2*)(P16 + (size_t)r * 256 + 4 * lane) = w;
                }
#ifdef NO_ROWS
            } else if (0) {
#else
            } else if (k == 3 || k == 5) {
#endif
                locseam = (k == 3);
                for (int r = rbeg; r < rend; r += rstep) { const int m = m0 + r; const int tseq = m < TP ? m : (m - TP) % SS;
                    if (k == 3) post1_row(a, layer, PROJ + (size_t)r * NP, tseq, lane);
                    else post2_row(a, layer, QB + (size_t)r * 768, KB + (size_t)r * 768, PROJ + (size_t)r * NP, tseq, lane); }
            } else if (k == 6) {
                AttnBufs B{PROJ, VT, QB, KB, VTB, BR, tabA, tabD};
#ifndef NO_ATTN
                #if ATTN_V2
                attn2_phase(a, B, layer, chunk, ctl + 64 * (layer * NCHUNK + chunk), tid, lane, wave, lds);
#else
                attn_phase(a, B, layer, chunk, ctl + 64 * (layer * NCHUNK + chunk), lane, (LAS float*)(lds + wave * 16384));
#endif
#endif
            } else {
                const int njobs = (k == 2 || k == 11) ? 2 : (k == 4 ? 3 : 1);
                locseam = (k != 15);
                int coff = 0;
                for (int j = 0; j < njobs; ++j) {
                    pg8::Gemm g; pg8::Epi E; int nM = nMt, nN = 8, rep = 1, adiv = 1 << 30; long astep = 0;
                    E.kind = pg8::EK_BF16; E.O = nullptr; E.ldc = 0; E.Y = nullptr; E.xin = nullptr; E.xob = nullptr; E.xof = nullptr; E.ssq = nullptr; E.rsq = nullptr;
                    bf16_t* XBc = XB + (size_t)m0 * DM;
                    g.A = H; g.Bt = (const bf16_t*)(W + WO_IN); g.lda = 2048; g.ldb = 2048; g.K = 2048;
                    if (k == 2 && j == 0) { nN = NP / 256; E.O = PROJ; E.ldc = NP; }
                    else if (k == 2) { g.A = (const bf16_t*)(W + WO_INV); g.Bt = H; nM = NVT / 256; nN = nMt; E.O = VT; E.ldc = TCM; }
                    else if (k == 4 && j == 0) { g.A = PROJ + PC_BCQ; g.lda = NP; g.Bt = (const bf16_t*)(W + WO_UQ); g.ldb = 512; g.K = 512; nN = 3; E.O = QB; E.ldc = 768; }
                    else if (k == 4 && j == 1) { g.A = PROJ + PC_BCKV; g.lda = NP; g.Bt = (const bf16_t*)(W + WO_UKN); g.ldb = 512; g.K = 512; nN = 2; E.kind = pg8::EK_SPLIT192; E.O = KB; E.ldc = 768; }
                    else if (k == 4) { g.A = (const bf16_t*)(W + WO_UKV); g.lda = 512; g.Bt = PROJ + PC_BCKV; g.ldb = NP; g.K = 512; nM = 2; nN = nMt; E.O = VTB; E.ldc = TCM; }
                    else if (k == 7) { g.A = BR; g.Bt = (const bf16_t*)(W + WO_B); g.ldb = 512; g.K = 512; nN = 32; adiv = 8; astep = 1024; E.O = Y; E.ldc = 8192; }
                    else if (k == 8) { g.Bt = (const bf16_t*)(W + WO_G); nN = 32; E.kind = pg8::EK_GATE; E.O = MERGED; E.Y = Y; }
                    else if (k == 9) { g.A = MERGED; g.Bt = (const bf16_t*)(W + WO_O); E.kind = pg8::EK_RES; E.xin = XBc; E.xob = XBc; E.ssq = ssA; }
                    else if (k == 11 && j == 0) { g.A = XBc; g.Bt = (const bf16_t*)(W + WO_1); nN = 32; E.kind = pg8::EK_RELU2; E.O = FFH; E.ldc = 8192; E.rsq = ssA; }
                    else if (k == 11) { g.A = P16; g.lda = 256; g.Bt = (const bf16_t*)(W + WO_PP); g.ldb = 256; g.K = 256; E.O = U; E.ldc = 2048; }
                    else if (k == 12) { g.A = FFH; g.lda = 8192; g.Bt = (const bf16_t*)(W + WO_2); g.ldb = 8192; g.K = 8192; E.kind = pg8::EK_RES; E.xin = XBc; E.xob = H; E.ssq = ssB; }
                    else { g.Bt = (const bf16_t*)(W + WO_PG); E.kind = pg8::EK_PLE; E.Y = U; E.xin = H; E.rsq = ssB; if (layer == 1) E.xof = a.out + (size_t)m0 * DM; else E.xob = XBc; }
                    const int vbx = __builtin_amdgcn_readfirstlane((int)bst[3]);
                    const bool swj = (k == 2 && j == 1) || (k == 4 && j == 2);
                    pg8::Order S; if (swj) S.init(nN, nM, G, (vbx + G - coff) % G, rep, adiv, astep, 1); else S.init(nM, nN, G, (vbx + G - coff) % G, rep, adiv, astep, 0);
#ifndef NO_GEMM
                    pg8::gemm_phase<true>(lds, g, S, E, tid);
#endif
                    coff = (coff + (nM * nN) % G) % G;
                }
            }
        }
        if (pid + 1 < a.ph_hi) {
            if (pid == a.ph_lo) {
                grid.sync();
                if (threadIdx.x == 0) { bool ok = (G % 8 == 0);
                    for (unsigned j = 0; j < 16; ++j) { const unsigned cnt = xb_ld(&xbar.bar[XB_XCNT(j)]); if (cnt != (j < 8 ? (unsigned)G / 8u : 0u)) ok = false; }
                    bst[3] = ok ? (bst[2] * 8u + xbar.x) : (unsigned)bx; bst[4] = ok ? 1u : 0u; }
                __syncthreads();
            } else {
                xcd_barrier(xbar, locseam && bst[4] != 0u); } }
    }
}

extern "C" void kernel_launch(void* const* d_in, const int* in_sizes, int n_in, void* d_out, int out_size, void* d_ws, size_t ws_size, hipStream_t stream) {
    static int grid = 0;
    if (grid == 0) {
        if (n_in != 33 || out_size != TALL * DM || ws_size < WS_END) { fprintf(stderr, "kernel_launch: unexpected shapes (n_in %d out %d ws %zu need %zu)\n", n_in, out_size, ws_size, (size_t)WS_END); grid = -1; return; }
        int dev = 0, cus = 0, per_cu = 0;
        hipGetDevice(&dev); hipDeviceGetAttribute(&cus, hipDeviceAttributeMultiprocessorCount, dev);
        if (hipFuncSetAttribute((const void*)mega, hipFuncAttributeMaxDynamicSharedMemorySize, LDS_BYTES) != hipSuccess) { fprintf(stderr, "kernel_launch: hipFuncSetAttribute failed\n"); grid = -1; return; }
        if (hipOccupancyMaxActiveBlocksPerMultiprocessor(&per_cu, (const void*)mega, 512, LDS_BYTES) != hipSuccess || per_cu < 1) per_cu = 1;
        (void)hipGetLastError();
        grid = cus * per_cu;
        if (grid <= 0) grid = 256;
    }
    if (grid < 0) return;
    hipMemsetAsync((char*)d_ws + WS_CTL, 0, 32768, stream);
    Args a{};
    for (int i = 0; i < 33; ++i) a.in[i] = (const float*)d_in[i];
    a.out = (float*)d_out; a.ws = (unsigned char*)d_ws;
    constexpr int NPH = 2 * (1 + 12 * NCHUNK);
#if COOP
    a.ph_lo = 0; a.ph_hi = NPH;
    void* args[] = {&a};
    hipError_t e = hipLaunchCooperativeKernel((const void*)mega, dim3(grid), dim3(512), args, LDS_BYTES, stream);
    if (e != hipSuccess) fprintf(stderr, "cooperative launch failed: %s (grid %d)\n", hipGetErrorString(e), grid);
#else
    for (int p = 0; p < NPH; ++p) { a.ph_lo = p; a.ph_hi = p + 1; hipLaunchKernelGGL(mega, dim3(grid), dim3(512), LDS_BYTES, stream, a); }
#endif
}
```
